# Optimizing an MI355X kernel written in HIP

```python
import jax
import jax.numpy as jnp
from jax import lax
import numpy as np

D_MODEL = 1024
BATCH = 8
SEQ = 2048
DEPTH = 1
DEC_BATCH = 128
DEC_SEQ = 8
PAST_LEN = 16384
PAGE_SIZE = 128

N_MEM = 256
CONV_WIDTH = 3
D_CONV = D_MODEL
RWKV_HEAD = 64
RWKV_HEADS = D_MODEL // RWKV_HEAD
D_RWKV = RWKV_HEADS * RWKV_HEAD
DECAY_LORA = 64
ICL_LORA = 64
MEM_HEADS = 4
MEM_HEAD_DIM = D_MODEL // MEM_HEADS
D_MEM = MEM_HEADS * MEM_HEAD_DIM
N_BRANCH = 3
D_SHIFT = 3 * D_RWKV + DECAY_LORA + ICL_LORA
D_IN = 4 * D_CONV + D_SHIFT + D_RWKV + 2 * D_MEM + N_BRANCH * D_MODEL
NORM_EPS = 1e-6
GN_EPS = RWKV_HEAD * 1e-5

kernel_name = 'hybrid_shortconv_rwkv7_memxattn_step'


def _in_split_points():
    sizes = [D_CONV, D_CONV, D_CONV, D_CONV,
             D_SHIFT, D_RWKV,
             D_MEM, D_MEM,
             D_MODEL, D_MODEL, D_MODEL]
    pts = []
    acc = 0
    for s in sizes[:-1]:
        acc += s
        pts.append(acc)
    return pts


def _rmsnorm(x, g):
    xf = x.astype(jnp.float32)
    y = xf * lax.rsqrt(jnp.mean(xf * xf, axis=-1, keepdims=True) + NORM_EPS)
    return (y * g.astype(jnp.float32)).astype(x.dtype)


def _short_conv(u, conv_w, conv_b, conv_state):
    t = u.shape[1]
    ext = jnp.concatenate([conv_state.astype(u.dtype), u], axis=1)
    y = conv_b
    for j in range(CONV_WIDTH):
        y = y + ext[:, j:j + t] * conv_w[j]
    return y, ext[:, t:]


def _wkv_step(S, inp):
    r, w, k, v, kk, a = inp
    sa = jnp.einsum('bhvk,bhk->bhv', S, kk)
    S = (S * w[:, :, None, :] - sa[..., None] * (kk * a)[:, :, None, :]
         + v[..., None] * k[:, :, None, :])
    o = jnp.einsum('bhvk,bhk->bhv', S, r)
    return S, o


def _rwkv7(p, prev_row, wkv_state, mu, w0, w_up, a0, a_up, k_k, k_a, r_k, ln_g, ln_b):
    b, t, _ = p.shape
    pf = p.astype(jnp.float32)
    prev = jnp.concatenate([prev_row[:, None].astype(jnp.float32), pf[:, :-1]], axis=1)
    ps = pf + mu.astype(jnp.float32) * (prev - pf)
    r, k, v, wd, ad = jnp.split(ps, [D_RWKV, 2 * D_RWKV, 3 * D_RWKV, 3 * D_RWKV + DECAY_LORA], axis=-1)
    w_log = -jax.nn.softplus(-(w0 + jnp.tanh(wd) @ w_up)) - 0.5
    decay = jnp.exp(-jnp.exp(w_log))
    a = jax.nn.sigmoid(a0 + ad @ a_up)
    heads = lambda z: z.reshape(b, t, RWKV_HEADS, RWKV_HEAD)
    r, k, v, decay, a = heads(r), heads(k), heads(v), heads(decay), heads(a)
    kk = k * k_k.reshape(RWKV_HEADS, RWKV_HEAD)
    kk = kk * lax.rsqrt(jnp.sum(kk * kk, axis=-1, keepdims=True) + 1e-12)
    k = k * (1.0 + (a - 1.0) * k_a.reshape(RWKV_HEADS, RWKV_HEAD))
    seq = tuple(jnp.moveaxis(z, 1, 0) for z in (r, decay, k, v, kk, a))
    s_final, o = lax.scan(_wkv_step, wkv_state.astype(jnp.float32), seq)
    o = jnp.moveaxis(o, 0, 1)
    mean = jnp.mean(o, axis=-1, keepdims=True)
    var = jnp.mean(jnp.square(o - mean), axis=-1, keepdims=True)
    o = ((o - mean) * lax.rsqrt(var + GN_EPS) * ln_g.reshape(RWKV_HEADS, RWKV_HEAD)
         + ln_b.reshape(RWKV_HEADS, RWKV_HEAD))
    o = o + jnp.sum(r * k * r_k, axis=-1, keepdims=True) * v
    return o.reshape(b, t, D_RWKV), p[:, -1], s_final


def _mem_kv(mem, norm_g, w_kv):
    b, m, _ = mem.shape
    kv = _rmsnorm(mem, norm_g) @ w_kv
    mk, mv = jnp.split(kv, 2, axis=-1)
    return (mk.reshape(b, m, MEM_HEADS, MEM_HEAD_DIM), mv.reshape(b, m, MEM_HEADS, MEM_HEAD_DIM))


def _mem_attention(q, mem_k, mem_v):
    b, t, _ = q.shape
    qh = q.reshape(b, t, MEM_HEADS, MEM_HEAD_DIM).astype(jnp.float32)
    s = jnp.einsum('bthd,bmhd->bhtm', qh, mem_k.astype(jnp.float32)) * (MEM_HEAD_DIM ** -0.5)
    pr = jax.nn.softmax(s, axis=-1)
    o = jnp.einsum('bhtm,bmhd->bthd', pr, mem_v.astype(jnp.float32))
    return o.reshape(b, t, D_MEM)


def _layer(x, conv_state, shift_state, wkv_state, mem_k, mem_v,
           norm_g, w_in, conv_w, conv_b, mu, w0, w_up, a0, a_up, k_k, k_a, r_k,
           ln_g, ln_b, w_branch, w_out):
    xn = _rmsnorm(x, norm_g)
    proj = xn @ w_in
    (h, b_gate, c_gate, g_conv, p_shift, g_rwkv, q_mem, g_mem,
     m_conv, m_rwkv, m_mem) = jnp.split(proj, _in_split_points(), axis=-1)
    y_conv, conv_new = _short_conv(c_gate * h, conv_w, conv_b, conv_state)
    y_conv = b_gate * y_conv * jax.nn.silu(g_conv)
    y_rwkv, shift_new, wkv_new = _rwkv7(p_shift, shift_state, wkv_state, mu, w0, w_up, a0, a_up,
                                        k_k, k_a, r_k, ln_g, ln_b)
    y_rwkv = y_rwkv.astype(x.dtype) * jax.nn.silu(g_rwkv)
    y_mem = _mem_attention(q_mem, mem_k, mem_v).astype(x.dtype) * jax.nn.silu(g_mem)
    merged = (jax.nn.sigmoid(m_conv) * (y_conv @ w_branch[0])
              + jax.nn.sigmoid(m_rwkv) * (y_rwkv @ w_branch[1])
              + jax.nn.sigmoid(m_mem) * (y_mem @ w_branch[2]))
    return x + merged @ w_out, conv_new, shift_new, wkv_new


def setup_inputs(seed: int = 0) -> dict:
    key = jax.random.key(seed)
    ks = jax.random.split(key, 32)
    nrm = lambda k, shape, s: jax.random.normal(k, shape, jnp.float32) * s
    H, N = RWKV_HEADS, RWKV_HEAD
    return {
        'x_prompt': nrm(ks[0], (BATCH, SEQ, D_MODEL), 1.0),
        'x_sample': nrm(ks[1], (DEC_BATCH, DEC_SEQ, D_MODEL), 1.0),
        'mem_prompt': nrm(ks[2], (BATCH, N_MEM, D_MODEL), 1.0),
        'cache_mem_k': nrm(ks[3], (DEPTH, DEC_BATCH, N_MEM, MEM_HEADS, MEM_HEAD_DIM), 1.0),
        'cache_mem_v': nrm(ks[4], (DEPTH, DEC_BATCH, N_MEM, MEM_HEADS, MEM_HEAD_DIM), 1.0),
        'state_conv': nrm(ks[5], (DEPTH, DEC_BATCH, CONV_WIDTH - 1, D_CONV), 1.0),
        'state_shift': nrm(ks[6], (DEPTH, DEC_BATCH, D_SHIFT), 1.0),
        'state_wkv': nrm(ks[7], (DEPTH, DEC_BATCH, H, N, N), 0.3),
        'norm_in': 1.0 + nrm(ks[8], (DEPTH, D_MODEL), 0.02),
        'w_in': nrm(ks[9], (DEPTH, D_MODEL, D_IN), D_MODEL ** -0.5),
        'conv_w': nrm(ks[10], (DEPTH, CONV_WIDTH, D_CONV), CONV_WIDTH ** -0.5),
        'conv_b': nrm(ks[11], (DEPTH, D_CONV), 0.02),
        'shift_mu': jax.random.uniform(ks[12], (DEPTH, D_SHIFT), jnp.float32),
        'decay_w0': jax.random.uniform(ks[13], (DEPTH, D_RWKV), jnp.float32, -4.0, 1.0),
        'decay_up': nrm(ks[14], (DEPTH, DECAY_LORA, D_RWKV), 0.1),
        'icl_a0': nrm(ks[15], (DEPTH, D_RWKV), 0.1),
        'icl_up': nrm(ks[16], (DEPTH, ICL_LORA, D_RWKV), 0.5 * ICL_LORA ** -0.5),
        'k_k': 0.85 + nrm(ks[17], (DEPTH, D_RWKV), 0.05),
        'k_a': 1.0 + nrm(ks[18], (DEPTH, D_RWKV), 0.05),
        'r_k': nrm(ks[19], (DEPTH, H, N), 0.1),
        'ln_x_g': 1.0 + nrm(ks[20], (DEPTH, D_RWKV), 0.02),
        'ln_x_b': nrm(ks[21], (DEPTH, D_RWKV), 0.02),
        'norm_mem': 1.0 + nrm(ks[22], (DEPTH, D_MODEL), 0.02),
        'w_mem_kv': nrm(ks[23], (DEPTH, D_MODEL, 2 * D_MEM), D_MODEL ** -0.5),
        'w_branch': nrm(ks[24], (DEPTH, N_BRANCH, D_CONV, D_MODEL), D_CONV ** -0.5),
        'w_out': nrm(ks[25], (DEPTH, D_MODEL, D_MODEL), D_MODEL ** -0.5),
        'norm_final': 1.0 + nrm(ks[26], (D_MODEL,), 0.02),
    }


def reference(x_prompt, x_sample, mem_prompt, cache_mem_k, cache_mem_v, state_conv, state_shift,
              state_wkv, norm_in, w_in, conv_w, conv_b, shift_mu, decay_w0, decay_up, icl_a0,
              icl_up, k_k, k_a, r_k, ln_x_g, ln_x_b, norm_mem, w_mem_kv, w_branch, w_out,
              norm_final):
    bp = x_prompt.shape[0]
    hp, hs = x_prompt, x_sample
    mk_p, mv_p, conv_p, shift_p, wkv_p = [], [], [], [], []
    conv_s, shift_s, wkv_s = [], [], []
    for l in range(DEPTH):
        lw = (norm_in[l], w_in[l], conv_w[l], conv_b[l], shift_mu[l], decay_w0[l], decay_up[l],
              icl_a0[l], icl_up[l], k_k[l], k_a[l], r_k[l], ln_x_g[l], ln_x_b[l],
              w_branch[l], w_out[l])
        mk, mv = _mem_kv(mem_prompt, norm_mem[l], w_mem_kv[l])
        zc = jnp.zeros((bp, CONV_WIDTH - 1, D_CONV), x_prompt.dtype)
        zs = jnp.zeros((bp, D_SHIFT), x_prompt.dtype)
        zw = jnp.zeros((bp, RWKV_HEADS, RWKV_HEAD, RWKV_HEAD), jnp.float32)
        hp, cp, sp, wp = _layer(hp, zc, zs, zw, mk, mv, *lw)
        hs, cs, ss, ws = _layer(hs, state_conv[l], state_shift[l], state_wkv[l],
                                cache_mem_k[l], cache_mem_v[l], *lw)
        mk_p.append(mk); mv_p.append(mv)
        conv_p.append(cp); shift_p.append(sp); wkv_p.append(wp)
        conv_s.append(cs); shift_s.append(ss); wkv_s.append(ws)
    y_prompt = _rmsnorm(hp, norm_final)
    y_sample = _rmsnorm(hs, norm_final)
    return (y_prompt, y_sample, jnp.stack(mk_p), jnp.stack(mv_p), jnp.stack(conv_p),
            jnp.stack(shift_p), jnp.stack(wkv_p), jnp.stack(conv_s), jnp.stack(shift_s),
            jnp.stack(wkv_s))
```

```cpp
#include <hip/hip_runtime.h>
#include <hip/hip_cooperative_groups.h>
#include <cstdio>
namespace cg = cooperative_groups;

#define LAS __attribute__((address_space(3)))
typedef unsigned short bf16_t;
typedef short bf16x8 __attribute__((ext_vector_type(8)));
typedef float f32x4 __attribute__((ext_vector_type(4)));
typedef float f32x2 __attribute__((ext_vector_type(2)));
typedef unsigned u32x4 __attribute__((ext_vector_type(4)));
typedef unsigned u32x2 __attribute__((ext_vector_type(2)));

constexpr int DM = 1024, TP = 2048, BP = 8, MP = BP * TP, BS = 128, TS = 8, MS = BS * TS, MALL = MP + MS;
constexpr int NMEM = 256, DIN = 13440, DSHIFT = 3200;
constexpr int NPAD = 13568;
constexpr int ACT_LD = 9472;
constexpr int C_PR = 0, C_PK = 1024, C_PV = 2048, C_WD = 3072, C_AD = 3136, C_SGR = 3328, C_QM = 4352, C_SGM = 5376, C_GATE = 6400;
constexpr size_t OUT_Y = 0, OUT_MK = 17825792, OUT_MV = 19922944, OUT_CONV_P = 22020096, OUT_SHIFT_P = 22036480, OUT_WKV_P = 22062080,
                 OUT_CONV_S = 22586368, OUT_SHIFT_S = 22848512, OUT_WKV_S = 23258112;
constexpr size_t al256(size_t x) { return (x + 255) & ~(size_t)255; }
constexpr size_t WS_AALL = 0;
constexpr size_t WS_BALL = al256(WS_AALL + (size_t)19456 * 1024 * 2);
constexpr size_t WS_YMEM = WS_AALL;
constexpr size_t WS_YCONV = WS_AALL + (size_t)MALL * 1024 * 2;
constexpr size_t WS_WB = al256(WS_BALL + (size_t)15616 * 1024 * 2);
constexpr size_t WS_WO = al256(WS_WB + (size_t)3072 * 1024 * 2);
constexpr size_t WS_U = al256(WS_WO + (size_t)1024 * 1024 * 2);
constexpr size_t WS_MERGED = WS_U;
constexpr size_t WS_BG = al256(WS_U + (size_t)MALL * 1024 * 2);
constexpr size_t WS_ACT = al256(WS_BG + (size_t)MALL * 1024 * 2);
constexpr size_t WS_KBF = al256(WS_ACT + (size_t)MALL * ACT_LD * 2);
constexpr size_t WS_VT = al256(WS_KBF + (size_t)2048 * 1024 * 2);
constexpr size_t WS_YRWKV = al256(WS_VT + (size_t)2048 * 1024 * 2);
constexpr size_t WS_C3 = al256(WS_YRWKV + (size_t)MALL * 1024 * 2);
constexpr size_t WS_SUMSQ = al256(WS_C3 + (size_t)MALL * 16 * 4);
constexpr size_t WS_END = al256(WS_SUMSQ + (size_t)MALL * 16 * 4);
static_assert(WS_YCONV + (size_t)MALL * 1024 * 2 <= WS_WB, "alias overflow");
static_assert(WS_END <= 536870912, "workspace too large");

constexpr int NTHREADS = 512;
constexpr int LDS_BYTES = 131072;

struct Params {
    const float *x_prompt, *x_sample, *mem_prompt, *cache_k, *cache_v, *state_conv, *state_shift, *state_wkv, *norm_in, *w_in, *conv_w, *conv_b,
        *shift_mu, *decay_w0, *decay_up, *icl_a0, *icl_up, *k_k, *k_a, *r_k, *ln_g, *ln_b, *norm_mem, *w_mem_kv, *w_branch, *w_out, *norm_final;
    float* out;
    unsigned char* ws;
};

__device__ __forceinline__ float bf2f(bf16_t v) { return __uint_as_float(((unsigned)v) << 16); }
__device__ __forceinline__ unsigned cvt_pk_bf16(float lo, float hi) { unsigned r; asm volatile("v_cvt_pk_bf16_f32 %0, %1, %2" : "=v"(r) : "v"(lo), "v"(hi)); return r; }
__device__ __forceinline__ float bflo(unsigned u) { return __uint_as_float(u << 16); }
__device__ __forceinline__ float bfhi(unsigned u) { return __uint_as_float(u & 0xffff0000u); }
__device__ __forceinline__ float fast_rcp(float x) { return __builtin_amdgcn_rcpf(x); }
__device__ __forceinline__ float sigmoidf_(float x) { return fast_rcp(1.0f + __expf(-x)); }
__device__ __forceinline__ float siluf_(float x) { return x * sigmoidf_(x); }
__device__ __forceinline__ float wave_sum(float v) {
#pragma unroll
    for (int o = 32; o > 0; o >>= 1) v += __shfl_xor(v, o, 64);
    return v;
}
template <int CTRL> __device__ __forceinline__ float dpp_f(float x) {
    return __int_as_float(__builtin_amdgcn_update_dpp(0, __float_as_int(x), CTRL, 0xF, 0xF, true));
}
__device__ __forceinline__ float row16_sum(float x) {
    x += dpp_f<0xB1>(x);
    x += dpp_f<0x4E>(x);
    x += dpp_f<0x141>(x);
    x += dpp_f<0x140>(x);
    return x;
}

constexpr int BM = 256, BK = 64, HALF = 128, HTB = HALF * BK * 2;
__device__ __forceinline__ int lds_byte(int r, int c) { const int st = (r >> 4) * 2 + (c >> 5), rr = r & 15, cc = c & 31, ob = rr * 64 + cc * 2; return st * 1024 + (ob ^ (((ob >> 9) & 1) << 5)); }
__device__ __forceinline__ void stage_rc(int b, int& R, int& C) { const int st = b / 1024, sb = b % 1024, swz = sb ^ (((sb >> 9) & 1) << 5); R = (st >> 1) * 16 + swz / 64; C = (st & 1) * 32 + (swz % 64) / 2; }

struct Unit { const char* a; const char* b; int x, y, z; };

template <class Sched, class Epi>
__device__ __forceinline__ void gemm_phase(LAS unsigned char* lds, const int lda, const int ldb, const int K, const Sched& S, const Epi& E) {
    const int tid = threadIdx.x, wid = __builtin_amdgcn_readfirstlane(tid >> 6), lane = tid & 63, wr = wid >> 2, wc = wid & 3, fr = lane & 15, fq = lane >> 4;
    const int nt = K / BK;
    unsigned voffA[2], voffB[2];
#pragma unroll
    for (int i = 0; i < 2; ++i) { int R, C; stage_rc(tid * 16 + i * 8192, R, C); voffA[i] = (unsigned)(R * lda + C * 2); voffB[i] = (unsigned)(R * ldb + C * 2); }
    const size_t kstep = (size_t)(BK * 2);
    const size_t hA = (size_t)HALF * lda, hB = (size_t)HALF * ldb;
    const unsigned ldsw = (unsigned)wid * 1024u;
    const int aoff = lds_byte(wr * 64 + fr, fq * 8), boff = lds_byte(wc * 32 + fr, fq * 8);
#define G_SA(b, h) (((b) * 2 + (h)) * HTB)
#define G_SB(b, h) ((4 + (b) * 2 + (h)) * HTB)
#define G_STAGE(bufoff, gbase, voff) do { _Pragma("unroll") for (int _i = 0; _i < 2; ++_i) \
        __builtin_amdgcn_global_load_lds((const unsigned*)((const char*)(gbase) + (voff)[_i]), (LAS unsigned*)(lds + (bufoff) + ldsw + _i * 8192), 16, 0, 0); } while (0)
#define G_LDA(dst, b, h) do { _Pragma("unroll") for (int m = 0; m < 4; ++m) _Pragma("unroll") for (int k = 0; k < 2; ++k) dst[m][k] = *(const LAS bf16x8*)(lds + G_SA(b, h) + aoff + m * 2048 + k * 1024); } while (0)
#define G_LDB(dst, b, h) do { _Pragma("unroll") for (int n = 0; n < 2; ++n) _Pragma("unroll") for (int k = 0; k < 2; ++k) dst[n][k] = *(const LAS bf16x8*)(lds + G_SB(b, h) + boff + n * 2048 + k * 1024); } while (0)
#define G_MMA(ai, bj, At, Bt) do { __builtin_amdgcn_s_setprio(1); _Pragma("unroll") for (int m = 0; m < 4; ++m) _Pragma("unroll") for (int n = 0; n < 2; ++n) _Pragma("unroll") for (int k = 0; k < 2; ++k) \
        acc[ai][bj][m][n] = __builtin_amdgcn_mfma_f32_16x16x32_bf16(Bt[n][k], At[m][k], acc[ai][bj][m][n], 0, 0, 0); __builtin_amdgcn_s_setprio(0); } while (0)
#define G_WAIT_V(n) asm volatile("s_waitcnt vmcnt(" #n ")" ::: "memory")
#define G_WAIT_L(n) asm volatile("s_waitcnt lgkmcnt(" #n ")" ::: "memory")
#define G_BAR __builtin_amdgcn_s_barrier()
#define G_SCHED __builtin_amdgcn_sched_barrier(0)
    Unit cur, nxt; int ui = 0;
    if (!S.next(0, cur)) return;
    f32x4 acc[2][2][4][2];
#pragma unroll
    for (int a = 0; a < 2; ++a)
#pragma unroll
        for (int b = 0; b < 2; ++b)
#pragma unroll
            for (int m = 0; m < 4; ++m)
#pragma unroll
                for (int n = 0; n < 2; ++n) acc[a][b][m][n] = (f32x4){0.f, 0.f, 0.f, 0.f};
    bf16x8 At[4][2], B0[2][2], B1[2][2];
    const char* cA = cur.a; const char* cB = cur.b;
    G_STAGE(G_SB(0, 0), cB, voffB); G_STAGE(G_SA(0, 0), cA, voffA); G_STAGE(G_SB(0, 1), cB + hB, voffB); G_STAGE(G_SA(0, 1), cA + hA, voffA);
    if (wr == 1) G_BAR;
    G_WAIT_V(4); G_BAR;
    G_STAGE(G_SB(1, 0), cB + kstep, voffB); G_STAGE(G_SA(1, 0), cA + kstep, voffA); G_STAGE(G_SB(1, 1), cB + hB + kstep, voffB);
    G_WAIT_V(6); G_BAR;
    for (;;) {
        const bool has_next = S.next(ui + 1, nxt);
        const char* nA = has_next ? nxt.a : cA; const char* nB = has_next ? nxt.b : cB;
        for (int t = 0; t < nt; t += 2) {
            const bool last = (t == nt - 2);
            const char* a1 = cA + (size_t)(t + 1) * kstep;
            const char* a2 = last ? nA : cA + (size_t)(t + 2) * kstep; const char* b2 = last ? nB : cB + (size_t)(t + 2) * kstep;
            const char* a3 = a2 + kstep; const char* b3 = b2 + kstep;
            G_LDB(B0, 0, 0); G_SCHED; G_LDA(At, 0, 0); G_STAGE(G_SA(1, 1), a1 + hA, voffA);
            G_WAIT_L(8); G_BAR; G_WAIT_L(0); G_MMA(0, 0, At, B0); G_BAR; G_SCHED;
            G_LDB(B1, 0, 1); G_STAGE(G_SB(0, 0), b2, voffB);
            G_BAR; G_WAIT_L(0); G_MMA(0, 1, At, B1); G_BAR;
            G_LDA(At, 0, 1); G_STAGE(G_SA(0, 0), a2, voffA);
            G_BAR; G_WAIT_L(0); G_MMA(1, 0, At, B0); G_BAR; G_SCHED;
            G_STAGE(G_SB(0, 1), b2 + hB, voffB);
            G_WAIT_V(6); G_BAR; G_MMA(1, 1, At, B1); G_BAR;
            G_LDB(B0, 1, 0); G_SCHED; G_LDA(At, 1, 0); G_STAGE(G_SA(0, 1), a2 + hA, voffA);
            G_WAIT_L(8); G_BAR; G_WAIT_L(0); G_MMA(0, 0, At, B0); G_BAR; G_SCHED;
            G_LDB(B1, 1, 1); G_STAGE(G_SB(1, 0), b3, voffB);
            G_BAR; G_WAIT_L(0); G_MMA(0, 1, At, B1); G_BAR;
            G_LDA(At, 1, 1); G_STAGE(G_SA(1, 0), a3, voffA);
            G_BAR; G_WAIT_L(0); G_MMA(1, 0, At, B0); G_BAR; G_SCHED;
            G_STAGE(G_SB(1, 1), b3 + hB, voffB);
            G_WAIT_V(6); G_BAR; G_MMA(1, 1, At, B1); G_BAR;
        }
        const bool keep = E(acc, cur, wr, wc, fr, fq);
        if (!has_next) break;
        if (!keep) {
#pragma unroll
            for (int a = 0; a < 2; ++a)
#pragma unroll
                for (int b = 0; b < 2; ++b)
#pragma unroll
                    for (int m = 0; m < 4; ++m)
#pragma unroll
                        for (int n = 0; n < 2; ++n) acc[a][b][m][n] = (f32x4){0.f, 0.f, 0.f, 0.f};
        }
        cur = nxt; cA = nA; cB = nB; ++ui;
    }
    G_WAIT_V(0);
    if (wr == 0) G_BAR;
    G_BAR;
#undef G_SA
#undef G_SB
#undef G_STAGE
#undef G_LDA
#undef G_LDB
#undef G_MMA
#undef G_WAIT_V
#undef G_WAIT_L
#undef G_BAR
#undef G_SCHED
}

__device__ __forceinline__ int perm8_local(int c) {
    const int bj = c >> 7, wc = (c >> 5) & 3, n = (c >> 4) & 1, fq = (c >> 2) & 3, e = c & 3;
    return 128 * bj + 32 * wc + 8 * fq + 4 * n + e;
}
__device__ __forceinline__ int colmap_in(int np) {
    const int j = np >> 8, c = np & 255;
    if (j < 16) {
        const int bj = c >> 7, wc = (c >> 5) & 3, n = (c >> 4) & 1, fq = (c >> 2) & 3, e = c & 3;
        return (2 * bj + n) * 1024 + j * 64 + wc * 16 + fq * 4 + e;
    }
    const int L = (j - 16) * 256 + perm8_local(c);
    if (L < 3200) return 4096 + L;
    if (L < 3328) return -1;
    return L + 3968;
}

__device__ void phase0(const Params& p, unsigned char* smem) {
    const int tid = threadIdx.x, lane = tid & 63, wid = tid >> 6;
    bf16_t* Aall = (bf16_t*)(p.ws + WS_AALL);
    for (int row = blockIdx.x * 8 + wid; row < 19456; row += gridDim.x * 8) {
        const float* src; const float* g;
        if (row < MP) { src = p.x_prompt + (size_t)row * 1024; g = p.norm_in; }
        else if (row < MALL) { src = p.x_sample + (size_t)(row - MP) * 1024; g = p.norm_in; }
        else { src = p.mem_prompt + (size_t)(row - MALL) * 1024; g = p.norm_mem; }
        f32x4 v[4]; float ss = 0.f;
#pragma unroll
        for (int i = 0; i < 4; ++i) { v[i] = *(const f32x4*)(src + i * 256 + lane * 4); ss += v[i][0] * v[i][0] + v[i][1] * v[i][1] + v[i][2] * v[i][2] + v[i][3] * v[i][3]; }
        ss = wave_sum(ss);
        const float inv = rsqrtf(ss * (1.0f / 1024.0f) + 1e-6f);
#pragma unroll
        for (int i = 0; i < 4; ++i) {
            const f32x4 gg = *(const f32x4*)(g + i * 256 + lane * 4);
            u32x2 o; o[0] = cvt_pk_bf16(v[i][0] * inv * gg[0], v[i][1] * inv * gg[1]); o[1] = cvt_pk_bf16(v[i][2] * inv * gg[2], v[i][3] * inv * gg[3]);
            *(u32x2*)(Aall + (size_t)row * 1024 + i * 256 + lane * 4) = o;
        }
    }
    bf16_t* T = (bf16_t*)smem;
    const int NT_IN = 212 * 16, NT_KV = 32 * 16, NT_WB = 3 * 16 * 16, NT_WO = 16 * 16;
    const int total = NT_IN + NT_KV + NT_WB + NT_WO;
    for (int tix = blockIdx.x; tix < total; tix += gridDim.x) {
        const float* src; int src_ld; bf16_t* dst; int n0, k0, mode;
        if (tix < NT_IN) { src = p.w_in; src_ld = DIN; dst = (bf16_t*)(p.ws + WS_BALL); n0 = (tix >> 4) * 64; k0 = (tix & 15) * 64; mode = 0; }
        else if (tix < NT_IN + NT_KV) { const int t2 = tix - NT_IN; src = p.w_mem_kv; src_ld = 2048; dst = (bf16_t*)(p.ws + WS_BALL) + (size_t)NPAD * 1024; n0 = (t2 >> 4) * 64; k0 = (t2 & 15) * 64; mode = 1; }
        else if (tix < NT_IN + NT_KV + NT_WB) { const int t2 = tix - NT_IN - NT_KV; const int i = t2 >> 8, t3 = t2 & 255; src = p.w_branch + (size_t)i * 1024 * 1024; src_ld = 1024;
            dst = (bf16_t*)(p.ws + WS_WB) + (size_t)i * 1024 * 1024; n0 = (t3 >> 4) * 64; k0 = (t3 & 15) * 64; mode = 2; }
        else { const int t3 = tix - NT_IN - NT_KV - NT_WB; src = p.w_out; src_ld = 1024; dst = (bf16_t*)(p.ws + WS_WO); n0 = (t3 >> 4) * 64; k0 = (t3 & 15) * 64; mode = 1; }
        {
            const int kk = tid >> 3, seg = tid & 7;
#pragma unroll
            for (int q = 0; q < 2; ++q) {
                const int nl = seg * 8 + q * 4, np = n0 + nl;
                int sc;
                if (mode == 0) sc = colmap_in(np);
                else if (mode == 1) sc = np;
                else sc = (np & ~255) + perm8_local(np & 255);
                f32x4 v = (f32x4){0.f, 0.f, 0.f, 0.f};
                if (sc >= 0) v = *(const f32x4*)(src + (size_t)(k0 + kk) * src_ld + sc);
                const unsigned a = cvt_pk_bf16(v[0], v[1]), b = cvt_pk_bf16(v[2], v[3]);
                T[(nl + 0) * 72 + kk] = (bf16_t)(a & 0xffff); T[(nl + 1) * 72 + kk] = (bf16_t)(a >> 16);
                T[(nl + 2) * 72 + kk] = (bf16_t)(b & 0xffff); T[(nl + 3) * 72 + kk] = (bf16_t)(b >> 16);
            }
        }
        __syncthreads();
        {
            const int nl = tid >> 3, ks = tid & 7;
            const u32x4 v = *(const u32x4*)(T + nl * 72 + ks * 8);
            *(u32x4*)(dst + (size_t)(n0 + nl) * 1024 + k0 + ks * 8) = v;
        }
        __syncthreads();
    }
}

struct SchedP1 {
    int G, c; const char* Aall; const char* Ball;
    __device__ __forceinline__ bool next(int i, Unit& u) const {
        const int L = i * G + c;
        constexpr int nM = 68, nN = 53, nwg = nM * nN, WGM = 8;
        if (L >= nwg + 96) return false;
        if (L < nwg) {
            int wgid = L; { const int q = nwg / 8, r = nwg % 8, xcd = wgid % 8, off = wgid / 8; wgid = (xcd < r ? xcd * (q + 1) : r * (q + 1) + (xcd - r) * q) + off; }
            const int nig = WGM * nN, gid = wgid / nig, fm = gid * WGM, gsz = (nM - fm) < WGM ? (nM - fm) : WGM;
            u.x = fm + ((wgid % nig) % gsz); u.y = (wgid % nig) / gsz; u.z = 0;
            u.a = Aall + (size_t)u.x * 256 * 2048; u.b = Ball + (size_t)u.y * 256 * 2048;
        } else {
            int k = L - nwg;
            if (k < 32) { u.x = k >> 2; u.y = k & 3; u.z = 1; u.a = Aall + (size_t)(68 + u.x) * 256 * 2048; u.b = Ball + (size_t)(53 + u.y) * 256 * 2048; }
            else if (k < 64) { k -= 32; u.x = k >> 2; u.y = k & 3; u.z = 2; u.a = Aall + (size_t)(68 + u.x) * 256 * 2048; u.b = Ball + (size_t)(57 + u.y) * 256 * 2048; }
            else { k -= 64; u.x = k >> 3; u.y = k & 7; u.z = 3; u.a = Ball + (size_t)(57 + u.x) * 256 * 2048; u.b = Aall + (size_t)(68 + u.y) * 256 * 2048; }
        }
        return true;
    }
};

struct EpiP1 {
    bf16_t* U; bf16_t* BG; bf16_t* ACT; float* out; bf16_t* Kbf; bf16_t* Vt;
    __device__ __forceinline__ bool operator()(f32x4 (&acc)[2][2][4][2], const Unit& u, int wr, int wc, int fr, int fq) const {
        const int type = u.z;
        if (type == 0) {
            const int pn = u.y, rbase = u.x * 256 + wr * 64 + fr;
            if (pn < 16) {
                const int ch0 = pn * 64 + wc * 16 + fq * 4;
#pragma unroll
                for (int ai = 0; ai < 2; ++ai)
#pragma unroll
                    for (int m = 0; m < 4; ++m) {
                        const int row = rbase + ai * 128 + m * 16;
                        const f32x4 h = acc[ai][0][m][0], Bv = acc[ai][0][m][1], Cv = acc[ai][1][m][0], g = acc[ai][1][m][1];
                        const f32x4 u4 = Cv * h;
                        f32x4 bg;
#pragma unroll
                        for (int e = 0; e < 4; ++e) bg[e] = Bv[e] * siluf_(g[e]);
                        u32x2 o; o[0] = cvt_pk_bf16(u4[0], u4[1]); o[1] = cvt_pk_bf16(u4[2], u4[3]);
                        *(u32x2*)(U + (size_t)row * 1024 + ch0) = o;
                        o[0] = cvt_pk_bf16(bg[0], bg[1]); o[1] = cvt_pk_bf16(bg[2], bg[3]);
                        *(u32x2*)(BG + (size_t)row * 1024 + ch0) = o;
                        if (row < MP) { const int t = row & 2047; if (t >= 2046) *(f32x4*)(out + OUT_CONV_P + (size_t)((row >> 11) * 2 + (t - 2046)) * 1024 + ch0) = u4; }
                        else { const int rs = row - MP, t = rs & 7; if (t >= 6) *(f32x4*)(out + OUT_CONV_S + (size_t)((rs >> 3) * 2 + (t - 6)) * 1024 + ch0) = u4; }
                    }
            } else {
                const int L0 = (pn - 16) * 256;
                const int kind = pn <= 28 ? 0 : pn <= 32 ? 1 : pn <= 36 ? 2 : pn <= 40 ? 1 : 3;
#pragma unroll
                for (int ai = 0; ai < 2; ++ai)
#pragma unroll
                    for (int m = 0; m < 4; ++m) {
                        const int row = rbase + ai * 128 + m * 16;
#pragma unroll
                        for (int bj = 0; bj < 2; ++bj) {
                            const int L = L0 + 128 * bj + 32 * wc + 8 * fq;
                            f32x4 v0 = acc[ai][bj][m][0], v1 = acc[ai][bj][m][1];
                            if (kind == 0) {
                                if (L < DSHIFT) {
                                    if (row < MP) { if ((row & 2047) == 2047) { float* d = out + OUT_SHIFT_P + (size_t)(row >> 11) * DSHIFT + L; *(f32x4*)d = v0; *(f32x4*)(d + 4) = v1; } }
                                    else { const int rs = row - MP; if ((rs & 7) == 7) { float* d = out + OUT_SHIFT_S + (size_t)(rs >> 3) * DSHIFT + L; *(f32x4*)d = v0; *(f32x4*)(d + 4) = v1; } }
                                }
                            } else if (kind == 1) {
#pragma unroll
                                for (int e = 0; e < 4; ++e) { v0[e] = siluf_(v0[e]); v1[e] = siluf_(v1[e]); }
                            } else if (kind == 2) { v0 *= 0.0625f; v1 *= 0.0625f; }
                            else {
#pragma unroll
                                for (int e = 0; e < 4; ++e) { v0[e] = sigmoidf_(v0[e]); v1[e] = sigmoidf_(v1[e]); }
                            }
                            u32x4 o; o[0] = cvt_pk_bf16(v0[0], v0[1]); o[1] = cvt_pk_bf16(v0[2], v0[3]); o[2] = cvt_pk_bf16(v1[0], v1[1]); o[3] = cvt_pk_bf16(v1[2], v1[3]);
                            *(u32x4*)(ACT + (size_t)row * ACT_LD + L) = o;
                        }
                    }
            }
        } else {
            const int rbase = u.x * 256 + wr * 64 + fr, cbase = u.y * 256 + wc * 32 + fq * 4;
#pragma unroll
            for (int ai = 0; ai < 2; ++ai)
#pragma unroll
                for (int m = 0; m < 4; ++m) {
                    const int row = rbase + ai * 128 + m * 16;
#pragma unroll
                    for (int bj = 0; bj < 2; ++bj)
#pragma unroll
                        for (int n = 0; n < 2; ++n) {
                            const int col = cbase + bj * 128 + n * 16;
                            const f32x4 v = acc[ai][bj][m][n];
                            if (type == 1) { *(f32x4*)(out + OUT_MK + (size_t)row * 1024 + col) = v;
                                u32x2 o; o[0] = cvt_pk_bf16(v[0], v[1]); o[1] = cvt_pk_bf16(v[2], v[3]); *(u32x2*)(Kbf + (size_t)row * 1024 + col) = o; }
                            else if (type == 2) { *(f32x4*)(out + OUT_MV + (size_t)row * 1024 + col) = v; }
                            else { u32x2 o; o[0] = cvt_pk_bf16(v[0], v[1]); o[1] = cvt_pk_bf16(v[2], v[3]); *(u32x2*)(Vt + (size_t)row * 2048 + col) = o; }
                        }
                }
        }
        return false;
    }
};

__device__ void scan_item(const Params& p, float* sm, const int r0, const int T, const int b, const int h, const int half, const bool samp) {
    const int tid = threadIdx.x, lane = tid & 63, wid = tid >> 6;
    const bf16_t* ACT = (const bf16_t*)(p.ws + WS_ACT);
    float* ORAW = p.out + OUT_Y;
    float* C3 = (float*)(p.ws + WS_C3);
    float* wup = sm;
    float* aup = sm + 4096;
    float* rs = sm + 8192;
    float* ks = rs + 2048;
    float* vs = ks + 2048;
    float* twdT = vs + 2048;
    float* adsT = twdT + 2048;
    float* kk = adsT + 2048;
    float* wrr = kk + 2048;
    float* ww = wrr + 2048;
    float* bb = ww + 2048;
    float* kp = bb + 2048;
    float* c12 = kp + 2048;
    float* obuf = c12 + 64;
    __syncthreads();
    for (int idx = tid; idx < 4096; idx += NTHREADS) { const int j = idx >> 6, i = idx & 63; wup[idx] = p.decay_up[(size_t)j * 1024 + h * 64 + i]; aup[idx] = p.icl_up[(size_t)j * 1024 + h * 64 + i]; }
    const int c = lane & 15, rg = lane >> 4;
    const int rl = (wid & 3) * 8 + rg * 2;
    f32x4 s0 = (f32x4){0.f, 0.f, 0.f, 0.f}, s1 = s0;
    const size_t st_off = ((size_t)(b * 16 + h) * 64 + half * 32 + rl) * 64 + 4 * c;
    if (samp && wid < 4) { s0 = *(const f32x4*)(p.state_wkv + st_off); s1 = *(const f32x4*)(p.state_wkv + st_off + 64); }
    const int Tc = T < 32 ? T : 32;
    const int ch = h * 64 + (tid & 63);
    const float w0v = p.decay_w0[ch], a0v = p.icl_a0[ch], kkv = p.k_k[ch], kav = p.k_a[ch], rkv = p.r_k[ch];
    for (int t0 = 0; t0 < T; t0 += Tc) {
        for (int idx = tid; idx < Tc * 320; idx += NTHREADS) {
            const int t = idx / 320, cc = idx - t * 320, which = cc >> 6, i = cc & 63;
            const int col = which < 3 ? which * 1024 + h * 64 + i : 3072 + (which - 3) * 64 + i;
            const size_t row = (size_t)(r0 + t0 + t);
            const float cur = bf2f(ACT[row * ACT_LD + col]);
            float prev;
            if (t0 + t == 0) prev = samp ? p.state_shift[(size_t)b * DSHIFT + col] : 0.f;
            else prev = bf2f(ACT[(row - 1) * ACT_LD + col]);
            const float ps = cur + p.shift_mu[col] * (prev - cur);
            if (which == 0) rs[t * 64 + i] = ps;
            else if (which == 1) ks[t * 64 + i] = ps;
            else if (which == 2) vs[t * 64 + i] = ps;
            else if (which == 3) twdT[i * 32 + t] = tanhf(ps);
            else adsT[i * 32 + t] = ps;
        }
        __syncthreads();
        if (wid * 4 < Tc) {
            const int i = lane, tb = wid * 4;
            float xw[4] = {w0v, w0v, w0v, w0v}, xa[4] = {a0v, a0v, a0v, a0v};
            for (int j = 0; j < 64; ++j) {
                const float wu = wup[j * 64 + i], au = aup[j * 64 + i];
                const f32x4 tw = *(const f32x4*)(twdT + j * 32 + tb), ad = *(const f32x4*)(adsT + j * 32 + tb);
#pragma unroll
                for (int q = 0; q < 4; ++q) { xw[q] += tw[q] * wu; xa[q] += ad[q] * au; }
            }
#pragma unroll
            for (int q = 0; q < 4; ++q) {
                const int t = tb + q;
                const float dec = __expf(-0.6065306597f * sigmoidf_(xw[q]));
                const float a = sigmoidf_(xa[q]);
                const float k_ = ks[t * 64 + i], r_ = rs[t * 64 + i];
                float kn = k_ * kkv;
                const float ss = wave_sum(kn * kn);
                kn *= rsqrtf(ss + 1e-12f);
                const float kpv = k_ * (1.0f + (a - 1.0f) * kav);
                const float bv = kn * a;
                const float c1 = wave_sum(bv * r_), c2 = wave_sum(kpv * r_), c3 = wave_sum(r_ * kpv * rkv);
                kk[t * 64 + i] = kn; wrr[t * 64 + i] = dec * r_; ww[t * 64 + i] = dec; bb[t * 64 + i] = bv; kp[t * 64 + i] = kpv;
                if (lane == 0) { c12[t * 2] = c1; c12[t * 2 + 1] = c2; if (half == 0) C3[(size_t)(r0 + t0 + t) * 16 + h] = c3; }
            }
        }
        __syncthreads();
        if (wid < 4) {
            for (int t = 0; t < Tc; ++t) {
                const f32x4 kk4 = *(const f32x4*)(kk + t * 64 + 4 * c), wr4 = *(const f32x4*)(wrr + t * 64 + 4 * c), w4 = *(const f32x4*)(ww + t * 64 + 4 * c),
                            b4 = *(const f32x4*)(bb + t * 64 + 4 * c), k4 = *(const f32x4*)(kp + t * 64 + 4 * c);
                const f32x2 v2 = *(const f32x2*)(vs + t * 64 + half * 32 + rl);
                const f32x2 cc = *(const f32x2*)(c12 + t * 2);
                float d0 = s0[0] * kk4[0] + s0[1] * kk4[1] + s0[2] * kk4[2] + s0[3] * kk4[3];
                float d1 = s1[0] * kk4[0] + s1[1] * kk4[1] + s1[2] * kk4[2] + s1[3] * kk4[3];
                float e0 = s0[0] * wr4[0] + s0[1] * wr4[1] + s0[2] * wr4[2] + s0[3] * wr4[3];
                float e1 = s1[0] * wr4[0] + s1[1] * wr4[1] + s1[2] * wr4[2] + s1[3] * wr4[3];
                d0 = row16_sum(d0); d1 = row16_sum(d1); e0 = row16_sum(e0); e1 = row16_sum(e1);
                s0 = s0 * w4 + (k4 * v2[0] - b4 * d0);
                s1 = s1 * w4 + (k4 * v2[1] - b4 * d1);
                if (c == 0) { f32x2 o; o[0] = e0 - d0 * cc[0] + v2[0] * cc[1]; o[1] = e1 - d1 * cc[0] + v2[1] * cc[1]; *(f32x2*)(obuf + t * 32 + rl) = o; }
            }
        }
        __syncthreads();
        for (int idx = tid; idx < Tc * 32; idx += NTHREADS) { const int t = idx >> 5, j = idx & 31; ORAW[(size_t)(r0 + t0 + t) * 1024 + h * 64 + half * 32 + j] = obuf[idx]; }
    }
    if (wid < 4) {
        float* so = p.out + (samp ? OUT_WKV_S : OUT_WKV_P) + st_off;
        *(f32x4*)so = s0; *(f32x4*)(so + 64) = s1;
    }
}

__device__ void attn_unit(const Params& p, unsigned char* smem, const int unit) {
    const int tid = threadIdx.x, lane = tid & 63, wid = __builtin_amdgcn_readfirstlane(tid >> 6), fr = lane & 15, fq = lane >> 4;
    const bool samp = unit >= 512;
    int b, h, tile = 0;
    if (!samp) { b = unit >> 6; h = (unit >> 4) & 3; tile = unit & 15; } else { const int u2 = unit - 512; b = u2 >> 2; h = u2 & 3; }
    const bf16_t* ACT = (const bf16_t*)(p.ws + WS_ACT);
    const bf16_t* Kbf = (const bf16_t*)(p.ws + WS_KBF);
    const bf16_t* Vt = (const bf16_t*)(p.ws + WS_VT);
    bf16_t* Ymem = (bf16_t*)(p.ws + WS_YMEM);
    bf16_t* Kc = (bf16_t*)smem;
    bf16_t* Vc = (bf16_t*)smem;
    const int row = samp ? MP + b * 8 + (fr & 7) : b * 2048 + tile * 128 + wid * 16 + fr;
    const bool valid = !samp || fr < 8;
    bf16x8 qf[8];
#pragma unroll
    for (int ks = 0; ks < 8; ++ks) qf[ks] = *(const bf16x8*)(ACT + (size_t)row * ACT_LD + C_QM + h * 256 + ks * 32 + fq * 8);
    f32x4 sacc[16];
#pragma unroll
    for (int i = 0; i < 16; ++i) sacc[i] = (f32x4){0.f, 0.f, 0.f, 0.f};
#pragma unroll
    for (int hf = 0; hf < 2; ++hf) {
        __syncthreads();
#pragma unroll
        for (int i = 0; i < 8; ++i) {
            const int id = tid + i * NTHREADS, key = id >> 5, d = (id & 31) * 8;
            u32x4 v;
            if (!samp) v = *(const u32x4*)(Kbf + (size_t)(b * 256 + hf * 128 + key) * 1024 + h * 256 + d);
            else { const float* s = p.cache_k + ((size_t)(b * 256 + hf * 128 + key) * 4 + h) * 256 + d; const f32x4 x0 = *(const f32x4*)s, x1 = *(const f32x4*)(s + 4);
                v[0] = cvt_pk_bf16(x0[0], x0[1]); v[1] = cvt_pk_bf16(x0[2], x0[3]); v[2] = cvt_pk_bf16(x1[0], x1[1]); v[3] = cvt_pk_bf16(x1[2], x1[3]); }
            *(u32x4*)(Kc + key * 264 + d) = v;
        }
        __syncthreads();
#pragma unroll
        for (int kt = 0; kt < 8; ++kt)
#pragma unroll
            for (int ks = 0; ks < 8; ++ks) {
                const bf16x8 kf = *(const bf16x8*)(Kc + (kt * 16 + fr) * 264 + ks * 32 + fq * 8);
                sacc[hf * 8 + kt] = __builtin_amdgcn_mfma_f32_16x16x32_bf16(kf, qf[ks], sacc[hf * 8 + kt], 0, 0, 0);
            }
    }
    float mx = -3.0e38f;
#pragma unroll
    for (int i = 0; i < 16; ++i) mx = fmaxf(mx, fmaxf(fmaxf(sacc[i][0], sacc[i][1]), fmaxf(sacc[i][2], sacc[i][3])));
    mx = fmaxf(mx, __shfl_xor(mx, 16, 64)); mx = fmaxf(mx, __shfl_xor(mx, 32, 64));
    float sum = 0.f;
#pragma unroll
    for (int i = 0; i < 16; ++i)
#pragma unroll
        for (int e = 0; e < 4; ++e) { const float ex = __expf(sacc[i][e] - mx); sacc[i][e] = ex; sum += ex; }
    sum += __shfl_xor(sum, 16, 64); sum += __shfl_xor(sum, 32, 64);
    const float inv = fast_rcp(sum);
    bf16x8 pf[8];
#pragma unroll
    for (int s = 0; s < 8; ++s) {
        u32x4 t; t[0] = cvt_pk_bf16(sacc[2 * s][0], sacc[2 * s][1]); t[1] = cvt_pk_bf16(sacc[2 * s][2], sacc[2 * s][3]);
        t[2] = cvt_pk_bf16(sacc[2 * s + 1][0], sacc[2 * s + 1][1]); t[3] = cvt_pk_bf16(sacc[2 * s + 1][2], sacc[2 * s + 1][3]);
        pf[s] = __builtin_bit_cast(bf16x8, t);
    }
    f32x4 oacc[16];
#pragma unroll
    for (int i = 0; i < 16; ++i) oacc[i] = (f32x4){0.f, 0.f, 0.f, 0.f};
#pragma unroll
    for (int hf = 0; hf < 2; ++hf) {
        __syncthreads();
        if (!samp) {
#pragma unroll
            for (int i = 0; i < 8; ++i) {
                const int id = tid + i * NTHREADS, d = id >> 4, kc = (id & 15) * 8;
                const u32x4 v = *(const u32x4*)(Vt + (size_t)(h * 256 + d) * 2048 + b * 256 + hf * 128 + kc);
                *(u32x4*)(Vc + d * 136 + kc) = v;
            }
        } else {
#pragma unroll
            for (int i = 0; i < 16; ++i) {
                const int id = tid + i * NTHREADS, key = id >> 6, d = (id & 63) * 4;
                const f32x4 x = *(const f32x4*)(p.cache_v + ((size_t)(b * 256 + hf * 128 + key) * 4 + h) * 256 + d);
                const unsigned a = cvt_pk_bf16(x[0], x[1]), bq = cvt_pk_bf16(x[2], x[3]);
                Vc[(d + 0) * 136 + key] = (bf16_t)(a & 0xffff); Vc[(d + 1) * 136 + key] = (bf16_t)(a >> 16);
                Vc[(d + 2) * 136 + key] = (bf16_t)(bq & 0xffff); Vc[(d + 3) * 136 + key] = (bf16_t)(bq >> 16);
            }
        }
        __syncthreads();
#pragma unroll
        for (int dt = 0; dt < 16; ++dt) {
            if (!samp || (dt >> 1) == wid) {
#pragma unroll
                for (int s2 = 0; s2 < 4; ++s2) {
                    const u32x2 lo = *(const u32x2*)(Vc + (dt * 16 + fr) * 136 + s2 * 32 + 4 * fq), hi = *(const u32x2*)(Vc + (dt * 16 + fr) * 136 + s2 * 32 + 16 + 4 * fq);
                    u32x4 t; t[0] = lo[0]; t[1] = lo[1]; t[2] = hi[0]; t[3] = hi[1];
                    oacc[dt] = __builtin_amdgcn_mfma_f32_16x16x32_bf16(__builtin_bit_cast(bf16x8, t), pf[hf * 4 + s2], oacc[dt], 0, 0, 0);
                }
            }
        }
    }
    if (valid) {
#pragma unroll
        for (int dt = 0; dt < 16; ++dt) {
            if (!samp || (dt >> 1) == wid) {
                const int d = h * 256 + dt * 16 + 4 * fq;
                const u32x2 g = *(const u32x2*)(ACT + (size_t)row * ACT_LD + C_SGM + d);
                u32x2 o; o[0] = cvt_pk_bf16(oacc[dt][0] * inv * bflo(g[0]), oacc[dt][1] * inv * bfhi(g[0])); o[1] = cvt_pk_bf16(oacc[dt][2] * inv * bflo(g[1]), oacc[dt][3] * inv * bfhi(g[1]));
                *(u32x2*)(Ymem + (size_t)row * 1024 + d) = o;
            }
        }
    }
}

__device__ void phase2(const Params& p, unsigned char* smem) {
    float* sm = (float*)smem;
    for (int it = blockIdx.x; it < 256; it += gridDim.x) { const int chain = it >> 1, b = chain >> 4, h = chain & 15; scan_item(p, sm, b * TP, TP, b, h, it & 1, false); }
    for (int it = blockIdx.x; it < 4096; it += gridDim.x) { const int chain = it >> 1, b = chain >> 4, h = chain & 15; scan_item(p, sm, MP + b * TS, TS, b, h, it & 1, true); }
    __syncthreads();
    for (int u = blockIdx.x; u < 1024; u += gridDim.x) attn_unit(p, smem, u);
}

__device__ void phase2b(const Params& p) {
    const int lane = threadIdx.x & 63, wid = threadIdx.x >> 6;
    const bf16_t* U = (const bf16_t*)(p.ws + WS_U); const bf16_t* BG = (const bf16_t*)(p.ws + WS_BG); const bf16_t* ACT = (const bf16_t*)(p.ws + WS_ACT);
    const float* ORAW = p.out + OUT_Y; const float* C3 = (const float*)(p.ws + WS_C3);
    bf16_t* Yc = (bf16_t*)(p.ws + WS_YCONV); bf16_t* Yr = (bf16_t*)(p.ws + WS_YRWKV);
    for (int row = blockIdx.x * 8 + wid; row < MALL; row += gridDim.x * 8) {
        int b, t; const bool samp = row >= MP;
        if (!samp) { b = row >> 11; t = row & 2047; } else { b = (row - MP) >> 3; t = (row - MP) & 7; }
#pragma unroll
        for (int q = 0; q < 2; ++q) {
            const int ch = q * 512 + lane * 8;
            const u32x4 u0 = *(const u32x4*)(U + (size_t)row * 1024 + ch), bg = *(const u32x4*)(BG + (size_t)row * 1024 + ch);
            float um1[8], um2[8];
            if (t >= 1) { const u32x4 v = *(const u32x4*)(U + (size_t)(row - 1) * 1024 + ch);
#pragma unroll
                for (int e = 0; e < 4; ++e) { um1[2 * e] = bflo(v[e]); um1[2 * e + 1] = bfhi(v[e]); } }
            else {
#pragma unroll
                for (int e = 0; e < 8; ++e) um1[e] = samp ? p.state_conv[((size_t)b * 2 + 1) * 1024 + ch + e] : 0.f; }
            if (t >= 2) { const u32x4 v = *(const u32x4*)(U + (size_t)(row - 2) * 1024 + ch);
#pragma unroll
                for (int e = 0; e < 4; ++e) { um2[2 * e] = bflo(v[e]); um2[2 * e + 1] = bfhi(v[e]); } }
            else {
#pragma unroll
                for (int e = 0; e < 8; ++e) um2[e] = samp ? p.state_conv[((size_t)b * 2 + t) * 1024 + ch + e] : 0.f; }
            float y[8];
#pragma unroll
            for (int e = 0; e < 8; ++e) {
                const float uc = (e & 1) ? bfhi(u0[e >> 1]) : bflo(u0[e >> 1]);
                const float g = (e & 1) ? bfhi(bg[e >> 1]) : bflo(bg[e >> 1]);
                const float cv = p.conv_b[ch + e] + p.conv_w[ch + e] * um2[e] + p.conv_w[1024 + ch + e] * um1[e] + p.conv_w[2048 + ch + e] * uc;
                y[e] = g * cv;
            }
            u32x4 o; o[0] = cvt_pk_bf16(y[0], y[1]); o[1] = cvt_pk_bf16(y[2], y[3]); o[2] = cvt_pk_bf16(y[4], y[5]); o[3] = cvt_pk_bf16(y[6], y[7]);
            *(u32x4*)(Yc + (size_t)row * 1024 + ch) = o;
        }
        for (int h = 0; h < 16; ++h) {
            const int ch = h * 64 + lane;
            const float o = ORAW[(size_t)row * 1024 + ch];
            const float mean = wave_sum(o) * (1.0f / 64.0f);
            const float dlt = o - mean;
            const float var = wave_sum(dlt * dlt) * (1.0f / 64.0f);
            const float vcur = bf2f(ACT[(size_t)row * ACT_LD + C_PV + ch]);
            float vprev;
            if (t == 0) vprev = samp ? p.state_shift[(size_t)b * DSHIFT + 2048 + ch] : 0.f;
            else vprev = bf2f(ACT[(size_t)(row - 1) * ACT_LD + C_PV + ch]);
            const float vsft = vcur + p.shift_mu[2048 + ch] * (vprev - vcur);
            float y = dlt * rsqrtf(var + 6.4e-4f) * p.ln_g[ch] + p.ln_b[ch] + C3[(size_t)row * 16 + h] * vsft;
            y *= bf2f(ACT[(size_t)row * ACT_LD + C_SGR + ch]);
            const unsigned pk = cvt_pk_bf16(y, y);
            Yr[(size_t)row * 1024 + ch] = (bf16_t)(pk & 0xffff);
        }
    }
}

struct SchedP3 {
    int G, c; const char* ws;
    __device__ __forceinline__ bool next(int i, Unit& u) const {
        const int tl = (i / 3) * G + c, seg = i % 3;
        if (tl >= 272) return false;
        u.x = tl >> 2; u.y = tl & 3; u.z = seg;
        u.a = ws + (seg == 0 ? WS_YCONV : seg == 1 ? WS_YRWKV : WS_YMEM) + (size_t)u.x * 256 * 2048; u.b = ws + WS_WB + ((size_t)seg * 1024 + (size_t)u.y * 256) * 2048;
        return true;
    }
};
struct EpiP3 {
    const bf16_t* ACT; bf16_t* MERGED;
    __device__ __forceinline__ bool operator()(f32x4 (&acc)[2][2][4][2], const Unit& u, int wr, int wc, int fr, int fq) const {
        const int seg = u.z, rbase = u.x * 256 + wr * 64 + fr, cb = u.y * 256 + wc * 32 + 8 * fq;
#pragma unroll
        for (int ai = 0; ai < 2; ++ai)
#pragma unroll
            for (int m = 0; m < 4; ++m) {
                const int row = rbase + ai * 128 + m * 16;
#pragma unroll
                for (int bj = 0; bj < 2; ++bj) {
                    const int col = cb + 128 * bj;
                    const u32x4 g = *(const u32x4*)(ACT + (size_t)row * ACT_LD + C_GATE + seg * 1024 + col);
                    float f[8];
#pragma unroll
                    for (int e = 0; e < 4; ++e) { f[2 * e] = bflo(g[e]); f[2 * e + 1] = bfhi(g[e]); }
                    if (seg < 2) {
                        const u32x4 g2 = *(const u32x4*)(ACT + (size_t)row * ACT_LD + C_GATE + (seg + 1) * 1024 + col);
#pragma unroll
                        for (int e = 0; e < 4; ++e) { f[2 * e] *= fast_rcp(bflo(g2[e])); f[2 * e + 1] *= fast_rcp(bfhi(g2[e])); }
                    }
                    f32x4& v0 = acc[ai][bj][m][0]; f32x4& v1 = acc[ai][bj][m][1];
#pragma unroll
                    for (int e = 0; e < 4; ++e) { v0[e] *= f[e]; v1[e] *= f[4 + e]; }
                    if (seg == 2) {
                        u32x4 o; o[0] = cvt_pk_bf16(v0[0], v0[1]); o[1] = cvt_pk_bf16(v0[2], v0[3]); o[2] = cvt_pk_bf16(v1[0], v1[1]); o[3] = cvt_pk_bf16(v1[2], v1[3]);
                        *(u32x4*)(MERGED + (size_t)row * 1024 + col) = o;
                    }
                }
            }
        return seg < 2;
    }
};
struct SchedP4 {
    int G, c; const char* A; const char* B;
    __device__ __forceinline__ bool next(int i, Unit& u) const {
        const int tl = i * G + c;
        if (tl >= 272) return false;
        u.x = tl >> 2; u.y = tl & 3; u.z = 0;
        u.a = A + (size_t)u.x * 256 * 2048; u.b = B + (size_t)u.y * 256 * 2048;
        return true;
    }
};
struct EpiP4 {
    const float* xp; const float* xs; float* out; float* SUMSQ;
    __device__ __forceinline__ bool operator()(f32x4 (&acc)[2][2][4][2], const Unit& u, int wr, int wc, int fr, int fq) const {
        const int rbase = u.x * 256 + wr * 64 + fr, cbase = u.y * 256 + wc * 32 + fq * 4;
#pragma unroll
        for (int ai = 0; ai < 2; ++ai)
#pragma unroll
            for (int m = 0; m < 4; ++m) {
                const int row = rbase + ai * 128 + m * 16;
                const float* xr = row < MP ? xp + (size_t)row * 1024 : xs + (size_t)(row - MP) * 1024;
                float ss = 0.f;
#pragma unroll
                for (int bj = 0; bj < 2; ++bj)
#pragma unroll
                    for (int n = 0; n < 2; ++n) {
                        const int col = cbase + bj * 128 + n * 16;
                        const f32x4 v = acc[ai][bj][m][n] + *(const f32x4*)(xr + col);
                        ss += v[0] * v[0] + v[1] * v[1] + v[2] * v[2] + v[3] * v[3];
                        *(f32x4*)(out + OUT_Y + (size_t)row * 1024 + col) = v;
                    }
                ss += __shfl_xor(ss, 16, 64); ss += __shfl_xor(ss, 32, 64);
                if (fq == 0) SUMSQ[(size_t)row * 16 + u.y * 4 + wc] = ss;
            }
        return false;
    }
};
__device__ void phase5(const Params& p) {
    const int lane = threadIdx.x & 63, wid = threadIdx.x >> 6;
    const float* SUMSQ = (const float*)(p.ws + WS_SUMSQ);
    for (int row = blockIdx.x * 8 + wid; row < MALL; row += gridDim.x * 8) {
        float ss = lane < 16 ? SUMSQ[(size_t)row * 16 + lane] : 0.f;
        ss = wave_sum(ss);
        const float inv = rsqrtf(ss * (1.0f / 1024.0f) + 1e-6f);
        float* y = p.out + OUT_Y + (size_t)row * 1024;
#pragma unroll
        for (int i = 0; i < 4; ++i) {
            f32x4 v = *(const f32x4*)(y + i * 256 + lane * 4); const f32x4 g = *(const f32x4*)(p.norm_final + i * 256 + lane * 4);
            v = v * inv * g;
            *(f32x4*)(y + i * 256 + lane * 4) = v;
        }
    }
}

__global__ void __launch_bounds__(NTHREADS) fwd_megakernel(Params p) {
    extern __shared__ __attribute__((aligned(16))) unsigned char smem[];
    cg::grid_group grid = cg::this_grid();
    LAS unsigned char* lds = (LAS unsigned char*)smem;
    phase0(p, smem);
    grid.sync();
    {
        SchedP1 S{(int)gridDim.x, (int)blockIdx.x, (const char*)(p.ws + WS_AALL), (const char*)(p.ws + WS_BALL)};
        EpiP1 E{(bf16_t*)(p.ws + WS_U), (bf16_t*)(p.ws + WS_BG), (bf16_t*)(p.ws + WS_ACT), p.out, (bf16_t*)(p.ws + WS_KBF), (bf16_t*)(p.ws + WS_VT)};
        gemm_phase(lds, 2048, 2048, 1024, S, E);
    }
    grid.sync();
    phase2(p, smem);
    grid.sync();
    phase2b(p);
    grid.sync();
    {
        SchedP3 S{(int)gridDim.x, (int)blockIdx.x, (const char*)p.ws};
        EpiP3 E{(const bf16_t*)(p.ws + WS_ACT), (bf16_t*)(p.ws + WS_MERGED)};
        gemm_phase(lds, 2048, 2048, 1024, S, E);
    }
    grid.sync();
    {
        SchedP4 S{(int)gridDim.x, (int)blockIdx.x, (const char*)(p.ws + WS_MERGED), (const char*)(p.ws + WS_WO)};
        EpiP4 E{p.x_prompt, p.x_sample, p.out, (float*)(p.ws + WS_SUMSQ)};
        gemm_phase(lds, 2048, 2048, 1024, S, E);
    }
    grid.sync();
    phase5(p);
}

extern "C" void kernel_launch(void* const* d_in, const int* in_sizes, int n_in, void* d_out, int out_size, void* d_ws, size_t ws_size, hipStream_t stream) {
    static int grid_blocks = 0;
    if (!grid_blocks) {
        int dev = 0, cus = 0, per_cu = 0;
        hipGetDevice(&dev);
        hipDeviceGetAttribute(&cus, hipDeviceAttributeMultiprocessorCount, dev);
        if (hipFuncSetAttribute((const void*)fwd_megakernel, hipFuncAttributeMaxDynamicSharedMemorySize, LDS_BYTES) != hipSuccess) fprintf(stderr, "hipFuncSetAttribute failed\n");
        hipOccupancyMaxActiveBlocksPerMultiprocessor(&per_cu, (const void*)fwd_megakernel, NTHREADS, LDS_BYTES);
        if (per_cu < 1) { fprintf(stderr, "occupancy query returned %d\n", per_cu); per_cu = 1; }
        if (per_cu > 1) per_cu = 1;
        grid_blocks = cus * per_cu;
        if (ws_size < WS_END) { fprintf(stderr, "workspace too small: %zu < %zu\n", ws_size, (size_t)WS_END); grid_blocks = -1; }
    }
    if (grid_blocks < 0) return;
    Params p{};
    const float** pp = (const float**)&p;
    for (int i = 0; i < 27; ++i) pp[i] = (const float*)d_in[i];
    p.out = (float*)d_out; p.ws = (unsigned char*)d_ws;
    void* args[] = {&p};
    hipError_t e = hipLaunchCooperativeKernel((const void*)fwd_megakernel, dim3(grid_blocks), dim3(NTHREADS), args, LDS_BYTES, stream);
    if (e != hipSuccess) fprintf(stderr, "cooperative launch failed: %s (grid %d)\n", hipGetErrorString(e), grid_blocks);
}
```

```cpp
#include <hip/hip_runtime.h>
#include <hip/hip_cooperative_groups.h>
#include <cstdio>
namespace cg = cooperative_groups;

#define LAS __attribute__((address_space(3)))
typedef unsigned short bf16_t;
typedef short bf16x8 __attribute__((ext_vector_type(8)));
typedef float f32x4 __attribute__((ext_vector_type(4)));
typedef float f32x2 __attribute__((ext_vector_type(2)));
typedef unsigned u32x4 __attribute__((ext_vector_type(4)));
typedef unsigned u32x2 __attribute__((ext_vector_type(2)));

constexpr int DM = 1024, TP = 2048, BP = 8, MP = BP * TP, BS = 128, TS = 8, MS = BS * TS, MALL = MP + MS;
constexpr int NMEM = 256, DIN = 13440, DSHIFT = 3200;
constexpr int NPAD = 13568;
constexpr int ACT_LD = 9472;
constexpr int C_PR = 0, C_PK = 1024, C_PV = 2048, C_WD = 3072, C_AD = 3136, C_SGR = 3328, C_QM = 4352, C_SGM = 5376, C_GATE = 6400;
constexpr size_t OUT_Y = 0, OUT_MK = 17825792, OUT_MV = 19922944, OUT_CONV_P = 22020096, OUT_SHIFT_P = 22036480, OUT_WKV_P = 22062080,
                 OUT_CONV_S = 22586368, OUT_SHIFT_S = 22848512, OUT_WKV_S = 23258112;
constexpr size_t al256(size_t x) { return (x + 255) & ~(size_t)255; }
constexpr size_t WS_AALL = 0;
constexpr size_t WS_BALL = al256(WS_AALL + (size_t)19456 * 1024 * 2);
constexpr size_t WS_YMEM = WS_AALL;
constexpr size_t WS_YCONV = WS_AALL + (size_t)MALL * 1024 * 2;
constexpr size_t WS_WB = al256(WS_BALL + (size_t)15616 * 1024 * 2);
constexpr size_t WS_WO = al256(WS_WB + (size_t)3072 * 1024 * 2);
constexpr size_t WS_U = al256(WS_WO + (size_t)1024 * 1024 * 2);
constexpr size_t WS_MERGED = WS_U;
constexpr size_t WS_BG = al256(WS_U + (size_t)MALL * 1024 * 2);
constexpr size_t WS_ACT = al256(WS_BG + (size_t)MALL * 1024 * 2);
constexpr size_t WS_KBF = al256(WS_ACT + (size_t)MALL * ACT_LD * 2);
constexpr size_t WS_VT = al256(WS_KBF + (size_t)2048 * 1024 * 2);
constexpr size_t WS_YRWKV = al256(WS_VT + (size_t)2048 * 1024 * 2);
constexpr size_t WS_C3 = al256(WS_YRWKV + (size_t)MALL * 1024 * 2);
constexpr size_t WS_SUMSQ = al256(WS_C3 + (size_t)MALL * 16 * 4);
constexpr size_t WS_END = al256(WS_SUMSQ + (size_t)MALL * 16 * 4);
static_assert(WS_YCONV + (size_t)MALL * 1024 * 2 <= WS_WB, "alias overflow");
static_assert(WS_END <= 536870912, "workspace too large");

constexpr int NTHREADS = 512;
constexpr int LDS_BYTES = 131072;

struct Params {
    const float *x_prompt, *x_sample, *mem_prompt, *cache_k, *cache_v, *state_conv, *state_shift, *state_wkv, *norm_in, *w_in, *conv_w, *conv_b,
        *shift_mu, *decay_w0, *decay_up, *icl_a0, *icl_up, *k_k, *k_a, *r_k, *ln_g, *ln_b, *norm_mem, *w_mem_kv, *w_branch, *w_out, *norm_final;
    float* out;
    unsigned char* ws;
};

__device__ __forceinline__ float bf2f(bf16_t v) { return __uint_as_float(((unsigned)v) << 16); }
__device__ __forceinline__ unsigned cvt_pk_bf16(float lo, float hi) { unsigned r; asm volatile("v_cvt_pk_bf16_f32 %0, %1, %2" : "=v"(r) : "v"(lo), "v"(hi)); return r; }
__device__ __forceinline__ float bflo(unsigned u) { return __uint_as_float(u << 16); }
__device__ __forceinline__ float bfhi(unsigned u) { return __uint_as_float(u & 0xffff0000u); }
__device__ __forceinline__ float fast_rcp(float x) { return __builtin_amdgcn_rcpf(x); }
__device__ __forceinline__ float sigmoidf_(float x) { return fast_rcp(1.0f + __expf(-x)); }
__device__ __forceinline__ float siluf_(float x) { return x * sigmoidf_(x); }
__device__ __forceinline__ float wave_sum(float v) {
#pragma unroll
    for (int o = 32; o > 0; o >>= 1) v += __shfl_xor(v, o, 64);
    return v;
}
template <int CTRL> __device__ __forceinline__ float dpp_f(float x) {
    return __int_as_float(__builtin_amdgcn_update_dpp(0, __float_as_int(x), CTRL, 0xF, 0xF, true));
}
__device__ __forceinline__ float row16_sum(float x) {
    x += dpp_f<0xB1>(x);
    x += dpp_f<0x4E>(x);
    x += dpp_f<0x141>(x);
    x += dpp_f<0x140>(x);
    return x;
}

constexpr int BM = 256, BK = 64, HALF = 128, HTB = HALF * BK * 2;
__device__ __forceinline__ int lds_byte(int r, int c) { const int st = (r >> 4) * 2 + (c >> 5), rr = r & 15, cc = c & 31, ob = rr * 64 + cc * 2; return st * 1024 + (ob ^ (((ob >> 9) & 1) << 5)); }
__device__ __forceinline__ void stage_rc(int b, int& R, int& C) { const int st = b / 1024, sb = b % 1024, swz = sb ^ (((sb >> 9) & 1) << 5); R = (st >> 1) * 16 + swz / 64; C = (st & 1) * 32 + (swz % 64) / 2; }

struct Unit { const char* a; const char* b; int x, y, z; };

template <class Sched, class Epi>
__device__ __forceinline__ void gemm_phase(LAS unsigned char* lds, const int lda, const int ldb, const int K, const Sched& S, const Epi& E) {
    const int tid = threadIdx.x, wid = __builtin_amdgcn_readfirstlane(tid >> 6), lane = tid & 63, wr = wid >> 2, wc = wid & 3, fr = lane & 15, fq = lane >> 4;
    const int nt = K / BK;
    unsigned voffA[2], voffB[2];
#pragma unroll
    for (int i = 0; i < 2; ++i) { int R, C; stage_rc(tid * 16 + i * 8192, R, C); voffA[i] = (unsigned)(R * lda + C * 2); voffB[i] = (unsigned)(R * ldb + C * 2); }
    const size_t kstep = (size_t)(BK * 2);
    const size_t hA = (size_t)HALF * lda, hB = (size_t)HALF * ldb;
    const unsigned ldsw = (unsigned)wid * 1024u;
    const int aoff = lds_byte(wr * 64 + fr, fq * 8), boff = lds_byte(wc * 32 + fr, fq * 8);
#define G_SA(b, h) (((b) * 2 + (h)) * HTB)
#define G_SB(b, h) ((4 + (b) * 2 + (h)) * HTB)
#define G_STAGE(bufoff, gbase, voff) do { _Pragma("unroll") for (int _i = 0; _i < 2; ++_i) \
        __builtin_amdgcn_global_load_lds((const unsigned*)((const char*)(gbase) + (voff)[_i]), (LAS unsigned*)(lds + (bufoff) + ldsw + _i * 8192), 16, 0, 0); } while (0)
#define G_LDA(dst, b, h) do { _Pragma("unroll") for (int m = 0; m < 4; ++m) _Pragma("unroll") for (int k = 0; k < 2; ++k) dst[m][k] = *(const LAS bf16x8*)(lds + G_SA(b, h) + aoff + m * 2048 + k * 1024); } while (0)
#define G_LDB(dst, b, h) do { _Pragma("unroll") for (int n = 0; n < 2; ++n) _Pragma("unroll") for (int k = 0; k < 2; ++k) dst[n][k] = *(const LAS bf16x8*)(lds + G_SB(b, h) + boff + n * 2048 + k * 1024); } while (0)
#define G_MMA(ai, bj, At, Bt) do { __builtin_amdgcn_s_setprio(1); _Pragma("unroll") for (int m = 0; m < 4; ++m) _Pragma("unroll") for (int n = 0; n < 2; ++n) _Pragma("unroll") for (int k = 0; k < 2; ++k) \
        acc[ai][bj][m][n] = __builtin_amdgcn_mfma_f32_16x16x32_bf16(Bt[n][k], At[m][k], acc[ai][bj][m][n], 0, 0, 0); __builtin_amdgcn_s_setprio(0); } while (0)
#define G_WAIT_V(n) asm volatile("s_waitcnt vmcnt(" #n ")" ::: "memory")
#define G_WAIT_L(n) asm volatile("s_waitcnt lgkmcnt(" #n ")" ::: "memory")
#define G_BAR __builtin_amdgcn_s_barrier()
#define G_SCHED __builtin_amdgcn_sched_barrier(0)
    Unit cur, nxt; int ui = 0;
    if (!S.next(0, cur)) return;
    f32x4 acc[2][2][4][2];
#pragma unroll
    for (int a = 0; a < 2; ++a)
#pragma unroll
        for (int b = 0; b < 2; ++b)
#pragma unroll
            for (int m = 0; m < 4; ++m)
#pragma unroll
                for (int n = 0; n < 2; ++n) acc[a][b][m][n] = (f32x4){0.f, 0.f, 0.f, 0.f};
    bf16x8 At[4][2], B0[2][2], B1[2][2];
    const char* cA = cur.a; const char* cB = cur.b;
    G_STAGE(G_SB(0, 0), cB, voffB); G_STAGE(G_SA(0, 0), cA, voffA); G_STAGE(G_SB(0, 1), cB + hB, voffB); G_STAGE(G_SA(0, 1), cA + hA, voffA);
    if (wr == 1) G_BAR;
    G_WAIT_V(4); G_BAR;
    G_STAGE(G_SB(1, 0), cB + kstep, voffB); G_STAGE(G_SA(1, 0), cA + kstep, voffA); G_STAGE(G_SB(1, 1), cB + hB + kstep, voffB);
    G_WAIT_V(6); G_BAR;
    for (;;) {
        const bool has_next = S.next(ui + 1, nxt);
        const char* nA = has_next ? nxt.a : cA; const char* nB = has_next ? nxt.b : cB;
        for (int t = 0; t < nt; t += 2) {
            const bool last = (t == nt - 2);
            const char* a1 = cA + (size_t)(t + 1) * kstep;
            const char* a2 = last ? nA : cA + (size_t)(t + 2) * kstep; const char* b2 = last ? nB : cB + (size_t)(t + 2) * kstep;
            const char* a3 = a2 + kstep; const char* b3 = b2 + kstep;
            G_LDB(B0, 0, 0); G_SCHED; G_LDA(At, 0, 0); G_STAGE(G_SA(1, 1), a1 + hA, voffA);
            G_WAIT_L(8); G_BAR; G_WAIT_L(0); G_MMA(0, 0, At, B0); G_BAR; G_SCHED;
            G_LDB(B1, 0, 1); G_STAGE(G_SB(0, 0), b2, voffB);
            G_BAR; G_WAIT_L(0); G_MMA(0, 1, At, B1); G_BAR;
            G_LDA(At, 0, 1); G_STAGE(G_SA(0, 0), a2, voffA);
            G_BAR; G_WAIT_L(0); G_MMA(1, 0, At, B0); G_BAR; G_SCHED;
            G_STAGE(G_SB(0, 1), b2 + hB, voffB);
            G_WAIT_V(6); G_BAR; G_MMA(1, 1, At, B1); G_BAR;
            G_LDB(B0, 1, 0); G_SCHED; G_LDA(At, 1, 0); G_STAGE(G_SA(0, 1), a2 + hA, voffA);
            G_WAIT_L(8); G_BAR; G_WAIT_L(0); G_MMA(0, 0, At, B0); G_BAR; G_SCHED;
            G_LDB(B1, 1, 1); G_STAGE(G_SB(1, 0), b3, voffB);
            G_BAR; G_WAIT_L(0); G_MMA(0, 1, At, B1); G_BAR;
            G_LDA(At, 1, 1); G_STAGE(G_SA(1, 0), a3, voffA);
            G_BAR; G_WAIT_L(0); G_MMA(1, 0, At, B0); G_BAR; G_SCHED;
            G_STAGE(G_SB(1, 1), b3 + hB, voffB);
            G_WAIT_V(6); G_BAR; G_MMA(1, 1, At, B1); G_BAR;
        }
        const bool keep = E(acc, cur, wr, wc, fr, fq);
        if (!has_next) break;
        if (!keep) {
#pragma unroll
            for (int a = 0; a < 2; ++a)
#pragma unroll
                for (int b = 0; b < 2; ++b)
#pragma unroll
                    for (int m = 0; m < 4; ++m)
#pragma unroll
                        for (int n = 0; n < 2; ++n) acc[a][b][m][n] = (f32x4){0.f, 0.f, 0.f, 0.f};
        }
        cur = nxt; cA = nA; cB = nB; ++ui;
    }
    G_WAIT_V(0);
    if (wr == 0) G_BAR;
    G_BAR;
#undef G_SA
#undef G_SB
#undef G_STAGE
#undef G_LDA
#undef G_LDB
#undef G_MMA
#undef G_WAIT_V
#undef G_WAIT_L
#undef G_BAR
#undef G_SCHED
}

__device__ __forceinline__ int perm8_local(int c) {
    const int bj = c >> 7, wc = (c >> 5) & 3, n = (c >> 4) & 1, fq = (c >> 2) & 3, e = c & 3;
    return 128 * bj + 32 * wc + 8 * fq + 4 * n + e;
}
__device__ __forceinline__ int colmap_in(int np) {
    const int j = np >> 8, c = np & 255;
    if (j < 16) {
        const int bj = c >> 7, wc = (c >> 5) & 3, n = (c >> 4) & 1, fq = (c >> 2) & 3, e = c & 3;
        return (2 * bj + n) * 1024 + j * 64 + wc * 16 + fq * 4 + e;
    }
    const int L = (j - 16) * 256 + perm8_local(c);
    if (L < 3200) return 4096 + L;
    if (L < 3328) return -1;
    return L + 3968;
}

__device__ void phase0(const Params& p, unsigned char* smem) {
    const int tid = threadIdx.x, lane = tid & 63, wid = tid >> 6;
    bf16_t* Aall = (bf16_t*)(p.ws + WS_AALL);
    for (int row = blockIdx.x * 8 + wid; row < 19456; row += gridDim.x * 8) {
        const float* src; const float* g;
        if (row < MP) { src = p.x_prompt + (size_t)row * 1024; g = p.norm_in; }
        else if (row < MALL) { src = p.x_sample + (size_t)(row - MP) * 1024; g = p.norm_in; }
        else { src = p.mem_prompt + (size_t)(row - MALL) * 1024; g = p.norm_mem; }
        f32x4 v[4]; float ss = 0.f;
#pragma unroll
        for (int i = 0; i < 4; ++i) { v[i] = *(const f32x4*)(src + i * 256 + lane * 4); ss += v[i][0] * v[i][0] + v[i][1] * v[i][1] + v[i][2] * v[i][2] + v[i][3] * v[i][3]; }
        ss = wave_sum(ss);
        const float inv = rsqrtf(ss * (1.0f / 1024.0f) + 1e-6f);
#pragma unroll
        for (int i = 0; i < 4; ++i) {
            const f32x4 gg = *(const f32x4*)(g + i * 256 + lane * 4);
            u32x2 o; o[0] = cvt_pk_bf16(v[i][0] * inv * gg[0], v[i][1] * inv * gg[1]); o[1] = cvt_pk_bf16(v[i][2] * inv * gg[2], v[i][3] * inv * gg[3]);
            *(u32x2*)(Aall + (size_t)row * 1024 + i * 256 + lane * 4) = o;
        }
    }
    bf16_t* T = (bf16_t*)smem;
    const int NT_IN = 212 * 16, NT_KV = 32 * 16, NT_WB = 3 * 16 * 16, NT_WO = 16 * 16;
    const int total = NT_IN + NT_KV + NT_WB + NT_WO;
    for (int tix = blockIdx.x; tix < total; tix += gridDim.x) {
        const float* src; int src_ld; bf16_t* dst; int n0, k0, mode;
        if (tix < NT_IN) { src = p.w_in; src_ld = DIN; dst = (bf16_t*)(p.ws + WS_BALL); n0 = (tix >> 4) * 64; k0 = (tix & 15) * 64; mode = 0; }
        else if (tix < NT_IN + NT_KV) { const int t2 = tix - NT_IN; src = p.w_mem_kv; src_ld = 2048; dst = (bf16_t*)(p.ws + WS_BALL) + (size_t)NPAD * 1024; n0 = (t2 >> 4) * 64; k0 = (t2 & 15) * 64; mode = 1; }
        else if (tix < NT_IN + NT_KV + NT_WB) { const int t2 = tix - NT_IN - NT_KV; const int i = t2 >> 8, t3 = t2 & 255; src = p.w_branch + (size_t)i * 1024 * 1024; src_ld = 1024;
            dst = (bf16_t*)(p.ws + WS_WB) + (size_t)i * 1024 * 1024; n0 = (t3 >> 4) * 64; k0 = (t3 & 15) * 64; mode = 2; }
        else { const int t3 = tix - NT_IN - NT_KV - NT_WB; src = p.w_out; src_ld = 1024; dst = (bf16_t*)(p.ws + WS_WO); n0 = (t3 >> 4) * 64; k0 = (t3 & 15) * 64; mode = 1; }
        {
            const int kk = tid >> 3, seg = tid & 7;
#pragma unroll
            for (int q = 0; q < 2; ++q) {
                const int nl = seg * 8 + q * 4, np = n0 + nl;
                int sc;
                if (mode == 0) sc = colmap_in(np);
                else if (mode == 1) sc = np;
                else sc = (np & ~255) + perm8_local(np & 255);
                f32x4 v = (f32x4){0.f, 0.f, 0.f, 0.f};
                if (sc >= 0) v = *(const f32x4*)(src + (size_t)(k0 + kk) * src_ld + sc);
                const unsigned a = cvt_pk_bf16(v[0], v[1]), b = cvt_pk_bf16(v[2], v[3]);
                T[(nl + 0) * 72 + kk] = (bf16_t)(a & 0xffff); T[(nl + 1) * 72 + kk] = (bf16_t)(a >> 16);
                T[(nl + 2) * 72 + kk] = (bf16_t)(b & 0xffff); T[(nl + 3) * 72 + kk] = (bf16_t)(b >> 16);
            }
        }
        __syncthreads();
        {
            const int nl = tid >> 3, ks = tid & 7;
            const u32x4 v = *(const u32x4*)(T + nl * 72 + ks * 8);
            *(u32x4*)(dst + (size_t)(n0 + nl) * 1024 + k0 + ks * 8) = v;
        }
        __syncthreads();
    }
}

struct SchedP1 {
    int G, c; const char* Aall; const char* Ball;
    __device__ __forceinline__ bool next(int i, Unit& u) const {
        const int L = i * G + c;
        constexpr int nM = 68, nN = 53, nwg = nM * nN, WGM = 8;
        if (L >= nwg + 96) return false;
        if (L < nwg) {
            int wgid = L; { const int q = nwg / 8, r = nwg % 8, xcd = wgid % 8, off = wgid / 8; wgid = (xcd < r ? xcd * (q + 1) : r * (q + 1) + (xcd - r) * q) + off; }
            const int nig = WGM * nN, gid = wgid / nig, fm = gid * WGM, gsz = (nM - fm) < WGM ? (nM - fm) : WGM;
            u.x = fm + ((wgid % nig) % gsz); u.y = (wgid % nig) / gsz; u.z = 0;
            u.a = Aall + (size_t)u.x * 256 * 2048; u.b = Ball + (size_t)u.y * 256 * 2048;
        } else {
            int k = L - nwg;
            if (k < 32) { u.x = k >> 2; u.y = k & 3; u.z = 1; u.a = Aall + (size_t)(68 + u.x) * 256 * 2048; u.b = Ball + (size_t)(53 + u.y) * 256 * 2048; }
            else if (k < 64) { k -= 32; u.x = k >> 2; u.y = k & 3; u.z = 2; u.a = Aall + (size_t)(68 + u.x) * 256 * 2048; u.b = Ball + (size_t)(57 + u.y) * 256 * 2048; }
            else { k -= 64; u.x = k >> 3; u.y = k & 7; u.z = 3; u.a = Ball + (size_t)(57 + u.x) * 256 * 2048; u.b = Aall + (size_t)(68 + u.y) * 256 * 2048; }
        }
        return true;
    }
};

struct EpiP1 {
    bf16_t* U; bf16_t* BG; bf16_t* ACT; float* out; bf16_t* Kbf; bf16_t* Vt;
    __device__ __forceinline__ bool operator()(f32x4 (&acc)[2][2][4][2], const Unit& u, int wr, int wc, int fr, int fq) const {
        const int type = u.z;
        if (type == 0) {
            const int pn = u.y, rbase = u.x * 256 + wr * 64 + fr;
            if (pn < 16) {
                const int ch0 = pn * 64 + wc * 16 + fq * 4;
#pragma unroll
                for (int ai = 0; ai < 2; ++ai)
#pragma unroll
                    for (int m = 0; m < 4; ++m) {
                        const int row = rbase + ai * 128 + m * 16;
                        const f32x4 h = acc[ai][0][m][0], Bv = acc[ai][0][m][1], Cv = acc[ai][1][m][0], g = acc[ai][1][m][1];
                        const f32x4 u4 = Cv * h;
                        f32x4 bg;
#pragma unroll
                        for (int e = 0; e < 4; ++e) bg[e] = Bv[e] * siluf_(g[e]);
                        u32x2 o; o[0] = cvt_pk_bf16(u4[0], u4[1]); o[1] = cvt_pk_bf16(u4[2], u4[3]);
                        *(u32x2*)(U + (size_t)row * 1024 + ch0) = o;
                        o[0] = cvt_pk_bf16(bg[0], bg[1]); o[1] = cvt_pk_bf16(bg[2], bg[3]);
                        *(u32x2*)(BG + (size_t)row * 1024 + ch0) = o;
                        if (row < MP) { const int t = row & 2047; if (t >= 2046) *(f32x4*)(out + OUT_CONV_P + (size_t)((row >> 11) * 2 + (t - 2046)) * 1024 + ch0) = u4; }
                        else { const int rs = row - MP, t = rs & 7; if (t >= 6) *(f32x4*)(out + OUT_CONV_S + (size_t)((rs >> 3) * 2 + (t - 6)) * 1024 + ch0) = u4; }
                    }
            } else {
                const int L0 = (pn - 16) * 256;
                const int kind = pn <= 28 ? 0 : pn <= 32 ? 1 : pn <= 36 ? 2 : pn <= 40 ? 1 : 3;
#pragma unroll
                for (int ai = 0; ai < 2; ++ai)
#pragma unroll
                    for (int m = 0; m < 4; ++m) {
                        const int row = rbase + ai * 128 + m * 16;
#pragma unroll
                        for (int bj = 0; bj < 2; ++bj) {
                            const int L = L0 + 128 * bj + 32 * wc + 8 * fq;
                            f32x4 v0 = acc[ai][bj][m][0], v1 = acc[ai][bj][m][1];
                            if (kind == 0) {
                                if (L < DSHIFT) {
                                    if (row < MP) { if ((row & 2047) == 2047) { float* d = out + OUT_SHIFT_P + (size_t)(row >> 11) * DSHIFT + L; *(f32x4*)d = v0; *(f32x4*)(d + 4) = v1; } }
                                    else { const int rs = row - MP; if ((rs & 7) == 7) { float* d = out + OUT_SHIFT_S + (size_t)(rs >> 3) * DSHIFT + L; *(f32x4*)d = v0; *(f32x4*)(d + 4) = v1; } }
                                }
                            } else if (kind == 1) {
#pragma unroll
                                for (int e = 0; e < 4; ++e) { v0[e] = siluf_(v0[e]); v1[e] = siluf_(v1[e]); }
                            } else if (kind == 2) { v0 *= 0.0625f; v1 *= 0.0625f; }
                            else {
#pragma unroll
                                for (int e = 0; e < 4; ++e) { v0[e] = sigmoidf_(v0[e]); v1[e] = sigmoidf_(v1[e]); }
                            }
                            u32x4 o; o[0] = cvt_pk_bf16(v0[0], v0[1]); o[1] = cvt_pk_bf16(v0[2], v0[3]); o[2] = cvt_pk_bf16(v1[0], v1[1]); o[3] = cvt_pk_bf16(v1[2], v1[3]);
                            *(u32x4*)(ACT + (size_t)row * ACT_LD + L) = o;
                        }
                    }
            }
        } else {
            const int rbase = u.x * 256 + wr * 64 + fr, cbase = u.y * 256 + wc * 32 + fq * 4;
#pragma unroll
            for (int ai = 0; ai < 2; ++ai)
#pragma unroll
                for (int m = 0; m < 4; ++m) {
                    const int row = rbase + ai * 128 + m * 16;
#pragma unroll
                    for (int bj = 0; bj < 2; ++bj)
#pragma unroll
                        for (int n = 0; n < 2; ++n) {
                            const int col = cbase + bj * 128 + n * 16;
                            const f32x4 v = acc[ai][bj][m][n];
                            if (type == 1) { *(f32x4*)(out + OUT_MK + (size_t)row * 1024 + col) = v;
                                u32x2 o; o[0] = cvt_pk_bf16(v[0], v[1]); o[1] = cvt_pk_bf16(v[2], v[3]); *(u32x2*)(Kbf + (size_t)row * 1024 + col) = o; }
                            else if (type == 2) { *(f32x4*)(out + OUT_MV + (size_t)row * 1024 + col) = v; }
                            else { u32x2 o; o[0] = cvt_pk_bf16(v[0], v[1]); o[1] = cvt_pk_bf16(v[2], v[3]); *(u32x2*)(Vt + (size_t)row * 2048 + col) = o; }
                        }
                }
        }
        return false;
    }
};

struct ChunkDesc { int r0, b, h, half, samp, t0, n, first, last; };
__device__ __forceinline__ bool chunk_desc(const int ci, const int bid, const int G, ChunkDesc& d) {
    const int n_long = bid < 256 ? (255 - bid) / G + 1 : 0;
    const int n_samp = bid < 4096 ? (4095 - bid) / G + 1 : 0;
    const int nc_long = n_long * 64;
    if (ci < nc_long) { const int k = ci >> 6, it = bid + k * G, chain = it >> 1; d.b = chain >> 4; d.h = chain & 15; d.half = it & 1; d.samp = 0; d.r0 = d.b * TP;
        d.t0 = (ci & 63) * 32; d.n = 32; d.first = (ci & 63) == 0; d.last = (ci & 63) == 63; return true; }
    const int k = ci - nc_long; if (k >= n_samp) return false;
    const int it = bid + k * G, chain = it >> 1; d.b = chain >> 4; d.h = chain & 15; d.half = it & 1; d.samp = 1; d.r0 = MP + d.b * TS; d.t0 = 0; d.n = 8; d.first = 1; d.last = 1; return true;
}
constexpr int SROW = 68;
constexpr int SBUF = 6 * 32 * SROW + 64;
__device__ __forceinline__ f32x2 lo2(const f32x4 v) { return __builtin_shufflevector(v, v, 0, 1); }
__device__ __forceinline__ f32x2 hi2(const f32x4 v) { return __builtin_shufflevector(v, v, 2, 3); }
__device__ __forceinline__ float tanh_fast(float x) { return 1.0f - 2.0f * fast_rcp(1.0f + __expf(2.0f * x)); }

__device__ __forceinline__ void unpack4(const u32x2 v, float (&o)[4]) { o[0] = bflo(v[0]); o[1] = bfhi(v[0]); o[2] = bflo(v[1]); o[3] = bfhi(v[1]); }

__device__ __forceinline__ void prev4(const bf16_t* prv, const float* st, const bool isfirst, const bool samp, const int col, float (&o)[4]) {
    if (!isfirst) unpack4(*(const u32x2*)(prv + col), o);
    else if (samp) { const f32x4 v = *(const f32x4*)(st + col); o[0] = v[0]; o[1] = v[1]; o[2] = v[2]; o[3] = v[3]; }
    else { o[0] = 0.f; o[1] = 0.f; o[2] = 0.f; o[3] = 0.f; }
}

__device__ __forceinline__ void prep_pass(const Params& p, const ChunkDesc& d, const int tb, float* buf, const float* par, const bf16x8 (&Wf)[4][2], const bf16x8 (&Af)[4][2], const int lane) {
    const int fr = lane & 15, fq = lane >> 4;
    const int t = tb + fr; const bool valid = t < d.n; const int tt = valid ? t : d.n - 1;
    const size_t row = (size_t)(d.r0 + d.t0 + tt);
    const bool isfirst = (d.t0 + tt) == 0, samp = d.samp != 0;
    const bf16_t* cur = (const bf16_t*)(p.ws + WS_ACT) + row * ACT_LD;
    const bf16_t* prv = cur - ACT_LD;
    const float* st = p.state_shift + (size_t)d.b * DSHIFT;
    bf16x8 bw[2], ba[2];
#pragma unroll
    for (int ks = 0; ks < 2; ++ks) {
#pragma unroll
        for (int which = 0; which < 2; ++which) {
            const int col = (which ? C_AD : C_WD) + ks * 32 + fq * 8;
            float c0[4], c1[4], q0[4], q1[4];
            const u32x4 cv = *(const u32x4*)(cur + col);
            unpack4((u32x2){cv[0], cv[1]}, c0); unpack4((u32x2){cv[2], cv[3]}, c1);
            prev4(prv, st, isfirst, samp, col, q0); prev4(prv, st, isfirst, samp, col + 4, q1);
            const f32x4 m0 = *(const f32x4*)(p.shift_mu + col), m1 = *(const f32x4*)(p.shift_mu + col + 4);
            float x[8];
#pragma unroll
            for (int e = 0; e < 4; ++e) { x[e] = c0[e] + m0[e] * (q0[e] - c0[e]); x[4 + e] = c1[e] + m1[e] * (q1[e] - c1[e]); }
            if (!which) {
#pragma unroll
                for (int e = 0; e < 8; ++e) x[e] = tanh_fast(x[e]);
            }
            u32x4 pk; pk[0] = cvt_pk_bf16(x[0], x[1]); pk[1] = cvt_pk_bf16(x[2], x[3]); pk[2] = cvt_pk_bf16(x[4], x[5]); pk[3] = cvt_pk_bf16(x[6], x[7]);
            if (which) ba[ks] = __builtin_bit_cast(bf16x8, pk); else bw[ks] = __builtin_bit_cast(bf16x8, pk);
        }
    }
    f32x4 aw[4], aa[4];
#pragma unroll
    for (int it = 0; it < 4; ++it) {
        aw[it] = (f32x4){0.f, 0.f, 0.f, 0.f}; aa[it] = aw[it];
#pragma unroll
        for (int ks = 0; ks < 2; ++ks) {
            aw[it] = __builtin_amdgcn_mfma_f32_16x16x32_bf16(Wf[it][ks], bw[ks], aw[it], 0, 0, 0);
            aa[it] = __builtin_amdgcn_mfma_f32_16x16x32_bf16(Af[it][ks], ba[ks], aa[it], 0, 0, 0);
        }
    }
    const int hc = d.h * 64 + 4 * fq;
    float ksf[16]; float ss = 0.f;
#pragma unroll
    for (int it = 0; it < 4; ++it) {
        float kc[4], kq[4];
        unpack4(*(const u32x2*)(cur + C_PK + hc + it * 16), kc); prev4(prv, st, isfirst, samp, C_PK + hc + it * 16, kq);
        const f32x4 mk = *(const f32x4*)(par + 64 + it * 16 + 4 * fq), kkp = *(const f32x4*)(par + 5 * 64 + it * 16 + 4 * fq);
#pragma unroll
        for (int e = 0; e < 4; ++e) { const float k_ = kc[e] + mk[e] * (kq[e] - kc[e]); ksf[it * 4 + e] = k_; const float kr = k_ * kkp[e]; ss += kr * kr; }
    }
    ss += __shfl_xor(ss, 16, 64); ss += __shfl_xor(ss, 32, 64);
    const float rn = rsqrtf(ss + 1e-12f);
    float c1 = 0.f, c2 = 0.f, c3 = 0.f;
    float* kkA = buf; float* wrA = buf + 32 * SROW; float* wA = buf + 2 * 32 * SROW; float* bA = buf + 3 * 32 * SROW; float* kpA = buf + 4 * 32 * SROW; float* vsA = buf + 5 * 32 * SROW; float* c12 = buf + 6 * 32 * SROW;
#pragma unroll
    for (int it = 0; it < 4; ++it) {
        float rc[4], rq[4], vc[4], vq[4];
        unpack4(*(const u32x2*)(cur + C_PR + hc + it * 16), rc); prev4(prv, st, isfirst, samp, C_PR + hc + it * 16, rq);
        unpack4(*(const u32x2*)(cur + C_PV + hc + it * 16), vc); prev4(prv, st, isfirst, samp, C_PV + hc + it * 16, vq);
        const int po = it * 16 + 4 * fq;
        const f32x4 mr = *(const f32x4*)(par + po), mv = *(const f32x4*)(par + 2 * 64 + po), w0 = *(const f32x4*)(par + 3 * 64 + po), a0 = *(const f32x4*)(par + 4 * 64 + po),
                    kkp = *(const f32x4*)(par + 5 * 64 + po), ka = *(const f32x4*)(par + 6 * 64 + po), rk = *(const f32x4*)(par + 7 * 64 + po);
        f32x4 o_kk, o_wr, o_w, o_b, o_kp, o_vs;
#pragma unroll
        for (int e = 0; e < 4; ++e) {
            const float r_ = rc[e] + mr[e] * (rq[e] - rc[e]);
            const float v_ = vc[e] + mv[e] * (vq[e] - vc[e]);
            const float k_ = ksf[it * 4 + e];
            const float dec = __expf(-0.6065306597f * sigmoidf_(aw[it][e] + w0[e]));
            const float a = sigmoidf_(aa[it][e] + a0[e]);
            const float kn = k_ * kkp[e] * rn;
            const float kpv = k_ * (1.0f + (a - 1.0f) * ka[e]);
            const float bv = kn * a;
            c1 += bv * r_; c2 += kpv * r_; c3 += r_ * kpv * rk[e];
            o_kk[e] = kn; o_wr[e] = dec * r_; o_w[e] = dec; o_b[e] = bv; o_kp[e] = kpv; o_vs[e] = v_;
        }
        if (valid) {
            const int o = t * SROW + po;
            *(f32x4*)(kkA + o) = o_kk; *(f32x4*)(wrA + o) = o_wr; *(f32x4*)(wA + o) = o_w; *(f32x4*)(bA + o) = o_b; *(f32x4*)(kpA + o) = o_kp; *(f32x4*)(vsA + o) = o_vs;
        }
    }
    c1 += __shfl_xor(c1, 16, 64); c1 += __shfl_xor(c1, 32, 64);
    c2 += __shfl_xor(c2, 16, 64); c2 += __shfl_xor(c2, 32, 64);
    c3 += __shfl_xor(c3, 16, 64); c3 += __shfl_xor(c3, 32, 64);
    if (valid && fq == 0) { c12[t * 2] = c1; c12[t * 2 + 1] = c2; if (d.half == 0) ((float*)(p.ws + WS_C3))[row * 16 + d.h] = c3; }
}

__device__ void phase2_scan(const Params& p, unsigned char* smem) {
    const int tid = threadIdx.x, lane = tid & 63, wid = __builtin_amdgcn_readfirstlane(tid >> 6);
    const int bid = blockIdx.x, G = gridDim.x;
    float* sm = (float*)smem;
    float* bufs = sm;
    float* obuf = sm + 2 * SBUF;
    float* parb = obuf + 2 * 1024;
    const int n_long = bid < 256 ? (255 - bid) / G + 1 : 0, n_samp = bid < 4096 ? (4095 - bid) / G + 1 : 0;
    const int NC = n_long * 64 + n_samp;
    float* ORAW = p.out + OUT_Y;
    __syncthreads();
    bf16x8 Wf[4][2], Af[4][2];
    int cur_h = -1;
    float* par = parb + (wid & 1) * 512;
    auto prep = [&](const int ci) {
        ChunkDesc d;
        if (!chunk_desc(ci, bid, G, d)) return;
        if (d.h != cur_h) {
            cur_h = d.h;
            const int fr = lane & 15, fq = lane >> 4;
#pragma unroll
            for (int it = 0; it < 4; ++it)
#pragma unroll
                for (int ks = 0; ks < 2; ++ks) {
                    float w[8], a[8];
#pragma unroll
                    for (int jj = 0; jj < 8; ++jj) { const size_t o = (size_t)(ks * 32 + fq * 8 + jj) * 1024 + d.h * 64 + it * 16 + fr; w[jj] = p.decay_up[o]; a[jj] = p.icl_up[o]; }
                    u32x4 pw, pa;
#pragma unroll
                    for (int q = 0; q < 4; ++q) { pw[q] = cvt_pk_bf16(w[2 * q], w[2 * q + 1]); pa[q] = cvt_pk_bf16(a[2 * q], a[2 * q + 1]); }
                    Wf[it][ks] = __builtin_bit_cast(bf16x8, pw); Af[it][ks] = __builtin_bit_cast(bf16x8, pa);
                }
            const int ch = d.h * 64 + lane;
            par[lane] = p.shift_mu[ch]; par[64 + lane] = p.shift_mu[1024 + ch]; par[128 + lane] = p.shift_mu[2048 + ch]; par[192 + lane] = p.decay_w0[ch];
            par[256 + lane] = p.icl_a0[ch]; par[320 + lane] = p.k_k[ch]; par[384 + lane] = p.k_a[ch]; par[448 + lane] = p.r_k[ch];
        }
        const int tb = (wid & 1) * 16;
        if (tb < d.n) prep_pass(p, d, tb, bufs + (ci & 1) * SBUF, par, Wf, Af, lane);
    };
    if (wid < 4) {
        const int c = lane & 15, rg = lane >> 4, rl = wid * 8 + rg * 2;
        f32x2 s00 = (f32x2){0.f, 0.f}, s01 = s00, s10 = s00, s11 = s00;
        __syncthreads();
        for (int ci = 0; ci < NC; ++ci) {
            ChunkDesc d; chunk_desc(ci, bid, G, d);
            const size_t st_off = ((size_t)(d.b * 16 + d.h) * 64 + d.half * 32 + rl) * 64 + 4 * c;
            if (d.first) {
                if (d.samp) { const f32x4 a = *(const f32x4*)(p.state_wkv + st_off), b2 = *(const f32x4*)(p.state_wkv + st_off + 64); s00 = lo2(a); s01 = hi2(a); s10 = lo2(b2); s11 = hi2(b2); }
                else { s00 = (f32x2){0.f, 0.f}; s01 = s00; s10 = s00; s11 = s00; }
            }
            const float* buf = bufs + (ci & 1) * SBUF;
            const float* kkA = buf + 4 * c; const float* vsA = buf + 5 * 32 * SROW + d.half * 32 + rl; const float* c12 = buf + 6 * 32 * SROW;
            float* ob = obuf + (ci & 1) * 1024 + rl;
            const int n = d.n;
            f32x4 kk4 = *(const f32x4*)(kkA), wr4 = *(const f32x4*)(kkA + 32 * SROW), w4 = *(const f32x4*)(kkA + 2 * 32 * SROW), b4 = *(const f32x4*)(kkA + 3 * 32 * SROW), k4 = *(const f32x4*)(kkA + 4 * 32 * SROW);
            f32x2 v2 = *(const f32x2*)(vsA), cc = *(const f32x2*)(c12);
            for (int t = 0; t < n; ++t) {
                const int tn = (t + 1 < n) ? t + 1 : t;
                const f32x4 nkk = *(const f32x4*)(kkA + tn * SROW), nwr = *(const f32x4*)(kkA + 32 * SROW + tn * SROW), nw = *(const f32x4*)(kkA + 2 * 32 * SROW + tn * SROW),
                            nb = *(const f32x4*)(kkA + 3 * 32 * SROW + tn * SROW), nk = *(const f32x4*)(kkA + 4 * 32 * SROW + tn * SROW);
                const f32x2 nv = *(const f32x2*)(vsA + tn * SROW), ncc = *(const f32x2*)(c12 + tn * 2);
                f32x2 pd0 = s00 * lo2(kk4) + s01 * hi2(kk4), pd1 = s10 * lo2(kk4) + s11 * hi2(kk4);
                f32x2 pe0 = s00 * lo2(wr4) + s01 * hi2(wr4), pe1 = s10 * lo2(wr4) + s11 * hi2(wr4);
                float d0 = pd0[0] + pd0[1], d1 = pd1[0] + pd1[1], e0 = pe0[0] + pe0[1], e1 = pe1[0] + pe1[1];
                d0 = row16_sum(d0); d1 = row16_sum(d1); e0 = row16_sum(e0); e1 = row16_sum(e1);
                const f32x2 vv0 = (f32x2){v2[0], v2[0]}, vv1 = (f32x2){v2[1], v2[1]}, dd0 = (f32x2){d0, d0}, dd1 = (f32x2){d1, d1};
                s00 = s00 * lo2(w4) + (lo2(k4) * vv0 - lo2(b4) * dd0);
                s01 = s01 * hi2(w4) + (hi2(k4) * vv0 - hi2(b4) * dd0);
                s10 = s10 * lo2(w4) + (lo2(k4) * vv1 - lo2(b4) * dd1);
                s11 = s11 * hi2(w4) + (hi2(k4) * vv1 - hi2(b4) * dd1);
                if (c == 0) { f32x2 o; o[0] = e0 - d0 * cc[0] + v2[0] * cc[1]; o[1] = e1 - d1 * cc[0] + v2[1] * cc[1]; *(f32x2*)(ob + t * 32) = o; }
                kk4 = nkk; wr4 = nwr; w4 = nw; b4 = nb; k4 = nk; v2 = nv; cc = ncc;
            }
            if (d.last) {
                float* so = p.out + (d.samp ? OUT_WKV_S : OUT_WKV_P) + st_off;
                f32x4 a, b2; a[0] = s00[0]; a[1] = s00[1]; a[2] = s01[0]; a[3] = s01[1]; b2[0] = s10[0]; b2[1] = s10[1]; b2[2] = s11[0]; b2[3] = s11[1];
                *(f32x4*)so = a; *(f32x4*)(so + 64) = b2;
            }
            __syncthreads();
        }
        __syncthreads();
    } else if (wid < 6) {
        prep(0);
        __syncthreads();
        for (int ci = 0; ci < NC; ++ci) { prep(ci + 1); __syncthreads(); }
        __syncthreads();
    } else {
        __syncthreads();
        for (int ci = 0; ci <= NC; ++ci) {
            if (ci >= 1) {
                ChunkDesc d; chunk_desc(ci - 1, bid, G, d);
                const float* ob = obuf + ((ci - 1) & 1) * 1024;
                for (int idx = tid - 384; idx < d.n * 8; idx += 128) { const int t = idx >> 3, j = (idx & 7) * 4; *(f32x4*)(ORAW + (size_t)(d.r0 + d.t0 + t) * 1024 + d.h * 64 + d.half * 32 + j) = *(const f32x4*)(ob + t * 32 + j); }
            }
            __syncthreads();
        }
    }
}

__device__ void attn_unit(const Params& p, unsigned char* smem, const int unit) {
    const int tid = threadIdx.x, lane = tid & 63, wid = __builtin_amdgcn_readfirstlane(tid >> 6), fr = lane & 15, fq = lane >> 4;
    const bool samp = unit >= 512;
    int b, h, tile = 0;
    if (!samp) { b = unit >> 6; h = (unit >> 4) & 3; tile = unit & 15; } else { const int u2 = unit - 512; b = u2 >> 2; h = u2 & 3; }
    const bf16_t* ACT = (const bf16_t*)(p.ws + WS_ACT);
    const bf16_t* Kbf = (const bf16_t*)(p.ws + WS_KBF);
    const bf16_t* Vt = (const bf16_t*)(p.ws + WS_VT);
    bf16_t* Ymem = (bf16_t*)(p.ws + WS_YMEM);
    bf16_t* Kc = (bf16_t*)smem;
    bf16_t* Vc = (bf16_t*)smem;
    const int row = samp ? MP + b * 8 + (fr & 7) : b * 2048 + tile * 128 + wid * 16 + fr;
    const bool valid = !samp || fr < 8;
    bf16x8 qf[8];
#pragma unroll
    for (int ks = 0; ks < 8; ++ks) qf[ks] = *(const bf16x8*)(ACT + (size_t)row * ACT_LD + C_QM + h * 256 + ks * 32 + fq * 8);
    f32x4 sacc[16];
#pragma unroll
    for (int i = 0; i < 16; ++i) sacc[i] = (f32x4){0.f, 0.f, 0.f, 0.f};
#pragma unroll
    for (int hf = 0; hf < 2; ++hf) {
        __syncthreads();
#pragma unroll
        for (int i = 0; i < 8; ++i) {
            const int id = tid + i * NTHREADS, key = id >> 5, d = (id & 31) * 8;
            u32x4 v;
            if (!samp) v = *(const u32x4*)(Kbf + (size_t)(b * 256 + hf * 128 + key) * 1024 + h * 256 + d);
            else { const float* s = p.cache_k + ((size_t)(b * 256 + hf * 128 + key) * 4 + h) * 256 + d; const f32x4 x0 = *(const f32x4*)s, x1 = *(const f32x4*)(s + 4);
                v[0] = cvt_pk_bf16(x0[0], x0[1]); v[1] = cvt_pk_bf16(x0[2], x0[3]); v[2] = cvt_pk_bf16(x1[0], x1[1]); v[3] = cvt_pk_bf16(x1[2], x1[3]); }
            *(u32x4*)(Kc + key * 264 + d) = v;
        }
        __syncthreads();
#pragma unroll
        for (int kt = 0; kt < 8; ++kt)
#pragma unroll
            for (int ks = 0; ks < 8; ++ks) {
                const bf16x8 kf = *(const bf16x8*)(Kc + (kt * 16 + fr) * 264 + ks * 32 + fq * 8);
                sacc[hf * 8 + kt] = __builtin_amdgcn_mfma_f32_16x16x32_bf16(kf, qf[ks], sacc[hf * 8 + kt], 0, 0, 0);
            }
    }
    float mx = -3.0e38f;
#pragma unroll
    for (int i = 0; i < 16; ++i) mx = fmaxf(mx, fmaxf(fmaxf(sacc[i][0], sacc[i][1]), fmaxf(sacc[i][2], sacc[i][3])));
    mx = fmaxf(mx, __shfl_xor(mx, 16, 64)); mx = fmaxf(mx, __shfl_xor(mx, 32, 64));
    float sum = 0.f;
#pragma unroll
    for (int i = 0; i < 16; ++i)
#pragma unroll
        for (int e = 0; e < 4; ++e) { const float ex = __expf(sacc[i][e] - mx); sacc[i][e] = ex; sum += ex; }
    sum += __shfl_xor(sum, 16, 64); sum += __shfl_xor(sum, 32, 64);
    const float inv = fast_rcp(sum);
    bf16x8 pf[8];
#pragma unroll
    for (int s = 0; s < 8; ++s) {
        u32x4 t; t[0] = cvt_pk_bf16(sacc[2 * s][0], sacc[2 * s][1]); t[1] = cvt_pk_bf16(sacc[2 * s][2], sacc[2 * s][3]);
        t[2] = cvt_pk_bf16(sacc[2 * s + 1][0], sacc[2 * s + 1][1]); t[3] = cvt_pk_bf16(sacc[2 * s + 1][2], sacc[2 * s + 1][3]);
        pf[s] = __builtin_bit_cast(bf16x8, t);
    }
    f32x4 oacc[16];
#pragma unroll
    for (int i = 0; i < 16; ++i) oacc[i] = (f32x4){0.f, 0.f, 0.f, 0.f};
#pragma unroll
    for (int hf = 0; hf < 2; ++hf) {
        __syncthreads();
        if (!samp) {
#pragma unroll
            for (int i = 0; i < 8; ++i) {
                const int id = tid + i * NTHREADS, d = id >> 4, kc = (id & 15) * 8;
                const u32x4 v = *(const u32x4*)(Vt + (size_t)(h * 256 + d) * 2048 + b * 256 + hf * 128 + kc);
                *(u32x4*)(Vc + d * 136 + kc) = v;
            }
        } else {
#pragma unroll
            for (int i = 0; i < 16; ++i) {
                const int id = tid + i * NTHREADS, key = id >> 6, d = (id & 63) * 4;
                const f32x4 x = *(const f32x4*)(p.cache_v + ((size_t)(b * 256 + hf * 128 + key) * 4 + h) * 256 + d);
                const unsigned a = cvt_pk_bf16(x[0], x[1]), bq = cvt_pk_bf16(x[2], x[3]);
                Vc[(d + 0) * 136 + key] = (bf16_t)(a & 0xffff); Vc[(d + 1) * 136 + key] = (bf16_t)(a >> 16);
                Vc[(d + 2) * 136 + key] = (bf16_t)(bq & 0xffff); Vc[(d + 3) * 136 + key] = (bf16_t)(bq >> 16);
            }
        }
        __syncthreads();
#pragma unroll
        for (int dt = 0; dt < 16; ++dt) {
            if (!samp || (dt >> 1) == wid) {
#pragma unroll
                for (int s2 = 0; s2 < 4; ++s2) {
                    const u32x2 lo = *(const u32x2*)(Vc + (dt * 16 + fr) * 136 + s2 * 32 + 4 * fq), hi = *(const u32x2*)(Vc + (dt * 16 + fr) * 136 + s2 * 32 + 16 + 4 * fq);
                    u32x4 t; t[0] = lo[0]; t[1] = lo[1]; t[2] = hi[0]; t[3] = hi[1];
                    oacc[dt] = __builtin_amdgcn_mfma_f32_16x16x32_bf16(__builtin_bit_cast(bf16x8, t), pf[hf * 4 + s2], oacc[dt], 0, 0, 0);
                }
            }
        }
    }
    if (valid) {
#pragma unroll
        for (int dt = 0; dt < 16; ++dt) {
            if (!samp || (dt >> 1) == wid) {
                const int d = h * 256 + dt * 16 + 4 * fq;
                const u32x2 g = *(const u32x2*)(ACT + (size_t)row * ACT_LD + C_SGM + d);
                u32x2 o; o[0] = cvt_pk_bf16(oacc[dt][0] * inv * bflo(g[0]), oacc[dt][1] * inv * bfhi(g[0])); o[1] = cvt_pk_bf16(oacc[dt][2] * inv * bflo(g[1]), oacc[dt][3] * inv * bfhi(g[1]));
                *(u32x2*)(Ymem + (size_t)row * 1024 + d) = o;
            }
        }
    }
}

__device__ void phase2_attn(const Params& p, unsigned char* smem) {
    __syncthreads();
    for (int u = blockIdx.x; u < 1024; u += gridDim.x) attn_unit(p, smem, u);
}

__device__ __forceinline__ void ld16bf(const bf16_t* ptr, float (&o)[16]) {
    const u32x4 a = *(const u32x4*)ptr, b = *(const u32x4*)(ptr + 8);
#pragma unroll
    for (int e = 0; e < 4; ++e) { o[2 * e] = bflo(a[e]); o[2 * e + 1] = bfhi(a[e]); o[8 + 2 * e] = bflo(b[e]); o[8 + 2 * e + 1] = bfhi(b[e]); }
}
__device__ __forceinline__ void ld16f(const float* ptr, float (&o)[16]) {
#pragma unroll
    for (int q = 0; q < 4; ++q) { const f32x4 v = *(const f32x4*)(ptr + 4 * q); o[4 * q] = v[0]; o[4 * q + 1] = v[1]; o[4 * q + 2] = v[2]; o[4 * q + 3] = v[3]; }
}
__device__ __forceinline__ void st16bf(bf16_t* ptr, const float (&y)[16]) {
    u32x4 a, b;
#pragma unroll
    for (int e = 0; e < 4; ++e) { a[e] = cvt_pk_bf16(y[2 * e], y[2 * e + 1]); b[e] = cvt_pk_bf16(y[8 + 2 * e], y[8 + 2 * e + 1]); }
    *(u32x4*)ptr = a; *(u32x4*)(ptr + 8) = b;
}
__device__ __forceinline__ float quad_sum(float x) { x += dpp_f<0xB1>(x); x += dpp_f<0x4E>(x); return x; }
__device__ void phase2b(const Params& p, unsigned char* smem) {
    const int tid = threadIdx.x, lane = tid & 63, wid = tid >> 6;
    float* tab = (float*)smem;
    __syncthreads();
    for (int idx = tid; idx < 7168; idx += NTHREADS)
        tab[idx] = idx < 3072 ? p.conv_w[idx] : idx < 4096 ? p.conv_b[idx - 3072] : idx < 5120 ? p.shift_mu[2048 + idx - 4096] : idx < 6144 ? p.ln_g[idx - 5120] : p.ln_b[idx - 6144];
    __syncthreads();
    const bf16_t* U = (const bf16_t*)(p.ws + WS_U); const bf16_t* BG = (const bf16_t*)(p.ws + WS_BG); const bf16_t* ACT = (const bf16_t*)(p.ws + WS_ACT);
    const float* ORAW = p.out + OUT_Y; const float* C3 = (const float*)(p.ws + WS_C3);
    bf16_t* Yc = (bf16_t*)(p.ws + WS_YCONV); bf16_t* Yr = (bf16_t*)(p.ws + WS_YRWKV);
    const int ch = lane * 16;
    for (int row = blockIdx.x * 8 + wid; row < MALL; row += gridDim.x * 8) {
        int b, t; const bool samp = row >= MP;
        if (!samp) { b = row >> 11; t = row & 2047; } else { b = (row - MP) >> 3; t = (row - MP) & 7; }
        float u0[16], um1[16], um2[16], bg[16], o[16], vc[16], vq[16], sg[16];
        ld16bf(U + (size_t)row * 1024 + ch, u0); ld16bf(BG + (size_t)row * 1024 + ch, bg);
        if (t >= 1) ld16bf(U + (size_t)(row - 1) * 1024 + ch, um1);
        else if (samp) ld16f(p.state_conv + ((size_t)b * 2 + 1) * 1024 + ch, um1);
        else {
#pragma unroll
            for (int e = 0; e < 16; ++e) um1[e] = 0.f; }
        if (t >= 2) ld16bf(U + (size_t)(row - 2) * 1024 + ch, um2);
        else if (samp) ld16f(p.state_conv + ((size_t)b * 2 + t) * 1024 + ch, um2);
        else {
#pragma unroll
            for (int e = 0; e < 16; ++e) um2[e] = 0.f; }
        ld16f(ORAW + (size_t)row * 1024 + ch, o);
        ld16bf(ACT + (size_t)row * ACT_LD + C_PV + ch, vc);
        if (t >= 1) ld16bf(ACT + (size_t)(row - 1) * ACT_LD + C_PV + ch, vq);
        else if (samp) ld16f(p.state_shift + (size_t)b * DSHIFT + 2048 + ch, vq);
        else {
#pragma unroll
            for (int e = 0; e < 16; ++e) vq[e] = 0.f; }
        ld16bf(ACT + (size_t)row * ACT_LD + C_SGR + ch, sg);
        const float c3 = C3[(size_t)row * 16 + (lane >> 2)];
        float y[16];
#pragma unroll
        for (int q = 0; q < 4; ++q) {
            const f32x4 w0 = *(const f32x4*)(tab + ch + 4 * q), w1 = *(const f32x4*)(tab + 1024 + ch + 4 * q), w2 = *(const f32x4*)(tab + 2048 + ch + 4 * q), cb = *(const f32x4*)(tab + 3072 + ch + 4 * q);
#pragma unroll
            for (int e = 0; e < 4; ++e) { const int i = 4 * q + e; y[i] = bg[i] * (cb[e] + w0[e] * um2[i] + w1[e] * um1[i] + w2[e] * u0[i]); }
        }
        st16bf(Yc + (size_t)row * 1024 + ch, y);
        float sm_ = 0.f;
#pragma unroll
        for (int e = 0; e < 16; ++e) sm_ += o[e];
        const float mean = quad_sum(sm_) * (1.0f / 64.0f);
        float vr = 0.f;
#pragma unroll
        for (int e = 0; e < 16; ++e) { o[e] -= mean; vr += o[e] * o[e]; }
        const float rstd = rsqrtf(quad_sum(vr) * (1.0f / 64.0f) + 6.4e-4f);
#pragma unroll
        for (int q = 0; q < 4; ++q) {
            const f32x4 mv = *(const f32x4*)(tab + 4096 + ch + 4 * q), lg = *(const f32x4*)(tab + 5120 + ch + 4 * q), lb = *(const f32x4*)(tab + 6144 + ch + 4 * q);
#pragma unroll
            for (int e = 0; e < 4; ++e) { const int i = 4 * q + e; const float vs = vc[i] + mv[e] * (vq[i] - vc[i]); y[i] = (o[i] * rstd * lg[e] + lb[e] + c3 * vs) * sg[i]; }
        }
        st16bf(Yr + (size_t)row * 1024 + ch, y);
    }
}

struct SchedP3 {
    int G, c; const char* ws;
    __device__ __forceinline__ bool next(int i, Unit& u) const {
        const int tl = (i / 3) * G + c, seg = i % 3;
        if (tl >= 272) return false;
        u.x = tl >> 2; u.y = tl & 3; u.z = seg;
        u.a = ws + (seg == 0 ? WS_YCONV : seg == 1 ? WS_YRWKV : WS_YMEM) + (size_t)u.x * 256 * 2048; u.b = ws + WS_WB + ((size_t)seg * 1024 + (size_t)u.y * 256) * 2048;
        return true;
    }
};
struct EpiP3 {
    const bf16_t* ACT; bf16_t* MERGED;
    __device__ __forceinline__ bool operator()(f32x4 (&acc)[2][2][4][2], const Unit& u, int wr, int wc, int fr, int fq) const {
        const int seg = u.z, rbase = u.x * 256 + wr * 64 + fr, cb = u.y * 256 + wc * 32 + 8 * fq;
#pragma unroll
        for (int ai = 0; ai < 2; ++ai)
#pragma unroll
            for (int m = 0; m < 4; ++m) {
                const int row = rbase + ai * 128 + m * 16;
#pragma unroll
                for (int bj = 0; bj < 2; ++bj) {
                    const int col = cb + 128 * bj;
                    const u32x4 g = *(const u32x4*)(ACT + (size_t)row * ACT_LD + C_GATE + seg * 1024 + col);
                    float f[8];
#pragma unroll
                    for (int e = 0; e < 4; ++e) { f[2 * e] = bflo(g[e]); f[2 * e + 1] = bfhi(g[e]); }
                    if (seg < 2) {
                        const u32x4 g2 = *(const u32x4*)(ACT + (size_t)row * ACT_LD + C_GATE + (seg + 1) * 1024 + col);
#pragma unroll
                        for (int e = 0; e < 4; ++e) { f[2 * e] *= fast_rcp(bflo(g2[e])); f[2 * e + 1] *= fast_rcp(bfhi(g2[e])); }
                    }
                    f32x4& v0 = acc[ai][bj][m][0]; f32x4& v1 = acc[ai][bj][m][1];
#pragma unroll
                    for (int e = 0; e < 4; ++e) { v0[e] *= f[e]; v1[e] *= f[4 + e]; }
                    if (seg == 2) {
                        u32x4 o; o[0] = cvt_pk_bf16(v0[0], v0[1]); o[1] = cvt_pk_bf16(v0[2], v0[3]); o[2] = cvt_pk_bf16(v1[0], v1[1]); o[3] = cvt_pk_bf16(v1[2], v1[3]);
                        *(u32x4*)(MERGED + (size_t)row * 1024 + col) = o;
                    }
                }
            }
        return seg < 2;
    }
};
struct SchedP4 {
    int G, c; const char* A; const char* B;
    __device__ __forceinline__ bool next(int i, Unit& u) const {
        const int tl = i * G + c;
        if (tl >= 272) return false;
        u.x = tl >> 2; u.y = tl & 3; u.z = 0;
        u.a = A + (size_t)u.x * 256 * 2048; u.b = B + (size_t)u.y * 256 * 2048;
        return true;
    }
};
struct EpiP4 {
    const float* xp; const float* xs; float* out; float* SUMSQ;
    __device__ __forceinline__ bool operator()(f32x4 (&acc)[2][2][4][2], const Unit& u, int wr, int wc, int fr, int fq) const {
        const int rbase = u.x * 256 + wr * 64 + fr, cbase = u.y * 256 + wc * 32 + fq * 4;
#pragma unroll
        for (int ai = 0; ai < 2; ++ai)
#pragma unroll
            for (int m = 0; m < 4; ++m) {
                const int row = rbase + ai * 128 + m * 16;
                const float* xr = row < MP ? xp + (size_t)row * 1024 : xs + (size_t)(row - MP) * 1024;
                float ss = 0.f;
#pragma unroll
                for (int bj = 0; bj < 2; ++bj)
#pragma unroll
                    for (int n = 0; n < 2; ++n) {
                        const int col = cbase + bj * 128 + n * 16;
                        const f32x4 v = acc[ai][bj][m][n] + *(const f32x4*)(xr + col);
                        ss += v[0] * v[0] + v[1] * v[1] + v[2] * v[2] + v[3] * v[3];
                        *(f32x4*)(out + OUT_Y + (size_t)row * 1024 + col) = v;
                    }
                ss += __shfl_xor(ss, 16, 64); ss += __shfl_xor(ss, 32, 64);
                if (fq == 0) SUMSQ[(size_t)row * 16 + u.y * 4 + wc] = ss;
            }
        return false;
    }
};
__device__ void phase5(const Params& p) {
    const int lane = threadIdx.x & 63, wid = threadIdx.x >> 6;
    const float* SUMSQ = (const float*)(p.ws + WS_SUMSQ);
    for (int row = blockIdx.x * 8 + wid; row < MALL; row += gridDim.x * 8) {
        float ss = lane < 16 ? SUMSQ[(size_t)row * 16 + lane] : 0.f;
        ss = wave_sum(ss);
        const float inv = rsqrtf(ss * (1.0f / 1024.0f) + 1e-6f);
        float* y = p.out + OUT_Y + (size_t)row * 1024;
#pragma unroll
        for (int i = 0; i < 4; ++i) {
            f32x4 v = *(const f32x4*)(y + i * 256 + lane * 4); const f32x4 g = *(const f32x4*)(p.norm_final + i * 256 + lane * 4);
            v = v * inv * g;
            *(f32x4*)(y + i * 256 + lane * 4) = v;
        }
    }
}

__global__ void __launch_bounds__(NTHREADS) fwd_megakernel(Params p) {
    extern __shared__ __attribute__((aligned(16))) unsigned char smem[];
    cg::grid_group grid = cg::this_grid();
    LAS unsigned char* lds = (LAS unsigned char*)smem;
#ifndef PROBE_REP
#define PROBE_REP 0
#endif
#define REP(k) for (int _r = 0; _r < ((PROBE_REP == (k)) ? 2 : 1); ++_r)
    REP(1) { phase0(p, smem); grid.sync(); }
    REP(2) {
        SchedP1 S{(int)gridDim.x, (int)blockIdx.x, (const char*)(p.ws + WS_AALL), (const char*)(p.ws + WS_BALL)};
        EpiP1 E{(bf16_t*)(p.ws + WS_U), (bf16_t*)(p.ws + WS_BG), (bf16_t*)(p.ws + WS_ACT), p.out, (bf16_t*)(p.ws + WS_KBF), (bf16_t*)(p.ws + WS_VT)};
        gemm_phase(lds, 2048, 2048, 1024, S, E);
        grid.sync();
    }
    REP(3) { phase2_scan(p, smem); if (PROBE_REP == 3) grid.sync(); }
    REP(5) { phase2_attn(p, smem); if (PROBE_REP == 5) grid.sync(); }
    grid.sync();
    REP(6) { phase2b(p, smem); grid.sync(); }
    REP(7) {
        SchedP3 S{(int)gridDim.x, (int)blockIdx.x, (const char*)p.ws};
        EpiP3 E{(const bf16_t*)(p.ws + WS_ACT), (bf16_t*)(p.ws + WS_MERGED)};
        gemm_phase(lds, 2048, 2048, 1024, S, E);
        grid.sync();
    }
    REP(8) {
        SchedP4 S{(int)gridDim.x, (int)blockIdx.x, (const char*)(p.ws + WS_MERGED), (const char*)(p.ws + WS_WO)};
        EpiP4 E{p.x_prompt, p.x_sample, p.out, (float*)(p.ws + WS_SUMSQ)};
        gemm_phase(lds, 2048, 2048, 1024, S, E);
        grid.sync();
    }
    phase5(p);
}

extern "C" void kernel_launch(void* const* d_in, const int* in_sizes, int n_in, void* d_out, int out_size, void* d_ws, size_t ws_size, hipStream_t stream) {
    static int grid_blocks = 0;
    if (!grid_blocks) {
        int dev = 0, cus = 0, per_cu = 0;
        hipGetDevice(&dev);
        hipDeviceGetAttribute(&cus, hipDeviceAttributeMultiprocessorCount, dev);
        if (hipFuncSetAttribute((const void*)fwd_megakernel, hipFuncAttributeMaxDynamicSharedMemorySize, LDS_BYTES) != hipSuccess) fprintf(stderr, "hipFuncSetAttribute failed\n");
        hipOccupancyMaxActiveBlocksPerMultiprocessor(&per_cu, (const void*)fwd_megakernel, NTHREADS, LDS_BYTES);
        if (per_cu < 1) { fprintf(stderr, "occupancy query returned %d\n", per_cu); per_cu = 1; }
        if (per_cu > 1) per_cu = 1;
        grid_blocks = cus * per_cu;
        if (ws_size < WS_END) { fprintf(stderr, "workspace too small: %zu < %zu\n", ws_size, (size_t)WS_END); grid_blocks = -1; }
    }
    if (grid_blocks < 0) return;
    Params p{};
    const float** pp = (const float**)&p;
    for (int i = 0; i < 27; ++i) pp[i] = (const float*)d_in[i];
    p.out = (float*)d_out; p.ws = (unsigned char*)d_ws;
    void* args[] = {&p};
    hipError_t e = hipLaunchCooperativeKernel((const void*)fwd_megakernel, dim3(grid_blocks), dim3(NTHREADS), args, LDS_BYTES, stream);
    if (e != hipSuccess) fprintf(stderr, "cooperative launch failed: %s (grid %d)\n", hipGetErrorString(e), grid_blocks);
}
```

```cpp
#include <hip/hip_runtime.h>
#include <hip/hip_cooperative_groups.h>
#include <cstdio>
namespace cg = cooperative_groups;

#define LAS __attribute__((address_space(3)))
typedef unsigned short bf16_t;
typedef short bf16x8 __attribute__((ext_vector_type(8)));
typedef float f32x4 __attribute__((ext_vector_type(4)));
typedef float f32x2 __attribute__((ext_vector_type(2)));
typedef unsigned u32x4 __attribute__((ext_vector_type(4)));
typedef unsigned u32x2 __attribute__((ext_vector_type(2)));

constexpr int DM = 1024, TP = 2048, BP = 8, MP = BP * TP, BS = 128, TS = 8, MS = BS * TS, MALL = MP + MS;
constexpr int NMEM = 256, DIN = 13440, DSHIFT = 3200;
constexpr int NPAD = 13568;
constexpr int ACT_LD = 9472;
constexpr int C_PR = 0, C_PK = 1024, C_PV = 2048, C_WD = 3072, C_AD = 3136, C_SGR = 3328, C_QM = 4352, C_SGM = 5376, C_GATE = 6400;
constexpr size_t OUT_Y = 0, OUT_MK = 17825792, OUT_MV = 19922944, OUT_CONV_P = 22020096, OUT_SHIFT_P = 22036480, OUT_WKV_P = 22062080,
                 OUT_CONV_S = 22586368, OUT_SHIFT_S = 22848512, OUT_WKV_S = 23258112;
constexpr size_t al256(size_t x) { return (x + 255) & ~(size_t)255; }
constexpr int XCD_BAR_WORDS_C = 3456;
constexpr size_t WS_AALL = 0;
constexpr size_t WS_BALL = al256(WS_AALL + (size_t)19456 * 1024 * 2);
constexpr size_t WS_YMEM = WS_AALL;
constexpr size_t WS_YCONV = WS_AALL + (size_t)MALL * 1024 * 2;
constexpr size_t WS_WB = al256(WS_BALL + (size_t)15616 * 1024 * 2);
constexpr size_t WS_WO = al256(WS_WB + (size_t)3072 * 1024 * 2);
constexpr size_t WS_U = al256(WS_WO + (size_t)1024 * 1024 * 2);
constexpr size_t WS_MERGED = WS_U;
constexpr size_t WS_BG = al256(WS_U + (size_t)MALL * 1024 * 2);
constexpr size_t WS_ACT = al256(WS_BG + (size_t)MALL * 1024 * 2);
constexpr size_t WS_KBF = al256(WS_ACT + (size_t)MALL * ACT_LD * 2);
constexpr size_t WS_VT = al256(WS_KBF + (size_t)2048 * 1024 * 2);
constexpr size_t WS_YRWKV = al256(WS_VT + (size_t)2048 * 1024 * 2);
constexpr size_t WS_C3 = al256(WS_YRWKV + (size_t)MALL * 1024 * 2);
constexpr size_t WS_SUMSQ = al256(WS_C3 + (size_t)MALL * 16 * 4);
constexpr size_t WS_BAR = al256(WS_SUMSQ + (size_t)MALL * 16 * 4);
constexpr size_t WS_FRAG = al256(WS_BAR + (size_t)XCD_BAR_WORDS_C * 4);
constexpr size_t WS_END = al256(WS_FRAG + (size_t)16 * 2 * 8 * 64 * 16);
static_assert(WS_YCONV + (size_t)MALL * 1024 * 2 <= WS_WB, "alias overflow");
static_assert(WS_END <= 536870912, "workspace too large");

constexpr int NTHREADS = 512;
constexpr int LDS_MAIN = 131072;
constexpr int LDS_BYTES = LDS_MAIN + 16;

struct Params {
    const float *x_prompt, *x_sample, *mem_prompt, *cache_k, *cache_v, *state_conv, *state_shift, *state_wkv, *norm_in, *w_in, *conv_w, *conv_b,
        *shift_mu, *decay_w0, *decay_up, *icl_a0, *icl_up, *k_k, *k_a, *r_k, *ln_g, *ln_b, *norm_mem, *w_mem_kv, *w_branch, *w_out, *norm_final;
    float* out;
    unsigned char* ws;
};

__device__ __forceinline__ float bf2f(bf16_t v) { return __uint_as_float(((unsigned)v) << 16); }
__device__ __forceinline__ unsigned cvt_pk_bf16(float lo, float hi) { unsigned r; asm volatile("v_cvt_pk_bf16_f32 %0, %1, %2" : "=v"(r) : "v"(lo), "v"(hi)); return r; }
__device__ __forceinline__ float bflo(unsigned u) { return __uint_as_float(u << 16); }
__device__ __forceinline__ float bfhi(unsigned u) { return __uint_as_float(u & 0xffff0000u); }
__device__ __forceinline__ float fast_rcp(float x) { return __builtin_amdgcn_rcpf(x); }
__device__ __forceinline__ float sigmoidf_(float x) { return fast_rcp(1.0f + __expf(-x)); }
__device__ __forceinline__ float siluf_(float x) { return x * sigmoidf_(x); }
__device__ __forceinline__ float wave_sum(float v) {
#pragma unroll
    for (int o = 32; o > 0; o >>= 1) v += __shfl_xor(v, o, 64);
    return v;
}
template <int CTRL> __device__ __forceinline__ float dpp_f(float x) {
    return __int_as_float(__builtin_amdgcn_update_dpp(0, __float_as_int(x), CTRL, 0xF, 0xF, true));
}
__device__ __forceinline__ float row16_sum(float x) {
    x += dpp_f<0xB1>(x);
    x += dpp_f<0x4E>(x);
    x += dpp_f<0x141>(x);
    x += dpp_f<0x140>(x);
    return x;
}


#define XB_TMO      128
#define XB_XCNT(j)  (256  + 64 * (j))
#define XB_XSUB(j)  (1280 + 64 * (j))
#define XB_XGEN(j)  (2304 + 64 * (j))
#define XB_TOP      3328
#define XB_TOPGEN   3392
#define XCD_BAR_WORDS 3456
#define XB_SPIN_CAP (1u << 22)
__device__ __forceinline__ unsigned xb_ld(unsigned* p)              { return __hip_atomic_load(p, __ATOMIC_RELAXED, __HIP_MEMORY_SCOPE_AGENT); }
__device__ __forceinline__ unsigned xb_add(unsigned* p, unsigned v) { return __hip_atomic_fetch_add(p, v, __ATOMIC_RELAXED, __HIP_MEMORY_SCOPE_AGENT); }
__device__ __forceinline__ unsigned xb_xcc_id() { return (unsigned)__builtin_amdgcn_s_getreg((3 << 11) | 20) & 0xFu; }
#define XB_SPIN(cond, bar) do { unsigned _sp = 0; while (cond) { __builtin_amdgcn_s_sleep(1); \
    if ((++_sp & 255u) == 0u) { if (xb_ld(&(bar)[XB_TMO])) break; if (_sp > XB_SPIN_CAP) { atomicAdd(&(bar)[XB_TMO], 1u); break; } } } } while (0)
struct XcdBarrier { unsigned* bar; unsigned x; volatile LAS unsigned* st; };
__device__ __forceinline__ XcdBarrier xcd_barrier_post(unsigned* bar, volatile LAS unsigned* st) {
    XcdBarrier b; b.bar = bar; b.x = xb_xcc_id(); b.st = st;
    if (threadIdx.x == 0) (void)xb_add(&bar[XB_XCNT(b.x)], 1u);
    return b;
}
__device__ __forceinline__ void xcd_barrier_complete(unsigned* bar, unsigned x, unsigned& nloc, unsigned& nx) {
    const unsigned G = gridDim.x * gridDim.y * gridDim.z;
    unsigned sum, cnt, mine, sp = 0u;
    for (;;) {
        sum = 0u; cnt = 0u; mine = 0u;
#pragma unroll
        for (unsigned j = 0; j < 16; ++j) { const unsigned c = xb_ld(&bar[XB_XCNT(j)]); sum += c; cnt += (c > 0u) ? 1u : 0u; mine = (j == x) ? c : mine; }
        if (sum == G) break;
        __builtin_amdgcn_s_sleep(1);
        if ((++sp & 255u) == 0u) { if (xb_ld(&bar[XB_TMO])) break; if (sp > XB_SPIN_CAP) { atomicAdd(&bar[XB_TMO], 1u); break; } }
    }
    nloc = mine > 0u ? mine : 1u; nx = cnt > 0u ? cnt : 1u;
}
__device__ __forceinline__ void xcd_barrier(const XcdBarrier& b) {
    asm volatile("s_waitcnt vmcnt(0)" ::: "memory");
    __syncthreads();
    if (threadIdx.x == 0) {
        unsigned* bar = b.bar;
        __builtin_amdgcn_s_waitcnt(0);
        unsigned nloc = b.st[0], nx = b.st[1];
        if (nloc == 0u) { xcd_barrier_complete(bar, b.x, nloc, nx); b.st[0] = nloc; b.st[1] = nx; }
        const unsigned old = xb_add(&bar[XB_XSUB(b.x)], 1u);
        const unsigned gen = old / nloc;
        if (old + 1u == (gen + 1u) * nloc) {
            __builtin_amdgcn_fence(__ATOMIC_RELEASE, "agent");
            asm volatile("s_waitcnt vmcnt(0)" ::: "memory");
            const unsigned og = xb_add(&bar[XB_TOP], 1u);
            const unsigned tg = og / nx;
            if (og + 1u == (tg + 1u) * nx) xb_add(&bar[XB_TOPGEN], 1u);
            else XB_SPIN(xb_ld(&bar[XB_TOPGEN]) == tg, bar);
            __builtin_amdgcn_fence(__ATOMIC_ACQUIRE, "agent");
            xb_add(&bar[XB_XGEN(b.x)], 1u);
            asm volatile("s_waitcnt vmcnt(0)" ::: "memory");
        } else {
            XB_SPIN(xb_ld(&bar[XB_XGEN(b.x)]) == gen, bar);
            __builtin_amdgcn_fence(__ATOMIC_ACQUIRE, "agent");
            asm volatile("s_waitcnt vmcnt(0)" ::: "memory");
        }
    }
    __syncthreads();
}

constexpr int BM = 256, BK = 64, HALF = 128, HTB = HALF * BK * 2;
__device__ __forceinline__ int lds_byte(int r, int c) { const int st = (r >> 4) * 2 + (c >> 5), rr = r & 15, cc = c & 31, ob = rr * 64 + cc * 2; return st * 1024 + (ob ^ (((ob >> 9) & 1) << 5)); }
__device__ __forceinline__ void stage_rc(int b, int& R, int& C) { const int st = b / 1024, sb = b % 1024, swz = sb ^ (((sb >> 9) & 1) << 5); R = (st >> 1) * 16 + swz / 64; C = (st & 1) * 32 + (swz % 64) / 2; }

struct Unit { const char* a; const char* b; int x, y, z; };

template <class Sched, class Epi>
__device__ __forceinline__ void gemm_phase(LAS unsigned char* lds, const int lda, const int ldb, const int K, const Sched& S, const Epi& E) {
    const int tid = threadIdx.x, wid = __builtin_amdgcn_readfirstlane(tid >> 6), lane = tid & 63, wr = wid >> 2, wc = wid & 3, fr = lane & 15, fq = lane >> 4;
    const int nt = K / BK;
    unsigned voffA[2], voffB[2];
#pragma unroll
    for (int i = 0; i < 2; ++i) { int R, C; stage_rc(tid * 16 + i * 8192, R, C); voffA[i] = (unsigned)(R * lda + C * 2); voffB[i] = (unsigned)(R * ldb + C * 2); }
    const size_t kstep = (size_t)(BK * 2);
    const size_t hA = (size_t)HALF * lda, hB = (size_t)HALF * ldb;
    const unsigned ldsw = (unsigned)wid * 1024u;
    const int aoff = lds_byte(wr * 64 + fr, fq * 8), boff = lds_byte(wc * 32 + fr, fq * 8);
#define G_SA(b, h) (((b) * 2 + (h)) * HTB)
#define G_SB(b, h) ((4 + (b) * 2 + (h)) * HTB)
#define G_STAGE(bufoff, gbase, voff) do { _Pragma("unroll") for (int _i = 0; _i < 2; ++_i) \
        __builtin_amdgcn_global_load_lds((const unsigned*)((const char*)(gbase) + (voff)[_i]), (LAS unsigned*)(lds + (bufoff) + ldsw + _i * 8192), 16, 0, 0); } while (0)
#define G_LDA(dst, b, h) do { _Pragma("unroll") for (int m = 0; m < 4; ++m) _Pragma("unroll") for (int k = 0; k < 2; ++k) dst[m][k] = *(const LAS bf16x8*)(lds + G_SA(b, h) + aoff + m * 2048 + k * 1024); } while (0)
#define G_LDB(dst, b, h) do { _Pragma("unroll") for (int n = 0; n < 2; ++n) _Pragma("unroll") for (int k = 0; k < 2; ++k) dst[n][k] = *(const LAS bf16x8*)(lds + G_SB(b, h) + boff + n * 2048 + k * 1024); } while (0)
#define G_MMA(ai, bj, At, Bt) do { __builtin_amdgcn_s_setprio(1); _Pragma("unroll") for (int m = 0; m < 4; ++m) _Pragma("unroll") for (int n = 0; n < 2; ++n) _Pragma("unroll") for (int k = 0; k < 2; ++k) \
        acc[ai][bj][m][n] = __builtin_amdgcn_mfma_f32_16x16x32_bf16(Bt[n][k], At[m][k], acc[ai][bj][m][n], 0, 0, 0); __builtin_amdgcn_s_setprio(0); } while (0)
#define G_WAIT_V(n) asm volatile("s_waitcnt vmcnt(" #n ")" ::: "memory")
#define G_WAIT_L(n) asm volatile("s_waitcnt lgkmcnt(" #n ")" ::: "memory")
#define G_BAR __builtin_amdgcn_s_barrier()
#define G_SCHED __builtin_amdgcn_sched_barrier(0)
    Unit cur, nxt; int ui = 0;
    if (!S.next(0, cur)) return;
    f32x4 acc[2][2][4][2];
#pragma unroll
    for (int a = 0; a < 2; ++a)
#pragma unroll
        for (int b = 0; b < 2; ++b)
#pragma unroll
            for (int m = 0; m < 4; ++m)
#pragma unroll
                for (int n = 0; n < 2; ++n) acc[a][b][m][n] = (f32x4){0.f, 0.f, 0.f, 0.f};
    bf16x8 At[4][2], B0[2][2], B1[2][2];
    const char* cA = cur.a; const char* cB = cur.b;
    G_STAGE(G_SB(0, 0), cB, voffB); G_STAGE(G_SA(0, 0), cA, voffA); G_STAGE(G_SB(0, 1), cB + hB, voffB); G_STAGE(G_SA(0, 1), cA + hA, voffA);
    if (wr == 1) G_BAR;
    G_WAIT_V(4); G_BAR;
    G_STAGE(G_SB(1, 0), cB + kstep, voffB); G_STAGE(G_SA(1, 0), cA + kstep, voffA); G_STAGE(G_SB(1, 1), cB + hB + kstep, voffB);
    G_WAIT_V(6); G_BAR;
    for (;;) {
        const bool has_next = S.next(ui + 1, nxt);
        const char* nA = has_next ? nxt.a : cA; const char* nB = has_next ? nxt.b : cB;
        for (int t = 0; t < nt; t += 2) {
            const bool last = (t == nt - 2);
            const char* a1 = cA + (size_t)(t + 1) * kstep;
            const char* a2 = last ? nA : cA + (size_t)(t + 2) * kstep; const char* b2 = last ? nB : cB + (size_t)(t + 2) * kstep;
            const char* a3 = a2 + kstep; const char* b3 = b2 + kstep;
            G_LDB(B0, 0, 0); G_SCHED; G_LDA(At, 0, 0); G_STAGE(G_SA(1, 1), a1 + hA, voffA);
            G_WAIT_L(8); G_BAR; G_WAIT_L(0); G_MMA(0, 0, At, B0); G_BAR; G_SCHED;
            G_LDB(B1, 0, 1); G_STAGE(G_SB(0, 0), b2, voffB);
            G_BAR; G_WAIT_L(0); G_MMA(0, 1, At, B1); G_BAR;
            G_LDA(At, 0, 1); G_STAGE(G_SA(0, 0), a2, voffA);
            G_BAR; G_WAIT_L(0); G_MMA(1, 0, At, B0); G_BAR; G_SCHED;
            G_STAGE(G_SB(0, 1), b2 + hB, voffB);
            G_WAIT_V(6); G_BAR; G_MMA(1, 1, At, B1); G_BAR;
            G_LDB(B0, 1, 0); G_SCHED; G_LDA(At, 1, 0); G_STAGE(G_SA(0, 1), a2 + hA, voffA);
            G_WAIT_L(8); G_BAR; G_WAIT_L(0); G_MMA(0, 0, At, B0); G_BAR; G_SCHED;
            G_LDB(B1, 1, 1); G_STAGE(G_SB(1, 0), b3, voffB);
            G_BAR; G_WAIT_L(0); G_MMA(0, 1, At, B1); G_BAR;
            G_LDA(At, 1, 1); G_STAGE(G_SA(1, 0), a3, voffA);
            G_BAR; G_WAIT_L(0); G_MMA(1, 0, At, B0); G_BAR; G_SCHED;
            G_STAGE(G_SB(1, 1), b3 + hB, voffB);
            G_WAIT_V(6); G_BAR; G_MMA(1, 1, At, B1); G_BAR;
        }
        const bool keep = E(acc, cur, wr, wc, fr, fq);
        if (!has_next) break;
        if (!keep) {
#pragma unroll
            for (int a = 0; a < 2; ++a)
#pragma unroll
                for (int b = 0; b < 2; ++b)
#pragma unroll
                    for (int m = 0; m < 4; ++m)
#pragma unroll
                        for (int n = 0; n < 2; ++n) acc[a][b][m][n] = (f32x4){0.f, 0.f, 0.f, 0.f};
        }
        cur = nxt; cA = nA; cB = nB; ++ui;
    }
    G_WAIT_V(0);
    if (wr == 0) G_BAR;
    G_BAR;
#undef G_SA
#undef G_SB
#undef G_STAGE
#undef G_LDA
#undef G_LDB
#undef G_MMA
#undef G_WAIT_V
#undef G_WAIT_L
#undef G_BAR
#undef G_SCHED
}

__device__ __forceinline__ int perm8_local(int c) {
    const int bj = c >> 7, wc = (c >> 5) & 3, n = (c >> 4) & 1, fq = (c >> 2) & 3, e = c & 3;
    return 128 * bj + 32 * wc + 8 * fq + 4 * n + e;
}
__device__ __forceinline__ int colmap_in(int np) {
    const int j = np >> 8, c = np & 255;
    if (j < 16) {
        const int bj = c >> 7, wc = (c >> 5) & 3, n = (c >> 4) & 1, fq = (c >> 2) & 3, e = c & 3;
        return (2 * bj + n) * 1024 + j * 64 + wc * 16 + fq * 4 + e;
    }
    const int L = (j - 16) * 256 + perm8_local(c);
    if (L < 3200) return 4096 + L;
    if (L < 3328) return -1;
    return L + 3968;
}

__device__ void phase0(const Params& p, unsigned char* smem) {
    const int tid = threadIdx.x, lane = tid & 63, wid = tid >> 6;
    bf16_t* Aall = (bf16_t*)(p.ws + WS_AALL);
    for (int row = blockIdx.x * 8 + wid; row < 19456; row += gridDim.x * 8) {
        const float* src; const float* g;
        if (row < MP) { src = p.x_prompt + (size_t)row * 1024; g = p.norm_in; }
        else if (row < MALL) { src = p.x_sample + (size_t)(row - MP) * 1024; g = p.norm_in; }
        else { src = p.mem_prompt + (size_t)(row - MALL) * 1024; g = p.norm_mem; }
        f32x4 v[4]; float ss = 0.f;
#pragma unroll
        for (int i = 0; i < 4; ++i) { v[i] = *(const f32x4*)(src + i * 256 + lane * 4); ss += v[i][0] * v[i][0] + v[i][1] * v[i][1] + v[i][2] * v[i][2] + v[i][3] * v[i][3]; }
        ss = wave_sum(ss);
        const float inv = rsqrtf(ss * (1.0f / 1024.0f) + 1e-6f);
#pragma unroll
        for (int i = 0; i < 4; ++i) {
            const f32x4 gg = *(const f32x4*)(g + i * 256 + lane * 4);
            u32x2 o; o[0] = cvt_pk_bf16(v[i][0] * inv * gg[0], v[i][1] * inv * gg[1]); o[1] = cvt_pk_bf16(v[i][2] * inv * gg[2], v[i][3] * inv * gg[3]);
            *(u32x2*)(Aall + (size_t)row * 1024 + i * 256 + lane * 4) = o;
        }
    }
    for (int idx = blockIdx.x * NTHREADS + tid; idx < 16 * 2 * 8 * 64; idx += gridDim.x * NTHREADS) {
        const int ln = idx & 63, f = (idx >> 6) & 7, mat = (idx >> 9) & 1, hh = idx >> 10;
        const int it = f >> 1, ks = f & 1, fr = ln & 15, fq = ln >> 4;
        const float* src = mat ? p.icl_up : p.decay_up;
        float w[8];
#pragma unroll
        for (int jj = 0; jj < 8; ++jj) w[jj] = src[(size_t)(ks * 32 + fq * 8 + jj) * 1024 + hh * 64 + it * 16 + fr];
        u32x4 pk; pk[0] = cvt_pk_bf16(w[0], w[1]); pk[1] = cvt_pk_bf16(w[2], w[3]); pk[2] = cvt_pk_bf16(w[4], w[5]); pk[3] = cvt_pk_bf16(w[6], w[7]);
        *(u32x4*)(p.ws + WS_FRAG + (size_t)idx * 16) = pk;
    }
    bf16_t* T = (bf16_t*)smem;
    const int NT_IN = 212 * 16, NT_KV = 32 * 16, NT_WB = 3 * 16 * 16, NT_WO = 16 * 16;
    const int total = NT_IN + NT_KV + NT_WB + NT_WO;
    for (int tix = blockIdx.x; tix < total; tix += gridDim.x) {
        const float* src; int src_ld; bf16_t* dst; int n0, k0, mode;
        if (tix < NT_IN) { src = p.w_in; src_ld = DIN; dst = (bf16_t*)(p.ws + WS_BALL); n0 = (tix >> 4) * 64; k0 = (tix & 15) * 64; mode = 0; }
        else if (tix < NT_IN + NT_KV) { const int t2 = tix - NT_IN; src = p.w_mem_kv; src_ld = 2048; dst = (bf16_t*)(p.ws + WS_BALL) + (size_t)NPAD * 1024; n0 = (t2 >> 4) * 64; k0 = (t2 & 15) * 64; mode = 1; }
        else if (tix < NT_IN + NT_KV + NT_WB) { const int t2 = tix - NT_IN - NT_KV; const int i = t2 >> 8, t3 = t2 & 255; src = p.w_branch + (size_t)i * 1024 * 1024; src_ld = 1024;
            dst = (bf16_t*)(p.ws + WS_WB) + (size_t)i * 1024 * 1024; n0 = (t3 >> 4) * 64; k0 = (t3 & 15) * 64; mode = 2; }
        else { const int t3 = tix - NT_IN - NT_KV - NT_WB; src = p.w_out; src_ld = 1024; dst = (bf16_t*)(p.ws + WS_WO); n0 = (t3 >> 4) * 64; k0 = (t3 & 15) * 64; mode = 1; }
        {
            const int kk = tid >> 3, seg = tid & 7;
#pragma unroll
            for (int q = 0; q < 2; ++q) {
                const int nl = seg * 8 + q * 4, np = n0 + nl;
                int sc;
                if (mode == 0) sc = colmap_in(np);
                else if (mode == 1) sc = np;
                else sc = (np & ~255) + perm8_local(np & 255);
                f32x4 v = (f32x4){0.f, 0.f, 0.f, 0.f};
                if (sc >= 0) v = *(const f32x4*)(src + (size_t)(k0 + kk) * src_ld + sc);
                const unsigned a = cvt_pk_bf16(v[0], v[1]), b = cvt_pk_bf16(v[2], v[3]);
                T[(nl + 0) * 72 + kk] = (bf16_t)(a & 0xffff); T[(nl + 1) * 72 + kk] = (bf16_t)(a >> 16);
                T[(nl + 2) * 72 + kk] = (bf16_t)(b & 0xffff); T[(nl + 3) * 72 + kk] = (bf16_t)(b >> 16);
            }
        }
        __syncthreads();
        {
            const int nl = tid >> 3, ks = tid & 7;
            const u32x4 v = *(const u32x4*)(T + nl * 72 + ks * 8);
            *(u32x4*)(dst + (size_t)(n0 + nl) * 1024 + k0 + ks * 8) = v;
        }
        __syncthreads();
    }
}

struct SchedP1 {
    int G, c; const char* Aall; const char* Ball;
    __device__ __forceinline__ bool next(int i, Unit& u) const {
        const int L = i * G + c;
        constexpr int nM = 68, nN = 53, nwg = nM * nN, WGM = 8;
        if (L >= nwg + 96) return false;
        if (L < nwg) {
            int wgid = L; { const int q = nwg / 8, r = nwg % 8, xcd = wgid % 8, off = wgid / 8; wgid = (xcd < r ? xcd * (q + 1) : r * (q + 1) + (xcd - r) * q) + off; }
            const int nig = WGM * nN, gid = wgid / nig, fm = gid * WGM, gsz = (nM - fm) < WGM ? (nM - fm) : WGM;
            u.x = fm + ((wgid % nig) % gsz); u.y = (wgid % nig) / gsz; u.z = 0;
            u.a = Aall + (size_t)u.x * 256 * 2048; u.b = Ball + (size_t)u.y * 256 * 2048;
        } else {
            int k = L - nwg;
            if (k < 32) { u.x = k >> 2; u.y = k & 3; u.z = 1; u.a = Aall + (size_t)(68 + u.x) * 256 * 2048; u.b = Ball + (size_t)(53 + u.y) * 256 * 2048; }
            else if (k < 64) { k -= 32; u.x = k >> 2; u.y = k & 3; u.z = 2; u.a = Aall + (size_t)(68 + u.x) * 256 * 2048; u.b = Ball + (size_t)(57 + u.y) * 256 * 2048; }
            else { k -= 64; u.x = k >> 3; u.y = k & 7; u.z = 3; u.a = Ball + (size_t)(57 + u.x) * 256 * 2048; u.b = Aall + (size_t)(68 + u.y) * 256 * 2048; }
        }
        return true;
    }
};

struct EpiP1 {
    bf16_t* U; bf16_t* BG; bf16_t* ACT; float* out; bf16_t* Kbf; bf16_t* Vt;
    __device__ __forceinline__ bool operator()(f32x4 (&acc)[2][2][4][2], const Unit& u, int wr, int wc, int fr, int fq) const {
        const int type = u.z;
        if (type == 0) {
            const int pn = u.y, rbase = u.x * 256 + wr * 64 + fr;
            if (pn < 16) {
                const int ch0 = pn * 64 + wc * 16 + fq * 4;
#pragma unroll
                for (int ai = 0; ai < 2; ++ai)
#pragma unroll
                    for (int m = 0; m < 4; ++m) {
                        const int row = rbase + ai * 128 + m * 16;
                        const f32x4 h = acc[ai][0][m][0], Bv = acc[ai][0][m][1], Cv = acc[ai][1][m][0], g = acc[ai][1][m][1];
                        const f32x4 u4 = Cv * h;
                        f32x4 bg;
#pragma unroll
                        for (int e = 0; e < 4; ++e) bg[e] = Bv[e] * siluf_(g[e]);
                        u32x2 o; o[0] = cvt_pk_bf16(u4[0], u4[1]); o[1] = cvt_pk_bf16(u4[2], u4[3]);
                        *(u32x2*)(U + (size_t)row * 1024 + ch0) = o;
                        o[0] = cvt_pk_bf16(bg[0], bg[1]); o[1] = cvt_pk_bf16(bg[2], bg[3]);
                        *(u32x2*)(BG + (size_t)row * 1024 + ch0) = o;
                        if (row < MP) { const int t = row & 2047; if (t >= 2046) *(f32x4*)(out + OUT_CONV_P + (size_t)((row >> 11) * 2 + (t - 2046)) * 1024 + ch0) = u4; }
                        else { const int rs = row - MP, t = rs & 7; if (t >= 6) *(f32x4*)(out + OUT_CONV_S + (size_t)((rs >> 3) * 2 + (t - 6)) * 1024 + ch0) = u4; }
                    }
            } else {
                const int L0 = (pn - 16) * 256;
                const int kind = pn <= 28 ? 0 : pn <= 32 ? 1 : pn <= 36 ? 2 : pn <= 40 ? 1 : 3;
#pragma unroll
                for (int ai = 0; ai < 2; ++ai)
#pragma unroll
                    for (int m = 0; m < 4; ++m) {
                        const int row = rbase + ai * 128 + m * 16;
#pragma unroll
                        for (int bj = 0; bj < 2; ++bj) {
                            const int L = L0 + 128 * bj + 32 * wc + 8 * fq;
                            f32x4 v0 = acc[ai][bj][m][0], v1 = acc[ai][bj][m][1];
                            if (kind == 0) {
                                if (L < DSHIFT) {
                                    if (row < MP) { if ((row & 2047) == 2047) { float* d = out + OUT_SHIFT_P + (size_t)(row >> 11) * DSHIFT + L; *(f32x4*)d = v0; *(f32x4*)(d + 4) = v1; } }
                                    else { const int rs = row - MP; if ((rs & 7) == 7) { float* d = out + OUT_SHIFT_S + (size_t)(rs >> 3) * DSHIFT + L; *(f32x4*)d = v0; *(f32x4*)(d + 4) = v1; } }
                                }
                            } else if (kind == 1) {
#pragma unroll
                                for (int e = 0; e < 4; ++e) { v0[e] = siluf_(v0[e]); v1[e] = siluf_(v1[e]); }
                            } else if (kind == 2) { v0 *= 0.0625f; v1 *= 0.0625f; }
                            else {
#pragma unroll
                                for (int e = 0; e < 4; ++e) { v0[e] = sigmoidf_(v0[e]); v1[e] = sigmoidf_(v1[e]); }
                            }
                            u32x4 o; o[0] = cvt_pk_bf16(v0[0], v0[1]); o[1] = cvt_pk_bf16(v0[2], v0[3]); o[2] = cvt_pk_bf16(v1[0], v1[1]); o[3] = cvt_pk_bf16(v1[2], v1[3]);
                            *(u32x4*)(ACT + (size_t)row * ACT_LD + L) = o;
                        }
                    }
            }
        } else {
            const int rbase = u.x * 256 + wr * 64 + fr, cbase = u.y * 256 + wc * 32 + fq * 4;
#pragma unroll
            for (int ai = 0; ai < 2; ++ai)
#pragma unroll
                for (int m = 0; m < 4; ++m) {
                    const int row = rbase + ai * 128 + m * 16;
#pragma unroll
                    for (int bj = 0; bj < 2; ++bj)
#pragma unroll
                        for (int n = 0; n < 2; ++n) {
                            const int col = cbase + bj * 128 + n * 16;
                            const f32x4 v = acc[ai][bj][m][n];
                            if (type == 1) { *(f32x4*)(out + OUT_MK + (size_t)row * 1024 + col) = v;
                                u32x2 o; o[0] = cvt_pk_bf16(v[0], v[1]); o[1] = cvt_pk_bf16(v[2], v[3]); *(u32x2*)(Kbf + (size_t)row * 1024 + col) = o; }
                            else if (type == 2) { *(f32x4*)(out + OUT_MV + (size_t)row * 1024 + col) = v; }
                            else { u32x2 o; o[0] = cvt_pk_bf16(v[0], v[1]); o[1] = cvt_pk_bf16(v[2], v[3]); *(u32x2*)(Vt + (size_t)row * 2048 + col) = o; }
                        }
                }
        }
        return false;
    }
};

struct ChunkDesc { int r0, b, h, half, samp, t0, n, first, last; };
__device__ __forceinline__ bool chunk_desc(const int ci, const int bid, const int G, ChunkDesc& d) {
    const int n_long = bid < 256 ? (255 - bid) / G + 1 : 0;
    const int n_samp = bid < 4096 ? (4095 - bid) / G + 1 : 0;
    const int nc_long = n_long * 64;
    if (ci < nc_long) { const int k = ci >> 6, it = bid + k * G, chain = it >> 1; d.b = chain >> 4; d.h = chain & 15; d.half = it & 1; d.samp = 0; d.r0 = d.b * TP;
        d.t0 = (ci & 63) * 32; d.n = 32; d.first = (ci & 63) == 0; d.last = (ci & 63) == 63; return true; }
    const int k = ci - nc_long; if (k >= n_samp) return false;
    const int it = bid + k * G, chain = it >> 1; d.b = chain >> 4; d.h = chain & 15; d.half = it & 1; d.samp = 1; d.r0 = MP + d.b * TS; d.t0 = 0; d.n = 8; d.first = 1; d.last = 1; return true;
}
constexpr int SROW = 68;
constexpr int SBUF = 6 * 32 * SROW + 64;
__device__ __forceinline__ f32x2 lo2(const f32x4 v) { return __builtin_shufflevector(v, v, 0, 1); }
__device__ __forceinline__ f32x2 hi2(const f32x4 v) { return __builtin_shufflevector(v, v, 2, 3); }
__device__ __forceinline__ float tanh_fast(float x) { return 1.0f - 2.0f * fast_rcp(1.0f + __expf(2.0f * x)); }

__device__ __forceinline__ void unpack4(const u32x2 v, float (&o)[4]) { o[0] = bflo(v[0]); o[1] = bfhi(v[0]); o[2] = bflo(v[1]); o[3] = bfhi(v[1]); }

struct PrepState { f32x4 aw[4], aa[4]; float ksf[16], rsf[16], vsf[16]; float rn; };

__device__ __forceinline__ void shifted4(const bf16_t* cur, const bf16_t* prvc, const float* st, const bool isfirst, const bool samp, const int col, const f32x4 mu, float (&o)[4]) {
    float c[4], q[4];
    unpack4(*(const u32x2*)(cur + col), c); unpack4(*(const u32x2*)(prvc + col), q);
    if (isfirst) {
        if (samp) { const f32x4 v = *(const f32x4*)(st + col); q[0] = v[0]; q[1] = v[1]; q[2] = v[2]; q[3] = v[3]; }
        else { q[0] = 0.f; q[1] = 0.f; q[2] = 0.f; q[3] = 0.f; }
    }
#pragma unroll
    for (int e = 0; e < 4; ++e) o[e] = c[e] + mu[e] * (q[e] - c[e]);
}

__device__ __forceinline__ void prep_stage1(const Params& p, const ChunkDesc& d, const int tb, const float* par, const int lane, PrepState& S) {
    const int fr = lane & 15, fq = lane >> 4;
    const int t = tb + fr; const int tt = t < d.n ? t : d.n - 1;
    const size_t row = (size_t)(d.r0 + d.t0 + tt);
    const bool isfirst = (d.t0 + tt) == 0, samp = d.samp != 0;
    const bf16_t* cur = (const bf16_t*)(p.ws + WS_ACT) + row * ACT_LD;
    const bf16_t* prvc = isfirst ? cur : cur - ACT_LD;
    const float* st = p.state_shift + (size_t)d.b * DSHIFT;
    bf16x8 bw[2], ba[2];
#pragma unroll
    for (int ks = 0; ks < 2; ++ks) {
#pragma unroll
        for (int which = 0; which < 2; ++which) {
            const int col = (which ? C_AD : C_WD) + ks * 32 + fq * 8;
            float x0[4], x1[4];
            shifted4(cur, prvc, st, isfirst, samp, col, *(const f32x4*)(p.shift_mu + col), x0);
            shifted4(cur, prvc, st, isfirst, samp, col + 4, *(const f32x4*)(p.shift_mu + col + 4), x1);
            if (!which) {
#pragma unroll
                for (int e = 0; e < 4; ++e) { x0[e] = tanh_fast(x0[e]); x1[e] = tanh_fast(x1[e]); }
            }
            u32x4 pk; pk[0] = cvt_pk_bf16(x0[0], x0[1]); pk[1] = cvt_pk_bf16(x0[2], x0[3]); pk[2] = cvt_pk_bf16(x1[0], x1[1]); pk[3] = cvt_pk_bf16(x1[2], x1[3]);
            if (which) ba[ks] = __builtin_bit_cast(bf16x8, pk); else bw[ks] = __builtin_bit_cast(bf16x8, pk);
        }
    }
    const bf16x8* ft = (const bf16x8*)(p.ws + WS_FRAG) + (size_t)d.h * 1024 + lane;
#pragma unroll
    for (int it = 0; it < 4; ++it) {
        S.aw[it] = (f32x4){0.f, 0.f, 0.f, 0.f}; S.aa[it] = S.aw[it];
#pragma unroll
        for (int ks = 0; ks < 2; ++ks) {
            S.aw[it] = __builtin_amdgcn_mfma_f32_16x16x32_bf16(ft[(it * 2 + ks) * 64], bw[ks], S.aw[it], 0, 0, 0);
            S.aa[it] = __builtin_amdgcn_mfma_f32_16x16x32_bf16(ft[(8 + it * 2 + ks) * 64], ba[ks], S.aa[it], 0, 0, 0);
        }
    }
    const int hc = d.h * 64 + 4 * fq;
    float ss = 0.f;
#pragma unroll
    for (int it = 0; it < 4; ++it) {
        const int po = it * 16 + 4 * fq;
        float k4[4], r4[4], v4[4];
        shifted4(cur, prvc, st, isfirst, samp, C_PK + hc + it * 16, *(const f32x4*)(par + 64 + po), k4);
        shifted4(cur, prvc, st, isfirst, samp, C_PR + hc + it * 16, *(const f32x4*)(par + po), r4);
        shifted4(cur, prvc, st, isfirst, samp, C_PV + hc + it * 16, *(const f32x4*)(par + 128 + po), v4);
        const f32x4 kkp = *(const f32x4*)(par + 5 * 64 + po);
#pragma unroll
        for (int e = 0; e < 4; ++e) { S.ksf[it * 4 + e] = k4[e]; S.rsf[it * 4 + e] = r4[e]; S.vsf[it * 4 + e] = v4[e]; const float kr = k4[e] * kkp[e]; ss += kr * kr; }
    }
    ss += __shfl_xor(ss, 16, 64); ss += __shfl_xor(ss, 32, 64);
    S.rn = rsqrtf(ss + 1e-12f);
}

__device__ __forceinline__ void prep_stage2(const Params& p, const ChunkDesc& d, const int tb, float* buf, const float* par, const int lane, const PrepState& S) {
    const int fr = lane & 15, fq = lane >> 4;
    const int t = tb + fr; const bool valid = t < d.n;
    float c1 = 0.f, c2 = 0.f, c3 = 0.f;
    float* kkA = buf; float* wrA = buf + 32 * SROW; float* wA = buf + 2 * 32 * SROW; float* bA = buf + 3 * 32 * SROW; float* kpA = buf + 4 * 32 * SROW; float* vsA = buf + 5 * 32 * SROW; float* c12 = buf + 6 * 32 * SROW;
#pragma unroll
    for (int it = 0; it < 4; ++it) {
        const int po = it * 16 + 4 * fq;
        const f32x4 w0 = *(const f32x4*)(par + 3 * 64 + po), a0 = *(const f32x4*)(par + 4 * 64 + po), kkp = *(const f32x4*)(par + 5 * 64 + po), ka = *(const f32x4*)(par + 6 * 64 + po), rk = *(const f32x4*)(par + 7 * 64 + po);
        f32x4 o_kk, o_wr, o_w, o_b, o_kp, o_vs;
#pragma unroll
        for (int e = 0; e < 4; ++e) {
            const float r_ = S.rsf[it * 4 + e], k_ = S.ksf[it * 4 + e];
            const float dec = __expf(-0.6065306597f * sigmoidf_(S.aw[it][e] + w0[e]));
            const float a = sigmoidf_(S.aa[it][e] + a0[e]);
            const float kn = k_ * kkp[e] * S.rn;
            const float kpv = k_ * (1.0f + (a - 1.0f) * ka[e]);
            const float bv = kn * a;
            c1 += bv * r_; c2 += kpv * r_; c3 += r_ * kpv * rk[e];
            o_kk[e] = kn; o_wr[e] = dec * r_; o_w[e] = dec; o_b[e] = bv; o_kp[e] = kpv; o_vs[e] = S.vsf[it * 4 + e];
        }
        if (valid) {
            const int o = t * SROW + po;
            *(f32x4*)(kkA + o) = o_kk; *(f32x4*)(wrA + o) = o_wr; *(f32x4*)(wA + o) = o_w; *(f32x4*)(bA + o) = o_b; *(f32x4*)(kpA + o) = o_kp; *(f32x4*)(vsA + o) = o_vs;
        }
    }
    c1 += __shfl_xor(c1, 16, 64); c1 += __shfl_xor(c1, 32, 64);
    c2 += __shfl_xor(c2, 16, 64); c2 += __shfl_xor(c2, 32, 64);
    c3 += __shfl_xor(c3, 16, 64); c3 += __shfl_xor(c3, 32, 64);
    if (valid && fq == 0) { c12[t * 2] = c1; c12[t * 2 + 1] = c2; if (d.half == 0) ((float*)(p.ws + WS_C3))[(size_t)(d.r0 + d.t0 + t) * 16 + d.h] = c3; }
}

__device__ void phase2_scan(const Params& p, unsigned char* smem) {
    const int tid = threadIdx.x, lane = tid & 63, wid = __builtin_amdgcn_readfirstlane(tid >> 6);
    const int bid = blockIdx.x, G = gridDim.x;
    float* sm = (float*)smem;
    float* bufs = sm;
    float* obuf = sm + 2 * SBUF;
    float* parb = obuf + 2 * 1024;
    const int n_long = bid < 256 ? (255 - bid) / G + 1 : 0, n_samp = bid < 4096 ? (4095 - bid) / G + 1 : 0;
    const int NC = n_long * 64 + n_samp;
    float* ORAW = p.out + OUT_Y;
    __syncthreads();
    if (wid < 4) {
        const int c = lane & 15, rg = lane >> 4, rl = wid * 8 + rg * 2;
        f32x2 s00 = (f32x2){0.f, 0.f}, s01 = s00, s10 = s00, s11 = s00;
        __syncthreads();
        __syncthreads();
        for (int ci = 0; ci < NC; ++ci) {
            ChunkDesc d; chunk_desc(ci, bid, G, d);
            const size_t st_off = ((size_t)(d.b * 16 + d.h) * 64 + d.half * 32 + rl) * 64 + 4 * c;
            if (d.first) {
                if (d.samp) { const f32x4 a = *(const f32x4*)(p.state_wkv + st_off), b2 = *(const f32x4*)(p.state_wkv + st_off + 64); s00 = lo2(a); s01 = hi2(a); s10 = lo2(b2); s11 = hi2(b2); }
                else { s00 = (f32x2){0.f, 0.f}; s01 = s00; s10 = s00; s11 = s00; }
            }
            const float* buf = bufs + (ci & 1) * SBUF;
            const float* kkA = buf + 4 * c; const float* vsA = buf + 5 * 32 * SROW + d.half * 32 + rl; const float* c12 = buf + 6 * 32 * SROW;
            float* ob = obuf + (ci & 1) * 1024 + rl;
            const int n = d.n;
            f32x4 kk4 = *(const f32x4*)(kkA), wr4 = *(const f32x4*)(kkA + 32 * SROW), w4 = *(const f32x4*)(kkA + 2 * 32 * SROW), b4 = *(const f32x4*)(kkA + 3 * 32 * SROW), k4 = *(const f32x4*)(kkA + 4 * 32 * SROW);
            f32x2 v2 = *(const f32x2*)(vsA), cc = *(const f32x2*)(c12);
            for (int t = 0; t < n; ++t) {
                const int tn = (t + 1 < n) ? t + 1 : t;
                const f32x4 nkk = *(const f32x4*)(kkA + tn * SROW), nwr = *(const f32x4*)(kkA + 32 * SROW + tn * SROW), nw = *(const f32x4*)(kkA + 2 * 32 * SROW + tn * SROW),
                            nb = *(const f32x4*)(kkA + 3 * 32 * SROW + tn * SROW), nk = *(const f32x4*)(kkA + 4 * 32 * SROW + tn * SROW);
                const f32x2 nv = *(const f32x2*)(vsA + tn * SROW), ncc = *(const f32x2*)(c12 + tn * 2);
                f32x2 pd0 = s00 * lo2(kk4) + s01 * hi2(kk4), pd1 = s10 * lo2(kk4) + s11 * hi2(kk4);
                f32x2 pe0 = s00 * lo2(wr4) + s01 * hi2(wr4), pe1 = s10 * lo2(wr4) + s11 * hi2(wr4);
                float d0 = pd0[0] + pd0[1], d1 = pd1[0] + pd1[1], e0 = pe0[0] + pe0[1], e1 = pe1[0] + pe1[1];
                d0 = row16_sum(d0); d1 = row16_sum(d1); e0 = row16_sum(e0); e1 = row16_sum(e1);
                const f32x2 vv0 = (f32x2){v2[0], v2[0]}, vv1 = (f32x2){v2[1], v2[1]}, dd0 = (f32x2){d0, d0}, dd1 = (f32x2){d1, d1};
                s00 = s00 * lo2(w4) + (lo2(k4) * vv0 - lo2(b4) * dd0);
                s01 = s01 * hi2(w4) + (hi2(k4) * vv0 - hi2(b4) * dd0);
                s10 = s10 * lo2(w4) + (lo2(k4) * vv1 - lo2(b4) * dd1);
                s11 = s11 * hi2(w4) + (hi2(k4) * vv1 - hi2(b4) * dd1);
                if (c == 0) { f32x2 o; o[0] = e0 - d0 * cc[0] + v2[0] * cc[1]; o[1] = e1 - d1 * cc[0] + v2[1] * cc[1]; *(f32x2*)(ob + t * 32) = o; }
                kk4 = nkk; wr4 = nwr; w4 = nw; b4 = nb; k4 = nk; v2 = nv; cc = ncc;
            }
            if (d.last) {
                float* so = p.out + (d.samp ? OUT_WKV_S : OUT_WKV_P) + st_off;
                f32x4 a, b2; a[0] = s00[0]; a[1] = s00[1]; a[2] = s01[0]; a[3] = s01[1]; b2[0] = s10[0]; b2[1] = s10[1]; b2[2] = s11[0]; b2[3] = s11[1];
                *(f32x4*)so = a; *(f32x4*)(so + 64) = b2;
            }
            __syncthreads();
        }
        __syncthreads();
    } else {
        const int q = (wid >> 1) & 1, tb = (wid & 1) * 16;
        float* par = parb + (wid & 3) * 512;
        PrepState S;
        int cur_h = -1;
        for (int i = -2; i <= NC; ++i) {
            if ((i & 1) == q) {
                ChunkDesc d;
                if (i < NC && chunk_desc(i + 2, bid, G, d)) {
                    if (d.h != cur_h) {
                        cur_h = d.h;
                        const int ch = d.h * 64 + lane;
                        par[lane] = p.shift_mu[ch]; par[64 + lane] = p.shift_mu[1024 + ch]; par[128 + lane] = p.shift_mu[2048 + ch]; par[192 + lane] = p.decay_w0[ch];
                        par[256 + lane] = p.icl_a0[ch]; par[320 + lane] = p.k_k[ch]; par[384 + lane] = p.k_a[ch]; par[448 + lane] = p.r_k[ch];
                    }
                    if (tb < d.n) prep_stage1(p, d, tb, par, lane, S);
                }
            } else {
                ChunkDesc d;
                if (i >= 1 && chunk_desc(i - 1, bid, G, d)) {
                    const float* ob = obuf + ((i - 1) & 1) * 1024;
                    for (int idx = (wid & 1) * 64 + lane; idx < d.n * 8; idx += 128) { const int t = idx >> 3, j = (idx & 7) * 4; *(f32x4*)(ORAW + (size_t)(d.r0 + d.t0 + t) * 1024 + d.h * 64 + d.half * 32 + j) = *(const f32x4*)(ob + t * 32 + j); }
                }
                if (i >= -1 && i + 1 < NC && chunk_desc(i + 1, bid, G, d)) { if (tb < d.n) prep_stage2(p, d, tb, bufs + ((i + 1) & 1) * SBUF, par, lane, S); }
            }
            __syncthreads();
        }
    }
}

__device__ void attn_unit(const Params& p, unsigned char* smem, const int unit) {
    const int tid = threadIdx.x, lane = tid & 63, wid = __builtin_amdgcn_readfirstlane(tid >> 6), fr = lane & 15, fq = lane >> 4;
    const bool samp = unit >= 512;
    int b, h, tile = 0;
    if (!samp) { b = unit >> 6; h = (unit >> 4) & 3; tile = unit & 15; } else { const int u2 = unit - 512; b = u2 >> 2; h = u2 & 3; }
    const bf16_t* ACT = (const bf16_t*)(p.ws + WS_ACT);
    const bf16_t* Kbf = (const bf16_t*)(p.ws + WS_KBF);
    const bf16_t* Vt = (const bf16_t*)(p.ws + WS_VT);
    bf16_t* Ymem = (bf16_t*)(p.ws + WS_YMEM);
    bf16_t* Kc = (bf16_t*)smem;
    bf16_t* Vc = (bf16_t*)smem;
    const int row = samp ? MP + b * 8 + (fr & 7) : b * 2048 + tile * 128 + wid * 16 + fr;
    const bool valid = !samp || fr < 8;
    bf16x8 qf[8];
#pragma unroll
    for (int ks = 0; ks < 8; ++ks) qf[ks] = *(const bf16x8*)(ACT + (size_t)row * ACT_LD + C_QM + h * 256 + ks * 32 + fq * 8);
    f32x4 sacc[16];
#pragma unroll
    for (int i = 0; i < 16; ++i) sacc[i] = (f32x4){0.f, 0.f, 0.f, 0.f};
#pragma unroll
    for (int hf = 0; hf < 2; ++hf) {
        __syncthreads();
#pragma unroll
        for (int i = 0; i < 8; ++i) {
            const int id = tid + i * NTHREADS, key = id >> 5, d = (id & 31) * 8;
            u32x4 v;
            if (!samp) v = *(const u32x4*)(Kbf + (size_t)(b * 256 + hf * 128 + key) * 1024 + h * 256 + d);
            else { const float* s = p.cache_k + ((size_t)(b * 256 + hf * 128 + key) * 4 + h) * 256 + d; const f32x4 x0 = *(const f32x4*)s, x1 = *(const f32x4*)(s + 4);
                v[0] = cvt_pk_bf16(x0[0], x0[1]); v[1] = cvt_pk_bf16(x0[2], x0[3]); v[2] = cvt_pk_bf16(x1[0], x1[1]); v[3] = cvt_pk_bf16(x1[2], x1[3]); }
            *(u32x4*)(Kc + key * 264 + d) = v;
        }
        __syncthreads();
#pragma unroll
        for (int kt = 0; kt < 8; ++kt)
#pragma unroll
            for (int ks = 0; ks < 8; ++ks) {
                const bf16x8 kf = *(const bf16x8*)(Kc + (kt * 16 + fr) * 264 + ks * 32 + fq * 8);
                sacc[hf * 8 + kt] = __builtin_amdgcn_mfma_f32_16x16x32_bf16(kf, qf[ks], sacc[hf * 8 + kt], 0, 0, 0);
            }
    }
    float mx = -3.0e38f;
#pragma unroll
    for (int i = 0; i < 16; ++i) mx = fmaxf(mx, fmaxf(fmaxf(sacc[i][0], sacc[i][1]), fmaxf(sacc[i][2], sacc[i][3])));
    mx = fmaxf(mx, __shfl_xor(mx, 16, 64)); mx = fmaxf(mx, __shfl_xor(mx, 32, 64));
    float sum = 0.f;
#pragma unroll
    for (int i = 0; i < 16; ++i)
#pragma unroll
        for (int e = 0; e < 4; ++e) { const float ex = __expf(sacc[i][e] - mx); sacc[i][e] = ex; sum += ex; }
    sum += __shfl_xor(sum, 16, 64); sum += __shfl_xor(sum, 32, 64);
    const float inv = fast_rcp(sum);
    bf16x8 pf[8];
#pragma unroll
    for (int s = 0; s < 8; ++s) {
        u32x4 t; t[0] = cvt_pk_bf16(sacc[2 * s][0], sacc[2 * s][1]); t[1] = cvt_pk_bf16(sacc[2 * s][2], sacc[2 * s][3]);
        t[2] = cvt_pk_bf16(sacc[2 * s + 1][0], sacc[2 * s + 1][1]); t[3] = cvt_pk_bf16(sacc[2 * s + 1][2], sacc[2 * s + 1][3]);
        pf[s] = __builtin_bit_cast(bf16x8, t);
    }
    f32x4 oacc[16];
#pragma unroll
    for (int i = 0; i < 16; ++i) oacc[i] = (f32x4){0.f, 0.f, 0.f, 0.f};
#pragma unroll
    for (int hf = 0; hf < 2; ++hf) {
        __syncthreads();
        if (!samp) {
#pragma unroll
            for (int i = 0; i < 8; ++i) {
                const int id = tid + i * NTHREADS, d = id >> 4, kc = (id & 15) * 8;
                const u32x4 v = *(const u32x4*)(Vt + (size_t)(h * 256 + d) * 2048 + b * 256 + hf * 128 + kc);
                *(u32x4*)(Vc + d * 136 + kc) = v;
            }
        } else {
#pragma unroll
            for (int i = 0; i < 16; ++i) {
                const int id = tid + i * NTHREADS, key = id >> 6, d = (id & 63) * 4;
                const f32x4 x = *(const f32x4*)(p.cache_v + ((size_t)(b * 256 + hf * 128 + key) * 4 + h) * 256 + d);
                const unsigned a = cvt_pk_bf16(x[0], x[1]), bq = cvt_pk_bf16(x[2], x[3]);
                Vc[(d + 0) * 136 + key] = (bf16_t)(a & 0xffff); Vc[(d + 1) * 136 + key] = (bf16_t)(a >> 16);
                Vc[(d + 2) * 136 + key] = (bf16_t)(bq & 0xffff); Vc[(d + 3) * 136 + key] = (bf16_t)(bq >> 16);
            }
        }
        __syncthreads();
#pragma unroll
        for (int dt = 0; dt < 16; ++dt) {
            if (!samp || (dt >> 1) == wid) {
#pragma unroll
                for (int s2 = 0; s2 < 4; ++s2) {
                    const u32x2 lo = *(const u32x2*)(Vc + (dt * 16 + fr) * 136 + s2 * 32 + 4 * fq), hi = *(const u32x2*)(Vc + (dt * 16 + fr) * 136 + s2 * 32 + 16 + 4 * fq);
                    u32x4 t; t[0] = lo[0]; t[1] = lo[1]; t[2] = hi[0]; t[3] = hi[1];
                    oacc[dt] = __builtin_amdgcn_mfma_f32_16x16x32_bf16(__builtin_bit_cast(bf16x8, t), pf[hf * 4 + s2], oacc[dt], 0, 0, 0);
                }
            }
        }
    }
    if (valid) {
#pragma unroll
        for (int dt = 0; dt < 16; ++dt) {
            if (!samp || (dt >> 1) == wid) {
                const int d = h * 256 + dt * 16 + 4 * fq;
                const u32x2 g = *(const u32x2*)(ACT + (size_t)row * ACT_LD + C_SGM + d);
                u32x2 o; o[0] = cvt_pk_bf16(oacc[dt][0] * inv * bflo(g[0]), oacc[dt][1] * inv * bfhi(g[0])); o[1] = cvt_pk_bf16(oacc[dt][2] * inv * bflo(g[1]), oacc[dt][3] * inv * bfhi(g[1]));
                *(u32x2*)(Ymem + (size_t)row * 1024 + d) = o;
            }
        }
    }
}

__device__ void phase2_attn(const Params& p, unsigned char* smem) {
    __syncthreads();
    for (int u = blockIdx.x; u < 1024; u += gridDim.x) attn_unit(p, smem, u);
}

__device__ __forceinline__ void ld16bf(const bf16_t* ptr, float (&o)[16]) {
    const u32x4 a = *(const u32x4*)ptr, b = *(const u32x4*)(ptr + 8);
#pragma unroll
    for (int e = 0; e < 4; ++e) { o[2 * e] = bflo(a[e]); o[2 * e + 1] = bfhi(a[e]); o[8 + 2 * e] = bflo(b[e]); o[8 + 2 * e + 1] = bfhi(b[e]); }
}
__device__ __forceinline__ void ld16f(const float* ptr, float (&o)[16]) {
#pragma unroll
    for (int q = 0; q < 4; ++q) { const f32x4 v = *(const f32x4*)(ptr + 4 * q); o[4 * q] = v[0]; o[4 * q + 1] = v[1]; o[4 * q + 2] = v[2]; o[4 * q + 3] = v[3]; }
}
__device__ __forceinline__ void st16bf(bf16_t* ptr, const float (&y)[16]) {
    u32x4 a, b;
#pragma unroll
    for (int e = 0; e < 4; ++e) { a[e] = cvt_pk_bf16(y[2 * e], y[2 * e + 1]); b[e] = cvt_pk_bf16(y[8 + 2 * e], y[8 + 2 * e + 1]); }
    *(u32x4*)ptr = a; *(u32x4*)(ptr + 8) = b;
}
__device__ __forceinline__ float quad_sum(float x) { x += dpp_f<0xB1>(x); x += dpp_f<0x4E>(x); return x; }
__device__ void phase2b(const Params& p, unsigned char* smem) {
    const int tid = threadIdx.x, lane = tid & 63, wid = tid >> 6;
    float* tab = (float*)smem;
    __syncthreads();
    for (int idx = tid; idx < 7168; idx += NTHREADS)
        tab[idx] = idx < 3072 ? p.conv_w[idx] : idx < 4096 ? p.conv_b[idx - 3072] : idx < 5120 ? p.shift_mu[2048 + idx - 4096] : idx < 6144 ? p.ln_g[idx - 5120] : p.ln_b[idx - 6144];
    __syncthreads();
    const bf16_t* U = (const bf16_t*)(p.ws + WS_U); const bf16_t* BG = (const bf16_t*)(p.ws + WS_BG); const bf16_t* ACT = (const bf16_t*)(p.ws + WS_ACT);
    const float* ORAW = p.out + OUT_Y; const float* C3 = (const float*)(p.ws + WS_C3);
    bf16_t* Yc = (bf16_t*)(p.ws + WS_YCONV); bf16_t* Yr = (bf16_t*)(p.ws + WS_YRWKV);
    const int ch = lane * 16;
    for (int row = blockIdx.x * 8 + wid; row < MALL; row += gridDim.x * 8) {
        int b, t; const bool samp = row >= MP;
        if (!samp) { b = row >> 11; t = row & 2047; } else { b = (row - MP) >> 3; t = (row - MP) & 7; }
        float u0[16], um1[16], um2[16], bg[16], o[16], vc[16], vq[16], sg[16];
        ld16bf(U + (size_t)row * 1024 + ch, u0); ld16bf(BG + (size_t)row * 1024 + ch, bg);
        if (t >= 1) ld16bf(U + (size_t)(row - 1) * 1024 + ch, um1);
        else if (samp) ld16f(p.state_conv + ((size_t)b * 2 + 1) * 1024 + ch, um1);
        else {
#pragma unroll
            for (int e = 0; e < 16; ++e) um1[e] = 0.f; }
        if (t >= 2) ld16bf(U + (size_t)(row - 2) * 1024 + ch, um2);
        else if (samp) ld16f(p.state_conv + ((size_t)b * 2 + t) * 1024 + ch, um2);
        else {
#pragma unroll
            for (int e = 0; e < 16; ++e) um2[e] = 0.f; }
        ld16f(ORAW + (size_t)row * 1024 + ch, o);
        ld16bf(ACT + (size_t)row * ACT_LD + C_PV + ch, vc);
        if (t >= 1) ld16bf(ACT + (size_t)(row - 1) * ACT_LD + C_PV + ch, vq);
        else if (samp) ld16f(p.state_shift + (size_t)b * DSHIFT + 2048 + ch, vq);
        else {
#pragma unroll
            for (int e = 0; e < 16; ++e) vq[e] = 0.f; }
        ld16bf(ACT + (size_t)row * ACT_LD + C_SGR + ch, sg);
        const float c3 = C3[(size_t)row * 16 + (lane >> 2)];
        float y[16];
#pragma unroll
        for (int q = 0; q < 4; ++q) {
            const f32x4 w0 = *(const f32x4*)(tab + ch + 4 * q), w1 = *(const f32x4*)(tab + 1024 + ch + 4 * q), w2 = *(const f32x4*)(tab + 2048 + ch + 4 * q), cb = *(const f32x4*)(tab + 3072 + ch + 4 * q);
#pragma unroll
            for (int e = 0; e < 4; ++e) { const int i = 4 * q + e; y[i] = bg[i] * (cb[e] + w0[e] * um2[i] + w1[e] * um1[i] + w2[e] * u0[i]); }
        }
        st16bf(Yc + (size_t)row * 1024 + ch, y);
        float sm_ = 0.f;
#pragma unroll
        for (int e = 0; e < 16; ++e) sm_ += o[e];
        const float mean = quad_sum(sm_) * (1.0f / 64.0f);
        float vr = 0.f;
#pragma unroll
        for (int e = 0; e < 16; ++e) { o[e] -= mean; vr += o[e] * o[e]; }
        const float rstd = rsqrtf(quad_sum(vr) * (1.0f / 64.0f) + 6.4e-4f);
#pragma unroll
        for (int q = 0; q < 4; ++q) {
            const f32x4 mv = *(const f32x4*)(tab + 4096 + ch + 4 * q), lg = *(const f32x4*)(tab + 5120 + ch + 4 * q), lb = *(const f32x4*)(tab + 6144 + ch + 4 * q);
#pragma unroll
            for (int e = 0; e < 4; ++e) { const int i = 4 * q + e; const float vs = vc[i] + mv[e] * (vq[i] - vc[i]); y[i] = (o[i] * rstd * lg[e] + lb[e] + c3 * vs) * sg[i]; }
        }
        st16bf(Yr + (size_t)row * 1024 + ch, y);
    }
}

struct SchedP3 {
    int G, c; const char* ws;
    __device__ __forceinline__ bool next(int i, Unit& u) const {
        const int tl = (i / 3) * G + c, seg = i % 3;
        if (tl >= 272) return false;
        u.x = tl >> 2; u.y = tl & 3; u.z = seg;
        u.a = ws + (seg == 0 ? WS_YCONV : seg == 1 ? WS_YRWKV : WS_YMEM) + (size_t)u.x * 256 * 2048; u.b = ws + WS_WB + ((size_t)seg * 1024 + (size_t)u.y * 256) * 2048;
        return true;
    }
};
struct EpiP3 {
    const bf16_t* ACT; bf16_t* MERGED;
    __device__ __forceinline__ bool operator()(f32x4 (&acc)[2][2][4][2], const Unit& u, int wr, int wc, int fr, int fq) const {
        const int seg = u.z, rbase = u.x * 256 + wr * 64 + fr, cb = u.y * 256 + wc * 32 + 8 * fq;
#pragma unroll
        for (int ai = 0; ai < 2; ++ai)
#pragma unroll
            for (int m = 0; m < 4; ++m) {
                const int row = rbase + ai * 128 + m * 16;
#pragma unroll
                for (int bj = 0; bj < 2; ++bj) {
                    const int col = cb + 128 * bj;
                    const u32x4 g = *(const u32x4*)(ACT + (size_t)row * ACT_LD + C_GATE + seg * 1024 + col);
                    float f[8];
#pragma unroll
                    for (int e = 0; e < 4; ++e) { f[2 * e] = bflo(g[e]); f[2 * e + 1] = bfhi(g[e]); }
                    if (seg < 2) {
                        const u32x4 g2 = *(const u32x4*)(ACT + (size_t)row * ACT_LD + C_GATE + (seg + 1) * 1024 + col);
#pragma unroll
                        for (int e = 0; e < 4; ++e) { f[2 * e] *= fast_rcp(bflo(g2[e])); f[2 * e + 1] *= fast_rcp(bfhi(g2[e])); }
                    }
                    f32x4& v0 = acc[ai][bj][m][0]; f32x4& v1 = acc[ai][bj][m][1];
#pragma unroll
                    for (int e = 0; e < 4; ++e) { v0[e] *= f[e]; v1[e] *= f[4 + e]; }
                    if (seg == 2) {
                        u32x4 o; o[0] = cvt_pk_bf16(v0[0], v0[1]); o[1] = cvt_pk_bf16(v0[2], v0[3]); o[2] = cvt_pk_bf16(v1[0], v1[1]); o[3] = cvt_pk_bf16(v1[2], v1[3]);
                        *(u32x4*)(MERGED + (size_t)row * 1024 + col) = o;
                    }
                }
            }
        return seg < 2;
    }
};
struct SchedP4 {
    int G, c; const char* A; const char* B;
    __device__ __forceinline__ bool next(int i, Unit& u) const {
        const int tl = i * G + c;
        if (tl >= 272) return false;
        u.x = tl >> 2; u.y = tl & 3; u.z = 0;
        u.a = A + (size_t)u.x * 256 * 2048; u.b = B + (size_t)u.y * 256 * 2048;
        return true;
    }
};
struct EpiP4 {
    const float* xp; const float* xs; float* out; float* SUMSQ;
    __device__ __forceinline__ bool operator()(f32x4 (&acc)[2][2][4][2], const Unit& u, int wr, int wc, int fr, int fq) const {
        const int rbase = u.x * 256 + wr * 64 + fr, cbase = u.y * 256 + wc * 32 + fq * 4;
#pragma unroll
        for (int ai = 0; ai < 2; ++ai)
#pragma unroll
            for (int m = 0; m < 4; ++m) {
                const int row = rbase + ai * 128 + m * 16;
                const float* xr = row < MP ? xp + (size_t)row * 1024 : xs + (size_t)(row - MP) * 1024;
                float ss = 0.f;
#pragma unroll
                for (int bj = 0; bj < 2; ++bj)
#pragma unroll
                    for (int n = 0; n < 2; ++n) {
                        const int col = cbase + bj * 128 + n * 16;
                        const f32x4 v = acc[ai][bj][m][n] + *(const f32x4*)(xr + col);
                        ss += v[0] * v[0] + v[1] * v[1] + v[2] * v[2] + v[3] * v[3];
                        *(f32x4*)(out + OUT_Y + (size_t)row * 1024 + col) = v;
                    }
                ss += __shfl_xor(ss, 16, 64); ss += __shfl_xor(ss, 32, 64);
                if (fq == 0) SUMSQ[(size_t)row * 16 + u.y * 4 + wc] = ss;
            }
        return false;
    }
};
__device__ void phase5(const Params& p) {
    const int lane = threadIdx.x & 63, wid = threadIdx.x >> 6;
    const float* SUMSQ = (const float*)(p.ws + WS_SUMSQ);
    for (int row = blockIdx.x * 8 + wid; row < MALL; row += gridDim.x * 8) {
        float ss = lane < 16 ? SUMSQ[(size_t)row * 16 + lane] : 0.f;
        ss = wave_sum(ss);
        const float inv = rsqrtf(ss * (1.0f / 1024.0f) + 1e-6f);
        float* y = p.out + OUT_Y + (size_t)row * 1024;
#pragma unroll
        for (int i = 0; i < 4; ++i) {
            f32x4 v = *(const f32x4*)(y + i * 256 + lane * 4); const f32x4 g = *(const f32x4*)(p.norm_final + i * 256 + lane * 4);
            v = v * inv * g;
            *(f32x4*)(y + i * 256 + lane * 4) = v;
        }
    }
}

__global__ void __launch_bounds__(NTHREADS) fwd_megakernel(Params p) {
    extern __shared__ __attribute__((aligned(16))) unsigned char smem[];
    cg::grid_group grid = cg::this_grid();
    LAS unsigned char* lds = (LAS unsigned char*)smem;
#ifndef PROBE_REP
#define PROBE_REP 0
#endif
#define REP(k) for (int _r = 0; _r < ((PROBE_REP == (k)) ? 2 : 1); ++_r)
    volatile LAS unsigned* xst = (volatile LAS unsigned*)(lds + LDS_MAIN);
    if (threadIdx.x == 0) { xst[0] = 0u; xst[1] = 0u; xst[2] = 0u; xst[3] = 0u; }
    __syncthreads();
    const XcdBarrier xb = xcd_barrier_post((unsigned*)(p.ws + WS_BAR), xst);
    REP(1) { phase0(p, smem); if (PROBE_REP == 1 && _r == 0) xcd_barrier(xb); }
    grid.sync();
    REP(2) {
        SchedP1 S{(int)gridDim.x, (int)blockIdx.x, (const char*)(p.ws + WS_AALL), (const char*)(p.ws + WS_BALL)};
        EpiP1 E{(bf16_t*)(p.ws + WS_U), (bf16_t*)(p.ws + WS_BG), (bf16_t*)(p.ws + WS_ACT), p.out, (bf16_t*)(p.ws + WS_KBF), (bf16_t*)(p.ws + WS_VT)};
        gemm_phase(lds, 2048, 2048, 1024, S, E);
        xcd_barrier(xb);
    }
    REP(3) { phase2_scan(p, smem); if (PROBE_REP == 3) xcd_barrier(xb); }
    REP(5) { phase2_attn(p, smem); if (PROBE_REP == 5) xcd_barrier(xb); }
    xcd_barrier(xb);
    REP(6) { phase2b(p, smem); xcd_barrier(xb); }
    REP(7) {
        SchedP3 S{(int)gridDim.x, (int)blockIdx.x, (const char*)p.ws};
        EpiP3 E{(const bf16_t*)(p.ws + WS_ACT), (bf16_t*)(p.ws + WS_MERGED)};
        gemm_phase(lds, 2048, 2048, 1024, S, E);
        xcd_barrier(xb);
    }
    REP(8) {
        SchedP4 S{(int)gridDim.x, (int)blockIdx.x, (const char*)(p.ws + WS_MERGED), (const char*)(p.ws + WS_WO)};
        EpiP4 E{p.x_prompt, p.x_sample, p.out, (float*)(p.ws + WS_SUMSQ)};
        gemm_phase(lds, 2048, 2048, 1024, S, E);
        xcd_barrier(xb);
    }
    phase5(p);
}

extern "C" void kernel_launch(void* const* d_in, const int* in_sizes, int n_in, void* d_out, int out_size, void* d_ws, size_t ws_size, hipStream_t stream) {
    static int grid_blocks = 0;
    if (!grid_blocks) {
        int dev = 0, cus = 0, per_cu = 0;
        hipGetDevice(&dev);
        hipDeviceGetAttribute(&cus, hipDeviceAttributeMultiprocessorCount, dev);
        if (hipFuncSetAttribute((const void*)fwd_megakernel, hipFuncAttributeMaxDynamicSharedMemorySize, LDS_BYTES) != hipSuccess) fprintf(stderr, "hipFuncSetAttribute failed\n");
        hipOccupancyMaxActiveBlocksPerMultiprocessor(&per_cu, (const void*)fwd_megakernel, NTHREADS, LDS_BYTES);
        if (per_cu < 1) { fprintf(stderr, "occupancy query returned %d\n", per_cu); per_cu = 1; }
        if (per_cu > 1) per_cu = 1;
        grid_blocks = cus * per_cu;
        if (ws_size < WS_END) { fprintf(stderr, "workspace too small: %zu < %zu\n", ws_size, (size_t)WS_END); grid_blocks = -1; }
    }
    if (grid_blocks < 0) return;
    Params p{};
    const float** pp = (const float**)&p;
    for (int i = 0; i < 27; ++i) pp[i] = (const float*)d_in[i];
    p.out = (float*)d_out; p.ws = (unsigned char*)d_ws;
    if (hipMemsetAsync((char*)d_ws + WS_BAR, 0, (size_t)XCD_BAR_WORDS_C * 4, stream) != hipSuccess) fprintf(stderr, "memset of barrier words failed\n");
    void* args[] = {&p};
    hipError_t e = hipLaunchCooperativeKernel((const void*)fwd_megakernel, dim3(grid_blocks), dim3(NTHREADS), args, LDS_BYTES, stream);
    if (e != hipSuccess) fprintf(stderr, "cooperative launch failed: %s (grid %d)\n", hipGetErrorString(e), grid_blocks);
}
```

```cpp
#include <hip/hip_runtime.h>
#include <hip/hip_cooperative_groups.h>
#include <cstdio>
namespace cg = cooperative_groups;

#define LAS __attribute__((address_space(3)))
typedef unsigned short bf16_t;
typedef short bf16x8 __attribute__((ext_vector_type(8)));
typedef float f32x4 __attribute__((ext_vector_type(4)));
typedef float f32x2 __attribute__((ext_vector_type(2)));
typedef unsigned u32x4 __attribute__((ext_vector_type(4)));
typedef unsigned u32x2 __attribute__((ext_vector_type(2)));

constexpr int DM = 1024, TP = 2048, BP = 8, MP = BP * TP, BS = 128, TS = 8, MS = BS * TS, MALL = MP + MS;
constexpr int NMEM = 256, DIN = 13440, DSHIFT = 3200;
constexpr int NPAD = 13568;
constexpr int ACT_LD = 9472;
constexpr int C_PR = 0, C_PK = 1024, C_PV = 2048, C_WD = 3072, C_AD = 3136, C_SGR = 3328, C_QM = 4352, C_SGM = 5376, C_GATE = 6400;
constexpr size_t OUT_Y = 0, OUT_MK = 17825792, OUT_MV = 19922944, OUT_CONV_P = 22020096, OUT_SHIFT_P = 22036480, OUT_WKV_P = 22062080,
                 OUT_CONV_S = 22586368, OUT_SHIFT_S = 22848512, OUT_WKV_S = 23258112;
constexpr size_t al256(size_t x) { return (x + 255) & ~(size_t)255; }
constexpr int XCD_BAR_WORDS_C = 3456;
constexpr size_t WS_AALL = 0;
constexpr size_t WS_BALL = al256(WS_AALL + (size_t)19456 * 1024 * 2);
constexpr size_t WS_YMEM = WS_AALL;
constexpr size_t WS_YCONV = WS_AALL + (size_t)MALL * 1024 * 2;
constexpr size_t WS_WB = al256(WS_BALL + (size_t)15616 * 1024 * 2);
constexpr size_t WS_WO = al256(WS_WB + (size_t)3072 * 1024 * 2);
constexpr size_t WS_U = al256(WS_WO + (size_t)1024 * 1024 * 2);
constexpr size_t WS_MERGED = WS_U;
constexpr size_t WS_BG = al256(WS_U + (size_t)MALL * 1024 * 2);
constexpr size_t WS_ACT = al256(WS_BG + (size_t)MALL * 1024 * 2);
constexpr size_t WS_KBF = al256(WS_ACT + (size_t)MALL * ACT_LD * 2);
constexpr size_t WS_VT = al256(WS_KBF + (size_t)2048 * 1024 * 2);
constexpr size_t WS_YRWKV = al256(WS_VT + (size_t)2048 * 1024 * 2);
constexpr size_t WS_C3 = al256(WS_YRWKV + (size_t)MALL * 1024 * 2);
constexpr size_t WS_SUMSQ = al256(WS_C3 + (size_t)MALL * 16 * 4);
constexpr size_t WS_BAR = al256(WS_SUMSQ + (size_t)MALL * 16 * 4);
constexpr size_t WS_FRAG = al256(WS_BAR + (size_t)XCD_BAR_WORDS_C * 4);
constexpr size_t WS_END = al256(WS_FRAG + (size_t)16 * 2 * 8 * 64 * 16);
static_assert(WS_YCONV + (size_t)MALL * 1024 * 2 <= WS_WB, "alias overflow");
static_assert(WS_END <= 536870912, "workspace too large");

constexpr int NTHREADS = 512;
constexpr int LDS_MAIN = 131072;
constexpr int LDS_BYTES = LDS_MAIN + 16;

struct Params {
    const float *x_prompt, *x_sample, *mem_prompt, *cache_k, *cache_v, *state_conv, *state_shift, *state_wkv, *norm_in, *w_in, *conv_w, *conv_b,
        *shift_mu, *decay_w0, *decay_up, *icl_a0, *icl_up, *k_k, *k_a, *r_k, *ln_g, *ln_b, *norm_mem, *w_mem_kv, *w_branch, *w_out, *norm_final;
    float* out;
    unsigned char* ws;
};

__device__ __forceinline__ int opaque_tid() { int t = threadIdx.x; asm volatile("" : "+v"(t)); return t; }
__device__ __forceinline__ float bf2f(bf16_t v) { return __uint_as_float(((unsigned)v) << 16); }
__device__ __forceinline__ unsigned cvt_pk_bf16(float lo, float hi) { unsigned r; asm volatile("v_cvt_pk_bf16_f32 %0, %1, %2" : "=v"(r) : "v"(lo), "v"(hi)); return r; }
__device__ __forceinline__ float bflo(unsigned u) { return __uint_as_float(u << 16); }
__device__ __forceinline__ float bfhi(unsigned u) { return __uint_as_float(u & 0xffff0000u); }
__device__ __forceinline__ float fast_rcp(float x) { return __builtin_amdgcn_rcpf(x); }
__device__ __forceinline__ float sigmoidf_(float x) { return fast_rcp(1.0f + __expf(-x)); }
__device__ __forceinline__ float siluf_(float x) { return x * sigmoidf_(x); }
__device__ __forceinline__ float wave_sum(float v) {
#pragma unroll
    for (int o = 32; o > 0; o >>= 1) v += __shfl_xor(v, o, 64);
    return v;
}
template <int CTRL> __device__ __forceinline__ float dpp_f(float x) {
    return __int_as_float(__builtin_amdgcn_update_dpp(0, __float_as_int(x), CTRL, 0xF, 0xF, true));
}
__device__ __forceinline__ float row16_sum(float x) {
    x += dpp_f<0xB1>(x);
    x += dpp_f<0x4E>(x);
    x += dpp_f<0x141>(x);
    x += dpp_f<0x140>(x);
    return x;
}


#define XB_TMO      128
#define XB_XCNT(j)  (256  + 64 * (j))
#define XB_XSUB(j)  (1280 + 64 * (j))
#define XB_XGEN(j)  (2304 + 64 * (j))
#define XB_TOP      3328
#define XB_TOPGEN   3392
#define XCD_BAR_WORDS 3456
#define XB_SPIN_CAP (1u << 22)
__device__ __forceinline__ unsigned xb_ld(unsigned* p)              { return __hip_atomic_load(p, __ATOMIC_RELAXED, __HIP_MEMORY_SCOPE_AGENT); }
__device__ __forceinline__ unsigned xb_add(unsigned* p, unsigned v) { return __hip_atomic_fetch_add(p, v, __ATOMIC_RELAXED, __HIP_MEMORY_SCOPE_AGENT); }
__device__ __forceinline__ unsigned xb_xcc_id() { return (unsigned)__builtin_amdgcn_s_getreg((3 << 11) | 20) & 0xFu; }
#define XB_SPIN(cond, bar) do { unsigned _sp = 0; while (cond) { __builtin_amdgcn_s_sleep(1); \
    if ((++_sp & 255u) == 0u) { if (xb_ld(&(bar)[XB_TMO])) break; if (_sp > XB_SPIN_CAP) { atomicAdd(&(bar)[XB_TMO], 1u); break; } } } } while (0)
struct XcdBarrier { unsigned* bar; unsigned x; volatile LAS unsigned* st; };
__device__ __forceinline__ XcdBarrier xcd_barrier_post(unsigned* bar, volatile LAS unsigned* st) {
    XcdBarrier b; b.bar = bar; b.x = xb_xcc_id(); b.st = st;
    if (threadIdx.x == 0) (void)xb_add(&bar[XB_XCNT(b.x)], 1u);
    return b;
}
__device__ __forceinline__ void xcd_barrier_complete(unsigned* bar, unsigned x, unsigned& nloc, unsigned& nx) {
    const unsigned G = gridDim.x * gridDim.y * gridDim.z;
    unsigned sum, cnt, mine, sp = 0u;
    for (;;) {
        sum = 0u; cnt = 0u; mine = 0u;
#pragma unroll
        for (unsigned j = 0; j < 16; ++j) { const unsigned c = xb_ld(&bar[XB_XCNT(j)]); sum += c; cnt += (c > 0u) ? 1u : 0u; mine = (j == x) ? c : mine; }
        if (sum == G) break;
        __builtin_amdgcn_s_sleep(1);
        if ((++sp & 255u) == 0u) { if (xb_ld(&bar[XB_TMO])) break; if (sp > XB_SPIN_CAP) { atomicAdd(&bar[XB_TMO], 1u); break; } }
    }
    nloc = mine > 0u ? mine : 1u; nx = cnt > 0u ? cnt : 1u;
}
__device__ __forceinline__ void xcd_barrier(const XcdBarrier& b) {
    asm volatile("s_waitcnt vmcnt(0)" ::: "memory");
    __syncthreads();
    if (threadIdx.x == 0) {
        unsigned* bar = b.bar;
        __builtin_amdgcn_s_waitcnt(0);
        unsigned nloc = b.st[0], nx = b.st[1];
        if (nloc == 0u) { xcd_barrier_complete(bar, b.x, nloc, nx); b.st[0] = nloc; b.st[1] = nx; }
        const unsigned old = xb_add(&bar[XB_XSUB(b.x)], 1u);
        const unsigned gen = old / nloc;
        if (old + 1u == (gen + 1u) * nloc) {
            __builtin_amdgcn_fence(__ATOMIC_RELEASE, "agent");
            asm volatile("s_waitcnt vmcnt(0)" ::: "memory");
            const unsigned og = xb_add(&bar[XB_TOP], 1u);
            const unsigned tg = og / nx;
            if (og + 1u == (tg + 1u) * nx) xb_add(&bar[XB_TOPGEN], 1u);
            else XB_SPIN(xb_ld(&bar[XB_TOPGEN]) == tg, bar);
            __builtin_amdgcn_fence(__ATOMIC_ACQUIRE, "agent");
            xb_add(&bar[XB_XGEN(b.x)], 1u);
            asm volatile("s_waitcnt vmcnt(0)" ::: "memory");
        } else {
            XB_SPIN(xb_ld(&bar[XB_XGEN(b.x)]) == gen, bar);
            __builtin_amdgcn_fence(__ATOMIC_ACQUIRE, "agent");
            asm volatile("s_waitcnt vmcnt(0)" ::: "memory");
        }
    }
    __syncthreads();
}

constexpr int BM = 256, BK = 64, HALF = 128, HTB = HALF * BK * 2;
__device__ __forceinline__ int lds_byte(int r, int c) { const int st = (r >> 4) * 2 + (c >> 5), rr = r & 15, cc = c & 31, ob = rr * 64 + cc * 2; return st * 1024 + (ob ^ (((ob >> 9) & 1) << 5)); }
__device__ __forceinline__ void stage_rc(int b, int& R, int& C) { const int st = b / 1024, sb = b % 1024, swz = sb ^ (((sb >> 9) & 1) << 5); R = (st >> 1) * 16 + swz / 64; C = (st & 1) * 32 + (swz % 64) / 2; }

struct Unit { const char* a; const char* b; int x, y, z; };

template <class Sched, class Epi>
__device__ __forceinline__ void gemm_phase(LAS unsigned char* lds, const int lda, const int ldb, const int K, const Sched& S, const Epi& E) {
    const int tid = opaque_tid(), wid = __builtin_amdgcn_readfirstlane(tid >> 6), lane = tid & 63, wr = wid >> 2, wc = wid & 3, fr = lane & 15, fq = lane >> 4;
    const int nt = K / BK;
    unsigned voffA[2], voffB[2];
#pragma unroll
    for (int i = 0; i < 2; ++i) { int R, C; stage_rc(tid * 16 + i * 8192, R, C); voffA[i] = (unsigned)(R * lda + C * 2); voffB[i] = (unsigned)(R * ldb + C * 2); }
    const size_t kstep = (size_t)(BK * 2);
    const size_t hA = (size_t)HALF * lda, hB = (size_t)HALF * ldb;
    const unsigned ldsw = (unsigned)wid * 1024u;
    const int aoff = lds_byte(wr * 64 + fr, fq * 8), boff = lds_byte(wc * 32 + fr, fq * 8);
#define G_SA(b, h) (((b) * 2 + (h)) * HTB)
#define G_SB(b, h) ((4 + (b) * 2 + (h)) * HTB)
#define G_STAGE(bufoff, gbase, voff) do { _Pragma("unroll") for (int _i = 0; _i < 2; ++_i) \
        __builtin_amdgcn_global_load_lds((const unsigned*)((const char*)(gbase) + (voff)[_i]), (LAS unsigned*)(lds + (bufoff) + ldsw + _i * 8192), 16, 0, 0); } while (0)
#define G_LDA(dst, b, h) do { _Pragma("unroll") for (int m = 0; m < 4; ++m) _Pragma("unroll") for (int k = 0; k < 2; ++k) dst[m][k] = *(const LAS bf16x8*)(lds + G_SA(b, h) + aoff + m * 2048 + k * 1024); } while (0)
#define G_LDB(dst, b, h) do { _Pragma("unroll") for (int n = 0; n < 2; ++n) _Pragma("unroll") for (int k = 0; k < 2; ++k) dst[n][k] = *(const LAS bf16x8*)(lds + G_SB(b, h) + boff + n * 2048 + k * 1024); } while (0)
#define G_MMA(ai, bj, At, Bt) do { __builtin_amdgcn_s_setprio(1); _Pragma("unroll") for (int m = 0; m < 4; ++m) _Pragma("unroll") for (int n = 0; n < 2; ++n) _Pragma("unroll") for (int k = 0; k < 2; ++k) \
        acc[ai][bj][m][n] = __builtin_amdgcn_mfma_f32_16x16x32_bf16(Bt[n][k], At[m][k], acc[ai][bj][m][n], 0, 0, 0); __builtin_amdgcn_s_setprio(0); } while (0)
#define G_WAIT_V(n) asm volatile("s_waitcnt vmcnt(" #n ")" ::: "memory")
#define G_WAIT_L(n) asm volatile("s_waitcnt lgkmcnt(" #n ")" ::: "memory")
#define G_BAR __builtin_amdgcn_s_barrier()
#define G_SCHED __builtin_amdgcn_sched_barrier(0)
    Unit cur, nxt; int ui = 0;
    if (!S.next(0, cur)) return;
    f32x4 acc[2][2][4][2];
#pragma unroll
    for (int a = 0; a < 2; ++a)
#pragma unroll
        for (int b = 0; b < 2; ++b)
#pragma unroll
            for (int m = 0; m < 4; ++m)
#pragma unroll
                for (int n = 0; n < 2; ++n) acc[a][b][m][n] = (f32x4){0.f, 0.f, 0.f, 0.f};
    bf16x8 At[4][2], B0[2][2], B1[2][2];
    const char* cA = cur.a; const char* cB = cur.b;
    G_STAGE(G_SB(0, 0), cB, voffB); G_STAGE(G_SA(0, 0), cA, voffA); G_STAGE(G_SB(0, 1), cB + hB, voffB); G_STAGE(G_SA(0, 1), cA + hA, voffA);
    if (wr == 1) G_BAR;
    G_WAIT_V(4); G_BAR;
    G_STAGE(G_SB(1, 0), cB + kstep, voffB); G_STAGE(G_SA(1, 0), cA + kstep, voffA); G_STAGE(G_SB(1, 1), cB + hB + kstep, voffB);
    G_WAIT_V(6); G_BAR;
    for (;;) {
        const bool has_next = S.next(ui + 1, nxt);
        const char* nA = has_next ? nxt.a : cA; const char* nB = has_next ? nxt.b : cB;
        for (int t = 0; t < nt; t += 2) {
            const bool last = (t == nt - 2);
            const char* a1 = cA + (size_t)(t + 1) * kstep;
            const char* a2 = last ? nA : cA + (size_t)(t + 2) * kstep; const char* b2 = last ? nB : cB + (size_t)(t + 2) * kstep;
            const char* a3 = a2 + kstep; const char* b3 = b2 + kstep;
            G_LDB(B0, 0, 0); G_SCHED; G_LDA(At, 0, 0); G_STAGE(G_SA(1, 1), a1 + hA, voffA);
            G_WAIT_L(8); G_BAR; G_WAIT_L(0); G_MMA(0, 0, At, B0); G_BAR; G_SCHED;
            G_LDB(B1, 0, 1); G_STAGE(G_SB(0, 0), b2, voffB);
            G_BAR; G_WAIT_L(0); G_MMA(0, 1, At, B1); G_BAR;
            G_LDA(At, 0, 1); G_STAGE(G_SA(0, 0), a2, voffA);
            G_BAR; G_WAIT_L(0); G_MMA(1, 0, At, B0); G_BAR; G_SCHED;
            G_STAGE(G_SB(0, 1), b2 + hB, voffB);
            G_WAIT_V(6); G_BAR; G_MMA(1, 1, At, B1); G_BAR;
            G_LDB(B0, 1, 0); G_SCHED; G_LDA(At, 1, 0); G_STAGE(G_SA(0, 1), a2 + hA, voffA);
            G_WAIT_L(8); G_BAR; G_WAIT_L(0); G_MMA(0, 0, At, B0); G_BAR; G_SCHED;
            G_LDB(B1, 1, 1); G_STAGE(G_SB(1, 0), b3, voffB);
            G_BAR; G_WAIT_L(0); G_MMA(0, 1, At, B1); G_BAR;
            G_LDA(At, 1, 1); G_STAGE(G_SA(1, 0), a3, voffA);
            G_BAR; G_WAIT_L(0); G_MMA(1, 0, At, B0); G_BAR; G_SCHED;
            G_STAGE(G_SB(1, 1), b3 + hB, voffB);
            G_WAIT_V(6); G_BAR; G_MMA(1, 1, At, B1); G_BAR;
        }
        const bool keep = E(acc, cur, wr, wc, fr, fq);
        if (!has_next) break;
        if (!keep) {
#pragma unroll
            for (int a = 0; a < 2; ++a)
#pragma unroll
                for (int b = 0; b < 2; ++b)
#pragma unroll
                    for (int m = 0; m < 4; ++m)
#pragma unroll
                        for (int n = 0; n < 2; ++n) acc[a][b][m][n] = (f32x4){0.f, 0.f, 0.f, 0.f};
        }
        cur = nxt; cA = nA; cB = nB; ++ui;
    }
    G_WAIT_V(0);
    if (wr == 0) G_BAR;
    G_BAR;
#undef G_SA
#undef G_SB
#undef G_STAGE
#undef G_LDA
#undef G_LDB
#undef G_MMA
#undef G_WAIT_V
#undef G_WAIT_L
#undef G_BAR
#undef G_SCHED
}

__device__ __forceinline__ int perm8_local(int c) {
    const int bj = c >> 7, wc = (c >> 5) & 3, n = (c >> 4) & 1, fq = (c >> 2) & 3, e = c & 3;
    return 128 * bj + 32 * wc + 8 * fq + 4 * n + e;
}
__device__ __forceinline__ int colmap_in(int np) {
    const int j = np >> 8, c = np & 255;
    if (j < 16) {
        const int bj = c >> 7, wc = (c >> 5) & 3, n = (c >> 4) & 1, fq = (c >> 2) & 3, e = c & 3;
        return (2 * bj + n) * 1024 + j * 64 + wc * 16 + fq * 4 + e;
    }
    const int L = (j - 16) * 256 + perm8_local(c);
    if (L < 3200) return 4096 + L;
    if (L < 3328) return -1;
    return L + 3968;
}

__device__ void phase0(const Params& p, unsigned char* smem) {
    const int tid = opaque_tid(), lane = tid & 63, wid = tid >> 6;
    bf16_t* Aall = (bf16_t*)(p.ws + WS_AALL);
    for (int row = blockIdx.x * 8 + wid; row < 19456; row += gridDim.x * 8) {
        const float* src; const float* g;
        if (row < MP) { src = p.x_prompt + (size_t)row * 1024; g = p.norm_in; }
        else if (row < MALL) { src = p.x_sample + (size_t)(row - MP) * 1024; g = p.norm_in; }
        else { src = p.mem_prompt + (size_t)(row - MALL) * 1024; g = p.norm_mem; }
        f32x4 v[4]; float ss = 0.f;
#pragma unroll
        for (int i = 0; i < 4; ++i) { v[i] = *(const f32x4*)(src + i * 256 + lane * 4); ss += v[i][0] * v[i][0] + v[i][1] * v[i][1] + v[i][2] * v[i][2] + v[i][3] * v[i][3]; }
        ss = wave_sum(ss);
        const float inv = rsqrtf(ss * (1.0f / 1024.0f) + 1e-6f);
#pragma unroll
        for (int i = 0; i < 4; ++i) {
            const f32x4 gg = *(const f32x4*)(g + i * 256 + lane * 4);
            u32x2 o; o[0] = cvt_pk_bf16(v[i][0] * inv * gg[0], v[i][1] * inv * gg[1]); o[1] = cvt_pk_bf16(v[i][2] * inv * gg[2], v[i][3] * inv * gg[3]);
            *(u32x2*)(Aall + (size_t)row * 1024 + i * 256 + lane * 4) = o;
        }
    }
    for (int idx = blockIdx.x * NTHREADS + tid; idx < 16 * 2 * 8 * 64; idx += gridDim.x * NTHREADS) {
        const int ln = idx & 63, f = (idx >> 6) & 7, mat = (idx >> 9) & 1, hh = idx >> 10;
        const int it = f >> 1, ks = f & 1, fr = ln & 15, fq = ln >> 4;
        const float* src = mat ? p.icl_up : p.decay_up;
        float w[8];
#pragma unroll
        for (int jj = 0; jj < 8; ++jj) w[jj] = src[(size_t)(ks * 32 + fq * 8 + jj) * 1024 + hh * 64 + it * 16 + fr];
        u32x4 pk; pk[0] = cvt_pk_bf16(w[0], w[1]); pk[1] = cvt_pk_bf16(w[2], w[3]); pk[2] = cvt_pk_bf16(w[4], w[5]); pk[3] = cvt_pk_bf16(w[6], w[7]);
        *(u32x4*)(p.ws + WS_FRAG + (size_t)idx * 16) = pk;
    }
    bf16_t* T = (bf16_t*)smem;
    const int NT_IN = 212 * 16, NT_KV = 32 * 16, NT_WB = 3 * 16 * 16, NT_WO = 16 * 16;
    const int total = NT_IN + NT_KV + NT_WB + NT_WO;
    for (int tix = blockIdx.x; tix < total; tix += gridDim.x) {
        const float* src; int src_ld; bf16_t* dst; int n0, k0, mode;
        if (tix < NT_IN) { src = p.w_in; src_ld = DIN; dst = (bf16_t*)(p.ws + WS_BALL); n0 = (tix >> 4) * 64; k0 = (tix & 15) * 64; mode = 0; }
        else if (tix < NT_IN + NT_KV) { const int t2 = tix - NT_IN; src = p.w_mem_kv; src_ld = 2048; dst = (bf16_t*)(p.ws + WS_BALL) + (size_t)NPAD * 1024; n0 = (t2 >> 4) * 64; k0 = (t2 & 15) * 64; mode = 1; }
        else if (tix < NT_IN + NT_KV + NT_WB) { const int t2 = tix - NT_IN - NT_KV; const int i = t2 >> 8, t3 = t2 & 255; src = p.w_branch + (size_t)i * 1024 * 1024; src_ld = 1024;
            dst = (bf16_t*)(p.ws + WS_WB) + (size_t)i * 1024 * 1024; n0 = (t3 >> 4) * 64; k0 = (t3 & 15) * 64; mode = 2; }
        else { const int t3 = tix - NT_IN - NT_KV - NT_WB; src = p.w_out; src_ld = 1024; dst = (bf16_t*)(p.ws + WS_WO); n0 = (t3 >> 4) * 64; k0 = (t3 & 15) * 64; mode = 1; }
        {
            const int kk = tid >> 3, seg = tid & 7;
#pragma unroll
            for (int q = 0; q < 2; ++q) {
                const int nl = seg * 8 + q * 4, np = n0 + nl;
                int sc;
                if (mode == 0) sc = colmap_in(np);
                else if (mode == 1) sc = np;
                else sc = (np & ~255) + perm8_local(np & 255);
                f32x4 v = (f32x4){0.f, 0.f, 0.f, 0.f};
                if (sc >= 0) v = *(const f32x4*)(src + (size_t)(k0 + kk) * src_ld + sc);
                const unsigned a = cvt_pk_bf16(v[0], v[1]), b = cvt_pk_bf16(v[2], v[3]);
                T[(nl + 0) * 72 + kk] = (bf16_t)(a & 0xffff); T[(nl + 1) * 72 + kk] = (bf16_t)(a >> 16);
                T[(nl + 2) * 72 + kk] = (bf16_t)(b & 0xffff); T[(nl + 3) * 72 + kk] = (bf16_t)(b >> 16);
            }
        }
        __syncthreads();
        {
            const int nl = tid >> 3, ks = tid & 7;
            const u32x4 v = *(const u32x4*)(T + nl * 72 + ks * 8);
            *(u32x4*)(dst + (size_t)(n0 + nl) * 1024 + k0 + ks * 8) = v;
        }
        __syncthreads();
    }
}

struct SchedP1 {
    int G, c; const char* Aall; const char* Ball;
    __device__ __forceinline__ bool next(int i, Unit& u) const {
        const int L = i * G + c;
        constexpr int nM = 68, nN = 53, nwg = nM * nN, WGM = 8;
        if (L >= nwg + 96) return false;
        if (L < nwg) {
            int wgid = L; { const int q = nwg / 8, r = nwg % 8, xcd = wgid % 8, off = wgid / 8; wgid = (xcd < r ? xcd * (q + 1) : r * (q + 1) + (xcd - r) * q) + off; }
            const int nig = WGM * nN, gid = wgid / nig, fm = gid * WGM, gsz = (nM - fm) < WGM ? (nM - fm) : WGM;
            u.x = fm + ((wgid % nig) % gsz); u.y = (wgid % nig) / gsz; u.z = 0;
            u.a = Aall + (size_t)u.x * 256 * 2048; u.b = Ball + (size_t)u.y * 256 * 2048;
        } else {
            int k = L - nwg;
            if (k < 32) { u.x = k >> 2; u.y = k & 3; u.z = 1; u.a = Aall + (size_t)(68 + u.x) * 256 * 2048; u.b = Ball + (size_t)(53 + u.y) * 256 * 2048; }
            else if (k < 64) { k -= 32; u.x = k >> 2; u.y = k & 3; u.z = 2; u.a = Aall + (size_t)(68 + u.x) * 256 * 2048; u.b = Ball + (size_t)(57 + u.y) * 256 * 2048; }
            else { k -= 64; u.x = k >> 3; u.y = k & 7; u.z = 3; u.a = Ball + (size_t)(57 + u.x) * 256 * 2048; u.b = Aall + (size_t)(68 + u.y) * 256 * 2048; }
        }
        return true;
    }
};

struct EpiP1 {
    bf16_t* U; bf16_t* BG; bf16_t* ACT; float* out; bf16_t* Kbf; bf16_t* Vt;
    __device__ __forceinline__ bool operator()(f32x4 (&acc)[2][2][4][2], const Unit& u, int wr, int wc, int fr, int fq) const {
        const int type = u.z;
        if (type == 0) {
            const int pn = u.y, rbase = u.x * 256 + wr * 64 + fr;
            if (pn < 16) {
                const int ch0 = pn * 64 + wc * 16 + fq * 4;
#pragma unroll
                for (int ai = 0; ai < 2; ++ai)
#pragma unroll
                    for (int m = 0; m < 4; ++m) {
                        const int row = rbase + ai * 128 + m * 16;
                        const f32x4 h = acc[ai][0][m][0], Bv = acc[ai][0][m][1], Cv = acc[ai][1][m][0], g = acc[ai][1][m][1];
                        const f32x4 u4 = Cv * h;
                        f32x4 bg;
#pragma unroll
                        for (int e = 0; e < 4; ++e) bg[e] = Bv[e] * siluf_(g[e]);
                        u32x2 o; o[0] = cvt_pk_bf16(u4[0], u4[1]); o[1] = cvt_pk_bf16(u4[2], u4[3]);
                        *(u32x2*)(U + (size_t)row * 1024 + ch0) = o;
                        o[0] = cvt_pk_bf16(bg[0], bg[1]); o[1] = cvt_pk_bf16(bg[2], bg[3]);
                        *(u32x2*)(BG + (size_t)row * 1024 + ch0) = o;
                        if (row < MP) { const int t = row & 2047; if (t >= 2046) *(f32x4*)(out + OUT_CONV_P + (size_t)((row >> 11) * 2 + (t - 2046)) * 1024 + ch0) = u4; }
                        else { const int rs = row - MP, t = rs & 7; if (t >= 6) *(f32x4*)(out + OUT_CONV_S + (size_t)((rs >> 3) * 2 + (t - 6)) * 1024 + ch0) = u4; }
                    }
            } else {
                const int L0 = (pn - 16) * 256;
                const int kind = pn <= 28 ? 0 : pn <= 32 ? 1 : pn <= 36 ? 2 : pn <= 40 ? 1 : 3;
#pragma unroll
                for (int ai = 0; ai < 2; ++ai)
#pragma unroll
                    for (int m = 0; m < 4; ++m) {
                        const int row = rbase + ai * 128 + m * 16;
#pragma unroll
                        for (int bj = 0; bj < 2; ++bj) {
                            const int L = L0 + 128 * bj + 32 * wc + 8 * fq;
                            f32x4 v0 = acc[ai][bj][m][0], v1 = acc[ai][bj][m][1];
                            if (kind == 0) {
                                if (L < DSHIFT) {
                                    if (row < MP) { if ((row & 2047) == 2047) { float* d = out + OUT_SHIFT_P + (size_t)(row >> 11) * DSHIFT + L; *(f32x4*)d = v0; *(f32x4*)(d + 4) = v1; } }
                                    else { const int rs = row - MP; if ((rs & 7) == 7) { float* d = out + OUT_SHIFT_S + (size_t)(rs >> 3) * DSHIFT + L; *(f32x4*)d = v0; *(f32x4*)(d + 4) = v1; } }
                                }
                            } else if (kind == 1) {
#pragma unroll
                                for (int e = 0; e < 4; ++e) { v0[e] = siluf_(v0[e]); v1[e] = siluf_(v1[e]); }
                            } else if (kind == 2) { v0 *= 0.0625f; v1 *= 0.0625f; }
                            else {
#pragma unroll
                                for (int e = 0; e < 4; ++e) { v0[e] = sigmoidf_(v0[e]); v1[e] = sigmoidf_(v1[e]); }
                            }
                            u32x4 o; o[0] = cvt_pk_bf16(v0[0], v0[1]); o[1] = cvt_pk_bf16(v0[2], v0[3]); o[2] = cvt_pk_bf16(v1[0], v1[1]); o[3] = cvt_pk_bf16(v1[2], v1[3]);
                            *(u32x4*)(ACT + (size_t)row * ACT_LD + L) = o;
                        }
                    }
            }
        } else {
            const int rbase = u.x * 256 + wr * 64 + fr, cbase = u.y * 256 + wc * 32 + fq * 4;
#pragma unroll
            for (int ai = 0; ai < 2; ++ai)
#pragma unroll
                for (int m = 0; m < 4; ++m) {
                    const int row = rbase + ai * 128 + m * 16;
#pragma unroll
                    for (int bj = 0; bj < 2; ++bj)
#pragma unroll
                        for (int n = 0; n < 2; ++n) {
                            const int col = cbase + bj * 128 + n * 16;
                            const f32x4 v = acc[ai][bj][m][n];
                            if (type == 1) { *(f32x4*)(out + OUT_MK + (size_t)row * 1024 + col) = v;
                                u32x2 o; o[0] = cvt_pk_bf16(v[0], v[1]); o[1] = cvt_pk_bf16(v[2], v[3]); *(u32x2*)(Kbf + (size_t)row * 1024 + col) = o; }
                            else if (type == 2) { *(f32x4*)(out + OUT_MV + (size_t)row * 1024 + col) = v; }
                            else { u32x2 o; o[0] = cvt_pk_bf16(v[0], v[1]); o[1] = cvt_pk_bf16(v[2], v[3]); *(u32x2*)(Vt + (size_t)row * 2048 + col) = o; }
                        }
                }
        }
        return false;
    }
};

struct ChunkDesc { int r0, b, h, half, samp, t0, n, first, last; };
__device__ __forceinline__ bool chunk_desc(const int ci, const int bid, const int G, ChunkDesc& d) {
    const int n_long = bid < 256 ? (255 - bid) / G + 1 : 0;
    const int n_samp = bid < 4096 ? (4095 - bid) / G + 1 : 0;
    const int nc_long = n_long * 64;
    if (ci < nc_long) { const int k = ci >> 6, it = bid + k * G, chain = it >> 1; d.b = chain >> 4; d.h = chain & 15; d.half = it & 1; d.samp = 0; d.r0 = d.b * TP;
        d.t0 = (ci & 63) * 32; d.n = 32; d.first = (ci & 63) == 0; d.last = (ci & 63) == 63; return true; }
    const int k = ci - nc_long; if (k >= n_samp) return false;
    const int it = bid + k * G, chain = it >> 1; d.b = chain >> 4; d.h = chain & 15; d.half = it & 1; d.samp = 1; d.r0 = MP + d.b * TS; d.t0 = 0; d.n = 8; d.first = 1; d.last = 1; return true;
}
constexpr int SROW = 68;
constexpr int SBUF = 6 * 32 * SROW + 64;
__device__ __forceinline__ f32x2 lo2(const f32x4 v) { return __builtin_shufflevector(v, v, 0, 1); }
__device__ __forceinline__ f32x2 hi2(const f32x4 v) { return __builtin_shufflevector(v, v, 2, 3); }
__device__ __forceinline__ float tanh_fast(float x) { return 1.0f - 2.0f * fast_rcp(1.0f + __expf(2.0f * x)); }

__device__ __forceinline__ void unpack4(const u32x2 v, float (&o)[4]) { o[0] = bflo(v[0]); o[1] = bfhi(v[0]); o[2] = bflo(v[1]); o[3] = bfhi(v[1]); }

struct OpSet { f32x4 kk, wr, w, b, k; f32x2 v, cc; };
__device__ __forceinline__ void reduce4_row16(float a0, float a1, float b0, float b1, float c0, float c1, float d0, float d1, float& A, float& B, float& C, float& D) {
    asm volatile(
        "v_add_f32 %0, %4, %5\n\tv_add_f32 %1, %6, %7\n\tv_add_f32 %2, %8, %9\n\tv_add_f32 %3, %10, %11\n\t"
        "v_add_f32_dpp %0, %0, %0 quad_perm:[1,0,3,2] row_mask:0xf bank_mask:0xf\n\tv_add_f32_dpp %1, %1, %1 quad_perm:[1,0,3,2] row_mask:0xf bank_mask:0xf\n\t"
        "v_add_f32_dpp %2, %2, %2 quad_perm:[1,0,3,2] row_mask:0xf bank_mask:0xf\n\tv_add_f32_dpp %3, %3, %3 quad_perm:[1,0,3,2] row_mask:0xf bank_mask:0xf\n\t"
        "v_add_f32_dpp %0, %0, %0 quad_perm:[2,3,0,1] row_mask:0xf bank_mask:0xf\n\tv_add_f32_dpp %1, %1, %1 quad_perm:[2,3,0,1] row_mask:0xf bank_mask:0xf\n\t"
        "v_add_f32_dpp %2, %2, %2 quad_perm:[2,3,0,1] row_mask:0xf bank_mask:0xf\n\tv_add_f32_dpp %3, %3, %3 quad_perm:[2,3,0,1] row_mask:0xf bank_mask:0xf\n\t"
        "v_add_f32_dpp %0, %0, %0 row_half_mirror row_mask:0xf bank_mask:0xf\n\tv_add_f32_dpp %1, %1, %1 row_half_mirror row_mask:0xf bank_mask:0xf\n\t"
        "v_add_f32_dpp %2, %2, %2 row_half_mirror row_mask:0xf bank_mask:0xf\n\tv_add_f32_dpp %3, %3, %3 row_half_mirror row_mask:0xf bank_mask:0xf\n\t"
        "v_add_f32_dpp %0, %0, %0 row_mirror row_mask:0xf bank_mask:0xf\n\tv_add_f32_dpp %1, %1, %1 row_mirror row_mask:0xf bank_mask:0xf\n\t"
        "v_add_f32_dpp %2, %2, %2 row_mirror row_mask:0xf bank_mask:0xf\n\tv_add_f32_dpp %3, %3, %3 row_mirror row_mask:0xf bank_mask:0xf\n\t"
        "s_nop 1"
        : "=&v"(A), "=&v"(B), "=&v"(C), "=&v"(D)
        : "v"(a0), "v"(a1), "v"(b0), "v"(b1), "v"(c0), "v"(c1), "v"(d0), "v"(d1));
}
struct PrepState { f32x4 aw[4], aa[4]; float ksf[16]; float rn; };

struct PrepRaw { u32x4 wdc[2], wdp[2], adc[2], adp[2]; u32x2 kc[4], kp[4]; };
struct PrepRaw2 { u32x2 rc[4], rp[4], vc[4], vp[4]; };
__device__ __forceinline__ void prep_load(const Params& p, const ChunkDesc& d, const int tb, const int lane, PrepRaw& R) {
    const int fr = lane & 15, fq = lane >> 4;
    const int t = tb + fr; const int tt = t < d.n ? t : d.n - 1;
    const size_t row = (size_t)(d.r0 + d.t0 + tt);
    const bool isfirst = (d.t0 + tt) == 0;
    const bf16_t* cur = (const bf16_t*)(p.ws + WS_ACT) + row * ACT_LD;
    const bf16_t* prv = isfirst ? cur : cur - ACT_LD;
    const int hc = d.h * 64 + 4 * fq;
#pragma unroll
    for (int ks = 0; ks < 2; ++ks) {
        R.wdc[ks] = *(const u32x4*)(cur + C_WD + ks * 32 + fq * 8); R.wdp[ks] = *(const u32x4*)(prv + C_WD + ks * 32 + fq * 8);
        R.adc[ks] = *(const u32x4*)(cur + C_AD + ks * 32 + fq * 8); R.adp[ks] = *(const u32x4*)(prv + C_AD + ks * 32 + fq * 8);
    }
#pragma unroll
    for (int it = 0; it < 4; ++it) { R.kc[it] = *(const u32x2*)(cur + C_PK + hc + it * 16); R.kp[it] = *(const u32x2*)(prv + C_PK + hc + it * 16); }
}
__device__ __forceinline__ void prep_load2(const Params& p, const ChunkDesc& d, const int tb, const int lane, PrepRaw2& R) {
    const int fr = lane & 15, fq = lane >> 4;
    const int t = tb + fr; const int tt = t < d.n ? t : d.n - 1;
    const size_t row = (size_t)(d.r0 + d.t0 + tt);
    const bool isfirst = (d.t0 + tt) == 0;
    const bf16_t* cur = (const bf16_t*)(p.ws + WS_ACT) + row * ACT_LD;
    const bf16_t* prv = isfirst ? cur : cur - ACT_LD;
    const int hc = d.h * 64 + 4 * fq;
#pragma unroll
    for (int it = 0; it < 4; ++it) {
        R.rc[it] = *(const u32x2*)(cur + C_PR + hc + it * 16); R.rp[it] = *(const u32x2*)(prv + C_PR + hc + it * 16);
        R.vc[it] = *(const u32x2*)(cur + C_PV + hc + it * 16); R.vp[it] = *(const u32x2*)(prv + C_PV + hc + it * 16);
    }
}
__device__ __forceinline__ void shift4(const u32x2 cu, const u32x2 pr, const float* st, const bool isfirst, const bool samp, const int col, const f32x4 mu, float (&o)[4]) {
    float c[4], q[4];
    unpack4(cu, c); unpack4(pr, q);
    if (isfirst) {
        if (samp) { const f32x4 v = *(const f32x4*)(st + col); q[0] = v[0]; q[1] = v[1]; q[2] = v[2]; q[3] = v[3]; }
        else { q[0] = 0.f; q[1] = 0.f; q[2] = 0.f; q[3] = 0.f; }
    }
#pragma unroll
    for (int e = 0; e < 4; ++e) o[e] = c[e] + mu[e] * (q[e] - c[e]);
}

__device__ __forceinline__ void prep_stage1(const Params& p, const ChunkDesc& d, const int tb, const float* par, const int lane, const PrepRaw& R, PrepState& S) {
    const int fr = lane & 15, fq = lane >> 4;
    const int t = tb + fr; const int tt = t < d.n ? t : d.n - 1;
    const bool isfirst = (d.t0 + tt) == 0, samp = d.samp != 0;
    const float* st = p.state_shift + (size_t)d.b * DSHIFT;
    bf16x8 bw[2], ba[2];
#pragma unroll
    for (int ks = 0; ks < 2; ++ks) {
#pragma unroll
        for (int which = 0; which < 2; ++which) {
            const int col = (which ? C_AD : C_WD) + ks * 32 + fq * 8;
            const u32x4 cu = which ? R.adc[ks] : R.wdc[ks], pr = which ? R.adp[ks] : R.wdp[ks];
            float x0[4], x1[4];
            shift4((u32x2){cu[0], cu[1]}, (u32x2){pr[0], pr[1]}, st, isfirst, samp, col, *(const f32x4*)(par + 512 + which * 64 + ks * 32 + fq * 8), x0);
            shift4((u32x2){cu[2], cu[3]}, (u32x2){pr[2], pr[3]}, st, isfirst, samp, col + 4, *(const f32x4*)(par + 512 + which * 64 + ks * 32 + fq * 8 + 4), x1);
            if (!which) {
#pragma unroll
                for (int e = 0; e < 4; ++e) { x0[e] = tanh_fast(x0[e]); x1[e] = tanh_fast(x1[e]); }
            }
            u32x4 pk; pk[0] = cvt_pk_bf16(x0[0], x0[1]); pk[1] = cvt_pk_bf16(x0[2], x0[3]); pk[2] = cvt_pk_bf16(x1[0], x1[1]); pk[3] = cvt_pk_bf16(x1[2], x1[3]);
            if (which) ba[ks] = __builtin_bit_cast(bf16x8, pk); else bw[ks] = __builtin_bit_cast(bf16x8, pk);
        }
    }
    const bf16x8* ft = (const bf16x8*)(p.ws + WS_FRAG) + (size_t)d.h * 1024 + lane;
    __builtin_amdgcn_sched_barrier(0);
#pragma unroll
    for (int it = 0; it < 4; ++it) {
        S.aw[it] = (f32x4){0.f, 0.f, 0.f, 0.f}; S.aa[it] = S.aw[it];
#pragma unroll
        for (int ks = 0; ks < 2; ++ks) {
            S.aw[it] = __builtin_amdgcn_mfma_f32_16x16x32_bf16(ft[(it * 2 + ks) * 64], bw[ks], S.aw[it], 0, 0, 0);
            S.aa[it] = __builtin_amdgcn_mfma_f32_16x16x32_bf16(ft[(8 + it * 2 + ks) * 64], ba[ks], S.aa[it], 0, 0, 0);
        }
        if (it & 1) __builtin_amdgcn_sched_barrier(0);
    }
    const int hc = d.h * 64 + 4 * fq;
    float ss = 0.f;
#pragma unroll
    for (int it = 0; it < 4; ++it) {
        const int po = it * 16 + 4 * fq;
        float k4[4];
        shift4(R.kc[it], R.kp[it], st, isfirst, samp, C_PK + hc + it * 16, *(const f32x4*)(par + 64 + po), k4);
        const f32x4 kkp = *(const f32x4*)(par + 5 * 64 + po);
#pragma unroll
        for (int e = 0; e < 4; ++e) { S.ksf[it * 4 + e] = k4[e]; const float kr = k4[e] * kkp[e]; ss += kr * kr; }
        __builtin_amdgcn_sched_barrier(0);
    }
    ss += __shfl_xor(ss, 16, 64); ss += __shfl_xor(ss, 32, 64);
    S.rn = rsqrtf(ss + 1e-12f);
}

__device__ __forceinline__ void prep_stage2(const Params& p, const ChunkDesc& d, const int tb, float* buf, const float* par, const int lane, const PrepRaw2& R, const PrepState& S) {
    const int fr = lane & 15, fq = lane >> 4;
    const int t = tb + fr; const bool valid = t < d.n; const int tt = valid ? t : d.n - 1;
    const bool isfirst = (d.t0 + tt) == 0, samp = d.samp != 0;
    const float* st = p.state_shift + (size_t)d.b * DSHIFT;
    const int hc = d.h * 64 + 4 * fq;
    float c1 = 0.f, c2 = 0.f, c3 = 0.f;
    float* kkA = buf; float* wrA = buf + 32 * SROW; float* wA = buf + 2 * 32 * SROW; float* bA = buf + 3 * 32 * SROW; float* kpA = buf + 4 * 32 * SROW; float* vsA = buf + 5 * 32 * SROW; float* c12 = buf + 6 * 32 * SROW;
#pragma unroll
    for (int it = 0; it < 4; ++it) {
        const int po = it * 16 + 4 * fq;
        const f32x4 w0 = *(const f32x4*)(par + 3 * 64 + po), a0 = *(const f32x4*)(par + 4 * 64 + po), kkp = *(const f32x4*)(par + 5 * 64 + po), ka = *(const f32x4*)(par + 6 * 64 + po), rk = *(const f32x4*)(par + 7 * 64 + po);
        f32x4 o_kk, o_wr, o_w, o_b, o_kp, o_vs;
        float r4[4], v4[4];
        shift4(R.rc[it], R.rp[it], st, isfirst, samp, C_PR + hc + it * 16, *(const f32x4*)(par + po), r4);
        shift4(R.vc[it], R.vp[it], st, isfirst, samp, C_PV + hc + it * 16, *(const f32x4*)(par + 128 + po), v4);
#pragma unroll
        for (int e = 0; e < 4; ++e) {
            const float r_ = r4[e], k_ = S.ksf[it * 4 + e];
            const float dec = __expf(-0.6065306597f * sigmoidf_(S.aw[it][e] + w0[e]));
            const float a = sigmoidf_(S.aa[it][e] + a0[e]);
            const float kn = k_ * kkp[e] * S.rn;
            const float kpv = k_ * (1.0f + (a - 1.0f) * ka[e]);
            const float bv = kn * a;
            c1 += bv * r_; c2 += kpv * r_; c3 += r_ * kpv * rk[e];
            o_kk[e] = kn; o_wr[e] = dec * r_; o_w[e] = dec; o_b[e] = bv; o_kp[e] = kpv; o_vs[e] = v4[e];
        }
        if (valid) {
            const int o = t * SROW + po;
            *(f32x4*)(kkA + o) = o_kk; *(f32x4*)(wrA + o) = o_wr; *(f32x4*)(wA + o) = o_w; *(f32x4*)(bA + o) = o_b; *(f32x4*)(kpA + o) = o_kp; *(f32x4*)(vsA + o) = o_vs;
        }
        __builtin_amdgcn_sched_barrier(0);
    }
    c1 += __shfl_xor(c1, 16, 64); c1 += __shfl_xor(c1, 32, 64);
    c2 += __shfl_xor(c2, 16, 64); c2 += __shfl_xor(c2, 32, 64);
    c3 += __shfl_xor(c3, 16, 64); c3 += __shfl_xor(c3, 32, 64);
    if (valid && fq == 0) { c12[t * 2] = c1; c12[t * 2 + 1] = c2; if (d.half == 0) ((float*)(p.ws + WS_C3))[(size_t)(d.r0 + d.t0 + t) * 16 + d.h] = c3; }
}

__device__ void phase2_scan(const Params& p, unsigned char* smem) {
    const int tid = opaque_tid(), lane = tid & 63, wid = __builtin_amdgcn_readfirstlane(tid >> 6);
    const int bid = blockIdx.x, G = gridDim.x;
    float* sm = (float*)smem;
    float* bufs = sm;
    float* obuf = sm + 2 * SBUF;
    float* parb = obuf + 2 * 1024;
    const int n_long = bid < 256 ? (255 - bid) / G + 1 : 0, n_samp = bid < 4096 ? (4095 - bid) / G + 1 : 0;
    const int NC = n_long * 64 + n_samp;
    float* ORAW = p.out + OUT_Y;
    __syncthreads();
    if (NC == 0) return;
    if (wid < 4) {
        const int c = lane & 15, rg = lane >> 4, rl = wid * 8 + rg * 2;
        f32x2 s00 = (f32x2){0.f, 0.f}, s01 = s00, s10 = s00, s11 = s00;
        __syncthreads();
        __syncthreads();
        for (int ci = 0; ci < NC; ++ci) {
            ChunkDesc d; chunk_desc(ci, bid, G, d);
            const size_t st_off = ((size_t)(d.b * 16 + d.h) * 64 + d.half * 32 + rl) * 64 + 4 * c;
            if (d.first) {
                if (d.samp) { const f32x4 a = *(const f32x4*)(p.state_wkv + st_off), b2 = *(const f32x4*)(p.state_wkv + st_off + 64); s00 = lo2(a); s01 = hi2(a); s10 = lo2(b2); s11 = hi2(b2); }
                else { s00 = (f32x2){0.f, 0.f}; s01 = s00; s10 = s00; s11 = s00; }
            }
            const float* buf = bufs + (ci & 1) * SBUF;
            const float* kkA = buf + 4 * c; const float* vsA = buf + 5 * 32 * SROW + d.half * 32 + rl; const float* c12 = buf + 6 * 32 * SROW;
            float* ob = obuf + (ci & 1) * 1024 + rl;
            const int n = d.n;
            OpSet A, B;
            auto ld = [&](OpSet& o, const int t) {
                o.kk = *(const f32x4*)(kkA + t * SROW); o.wr = *(const f32x4*)(kkA + 32 * SROW + t * SROW); o.w = *(const f32x4*)(kkA + 2 * 32 * SROW + t * SROW);
                o.b = *(const f32x4*)(kkA + 3 * 32 * SROW + t * SROW); o.k = *(const f32x4*)(kkA + 4 * 32 * SROW + t * SROW);
                o.v = *(const f32x2*)(vsA + t * SROW); o.cc = *(const f32x2*)(c12 + t * 2);
            };
            auto step = [&](const OpSet& o, const int t) {
                const f32x2 pd0 = s00 * lo2(o.kk) + s01 * hi2(o.kk), pd1 = s10 * lo2(o.kk) + s11 * hi2(o.kk);
                const f32x2 pe0 = s00 * lo2(o.wr) + s01 * hi2(o.wr), pe1 = s10 * lo2(o.wr) + s11 * hi2(o.wr);
                float d0, d1, e0, e1;
                reduce4_row16(pd0[0], pd0[1], pd1[0], pd1[1], pe0[0], pe0[1], pe1[0], pe1[1], d0, d1, e0, e1);
                const f32x2 vv0 = (f32x2){o.v[0], o.v[0]}, vv1 = (f32x2){o.v[1], o.v[1]}, dd0 = (f32x2){d0, d0}, dd1 = (f32x2){d1, d1};
                s00 = s00 * lo2(o.w) + (lo2(o.k) * vv0 - lo2(o.b) * dd0);
                s01 = s01 * hi2(o.w) + (hi2(o.k) * vv0 - hi2(o.b) * dd0);
                s10 = s10 * lo2(o.w) + (lo2(o.k) * vv1 - lo2(o.b) * dd1);
                s11 = s11 * hi2(o.w) + (hi2(o.k) * vv1 - hi2(o.b) * dd1);
                if (c == 0) { f32x2 ov; ov[0] = e0 - d0 * o.cc[0] + o.v[0] * o.cc[1]; ov[1] = e1 - d1 * o.cc[0] + o.v[1] * o.cc[1]; *(f32x2*)(ob + t * 32) = ov; }
            };
            ld(A, 0);
            for (int t = 0; t < n; t += 2) {
                ld(B, t + 1);
                step(A, t);
                ld(A, (t + 2 < n) ? t + 2 : t);
                step(B, t + 1);
            }
            if (d.last) {
                float* so = p.out + (d.samp ? OUT_WKV_S : OUT_WKV_P) + st_off;
                f32x4 a, b2; a[0] = s00[0]; a[1] = s00[1]; a[2] = s01[0]; a[3] = s01[1]; b2[0] = s10[0]; b2[1] = s10[1]; b2[2] = s11[0]; b2[3] = s11[1];
                *(f32x4*)so = a; *(f32x4*)(so + 64) = b2;
            }
            __syncthreads();
        }
        __syncthreads();
    } else {
        const int q = (wid >> 1) & 1, tb = (wid & 1) * 16;
        float* par = parb + (wid & 3) * 640;
        PrepState S;
        int cur_h = -1;
        for (int i = -2; i <= NC; ++i) {
            if ((i & 1) == q) {
                ChunkDesc d;
                int ck = i + 2; ck = ck < 0 ? 0 : (ck > NC - 1 ? NC - 1 : ck);
                chunk_desc(ck, bid, G, d);
                if (d.h != cur_h) {
                    cur_h = d.h;
                    const int ch = d.h * 64 + lane;
                    par[lane] = p.shift_mu[ch]; par[64 + lane] = p.shift_mu[1024 + ch]; par[128 + lane] = p.shift_mu[2048 + ch]; par[192 + lane] = p.decay_w0[ch];
                    par[256 + lane] = p.icl_a0[ch]; par[320 + lane] = p.k_k[ch]; par[384 + lane] = p.k_a[ch]; par[448 + lane] = p.r_k[ch];
                    par[512 + lane] = p.shift_mu[C_WD + lane]; par[576 + lane] = p.shift_mu[C_AD + lane];
                }
                PrepRaw R;
                prep_load(p, d, tb, lane, R);
                prep_stage1(p, d, tb, par, lane, R, S);
            } else {
                ChunkDesc d, d2;
                PrepRaw2 R2;
                const bool has2 = i >= -1 && i + 1 < NC && chunk_desc(i + 1, bid, G, d2) && tb < d2.n;
                if (has2) prep_load2(p, d2, tb, lane, R2);
                if (i >= 1 && chunk_desc(i - 1, bid, G, d)) {
                    const float* ob = obuf + ((i - 1) & 1) * 1024;
                    for (int idx = (wid & 1) * 64 + lane; idx < d.n * 8; idx += 128) { const int t = idx >> 3, j = (idx & 7) * 4; *(f32x4*)(ORAW + (size_t)(d.r0 + d.t0 + t) * 1024 + d.h * 64 + d.half * 32 + j) = *(const f32x4*)(ob + t * 32 + j); }
                }
                if (has2) prep_stage2(p, d2, tb, bufs + ((i + 1) & 1) * SBUF, par, lane, R2, S);
            }
            __syncthreads();
        }
    }
}

__device__ void attn_unit(const Params& p, unsigned char* smem, const int unit) {
    const int tid = opaque_tid(), lane = tid & 63, wid = __builtin_amdgcn_readfirstlane(tid >> 6), fr = lane & 15, fq = lane >> 4;
    const bool samp = unit >= 512;
    int b, h, tile = 0;
    if (!samp) { b = unit >> 6; h = (unit >> 4) & 3; tile = unit & 15; } else { const int u2 = unit - 512; b = u2 >> 2; h = u2 & 3; }
    const bf16_t* ACT = (const bf16_t*)(p.ws + WS_ACT);
    const bf16_t* Kbf = (const bf16_t*)(p.ws + WS_KBF);
    const bf16_t* Vt = (const bf16_t*)(p.ws + WS_VT);
    bf16_t* Ymem = (bf16_t*)(p.ws + WS_YMEM);
    bf16_t* Kc = (bf16_t*)smem;
    bf16_t* Vc = (bf16_t*)smem;
    const int row = samp ? MP + b * 8 + (fr & 7) : b * 2048 + tile * 128 + wid * 16 + fr;
    const bool valid = !samp || fr < 8;
    bf16x8 qf[8];
#pragma unroll
    for (int ks = 0; ks < 8; ++ks) qf[ks] = *(const bf16x8*)(ACT + (size_t)row * ACT_LD + C_QM + h * 256 + ks * 32 + fq * 8);
    f32x4 sacc[16];
#pragma unroll
    for (int i = 0; i < 16; ++i) sacc[i] = (f32x4){0.f, 0.f, 0.f, 0.f};
#pragma unroll
    for (int hf = 0; hf < 2; ++hf) {
        __syncthreads();
#pragma unroll
        for (int i = 0; i < 8; ++i) {
            const int id = tid + i * NTHREADS, key = id >> 5, d = (id & 31) * 8;
            u32x4 v;
            if (!samp) v = *(const u32x4*)(Kbf + (size_t)(b * 256 + hf * 128 + key) * 1024 + h * 256 + d);
            else { const float* s = p.cache_k + ((size_t)(b * 256 + hf * 128 + key) * 4 + h) * 256 + d; const f32x4 x0 = *(const f32x4*)s, x1 = *(const f32x4*)(s + 4);
                v[0] = cvt_pk_bf16(x0[0], x0[1]); v[1] = cvt_pk_bf16(x0[2], x0[3]); v[2] = cvt_pk_bf16(x1[0], x1[1]); v[3] = cvt_pk_bf16(x1[2], x1[3]); }
            *(u32x4*)(Kc + key * 264 + d) = v;
        }
        __syncthreads();
#pragma unroll
        for (int kt = 0; kt < 8; ++kt)
#pragma unroll
            for (int ks = 0; ks < 8; ++ks) {
                const bf16x8 kf = *(const bf16x8*)(Kc + (kt * 16 + fr) * 264 + ks * 32 + fq * 8);
                sacc[hf * 8 + kt] = __builtin_amdgcn_mfma_f32_16x16x32_bf16(kf, qf[ks], sacc[hf * 8 + kt], 0, 0, 0);
            }
    }
    float mx = -3.0e38f;
#pragma unroll
    for (int i = 0; i < 16; ++i) mx = fmaxf(mx, fmaxf(fmaxf(sacc[i][0], sacc[i][1]), fmaxf(sacc[i][2], sacc[i][3])));
    mx = fmaxf(mx, __shfl_xor(mx, 16, 64)); mx = fmaxf(mx, __shfl_xor(mx, 32, 64));
    float sum = 0.f;
#pragma unroll
    for (int i = 0; i < 16; ++i)
#pragma unroll
        for (int e = 0; e < 4; ++e) { const float ex = __expf(sacc[i][e] - mx); sacc[i][e] = ex; sum += ex; }
    sum += __shfl_xor(sum, 16, 64); sum += __shfl_xor(sum, 32, 64);
    const float inv = fast_rcp(sum);
    bf16x8 pf[8];
#pragma unroll
    for (int s = 0; s < 8; ++s) {
        u32x4 t; t[0] = cvt_pk_bf16(sacc[2 * s][0], sacc[2 * s][1]); t[1] = cvt_pk_bf16(sacc[2 * s][2], sacc[2 * s][3]);
        t[2] = cvt_pk_bf16(sacc[2 * s + 1][0], sacc[2 * s + 1][1]); t[3] = cvt_pk_bf16(sacc[2 * s + 1][2], sacc[2 * s + 1][3]);
        pf[s] = __builtin_bit_cast(bf16x8, t);
    }
    f32x4 oacc[16];
#pragma unroll
    for (int i = 0; i < 16; ++i) oacc[i] = (f32x4){0.f, 0.f, 0.f, 0.f};
#pragma unroll
    for (int hf = 0; hf < 2; ++hf) {
        __syncthreads();
        if (!samp) {
#pragma unroll
            for (int i = 0; i < 8; ++i) {
                const int id = tid + i * NTHREADS, d = id >> 4, kc = (id & 15) * 8;
                const u32x4 v = *(const u32x4*)(Vt + (size_t)(h * 256 + d) * 2048 + b * 256 + hf * 128 + kc);
                *(u32x4*)(Vc + d * 136 + kc) = v;
            }
        } else {
#pragma unroll
            for (int i = 0; i < 16; ++i) {
                const int id = tid + i * NTHREADS, key = id >> 6, d = (id & 63) * 4;
                const f32x4 x = *(const f32x4*)(p.cache_v + ((size_t)(b * 256 + hf * 128 + key) * 4 + h) * 256 + d);
                const unsigned a = cvt_pk_bf16(x[0], x[1]), bq = cvt_pk_bf16(x[2], x[3]);
                Vc[(d + 0) * 136 + key] = (bf16_t)(a & 0xffff); Vc[(d + 1) * 136 + key] = (bf16_t)(a >> 16);
                Vc[(d + 2) * 136 + key] = (bf16_t)(bq & 0xffff); Vc[(d + 3) * 136 + key] = (bf16_t)(bq >> 16);
            }
        }
        __syncthreads();
#pragma unroll
        for (int dt = 0; dt < 16; ++dt) {
            if (!samp || (dt >> 1) == wid) {
#pragma unroll
                for (int s2 = 0; s2 < 4; ++s2) {
                    const u32x2 lo = *(const u32x2*)(Vc + (dt * 16 + fr) * 136 + s2 * 32 + 4 * fq), hi = *(const u32x2*)(Vc + (dt * 16 + fr) * 136 + s2 * 32 + 16 + 4 * fq);
                    u32x4 t; t[0] = lo[0]; t[1] = lo[1]; t[2] = hi[0]; t[3] = hi[1];
                    oacc[dt] = __builtin_amdgcn_mfma_f32_16x16x32_bf16(__builtin_bit_cast(bf16x8, t), pf[hf * 4 + s2], oacc[dt], 0, 0, 0);
                }
            }
        }
    }
    if (valid) {
#pragma unroll
        for (int dt = 0; dt < 16; ++dt) {
            if (!samp || (dt >> 1) == wid) {
                const int d = h * 256 + dt * 16 + 4 * fq;
                const u32x2 g = *(const u32x2*)(ACT + (size_t)row * ACT_LD + C_SGM + d);
                u32x2 o; o[0] = cvt_pk_bf16(oacc[dt][0] * inv * bflo(g[0]), oacc[dt][1] * inv * bfhi(g[0])); o[1] = cvt_pk_bf16(oacc[dt][2] * inv * bflo(g[1]), oacc[dt][3] * inv * bfhi(g[1]));
                *(u32x2*)(Ymem + (size_t)row * 1024 + d) = o;
            }
        }
    }
}

__device__ void phase2_attn(const Params& p, unsigned char* smem) {
    __syncthreads();
    for (int u = blockIdx.x; u < 1024; u += gridDim.x) attn_unit(p, smem, u);
}

__device__ __forceinline__ void ld16bf(const bf16_t* ptr, float (&o)[16]) {
    const u32x4 a = *(const u32x4*)ptr, b = *(const u32x4*)(ptr + 8);
#pragma unroll
    for (int e = 0; e < 4; ++e) { o[2 * e] = bflo(a[e]); o[2 * e + 1] = bfhi(a[e]); o[8 + 2 * e] = bflo(b[e]); o[8 + 2 * e + 1] = bfhi(b[e]); }
}
__device__ __forceinline__ void ld16f(const float* ptr, float (&o)[16]) {
#pragma unroll
    for (int q = 0; q < 4; ++q) { const f32x4 v = *(const f32x4*)(ptr + 4 * q); o[4 * q] = v[0]; o[4 * q + 1] = v[1]; o[4 * q + 2] = v[2]; o[4 * q + 3] = v[3]; }
}
__device__ __forceinline__ void st16bf(bf16_t* ptr, const float (&y)[16]) {
    u32x4 a, b;
#pragma unroll
    for (int e = 0; e < 4; ++e) { a[e] = cvt_pk_bf16(y[2 * e], y[2 * e + 1]); b[e] = cvt_pk_bf16(y[8 + 2 * e], y[8 + 2 * e + 1]); }
    *(u32x4*)ptr = a; *(u32x4*)(ptr + 8) = b;
}
__device__ __forceinline__ float quad_sum(float x) { x += dpp_f<0xB1>(x); x += dpp_f<0x4E>(x); return x; }
__device__ void phase2b(const Params& p, unsigned char* smem) {
    const int tid = opaque_tid(), lane = tid & 63, wid = tid >> 6;
    float* tab = (float*)smem;
    __syncthreads();
    for (int idx = tid; idx < 7168; idx += NTHREADS)
        tab[idx] = idx < 3072 ? p.conv_w[idx] : idx < 4096 ? p.conv_b[idx - 3072] : idx < 5120 ? p.shift_mu[2048 + idx - 4096] : idx < 6144 ? p.ln_g[idx - 5120] : p.ln_b[idx - 6144];
    __syncthreads();
    const bf16_t* U = (const bf16_t*)(p.ws + WS_U); const bf16_t* BG = (const bf16_t*)(p.ws + WS_BG); const bf16_t* ACT = (const bf16_t*)(p.ws + WS_ACT);
    const float* ORAW = p.out + OUT_Y; const float* C3 = (const float*)(p.ws + WS_C3);
    bf16_t* Yc = (bf16_t*)(p.ws + WS_YCONV); bf16_t* Yr = (bf16_t*)(p.ws + WS_YRWKV);
    const int ch = lane * 16;
    for (int row = blockIdx.x * 8 + wid; row < MALL; row += gridDim.x * 8) {
        int b, t; const bool samp = row >= MP;
        if (!samp) { b = row >> 11; t = row & 2047; } else { b = (row - MP) >> 3; t = (row - MP) & 7; }
        float u0[16], um1[16], um2[16], bg[16], o[16], vc[16], vq[16], sg[16];
        ld16bf(U + (size_t)row * 1024 + ch, u0); ld16bf(BG + (size_t)row * 1024 + ch, bg);
        if (t >= 1) ld16bf(U + (size_t)(row - 1) * 1024 + ch, um1);
        else if (samp) ld16f(p.state_conv + ((size_t)b * 2 + 1) * 1024 + ch, um1);
        else {
#pragma unroll
            for (int e = 0; e < 16; ++e) um1[e] = 0.f; }
        if (t >= 2) ld16bf(U + (size_t)(row - 2) * 1024 + ch, um2);
        else if (samp) ld16f(p.state_conv + ((size_t)b * 2 + t) * 1024 + ch, um2);
        else {
#pragma unroll
            for (int e = 0; e < 16; ++e) um2[e] = 0.f; }
        ld16f(ORAW + (size_t)row * 1024 + ch, o);
        ld16bf(ACT + (size_t)row * ACT_LD + C_PV + ch, vc);
        if (t >= 1) ld16bf(ACT + (size_t)(row - 1) * ACT_LD + C_PV + ch, vq);
        else if (samp) ld16f(p.state_shift + (size_t)b * DSHIFT + 2048 + ch, vq);
        else {
#pragma unroll
            for (int e = 0; e < 16; ++e) vq[e] = 0.f; }
        ld16bf(ACT + (size_t)row * ACT_LD + C_SGR + ch, sg);
        const float c3 = C3[(size_t)row * 16 + (lane >> 2)];
        float y[16];
#pragma unroll
        for (int q = 0; q < 4; ++q) {
            const f32x4 w0 = *(const f32x4*)(tab + ch + 4 * q), w1 = *(const f32x4*)(tab + 1024 + ch + 4 * q), w2 = *(const f32x4*)(tab + 2048 + ch + 4 * q), cb = *(const f32x4*)(tab + 3072 + ch + 4 * q);
#pragma unroll
            for (int e = 0; e < 4; ++e) { const int i = 4 * q + e; y[i] = bg[i] * (cb[e] + w0[e] * um2[i] + w1[e] * um1[i] + w2[e] * u0[i]); }
        }
        st16bf(Yc + (size_t)row * 1024 + ch, y);
        float sm_ = 0.f;
#pragma unroll
        for (int e = 0; e < 16; ++e) sm_ += o[e];
        const float mean = quad_sum(sm_) * (1.0f / 64.0f);
        float vr = 0.f;
#pragma unroll
        for (int e = 0; e < 16; ++e) { o[e] -= mean; vr += o[e] * o[e]; }
        const float rstd = rsqrtf(quad_sum(vr) * (1.0f / 64.0f) + 6.4e-4f);
#pragma unroll
        for (int q = 0; q < 4; ++q) {
            const f32x4 mv = *(const f32x4*)(tab + 4096 + ch + 4 * q), lg = *(const f32x4*)(tab + 5120 + ch + 4 * q), lb = *(const f32x4*)(tab + 6144 + ch + 4 * q);
#pragma unroll
            for (int e = 0; e < 4; ++e) { const int i = 4 * q + e; const float vs = vc[i] + mv[e] * (vq[i] - vc[i]); y[i] = (o[i] * rstd * lg[e] + lb[e] + c3 * vs) * sg[i]; }
        }
        st16bf(Yr + (size_t)row * 1024 + ch, y);
    }
}

struct SchedP3 {
    int G, c; const char* ws;
    __device__ __forceinline__ bool next(int i, Unit& u) const {
        const int tl = (i / 3) * G + c, seg = i % 3;
        if (tl >= 272) return false;
        u.x = tl >> 2; u.y = tl & 3; u.z = seg;
        u.a = ws + (seg == 0 ? WS_YCONV : seg == 1 ? WS_YRWKV : WS_YMEM) + (size_t)u.x * 256 * 2048; u.b = ws + WS_WB + ((size_t)seg * 1024 + (size_t)u.y * 256) * 2048;
        return true;
    }
};
struct EpiP3 {
    const bf16_t* ACT; bf16_t* MERGED;
    __device__ __forceinline__ bool operator()(f32x4 (&acc)[2][2][4][2], const Unit& u, int wr, int wc, int fr, int fq) const {
        const int seg = u.z, rbase = u.x * 256 + wr * 64 + fr, cb = u.y * 256 + wc * 32 + 8 * fq;
        const bf16_t* gbase = ACT + C_GATE + seg * 1024 + cb;
#pragma unroll
        for (int ai = 0; ai < 2; ++ai) {
            u32x4 g[4][2], g2[4][2];
#pragma unroll
            for (int m = 0; m < 4; ++m)
#pragma unroll
                for (int bj = 0; bj < 2; ++bj) {
                    const bf16_t* gp = gbase + (size_t)(rbase + ai * 128 + m * 16) * ACT_LD + 128 * bj;
                    g[m][bj] = *(const u32x4*)gp;
                    if (seg < 2) g2[m][bj] = *(const u32x4*)(gp + 1024);
                }
#pragma unroll
            for (int m = 0; m < 4; ++m)
#pragma unroll
                for (int bj = 0; bj < 2; ++bj) {
                    float f[8];
#pragma unroll
                    for (int e = 0; e < 4; ++e) { f[2 * e] = bflo(g[m][bj][e]); f[2 * e + 1] = bfhi(g[m][bj][e]); }
                    if (seg < 2) {
#pragma unroll
                        for (int e = 0; e < 4; ++e) { f[2 * e] *= fast_rcp(bflo(g2[m][bj][e])); f[2 * e + 1] *= fast_rcp(bfhi(g2[m][bj][e])); }
                    }
                    f32x4& v0 = acc[ai][bj][m][0]; f32x4& v1 = acc[ai][bj][m][1];
#pragma unroll
                    for (int e = 0; e < 4; ++e) { v0[e] *= f[e]; v1[e] *= f[4 + e]; }
                    if (seg == 2) {
                        u32x4 o; o[0] = cvt_pk_bf16(v0[0], v0[1]); o[1] = cvt_pk_bf16(v0[2], v0[3]); o[2] = cvt_pk_bf16(v1[0], v1[1]); o[3] = cvt_pk_bf16(v1[2], v1[3]);
                        *(u32x4*)(MERGED + (size_t)(rbase + ai * 128 + m * 16) * 1024 + cb + 128 * bj) = o;
                    }
                }
        }
        return seg < 2;
    }
};
struct SchedP4 {
    int G, c; const char* A; const char* B;
    __device__ __forceinline__ bool next(int i, Unit& u) const {
        const int tl = i * G + c;
        if (tl >= 272) return false;
        u.x = tl >> 2; u.y = tl & 3; u.z = 0;
        u.a = A + (size_t)u.x * 256 * 2048; u.b = B + (size_t)u.y * 256 * 2048;
        return true;
    }
};
struct EpiP4 {
    const float* xp; const float* xs; float* out; float* SUMSQ;
    __device__ __forceinline__ bool operator()(f32x4 (&acc)[2][2][4][2], const Unit& u, int wr, int wc, int fr, int fq) const {
        const int rbase = u.x * 256 + wr * 64 + fr, cbase = u.y * 256 + wc * 32 + fq * 4;
#pragma unroll
        for (int ai = 0; ai < 2; ++ai) {
            f32x4 xv[4][2][2];
#pragma unroll
            for (int m = 0; m < 4; ++m) {
                const int row = rbase + ai * 128 + m * 16;
                const float* xr = row < MP ? xp + (size_t)row * 1024 : xs + (size_t)(row - MP) * 1024;
#pragma unroll
                for (int bj = 0; bj < 2; ++bj)
#pragma unroll
                    for (int n = 0; n < 2; ++n) xv[m][bj][n] = *(const f32x4*)(xr + cbase + bj * 128 + n * 16);
            }
#pragma unroll
            for (int m = 0; m < 4; ++m) {
                const int row = rbase + ai * 128 + m * 16;
                float ss = 0.f;
#pragma unroll
                for (int bj = 0; bj < 2; ++bj)
#pragma unroll
                    for (int n = 0; n < 2; ++n) {
                        const f32x4 v = acc[ai][bj][m][n] + xv[m][bj][n];
                        ss += v[0] * v[0] + v[1] * v[1] + v[2] * v[2] + v[3] * v[3];
                        *(f32x4*)(out + OUT_Y + (size_t)row * 1024 + cbase + bj * 128 + n * 16) = v;
                    }
                ss += __shfl_xor(ss, 16, 64); ss += __shfl_xor(ss, 32, 64);
                if (fq == 0) SUMSQ[(size_t)row * 16 + u.y * 4 + wc] = ss;
            }
        }
        return false;
    }
};
__device__ void phase5(const Params& p) {
    const int tid5 = opaque_tid(); const int lane = tid5 & 63, wid = tid5 >> 6;
    const float* SUMSQ = (const float*)(p.ws + WS_SUMSQ);
    for (int row = blockIdx.x * 8 + wid; row < MALL; row += gridDim.x * 8) {
        float ss = lane < 16 ? SUMSQ[(size_t)row * 16 + lane] : 0.f;
        ss = wave_sum(ss);
        const float inv = rsqrtf(ss * (1.0f / 1024.0f) + 1e-6f);
        float* y = p.out + OUT_Y + (size_t)row * 1024;
#pragma unroll
        for (int i = 0; i < 4; ++i) {
            f32x4 v = *(const f32x4*)(y + i * 256 + lane * 4); const f32x4 g = *(const f32x4*)(p.norm_final + i * 256 + lane * 4);
            v = v * inv * g;
            *(f32x4*)(y + i * 256 + lane * 4) = v;
        }
    }
}

__global__ void __launch_bounds__(NTHREADS) fwd_megakernel(Params p) {
    extern __shared__ __attribute__((aligned(16))) unsigned char smem[];
    cg::grid_group grid = cg::this_grid();
    LAS unsigned char* lds = (LAS unsigned char*)smem;
#ifndef PROBE_REP
#define PROBE_REP 0
#endif
#define REP(k) for (int _r = 0; _r < ((PROBE_REP == (k)) ? 2 : 1); ++_r)
    volatile LAS unsigned* xst = (volatile LAS unsigned*)(lds + LDS_MAIN);
    if (threadIdx.x == 0) { xst[0] = 0u; xst[1] = 0u; xst[2] = 0u; xst[3] = 0u; }
    __syncthreads();
    const XcdBarrier xb = xcd_barrier_post((unsigned*)(p.ws + WS_BAR), xst);
    REP(1) { phase0(p, smem); if (PROBE_REP == 1 && _r == 0) xcd_barrier(xb); }
    grid.sync();
    REP(2) {
        SchedP1 S{(int)gridDim.x, (int)blockIdx.x, (const char*)(p.ws + WS_AALL), (const char*)(p.ws + WS_BALL)};
        EpiP1 E{(bf16_t*)(p.ws + WS_U), (bf16_t*)(p.ws + WS_BG), (bf16_t*)(p.ws + WS_ACT), p.out, (bf16_t*)(p.ws + WS_KBF), (bf16_t*)(p.ws + WS_VT)};
        gemm_phase(lds, 2048, 2048, 1024, S, E);
        xcd_barrier(xb);
    }
    REP(3) { phase2_scan(p, smem); if (PROBE_REP == 3) xcd_barrier(xb); }
    REP(5) { phase2_attn(p, smem); if (PROBE_REP == 5) xcd_barrier(xb); }
    xcd_barrier(xb);
    REP(6) { phase2b(p, smem); xcd_barrier(xb); }
    REP(7) {
        SchedP3 S{(int)gridDim.x, (int)blockIdx.x, (const char*)p.ws};
        EpiP3 E{(const bf16_t*)(p.ws + WS_ACT), (bf16_t*)(p.ws + WS_MERGED)};
        gemm_phase(lds, 2048, 2048, 1024, S, E);
        xcd_barrier(xb);
    }
    REP(8) {
        SchedP4 S{(int)gridDim.x, (int)blockIdx.x, (const char*)(p.ws + WS_MERGED), (const char*)(p.ws + WS_WO)};
        EpiP4 E{p.x_prompt, p.x_sample, p.out, (float*)(p.ws + WS_SUMSQ)};
        gemm_phase(lds, 2048, 2048, 1024, S, E);
        xcd_barrier(xb);
    }
    phase5(p);
}

extern "C" void kernel_launch(void* const* d_in, const int* in_sizes, int n_in, void* d_out, int out_size, void* d_ws, size_t ws_size, hipStream_t stream) {
    static int grid_blocks = 0;
    if (!grid_blocks) {
        int dev = 0, cus = 0, per_cu = 0;
        hipGetDevice(&dev);
        hipDeviceGetAttribute(&cus, hipDeviceAttributeMultiprocessorCount, dev);
        if (hipFuncSetAttribute((const void*)fwd_megakernel, hipFuncAttributeMaxDynamicSharedMemorySize, LDS_BYTES) != hipSuccess) fprintf(stderr, "hipFuncSetAttribute failed\n");
        hipOccupancyMaxActiveBlocksPerMultiprocessor(&per_cu, (const void*)fwd_megakernel, NTHREADS, LDS_BYTES);
        if (per_cu < 1) { fprintf(stderr, "occupancy query returned %d\n", per_cu); per_cu = 1; }
        if (per_cu > 1) per_cu = 1;
        grid_blocks = cus * per_cu;
        if (grid_blocks > 256) grid_blocks = 256;
        grid_blocks &= ~31;
        if (grid_blocks < 32) grid_blocks = -1;
        if (ws_size < WS_END) { fprintf(stderr, "workspace too small: %zu < %zu\n", ws_size, (size_t)WS_END); grid_blocks = -1; }
    }
    if (grid_blocks < 0) return;
    Params p{};
    const float** pp = (const float**)&p;
    for (int i = 0; i < 27; ++i) pp[i] = (const float*)d_in[i];
    p.out = (float*)d_out; p.ws = (unsigned char*)d_ws;
    if (hipMemsetAsync((char*)d_ws + WS_BAR, 0, (size_t)XCD_BAR_WORDS_C * 4, stream) != hipSuccess) fprintf(stderr, "memset of barrier words failed\n");
    void* args[] = {&p};
    hipError_t e = hipLaunchCooperativeKernel((const void*)fwd_megakernel, dim3(grid_blocks), dim3(NTHREADS), args, LDS_BYTES, stream);
    if (e != hipSuccess) fprintf(stderr, "cooperative launch failed: %s (grid %d)\n", hipGetErrorString(e), grid_blocks);
}
```

```cpp
#include <hip/hip_runtime.h>
#include <hip/hip_cooperative_groups.h>
#include <cstdio>
namespace cg = cooperative_groups;

#define LAS __attribute__((address_space(3)))
typedef unsigned short bf16_t;
typedef short bf16x8 __attribute__((ext_vector_type(8)));
typedef float f32x4 __attribute__((ext_vector_type(4)));
typedef float f32x2 __attribute__((ext_vector_type(2)));
typedef unsigned u32x4 __attribute__((ext_vector_type(4)));
typedef unsigned u32x2 __attribute__((ext_vector_type(2)));

constexpr int DM = 1024, TP = 2048, BP = 8, MP = BP * TP, BS = 128, TS = 8, MS = BS * TS, MALL = MP + MS;
constexpr int NMEM = 256, DIN = 13440, DSHIFT = 3200;
constexpr int NPAD = 13568;
constexpr int ACT_LD = 9472;
constexpr int C_PR = 0, C_PK = 1024, C_PV = 2048, C_WD = 3072, C_AD = 3136, C_SGR = 3328, C_QM = 4352, C_SGM = 5376, C_GATE = 6400;
constexpr size_t OUT_Y = 0, OUT_MK = 17825792, OUT_MV = 19922944, OUT_CONV_P = 22020096, OUT_SHIFT_P = 22036480, OUT_WKV_P = 22062080,
                 OUT_CONV_S = 22586368, OUT_SHIFT_S = 22848512, OUT_WKV_S = 23258112;
constexpr size_t al256(size_t x) { return (x + 255) & ~(size_t)255; }
constexpr int XCD_BAR_WORDS_C = 3456;
constexpr size_t WS_AALL = 0;
constexpr size_t WS_BALL = al256(WS_AALL + (size_t)19456 * 1024 * 2);
constexpr size_t WS_YMEM = WS_AALL;
constexpr size_t WS_YCONV = WS_AALL + (size_t)MALL * 1024 * 2;
constexpr size_t WS_WB = al256(WS_BALL + (size_t)15616 * 1024 * 2);
constexpr size_t WS_WO = al256(WS_WB + (size_t)3072 * 1024 * 2);
constexpr size_t WS_U = al256(WS_WO + (size_t)1024 * 1024 * 2);
constexpr size_t WS_MERGED = WS_U;
constexpr size_t WS_BG = al256(WS_U + (size_t)MALL * 1024 * 2);
constexpr size_t WS_ACT = al256(WS_BG + (size_t)MALL * 1024 * 2);
constexpr size_t WS_KBF = al256(WS_ACT + (size_t)MALL * ACT_LD * 2);
constexpr size_t WS_VT = al256(WS_KBF + (size_t)2048 * 1024 * 2);
constexpr size_t WS_YRWKV = al256(WS_VT + (size_t)2048 * 1024 * 2);
constexpr size_t WS_C3 = al256(WS_YRWKV + (size_t)MALL * 1024 * 2);
constexpr size_t WS_SUMSQ = al256(WS_C3 + (size_t)MALL * 16 * 4);
constexpr size_t WS_BAR = al256(WS_SUMSQ + (size_t)MALL * 16 * 4);
constexpr size_t WS_FRAG = al256(WS_BAR + (size_t)XCD_BAR_WORDS_C * 4);
constexpr size_t WS_END = al256(WS_FRAG + (size_t)16 * 2 * 8 * 64 * 16);
static_assert(WS_YCONV + (size_t)MALL * 1024 * 2 <= WS_WB, "alias overflow");
static_assert(WS_END <= 536870912, "workspace too large");

constexpr int NTHREADS = 512;
constexpr int LDS_MAIN = 131072;
constexpr int LDS_BYTES = LDS_MAIN + 16;

struct Params {
    const float *x_prompt, *x_sample, *mem_prompt, *cache_k, *cache_v, *state_conv, *state_shift, *state_wkv, *norm_in, *w_in, *conv_w, *conv_b,
        *shift_mu, *decay_w0, *decay_up, *icl_a0, *icl_up, *k_k, *k_a, *r_k, *ln_g, *ln_b, *norm_mem, *w_mem_kv, *w_branch, *w_out, *norm_final;
    float* out;
    unsigned char* ws;
};

__device__ __forceinline__ int opaque_tid() { int t = threadIdx.x; asm volatile("" : "+v"(t)); return t; }
__device__ __forceinline__ float bf2f(bf16_t v) { return __uint_as_float(((unsigned)v) << 16); }
__device__ __forceinline__ unsigned cvt_pk_bf16(float lo, float hi) { unsigned r; asm volatile("v_cvt_pk_bf16_f32 %0, %1, %2" : "=v"(r) : "v"(lo), "v"(hi)); return r; }
__device__ __forceinline__ float bflo(unsigned u) { return __uint_as_float(u << 16); }
__device__ __forceinline__ float bfhi(unsigned u) { return __uint_as_float(u & 0xffff0000u); }
__device__ __forceinline__ float fast_rcp(float x) { return __builtin_amdgcn_rcpf(x); }
__device__ __forceinline__ float sigmoidf_(float x) { return fast_rcp(1.0f + __expf(-x)); }
__device__ __forceinline__ float siluf_(float x) { return x * sigmoidf_(x); }
__device__ __forceinline__ float wave_sum(float v) {
#pragma unroll
    for (int o = 32; o > 0; o >>= 1) v += __shfl_xor(v, o, 64);
    return v;
}
template <int CTRL> __device__ __forceinline__ float dpp_f(float x) {
    return __int_as_float(__builtin_amdgcn_update_dpp(0, __float_as_int(x), CTRL, 0xF, 0xF, true));
}
__device__ __forceinline__ float row16_sum(float x) {
    x += dpp_f<0xB1>(x);
    x += dpp_f<0x4E>(x);
    x += dpp_f<0x141>(x);
    x += dpp_f<0x140>(x);
    return x;
}


#define XB_TMO      128
#define XB_XCNT(j)  (256  + 64 * (j))
#define XB_XSUB(j)  (1280 + 64 * (j))
#define XB_XGEN(j)  (2304 + 64 * (j))
#define XB_TOP      3328
#define XB_TOPGEN   3392
#define XCD_BAR_WORDS 3456
#define XB_SPIN_CAP (1u << 22)
__device__ __forceinline__ unsigned xb_ld(unsigned* p)              { return __hip_atomic_load(p, __ATOMIC_RELAXED, __HIP_MEMORY_SCOPE_AGENT); }
__device__ __forceinline__ unsigned xb_add(unsigned* p, unsigned v) { return __hip_atomic_fetch_add(p, v, __ATOMIC_RELAXED, __HIP_MEMORY_SCOPE_AGENT); }
__device__ __forceinline__ unsigned xb_xcc_id() { return (unsigned)__builtin_amdgcn_s_getreg((3 << 11) | 20) & 0xFu; }
#define XB_SPIN(cond, bar) do { unsigned _sp = 0; while (cond) { __builtin_amdgcn_s_sleep(1); \
    if ((++_sp & 255u) == 0u) { if (xb_ld(&(bar)[XB_TMO])) break; if (_sp > XB_SPIN_CAP) { atomicAdd(&(bar)[XB_TMO], 1u); break; } } } } while (0)
struct XcdBarrier { unsigned* bar; unsigned x; volatile LAS unsigned* st; };
__device__ __forceinline__ XcdBarrier xcd_barrier_post(unsigned* bar, volatile LAS unsigned* st) {
    XcdBarrier b; b.bar = bar; b.x = xb_xcc_id(); b.st = st;
    if (threadIdx.x == 0) (void)xb_add(&bar[XB_XCNT(b.x)], 1u);
    return b;
}
__device__ __forceinline__ void xcd_barrier_complete(unsigned* bar, unsigned x, unsigned& nloc, unsigned& nx) {
    const unsigned G = gridDim.x * gridDim.y * gridDim.z;
    unsigned sum, cnt, mine, sp = 0u;
    for (;;) {
        sum = 0u; cnt = 0u; mine = 0u;
#pragma unroll
        for (unsigned j = 0; j < 16; ++j) { const unsigned c = xb_ld(&bar[XB_XCNT(j)]); sum += c; cnt += (c > 0u) ? 1u : 0u; mine = (j == x) ? c : mine; }
        if (sum == G) break;
        __builtin_amdgcn_s_sleep(1);
        if ((++sp & 255u) == 0u) { if (xb_ld(&bar[XB_TMO])) break; if (sp > XB_SPIN_CAP) { atomicAdd(&bar[XB_TMO], 1u); break; } }
    }
    nloc = mine > 0u ? mine : 1u; nx = cnt > 0u ? cnt : 1u;
}
__device__ __forceinline__ void xcd_barrier(const XcdBarrier& b) {
    asm volatile("s_waitcnt vmcnt(0)" ::: "memory");
    __syncthreads();
    if (threadIdx.x == 0) {
        unsigned* bar = b.bar;
        __builtin_amdgcn_s_waitcnt(0);
        unsigned nloc = b.st[0], nx = b.st[1];
        if (nloc == 0u) { xcd_barrier_complete(bar, b.x, nloc, nx); b.st[0] = nloc; b.st[1] = nx; }
        const unsigned old = xb_add(&bar[XB_XSUB(b.x)], 1u);
        const unsigned gen = old / nloc;
        if (old + 1u == (gen + 1u) * nloc) {
            __builtin_amdgcn_fence(__ATOMIC_RELEASE, "agent");
            asm volatile("s_waitcnt vmcnt(0)" ::: "memory");
            const unsigned og = xb_add(&bar[XB_TOP], 1u);
            const unsigned tg = og / nx;
            if (og + 1u == (tg + 1u) * nx) xb_add(&bar[XB_TOPGEN], 1u);
            else XB_SPIN(xb_ld(&bar[XB_TOPGEN]) == tg, bar);
            __builtin_amdgcn_fence(__ATOMIC_ACQUIRE, "agent");
            xb_add(&bar[XB_XGEN(b.x)], 1u);
            asm volatile("s_waitcnt vmcnt(0)" ::: "memory");
        } else {
            XB_SPIN(xb_ld(&bar[XB_XGEN(b.x)]) == gen, bar);
            __builtin_amdgcn_fence(__ATOMIC_ACQUIRE, "agent");
            asm volatile("s_waitcnt vmcnt(0)" ::: "memory");
        }
    }
    __syncthreads();
}

constexpr int BM = 256, BK = 64, HALF = 128, HTB = HALF * BK * 2;
__device__ __forceinline__ int lds_byte(int r, int c) { const int st = (r >> 4) * 2 + (c >> 5), rr = r & 15, cc = c & 31, ob = rr * 64 + cc * 2; return st * 1024 + (ob ^ (((ob >> 9) & 1) << 5)); }
__device__ __forceinline__ void stage_rc(int b, int& R, int& C) { const int st = b / 1024, sb = b % 1024, swz = sb ^ (((sb >> 9) & 1) << 5); R = (st >> 1) * 16 + swz / 64; C = (st & 1) * 32 + (swz % 64) / 2; }

struct Unit { const char* a; const char* b; int x, y, z; };

template <class Sched, class Epi>
__device__ __forceinline__ void gemm_phase(LAS unsigned char* lds, const int lda, const int ldb, const int K, const Sched& S, const Epi& E) {
    const int tid = opaque_tid(), wid = __builtin_amdgcn_readfirstlane(tid >> 6), lane = tid & 63, wr = wid >> 2, wc = wid & 3, fr = lane & 15, fq = lane >> 4;
    const int nt = K / BK;
    unsigned voffA[2], voffB[2];
#pragma unroll
    for (int i = 0; i < 2; ++i) { int R, C; stage_rc(tid * 16 + i * 8192, R, C); voffA[i] = (unsigned)(R * lda + C * 2); voffB[i] = (unsigned)(R * ldb + C * 2); }
    const size_t kstep = (size_t)(BK * 2);
    const size_t hA = (size_t)HALF * lda, hB = (size_t)HALF * ldb;
    const unsigned ldsw = (unsigned)wid * 1024u;
    const int aoff = lds_byte(wr * 64 + fr, fq * 8), boff = lds_byte(wc * 32 + fr, fq * 8);
#define G_SA(b, h) (((b) * 2 + (h)) * HTB)
#define G_SB(b, h) ((4 + (b) * 2 + (h)) * HTB)
#define G_STAGE(bufoff, gbase, voff) do { _Pragma("unroll") for (int _i = 0; _i < 2; ++_i) \
        __builtin_amdgcn_global_load_lds((const unsigned*)((const char*)(gbase) + (voff)[_i]), (LAS unsigned*)(lds + (bufoff) + ldsw + _i * 8192), 16, 0, 0); } while (0)
#define G_LDA(dst, b, h) do { _Pragma("unroll") for (int m = 0; m < 4; ++m) _Pragma("unroll") for (int k = 0; k < 2; ++k) dst[m][k] = *(const LAS bf16x8*)(lds + G_SA(b, h) + aoff + m * 2048 + k * 1024); } while (0)
#define G_LDB(dst, b, h) do { _Pragma("unroll") for (int n = 0; n < 2; ++n) _Pragma("unroll") for (int k = 0; k < 2; ++k) dst[n][k] = *(const LAS bf16x8*)(lds + G_SB(b, h) + boff + n * 2048 + k * 1024); } while (0)
#define G_MMA(ai, bj, At, Bt) do { __builtin_amdgcn_s_setprio(1); _Pragma("unroll") for (int m = 0; m < 4; ++m) _Pragma("unroll") for (int n = 0; n < 2; ++n) _Pragma("unroll") for (int k = 0; k < 2; ++k) \
        acc[ai][bj][m][n] = __builtin_amdgcn_mfma_f32_16x16x32_bf16(Bt[n][k], At[m][k], acc[ai][bj][m][n], 0, 0, 0); __builtin_amdgcn_s_setprio(0); } while (0)
#define G_WAIT_V(n) asm volatile("s_waitcnt vmcnt(" #n ")" ::: "memory")
#define G_WAIT_L(n) asm volatile("s_waitcnt lgkmcnt(" #n ")" ::: "memory")
#define G_BAR __builtin_amdgcn_s_barrier()
#define G_SCHED __builtin_amdgcn_sched_barrier(0)
    Unit cur, nxt; int ui = 0;
    if (!S.next(0, cur)) return;
    f32x4 acc[2][2][4][2];
#pragma unroll
    for (int a = 0; a < 2; ++a)
#pragma unroll
        for (int b = 0; b < 2; ++b)
#pragma unroll
            for (int m = 0; m < 4; ++m)
#pragma unroll
                for (int n = 0; n < 2; ++n) acc[a][b][m][n] = (f32x4){0.f, 0.f, 0.f, 0.f};
    bf16x8 At[4][2], B0[2][2], B1[2][2];
    const char* cA = cur.a; const char* cB = cur.b;
    G_STAGE(G_SB(0, 0), cB, voffB); G_STAGE(G_SA(0, 0), cA, voffA); G_STAGE(G_SB(0, 1), cB + hB, voffB); G_STAGE(G_SA(0, 1), cA + hA, voffA);
    if (wr == 1) G_BAR;
    G_WAIT_V(4); G_BAR;
    G_STAGE(G_SB(1, 0), cB + kstep, voffB); G_STAGE(G_SA(1, 0), cA + kstep, voffA); G_STAGE(G_SB(1, 1), cB + hB + kstep, voffB);
    G_WAIT_V(6); G_BAR;
    for (;;) {
        const bool has_next = S.next(ui + 1, nxt);
        const char* nA = has_next ? nxt.a : cA; const char* nB = has_next ? nxt.b : cB;
        for (int t = 0; t < nt; t += 2) {
            const bool last = (t == nt - 2);
            const char* a1 = cA + (size_t)(t + 1) * kstep;
            const char* a2 = last ? nA : cA + (size_t)(t + 2) * kstep; const char* b2 = last ? nB : cB + (size_t)(t + 2) * kstep;
            const char* a3 = a2 + kstep; const char* b3 = b2 + kstep;
            G_LDB(B0, 0, 0); G_SCHED; G_LDA(At, 0, 0); G_STAGE(G_SA(1, 1), a1 + hA, voffA);
            G_WAIT_L(8); G_BAR; G_WAIT_L(0); G_MMA(0, 0, At, B0); G_BAR; G_SCHED;
            G_LDB(B1, 0, 1); G_STAGE(G_SB(0, 0), b2, voffB);
            G_BAR; G_WAIT_L(0); G_MMA(0, 1, At, B1); G_BAR;
            G_LDA(At, 0, 1); G_STAGE(G_SA(0, 0), a2, voffA);
            G_BAR; G_WAIT_L(0); G_MMA(1, 0, At, B0); G_BAR; G_SCHED;
            G_STAGE(G_SB(0, 1), b2 + hB, voffB);
            G_WAIT_V(6); G_BAR; G_MMA(1, 1, At, B1); G_BAR;
            G_LDB(B0, 1, 0); G_SCHED; G_LDA(At, 1, 0); G_STAGE(G_SA(0, 1), a2 + hA, voffA);
            G_WAIT_L(8); G_BAR; G_WAIT_L(0); G_MMA(0, 0, At, B0); G_BAR; G_SCHED;
            G_LDB(B1, 1, 1); G_STAGE(G_SB(1, 0), b3, voffB);
            G_BAR; G_WAIT_L(0); G_MMA(0, 1, At, B1); G_BAR;
            G_LDA(At, 1, 1); G_STAGE(G_SA(1, 0), a3, voffA);
            G_BAR; G_WAIT_L(0); G_MMA(1, 0, At, B0); G_BAR; G_SCHED;
            G_STAGE(G_SB(1, 1), b3 + hB, voffB);
            G_WAIT_V(6); G_BAR; G_MMA(1, 1, At, B1); G_BAR;
        }
        const bool keep = E(acc, cur, wr, wc, fr, fq);
        if (!has_next) break;
        if (!keep) {
#pragma unroll
            for (int a = 0; a < 2; ++a)
#pragma unroll
                for (int b = 0; b < 2; ++b)
#pragma unroll
                    for (int m = 0; m < 4; ++m)
#pragma unroll
                        for (int n = 0; n < 2; ++n) acc[a][b][m][n] = (f32x4){0.f, 0.f, 0.f, 0.f};
        }
        cur = nxt; cA = nA; cB = nB; ++ui;
    }
    G_WAIT_V(0);
    if (wr == 0) G_BAR;
    G_BAR;
#undef G_SA
#undef G_SB
#undef G_STAGE
#undef G_LDA
#undef G_LDB
#undef G_MMA
#undef G_WAIT_V
#undef G_WAIT_L
#undef G_BAR
#undef G_SCHED
}

__device__ __forceinline__ int perm8_local(int c) {
    const int bj = c >> 7, wc = (c >> 5) & 3, n = (c >> 4) & 1, fq = (c >> 2) & 3, e = c & 3;
    return 128 * bj + 32 * wc + 8 * fq + 4 * n + e;
}
__device__ __forceinline__ int colmap_in(int np) {
    const int j = np >> 8, c = np & 255;
    if (j < 16) {
        const int bj = c >> 7, wc = (c >> 5) & 3, n = (c >> 4) & 1, fq = (c >> 2) & 3, e = c & 3;
        return (2 * bj + n) * 1024 + j * 64 + wc * 16 + fq * 4 + e;
    }
    const int L = (j - 16) * 256 + perm8_local(c);
    if (L < 3200) return 4096 + L;
    if (L < 3328) return -1;
    return L + 3968;
}

__device__ void phase0(const Params& p, unsigned char* smem) {
    const int tid = opaque_tid(), lane = tid & 63, wid = tid >> 6;
    bf16_t* Aall = (bf16_t*)(p.ws + WS_AALL);
    for (int row = blockIdx.x * 8 + wid; row < 19456; row += gridDim.x * 8) {
        const float* src; const float* g;
        if (row < MP) { src = p.x_prompt + (size_t)row * 1024; g = p.norm_in; }
        else if (row < MALL) { src = p.x_sample + (size_t)(row - MP) * 1024; g = p.norm_in; }
        else { src = p.mem_prompt + (size_t)(row - MALL) * 1024; g = p.norm_mem; }
        f32x4 v[4]; float ss = 0.f;
#pragma unroll
        for (int i = 0; i < 4; ++i) { v[i] = *(const f32x4*)(src + i * 256 + lane * 4); ss += v[i][0] * v[i][0] + v[i][1] * v[i][1] + v[i][2] * v[i][2] + v[i][3] * v[i][3]; }
        ss = wave_sum(ss);
        const float inv = rsqrtf(ss * (1.0f / 1024.0f) + 1e-6f);
#pragma unroll
        for (int i = 0; i < 4; ++i) {
            const f32x4 gg = *(const f32x4*)(g + i * 256 + lane * 4);
            u32x2 o; o[0] = cvt_pk_bf16(v[i][0] * inv * gg[0], v[i][1] * inv * gg[1]); o[1] = cvt_pk_bf16(v[i][2] * inv * gg[2], v[i][3] * inv * gg[3]);
            *(u32x2*)(Aall + (size_t)row * 1024 + i * 256 + lane * 4) = o;
        }
    }
    for (int idx = blockIdx.x * NTHREADS + tid; idx < 16 * 2 * 8 * 64; idx += gridDim.x * NTHREADS) {
        const int ln = idx & 63, f = (idx >> 6) & 7, mat = (idx >> 9) & 1, hh = idx >> 10;
        const int it = f >> 1, ks = f & 1, fr = ln & 15, fq = ln >> 4;
        const float* src = mat ? p.icl_up : p.decay_up;
        float w[8];
#pragma unroll
        for (int jj = 0; jj < 8; ++jj) w[jj] = src[(size_t)(ks * 32 + fq * 8 + jj) * 1024 + hh * 64 + it * 16 + fr];
        u32x4 pk; pk[0] = cvt_pk_bf16(w[0], w[1]); pk[1] = cvt_pk_bf16(w[2], w[3]); pk[2] = cvt_pk_bf16(w[4], w[5]); pk[3] = cvt_pk_bf16(w[6], w[7]);
        *(u32x4*)(p.ws + WS_FRAG + (size_t)idx * 16) = pk;
    }
    bf16_t* T = (bf16_t*)smem;
    const int NT_IN = 212 * 16, NT_KV = 32 * 16, NT_WB = 3 * 16 * 16, NT_WO = 16 * 16;
    const int total = NT_IN + NT_KV + NT_WB + NT_WO;
    for (int tix = blockIdx.x; tix < total; tix += gridDim.x) {
        const float* src; int src_ld; bf16_t* dst; int n0, k0, mode;
        if (tix < NT_IN) { src = p.w_in; src_ld = DIN; dst = (bf16_t*)(p.ws + WS_BALL); n0 = (tix >> 4) * 64; k0 = (tix & 15) * 64; mode = 0; }
        else if (tix < NT_IN + NT_KV) { const int t2 = tix - NT_IN; src = p.w_mem_kv; src_ld = 2048; dst = (bf16_t*)(p.ws + WS_BALL) + (size_t)NPAD * 1024; n0 = (t2 >> 4) * 64; k0 = (t2 & 15) * 64; mode = 1; }
        else if (tix < NT_IN + NT_KV + NT_WB) { const int t2 = tix - NT_IN - NT_KV; const int i = t2 >> 8, t3 = t2 & 255; src = p.w_branch + (size_t)i * 1024 * 1024; src_ld = 1024;
            dst = (bf16_t*)(p.ws + WS_WB) + (size_t)i * 1024 * 1024; n0 = (t3 >> 4) * 64; k0 = (t3 & 15) * 64; mode = 2; }
        else { const int t3 = tix - NT_IN - NT_KV - NT_WB; src = p.w_out; src_ld = 1024; dst = (bf16_t*)(p.ws + WS_WO); n0 = (t3 >> 4) * 64; k0 = (t3 & 15) * 64; mode = 1; }
        {
            const int kk = tid >> 3, seg = tid & 7;
#pragma unroll
            for (int q = 0; q < 2; ++q) {
                const int nl = seg * 8 + q * 4, np = n0 + nl;
                int sc;
                if (mode == 0) sc = colmap_in(np);
                else if (mode == 1) sc = np;
                else sc = (np & ~255) + perm8_local(np & 255);
                f32x4 v = (f32x4){0.f, 0.f, 0.f, 0.f};
                if (sc >= 0) v = *(const f32x4*)(src + (size_t)(k0 + kk) * src_ld + sc);
                const unsigned a = cvt_pk_bf16(v[0], v[1]), b = cvt_pk_bf16(v[2], v[3]);
                T[(nl + 0) * 72 + kk] = (bf16_t)(a & 0xffff); T[(nl + 1) * 72 + kk] = (bf16_t)(a >> 16);
                T[(nl + 2) * 72 + kk] = (bf16_t)(b & 0xffff); T[(nl + 3) * 72 + kk] = (bf16_t)(b >> 16);
            }
        }
        __syncthreads();
        {
            const int nl = tid >> 3, ks = tid & 7;
            const u32x4 v = *(const u32x4*)(T + nl * 72 + ks * 8);
            *(u32x4*)(dst + (size_t)(n0 + nl) * 1024 + k0 + ks * 8) = v;
        }
        __syncthreads();
    }
}

struct SchedP1 {
    int G, c; const char* Aall; const char* Ball;
    __device__ __forceinline__ bool next(int i, Unit& u) const {
        const int L = i * G + c;
        constexpr int nM = 68, nN = 53, nwg = nM * nN, WGM = 8;
        if (L >= nwg + 96) return false;
        if (L < nwg) {
            int wgid = L; { const int q = nwg / 8, r = nwg % 8, xcd = wgid % 8, off = wgid / 8; wgid = (xcd < r ? xcd * (q + 1) : r * (q + 1) + (xcd - r) * q) + off; }
            const int nig = WGM * nN, gid = wgid / nig, fm = gid * WGM, gsz = (nM - fm) < WGM ? (nM - fm) : WGM;
            u.x = fm + ((wgid % nig) % gsz); u.y = (wgid % nig) / gsz; u.z = 0;
            u.a = Aall + (size_t)u.x * 256 * 2048; u.b = Ball + (size_t)u.y * 256 * 2048;
        } else {
            int k = L - nwg;
            if (k < 32) { u.x = k >> 2; u.y = k & 3; u.z = 1; u.a = Aall + (size_t)(68 + u.x) * 256 * 2048; u.b = Ball + (size_t)(53 + u.y) * 256 * 2048; }
            else if (k < 64) { k -= 32; u.x = k >> 2; u.y = k & 3; u.z = 2; u.a = Aall + (size_t)(68 + u.x) * 256 * 2048; u.b = Ball + (size_t)(57 + u.y) * 256 * 2048; }
            else { k -= 64; u.x = k >> 3; u.y = k & 7; u.z = 3; u.a = Ball + (size_t)(57 + u.x) * 256 * 2048; u.b = Aall + (size_t)(68 + u.y) * 256 * 2048; }
        }
        return true;
    }
};

struct EpiNull { __device__ __forceinline__ bool operator()(f32x4 (&acc)[2][2][4][2], const Unit& u, int wr, int wc, int fr, int fq) const { float t = 0.f;
#pragma unroll
        for (int a = 0; a < 2; ++a)
#pragma unroll
            for (int b = 0; b < 2; ++b)
#pragma unroll
                for (int m = 0; m < 4; ++m)
#pragma unroll
                    for (int n = 0; n < 2; ++n) t += acc[a][b][m][n][0] + acc[a][b][m][n][1] + acc[a][b][m][n][2] + acc[a][b][m][n][3];
        if (t == 123.456f) sink[0] = t; return false; }
    float* sink; };
struct EpiP1 {
    bf16_t* U; bf16_t* BG; bf16_t* ACT; float* out; bf16_t* Kbf; bf16_t* Vt;
    __device__ __forceinline__ bool operator()(f32x4 (&acc)[2][2][4][2], const Unit& u, int wr, int wc, int fr, int fq) const {
        const int type = u.z;
        if (type == 0) {
            const int pn = u.y, rbase = u.x * 256 + wr * 64 + fr;
            if (pn < 16) {
                const int ch0 = pn * 64 + wc * 16 + fq * 4;
#pragma unroll
                for (int ai = 0; ai < 2; ++ai)
#pragma unroll
                    for (int m = 0; m < 4; ++m) {
                        const int row = rbase + ai * 128 + m * 16;
                        const f32x4 h = acc[ai][0][m][0], Bv = acc[ai][0][m][1], Cv = acc[ai][1][m][0], g = acc[ai][1][m][1];
                        const f32x4 u4 = Cv * h;
                        f32x4 bg;
#pragma unroll
                        for (int e = 0; e < 4; ++e) bg[e] = Bv[e] * siluf_(g[e]);
                        u32x2 o; o[0] = cvt_pk_bf16(u4[0], u4[1]); o[1] = cvt_pk_bf16(u4[2], u4[3]);
                        *(u32x2*)(U + (size_t)row * 1024 + ch0) = o;
                        o[0] = cvt_pk_bf16(bg[0], bg[1]); o[1] = cvt_pk_bf16(bg[2], bg[3]);
                        *(u32x2*)(BG + (size_t)row * 1024 + ch0) = o;
                        if (row < MP) { const int t = row & 2047; if (t >= 2046) *(f32x4*)(out + OUT_CONV_P + (size_t)((row >> 11) * 2 + (t - 2046)) * 1024 + ch0) = u4; }
                        else { const int rs = row - MP, t = rs & 7; if (t >= 6) *(f32x4*)(out + OUT_CONV_S + (size_t)((rs >> 3) * 2 + (t - 6)) * 1024 + ch0) = u4; }
                    }
            } else {
                const int L0 = (pn - 16) * 256;
                const int kind = pn <= 28 ? 0 : pn <= 32 ? 1 : pn <= 36 ? 2 : pn <= 40 ? 1 : 3;
#pragma unroll
                for (int ai = 0; ai < 2; ++ai)
#pragma unroll
                    for (int m = 0; m < 4; ++m) {
                        const int row = rbase + ai * 128 + m * 16;
#pragma unroll
                        for (int bj = 0; bj < 2; ++bj) {
                            const int L = L0 + 128 * bj + 32 * wc + 8 * fq;
                            f32x4 v0 = acc[ai][bj][m][0], v1 = acc[ai][bj][m][1];
                            if (kind == 0) {
                                if (L < DSHIFT) {
                                    if (row < MP) { if ((row & 2047) == 2047) { float* d = out + OUT_SHIFT_P + (size_t)(row >> 11) * DSHIFT + L; *(f32x4*)d = v0; *(f32x4*)(d + 4) = v1; } }
                                    else { const int rs = row - MP; if ((rs & 7) == 7) { float* d = out + OUT_SHIFT_S + (size_t)(rs >> 3) * DSHIFT + L; *(f32x4*)d = v0; *(f32x4*)(d + 4) = v1; } }
                                }
                            } else if (kind == 1) {
#pragma unroll
                                for (int e = 0; e < 4; ++e) { v0[e] = siluf_(v0[e]); v1[e] = siluf_(v1[e]); }
                            } else if (kind == 2) { v0 *= 0.0625f; v1 *= 0.0625f; }
                            else {
#pragma unroll
                                for (int e = 0; e < 4; ++e) { v0[e] = sigmoidf_(v0[e]); v1[e] = sigmoidf_(v1[e]); }
                            }
                            u32x4 o; o[0] = cvt_pk_bf16(v0[0], v0[1]); o[1] = cvt_pk_bf16(v0[2], v0[3]); o[2] = cvt_pk_bf16(v1[0], v1[1]); o[3] = cvt_pk_bf16(v1[2], v1[3]);
                            *(u32x4*)(ACT + (size_t)row * ACT_LD + L) = o;
                        }
                    }
            }
        } else {
            const int rbase = u.x * 256 + wr * 64 + fr, cbase = u.y * 256 + wc * 32 + fq * 4;
#pragma unroll
            for (int ai = 0; ai < 2; ++ai)
#pragma unroll
                for (int m = 0; m < 4; ++m) {
                    const int row = rbase + ai * 128 + m * 16;
#pragma unroll
                    for (int bj = 0; bj < 2; ++bj)
#pragma unroll
                        for (int n = 0; n < 2; ++n) {
                            const int col = cbase + bj * 128 + n * 16;
                            const f32x4 v = acc[ai][bj][m][n];
                            if (type == 1) { *(f32x4*)(out + OUT_MK + (size_t)row * 1024 + col) = v;
                                u32x2 o; o[0] = cvt_pk_bf16(v[0], v[1]); o[1] = cvt_pk_bf16(v[2], v[3]); *(u32x2*)(Kbf + (size_t)row * 1024 + col) = o; }
                            else if (type == 2) { *(f32x4*)(out + OUT_MV + (size_t)row * 1024 + col) = v; }
                            else { u32x2 o; o[0] = cvt_pk_bf16(v[0], v[1]); o[1] = cvt_pk_bf16(v[2], v[3]); *(u32x2*)(Vt + (size_t)row * 2048 + col) = o; }
                        }
                }
        }
        return false;
    }
};

struct ChunkDesc { int r0, b, h, half, samp, t0, n, first, last, bstep; };
__device__ __forceinline__ int n_chunks(const int bid, const int G) {
    const int n_long = bid < 256 ? (255 - bid) / G + 1 : 0, n_samp = bid < 4096 ? (4095 - bid) / G + 1 : 0;
    return n_long * 64 + ((n_samp + 3) >> 2);
}
__device__ __forceinline__ bool chunk_desc(const int ci, const int bid, const int G, ChunkDesc& d) {
    const int n_long = bid < 256 ? (255 - bid) / G + 1 : 0;
    const int n_samp = bid < 4096 ? (4095 - bid) / G + 1 : 0;
    const int nc_long = n_long * 64;
    if (ci < nc_long) { const int k = ci >> 6, it = bid + k * G, chain = it >> 1; d.b = chain >> 4; d.h = chain & 15; d.half = it & 1; d.samp = 0; d.r0 = d.b * TP; d.bstep = 0;
        d.t0 = (ci & 63) * 32; d.n = 32; d.first = (ci & 63) == 0; d.last = (ci & 63) == 63; return true; }
    const int k0 = (ci - nc_long) * 4; if (ci < 0 || k0 >= n_samp) return false;
    const int it = bid + k0 * G, chain = it >> 1; d.b = chain >> 4; d.h = chain & 15; d.half = it & 1; d.samp = 1; d.r0 = 0; d.t0 = 0; d.bstep = G >> 5;
    const int ni = n_samp - k0 < 4 ? n_samp - k0 : 4; d.n = ni * 8; d.first = 1; d.last = 1; return true;
}
__device__ __forceinline__ int cd_batch(const ChunkDesc& d, const int t) { return d.samp ? d.b + (t >> 3) * d.bstep : d.b; }
__device__ __forceinline__ int cd_row(const ChunkDesc& d, const int t) { return d.samp ? MP + (d.b + (t >> 3) * d.bstep) * 8 + (t & 7) : d.r0 + d.t0 + t; }
__device__ __forceinline__ bool cd_first(const ChunkDesc& d, const int t) { return d.samp ? (t & 7) == 0 : (d.t0 + t) == 0; }
constexpr int SROW = 68;
constexpr int SBUF = 6 * 32 * SROW + 64;
__device__ __forceinline__ f32x2 lo2(const f32x4 v) { return __builtin_shufflevector(v, v, 0, 1); }
__device__ __forceinline__ f32x2 hi2(const f32x4 v) { return __builtin_shufflevector(v, v, 2, 3); }
__device__ __forceinline__ float tanh_fast(float x) { return 1.0f - 2.0f * fast_rcp(1.0f + __expf(2.0f * x)); }

__device__ __forceinline__ void unpack4(const u32x2 v, float (&o)[4]) { o[0] = bflo(v[0]); o[1] = bfhi(v[0]); o[2] = bflo(v[1]); o[3] = bfhi(v[1]); }

struct OpSet { f32x4 kk, wr, w, b, k; f32x2 v, cc; };
__device__ __forceinline__ void reduce4_row16(float a0, float a1, float b0, float b1, float c0, float c1, float d0, float d1, float& A, float& B, float& C, float& D) {
    asm volatile(
        "v_add_f32 %0, %4, %5\n\tv_add_f32 %1, %6, %7\n\tv_add_f32 %2, %8, %9\n\tv_add_f32 %3, %10, %11\n\t"
        "v_add_f32_dpp %0, %0, %0 quad_perm:[1,0,3,2] row_mask:0xf bank_mask:0xf\n\tv_add_f32_dpp %1, %1, %1 quad_perm:[1,0,3,2] row_mask:0xf bank_mask:0xf\n\t"
        "v_add_f32_dpp %2, %2, %2 quad_perm:[1,0,3,2] row_mask:0xf bank_mask:0xf\n\tv_add_f32_dpp %3, %3, %3 quad_perm:[1,0,3,2] row_mask:0xf bank_mask:0xf\n\t"
        "v_add_f32_dpp %0, %0, %0 quad_perm:[2,3,0,1] row_mask:0xf bank_mask:0xf\n\tv_add_f32_dpp %1, %1, %1 quad_perm:[2,3,0,1] row_mask:0xf bank_mask:0xf\n\t"
        "v_add_f32_dpp %2, %2, %2 quad_perm:[2,3,0,1] row_mask:0xf bank_mask:0xf\n\tv_add_f32_dpp %3, %3, %3 quad_perm:[2,3,0,1] row_mask:0xf bank_mask:0xf\n\t"
        "v_add_f32_dpp %0, %0, %0 row_half_mirror row_mask:0xf bank_mask:0xf\n\tv_add_f32_dpp %1, %1, %1 row_half_mirror row_mask:0xf bank_mask:0xf\n\t"
        "v_add_f32_dpp %2, %2, %2 row_half_mirror row_mask:0xf bank_mask:0xf\n\tv_add_f32_dpp %3, %3, %3 row_half_mirror row_mask:0xf bank_mask:0xf\n\t"
        "v_add_f32_dpp %0, %0, %0 row_mirror row_mask:0xf bank_mask:0xf\n\tv_add_f32_dpp %1, %1, %1 row_mirror row_mask:0xf bank_mask:0xf\n\t"
        "v_add_f32_dpp %2, %2, %2 row_mirror row_mask:0xf bank_mask:0xf\n\tv_add_f32_dpp %3, %3, %3 row_mirror row_mask:0xf bank_mask:0xf\n\t"
        "s_nop 1"
        : "=&v"(A), "=&v"(B), "=&v"(C), "=&v"(D)
        : "v"(a0), "v"(a1), "v"(b0), "v"(b1), "v"(c0), "v"(c1), "v"(d0), "v"(d1));
}
struct PrepState { f32x4 aw[4], aa[4]; float ksf[16]; float rn; };

struct PrepRaw { u32x4 wdc[2], wdp[2], adc[2], adp[2]; u32x2 kc[4], kp[4]; };
struct PrepRaw2 { u32x2 rc[4], rp[4], vc[4], vp[4]; };
__device__ __forceinline__ void prep_load(const Params& p, const ChunkDesc& d, const int tb, const int lane, PrepRaw& R) {
    const int fr = lane & 15, fq = lane >> 4;
    const int t = tb + fr; const int tt = t < d.n ? t : d.n - 1;
    const size_t row = (size_t)cd_row(d, tt);
    const bool isfirst = cd_first(d, tt);
    const bf16_t* cur = (const bf16_t*)(p.ws + WS_ACT) + row * ACT_LD;
    const bf16_t* prv = isfirst ? cur : cur - ACT_LD;
    const int hc = d.h * 64 + 4 * fq;
#pragma unroll
    for (int ks = 0; ks < 2; ++ks) {
        R.wdc[ks] = *(const u32x4*)(cur + C_WD + ks * 32 + fq * 8); R.wdp[ks] = *(const u32x4*)(prv + C_WD + ks * 32 + fq * 8);
        R.adc[ks] = *(const u32x4*)(cur + C_AD + ks * 32 + fq * 8); R.adp[ks] = *(const u32x4*)(prv + C_AD + ks * 32 + fq * 8);
    }
#pragma unroll
    for (int it = 0; it < 4; ++it) { R.kc[it] = *(const u32x2*)(cur + C_PK + hc + it * 16); R.kp[it] = *(const u32x2*)(prv + C_PK + hc + it * 16); }
}
__device__ __forceinline__ void prep_load2(const Params& p, const ChunkDesc& d, const int tb, const int lane, PrepRaw2& R) {
    const int fr = lane & 15, fq = lane >> 4;
    const int t = tb + fr; const int tt = t < d.n ? t : d.n - 1;
    const size_t row = (size_t)cd_row(d, tt);
    const bool isfirst = cd_first(d, tt);
    const bf16_t* cur = (const bf16_t*)(p.ws + WS_ACT) + row * ACT_LD;
    const bf16_t* prv = isfirst ? cur : cur - ACT_LD;
    const int hc = d.h * 64 + 4 * fq;
#pragma unroll
    for (int it = 0; it < 4; ++it) {
        R.rc[it] = *(const u32x2*)(cur + C_PR + hc + it * 16); R.rp[it] = *(const u32x2*)(prv + C_PR + hc + it * 16);
        R.vc[it] = *(const u32x2*)(cur + C_PV + hc + it * 16); R.vp[it] = *(const u32x2*)(prv + C_PV + hc + it * 16);
    }
}
__device__ __forceinline__ void shift4(const u32x2 cu, const u32x2 pr, const float* st, const bool isfirst, const bool samp, const int col, const f32x4 mu, float (&o)[4]) {
    float c[4], q[4];
    unpack4(cu, c); unpack4(pr, q);
    if (isfirst) {
        if (samp) { const f32x4 v = *(const f32x4*)(st + col); q[0] = v[0]; q[1] = v[1]; q[2] = v[2]; q[3] = v[3]; }
        else { q[0] = 0.f; q[1] = 0.f; q[2] = 0.f; q[3] = 0.f; }
    }
#pragma unroll
    for (int e = 0; e < 4; ++e) o[e] = c[e] + mu[e] * (q[e] - c[e]);
}

__device__ __forceinline__ void prep_stage1(const Params& p, const ChunkDesc& d, const int tb, const float* par, const int lane, const PrepRaw& R, PrepState& S) {
    const int fr = lane & 15, fq = lane >> 4;
    const int t = tb + fr; const int tt = t < d.n ? t : d.n - 1;
    const bool isfirst = cd_first(d, tt), samp = d.samp != 0;
    const float* st = p.state_shift + (size_t)cd_batch(d, tt) * DSHIFT;
    bf16x8 bw[2], ba[2];
#pragma unroll
    for (int ks = 0; ks < 2; ++ks) {
#pragma unroll
        for (int which = 0; which < 2; ++which) {
            const int col = (which ? C_AD : C_WD) + ks * 32 + fq * 8;
            const u32x4 cu = which ? R.adc[ks] : R.wdc[ks], pr = which ? R.adp[ks] : R.wdp[ks];
            float x0[4], x1[4];
            shift4((u32x2){cu[0], cu[1]}, (u32x2){pr[0], pr[1]}, st, isfirst, samp, col, *(const f32x4*)(par + 512 + which * 64 + ks * 32 + fq * 8), x0);
            shift4((u32x2){cu[2], cu[3]}, (u32x2){pr[2], pr[3]}, st, isfirst, samp, col + 4, *(const f32x4*)(par + 512 + which * 64 + ks * 32 + fq * 8 + 4), x1);
            if (!which) {
#pragma unroll
                for (int e = 0; e < 4; ++e) { x0[e] = tanh_fast(x0[e]); x1[e] = tanh_fast(x1[e]); }
            }
            u32x4 pk; pk[0] = cvt_pk_bf16(x0[0], x0[1]); pk[1] = cvt_pk_bf16(x0[2], x0[3]); pk[2] = cvt_pk_bf16(x1[0], x1[1]); pk[3] = cvt_pk_bf16(x1[2], x1[3]);
            if (which) ba[ks] = __builtin_bit_cast(bf16x8, pk); else bw[ks] = __builtin_bit_cast(bf16x8, pk);
        }
    }
    const bf16x8* ft = (const bf16x8*)(p.ws + WS_FRAG) + (size_t)d.h * 1024 + lane;
    __builtin_amdgcn_sched_barrier(0);
#pragma unroll
    for (int it = 0; it < 4; ++it) {
        S.aw[it] = (f32x4){0.f, 0.f, 0.f, 0.f}; S.aa[it] = S.aw[it];
#pragma unroll
        for (int ks = 0; ks < 2; ++ks) {
            S.aw[it] = __builtin_amdgcn_mfma_f32_16x16x32_bf16(ft[(it * 2 + ks) * 64], bw[ks], S.aw[it], 0, 0, 0);
            S.aa[it] = __builtin_amdgcn_mfma_f32_16x16x32_bf16(ft[(8 + it * 2 + ks) * 64], ba[ks], S.aa[it], 0, 0, 0);
        }
        if (it & 1) __builtin_amdgcn_sched_barrier(0);
    }
    const int hc = d.h * 64 + 4 * fq;
    float ss = 0.f;
#pragma unroll
    for (int it = 0; it < 4; ++it) {
        const int po = it * 16 + 4 * fq;
        float k4[4];
        shift4(R.kc[it], R.kp[it], st, isfirst, samp, C_PK + hc + it * 16, *(const f32x4*)(par + 64 + po), k4);
        const f32x4 kkp = *(const f32x4*)(par + 5 * 64 + po);
#pragma unroll
        for (int e = 0; e < 4; ++e) { S.ksf[it * 4 + e] = k4[e]; const float kr = k4[e] * kkp[e]; ss += kr * kr; }
        __builtin_amdgcn_sched_barrier(0);
    }
    ss += __shfl_xor(ss, 16, 64); ss += __shfl_xor(ss, 32, 64);
    S.rn = rsqrtf(ss + 1e-12f);
}

__device__ __forceinline__ void prep_stage2(const Params& p, const ChunkDesc& d, const int tb, float* buf, const float* par, const int lane, const PrepRaw2& R, const PrepState& S) {
    const int fr = lane & 15, fq = lane >> 4;
    const int t = tb + fr; const bool valid = t < d.n; const int tt = valid ? t : d.n - 1;
    const bool isfirst = cd_first(d, tt), samp = d.samp != 0;
    const float* st = p.state_shift + (size_t)cd_batch(d, tt) * DSHIFT;
    const int hc = d.h * 64 + 4 * fq;
    float c1 = 0.f, c2 = 0.f, c3 = 0.f;
    float* kkA = buf; float* wrA = buf + 32 * SROW; float* wA = buf + 2 * 32 * SROW; float* bA = buf + 3 * 32 * SROW; float* kpA = buf + 4 * 32 * SROW; float* vsA = buf + 5 * 32 * SROW; float* c12 = buf + 6 * 32 * SROW;
#pragma unroll
    for (int it = 0; it < 4; ++it) {
        const int po = it * 16 + 4 * fq;
        const f32x4 w0 = *(const f32x4*)(par + 3 * 64 + po), a0 = *(const f32x4*)(par + 4 * 64 + po), kkp = *(const f32x4*)(par + 5 * 64 + po), ka = *(const f32x4*)(par + 6 * 64 + po), rk = *(const f32x4*)(par + 7 * 64 + po);
        f32x4 o_kk, o_wr, o_w, o_b, o_kp, o_vs;
        float r4[4], v4[4];
        shift4(R.rc[it], R.rp[it], st, isfirst, samp, C_PR + hc + it * 16, *(const f32x4*)(par + po), r4);
        shift4(R.vc[it], R.vp[it], st, isfirst, samp, C_PV + hc + it * 16, *(const f32x4*)(par + 128 + po), v4);
#pragma unroll
        for (int e = 0; e < 4; ++e) {
            const float r_ = r4[e], k_ = S.ksf[it * 4 + e];
            const float dec = __expf(-0.6065306597f * sigmoidf_(S.aw[it][e] + w0[e]));
            const float a = sigmoidf_(S.aa[it][e] + a0[e]);
            const float kn = k_ * kkp[e] * S.rn;
            const float kpv = k_ * (1.0f + (a - 1.0f) * ka[e]);
            const float bv = kn * a;
            c1 += bv * r_; c2 += kpv * r_; c3 += r_ * kpv * rk[e];
            o_kk[e] = kn; o_wr[e] = dec * r_; o_w[e] = dec; o_b[e] = bv; o_kp[e] = kpv; o_vs[e] = v4[e];
        }
        if (valid) {
            const int o = t * SROW + po;
            *(f32x4*)(kkA + o) = o_kk; *(f32x4*)(wrA + o) = o_wr; *(f32x4*)(wA + o) = o_w; *(f32x4*)(bA + o) = o_b; *(f32x4*)(kpA + o) = o_kp; *(f32x4*)(vsA + o) = o_vs;
        }
        __builtin_amdgcn_sched_barrier(0);
    }
    c1 += __shfl_xor(c1, 16, 64); c1 += __shfl_xor(c1, 32, 64);
    c2 += __shfl_xor(c2, 16, 64); c2 += __shfl_xor(c2, 32, 64);
    c3 += __shfl_xor(c3, 16, 64); c3 += __shfl_xor(c3, 32, 64);
    if (valid && fq == 0) { c12[t * 2] = c1; c12[t * 2 + 1] = c2; if (d.half == 0) ((float*)(p.ws + WS_C3))[(size_t)cd_row(d, t) * 16 + d.h] = c3; }
}

__device__ void phase2_scan(const Params& p, unsigned char* smem) {
    const int tid = opaque_tid(), lane = tid & 63, wid = __builtin_amdgcn_readfirstlane(tid >> 6);
    const int bid = blockIdx.x, G = gridDim.x;
    float* sm = (float*)smem;
    float* bufs = sm;
    float* obuf = sm + 2 * SBUF;
    float* parb = obuf + 2 * 1024;
    const int NC = n_chunks(bid, G);
    float* ORAW = p.out + OUT_Y;
    __syncthreads();
    if (NC == 0) return;
    if (wid < 4) {
        const int c = lane & 15, rg = lane >> 4, rl = wid * 8 + rg * 2;
        f32x2 s00 = (f32x2){0.f, 0.f}, s01 = s00, s10 = s00, s11 = s00;
        __syncthreads();
        __syncthreads();
        for (int ci = 0; ci < NC; ++ci) {
            ChunkDesc d; chunk_desc(ci, bid, G, d);
            const float* buf = bufs + (ci & 1) * SBUF;
            const float* kkA = buf + 4 * c; const float* vsA = buf + 5 * 32 * SROW + d.half * 32 + rl; const float* c12 = buf + 6 * 32 * SROW;
            float* ob = obuf + (ci & 1) * 1024 + rl;
            const int nsub = d.samp ? (d.n >> 3) : 1, slen = d.samp ? 8 : d.n;
            OpSet A, B;
            auto ld = [&](OpSet& o, const int t) {
                o.kk = *(const f32x4*)(kkA + t * SROW); o.wr = *(const f32x4*)(kkA + 32 * SROW + t * SROW); o.w = *(const f32x4*)(kkA + 2 * 32 * SROW + t * SROW);
                o.b = *(const f32x4*)(kkA + 3 * 32 * SROW + t * SROW); o.k = *(const f32x4*)(kkA + 4 * 32 * SROW + t * SROW);
                o.v = *(const f32x2*)(vsA + t * SROW); o.cc = *(const f32x2*)(c12 + t * 2);
            };
            auto step = [&](const OpSet& o, const int t) {
                const f32x2 pd0 = s00 * lo2(o.kk) + s01 * hi2(o.kk), pd1 = s10 * lo2(o.kk) + s11 * hi2(o.kk);
                const f32x2 pe0 = s00 * lo2(o.wr) + s01 * hi2(o.wr), pe1 = s10 * lo2(o.wr) + s11 * hi2(o.wr);
                float d0, d1, e0, e1;
                reduce4_row16(pd0[0], pd0[1], pd1[0], pd1[1], pe0[0], pe0[1], pe1[0], pe1[1], d0, d1, e0, e1);
                const f32x2 vv0 = (f32x2){o.v[0], o.v[0]}, vv1 = (f32x2){o.v[1], o.v[1]}, dd0 = (f32x2){d0, d0}, dd1 = (f32x2){d1, d1};
                s00 = s00 * lo2(o.w) + (lo2(o.k) * vv0 - lo2(o.b) * dd0);
                s01 = s01 * hi2(o.w) + (hi2(o.k) * vv0 - hi2(o.b) * dd0);
                s10 = s10 * lo2(o.w) + (lo2(o.k) * vv1 - lo2(o.b) * dd1);
                s11 = s11 * hi2(o.w) + (hi2(o.k) * vv1 - hi2(o.b) * dd1);
                if (c == 0) { f32x2 ov; ov[0] = e0 - d0 * o.cc[0] + o.v[0] * o.cc[1]; ov[1] = e1 - d1 * o.cc[0] + o.v[1] * o.cc[1]; *(f32x2*)(ob + t * 32) = ov; }
            };
            for (int sub = 0; sub < nsub; ++sub) {
                const int tbeg = sub * slen, tend = tbeg + slen;
                const size_t st_off = ((size_t)(cd_batch(d, tbeg) * 16 + d.h) * 64 + d.half * 32 + rl) * 64 + 4 * c;
                if (d.samp) { const f32x4 a = *(const f32x4*)(p.state_wkv + st_off), b2 = *(const f32x4*)(p.state_wkv + st_off + 64); s00 = lo2(a); s01 = hi2(a); s10 = lo2(b2); s11 = hi2(b2); }
                else if (d.first) { s00 = (f32x2){0.f, 0.f}; s01 = s00; s10 = s00; s11 = s00; }
                ld(A, tbeg);
                for (int t = tbeg; t < tend; t += 2) {
                    ld(B, t + 1);
                    step(A, t);
                    ld(A, (t + 2 < tend) ? t + 2 : t);
                    step(B, t + 1);
                }
                if (d.samp || d.last) {
                    float* so = p.out + (d.samp ? OUT_WKV_S : OUT_WKV_P) + st_off;
                    f32x4 a, b2; a[0] = s00[0]; a[1] = s00[1]; a[2] = s01[0]; a[3] = s01[1]; b2[0] = s10[0]; b2[1] = s10[1]; b2[2] = s11[0]; b2[3] = s11[1];
                    *(f32x4*)so = a; *(f32x4*)(so + 64) = b2;
                }
            }
            __syncthreads();
        }
        __syncthreads();
    } else {
        const int q = (wid >> 1) & 1, tb = (wid & 1) * 16;
        float* par = parb + (wid & 3) * 640;
        PrepState S;
        int cur_h = -1;
        for (int i = -2; i <= NC; ++i) {
            if ((i & 1) == q) {
                ChunkDesc d;
                int ck = i + 2; ck = ck < 0 ? 0 : (ck > NC - 1 ? NC - 1 : ck);
                chunk_desc(ck, bid, G, d);
                if (d.h != cur_h) {
                    cur_h = d.h;
                    const int ch = d.h * 64 + lane;
                    par[lane] = p.shift_mu[ch]; par[64 + lane] = p.shift_mu[1024 + ch]; par[128 + lane] = p.shift_mu[2048 + ch]; par[192 + lane] = p.decay_w0[ch];
                    par[256 + lane] = p.icl_a0[ch]; par[320 + lane] = p.k_k[ch]; par[384 + lane] = p.k_a[ch]; par[448 + lane] = p.r_k[ch];
                    par[512 + lane] = p.shift_mu[C_WD + lane]; par[576 + lane] = p.shift_mu[C_AD + lane];
                }
                PrepRaw R;
                prep_load(p, d, tb, lane, R);
                prep_stage1(p, d, tb, par, lane, R, S);
            } else {
                ChunkDesc d, d2;
                PrepRaw2 R2;
                const bool has2 = i >= -1 && i + 1 < NC && chunk_desc(i + 1, bid, G, d2) && tb < d2.n;
                if (has2) prep_load2(p, d2, tb, lane, R2);
                if (i >= 1 && chunk_desc(i - 1, bid, G, d)) {
                    const float* ob = obuf + ((i - 1) & 1) * 1024;
                    for (int idx = (wid & 1) * 64 + lane; idx < d.n * 8; idx += 128) { const int t = idx >> 3, j = (idx & 7) * 4; *(f32x4*)(ORAW + (size_t)cd_row(d, t) * 1024 + d.h * 64 + d.half * 32 + j) = *(const f32x4*)(ob + t * 32 + j); }
                }
                if (has2) prep_stage2(p, d2, tb, bufs + ((i + 1) & 1) * SBUF, par, lane, R2, S);
            }
            __syncthreads();
        }
    }
}

__device__ void attn_unit(const Params& p, unsigned char* smem, const int unit) {
    const int tid = opaque_tid(), lane = tid & 63, wid = __builtin_amdgcn_readfirstlane(tid >> 6), fr = lane & 15, fq = lane >> 4;
    const bool samp = unit >= 512;
    int b, h, tile = 0;
    if (!samp) { b = unit >> 6; h = (unit >> 4) & 3; tile = unit & 15; } else { const int u2 = unit - 512; b = u2 >> 2; h = u2 & 3; }
    const bf16_t* ACT = (const bf16_t*)(p.ws + WS_ACT);
    const bf16_t* Kbf = (const bf16_t*)(p.ws + WS_KBF);
    const bf16_t* Vt = (const bf16_t*)(p.ws + WS_VT);
    bf16_t* Ymem = (bf16_t*)(p.ws + WS_YMEM);
    bf16_t* Kc = (bf16_t*)smem;
    bf16_t* Vc = (bf16_t*)smem;
    const int row = samp ? MP + b * 8 + (fr & 7) : b * 2048 + tile * 128 + wid * 16 + fr;
    const bool valid = !samp || fr < 8;
    bf16x8 qf[8];
#pragma unroll
    for (int ks = 0; ks < 8; ++ks) qf[ks] = *(const bf16x8*)(ACT + (size_t)row * ACT_LD + C_QM + h * 256 + ks * 32 + fq * 8);
    f32x4 sacc[16];
#pragma unroll
    for (int i = 0; i < 16; ++i) sacc[i] = (f32x4){0.f, 0.f, 0.f, 0.f};
#pragma unroll
    for (int hf = 0; hf < 2; ++hf) {
        __syncthreads();
#pragma unroll
        for (int i = 0; i < 8; ++i) {
            const int id = tid + i * NTHREADS, key = id >> 5, d = (id & 31) * 8;
            u32x4 v;
            if (!samp) v = *(const u32x4*)(Kbf + (size_t)(b * 256 + hf * 128 + key) * 1024 + h * 256 + d);
            else { const float* s = p.cache_k + ((size_t)(b * 256 + hf * 128 + key) * 4 + h) * 256 + d; const f32x4 x0 = *(const f32x4*)s, x1 = *(const f32x4*)(s + 4);
                v[0] = cvt_pk_bf16(x0[0], x0[1]); v[1] = cvt_pk_bf16(x0[2], x0[3]); v[2] = cvt_pk_bf16(x1[0], x1[1]); v[3] = cvt_pk_bf16(x1[2], x1[3]); }
            *(u32x4*)(Kc + key * 264 + d) = v;
        }
        __syncthreads();
#pragma unroll
        for (int kt = 0; kt < 8; ++kt)
#pragma unroll
            for (int ks = 0; ks < 8; ++ks) {
                const bf16x8 kf = *(const bf16x8*)(Kc + (kt * 16 + fr) * 264 + ks * 32 + fq * 8);
                sacc[hf * 8 + kt] = __builtin_amdgcn_mfma_f32_16x16x32_bf16(kf, qf[ks], sacc[hf * 8 + kt], 0, 0, 0);
            }
    }
    float mx = -3.0e38f;
#pragma unroll
    for (int i = 0; i < 16; ++i) mx = fmaxf(mx, fmaxf(fmaxf(sacc[i][0], sacc[i][1]), fmaxf(sacc[i][2], sacc[i][3])));
    mx = fmaxf(mx, __shfl_xor(mx, 16, 64)); mx = fmaxf(mx, __shfl_xor(mx, 32, 64));
    float sum = 0.f;
#pragma unroll
    for (int i = 0; i < 16; ++i)
#pragma unroll
        for (int e = 0; e < 4; ++e) { const float ex = __expf(sacc[i][e] - mx); sacc[i][e] = ex; sum += ex; }
    sum += __shfl_xor(sum, 16, 64); sum += __shfl_xor(sum, 32, 64);
    const float inv = fast_rcp(sum);
    bf16x8 pf[8];
#pragma unroll
    for (int s = 0; s < 8; ++s) {
        u32x4 t; t[0] = cvt_pk_bf16(sacc[2 * s][0], sacc[2 * s][1]); t[1] = cvt_pk_bf16(sacc[2 * s][2], sacc[2 * s][3]);
        t[2] = cvt_pk_bf16(sacc[2 * s + 1][0], sacc[2 * s + 1][1]); t[3] = cvt_pk_bf16(sacc[2 * s + 1][2], sacc[2 * s + 1][3]);
        pf[s] = __builtin_bit_cast(bf16x8, t);
    }
    f32x4 oacc[16];
#pragma unroll
    for (int i = 0; i < 16; ++i) oacc[i] = (f32x4){0.f, 0.f, 0.f, 0.f};
#pragma unroll
    for (int hf = 0; hf < 2; ++hf) {
        __syncthreads();
        if (!samp) {
#pragma unroll
            for (int i = 0; i < 8; ++i) {
                const int id = tid + i * NTHREADS, d = id >> 4, kc = (id & 15) * 8;
                const u32x4 v = *(const u32x4*)(Vt + (size_t)(h * 256 + d) * 2048 + b * 256 + hf * 128 + kc);
                *(u32x4*)(Vc + d * 136 + kc) = v;
            }
        } else {
#pragma unroll
            for (int i = 0; i < 16; ++i) {
                const int id = tid + i * NTHREADS, key = id >> 6, d = (id & 63) * 4;
                const f32x4 x = *(const f32x4*)(p.cache_v + ((size_t)(b * 256 + hf * 128 + key) * 4 + h) * 256 + d);
                const unsigned a = cvt_pk_bf16(x[0], x[1]), bq = cvt_pk_bf16(x[2], x[3]);
                Vc[(d + 0) * 136 + key] = (bf16_t)(a & 0xffff); Vc[(d + 1) * 136 + key] = (bf16_t)(a >> 16);
                Vc[(d + 2) * 136 + key] = (bf16_t)(bq & 0xffff); Vc[(d + 3) * 136 + key] = (bf16_t)(bq >> 16);
            }
        }
        __syncthreads();
#pragma unroll
        for (int dt = 0; dt < 16; ++dt) {
            if (!samp || (dt >> 1) == wid) {
#pragma unroll
                for (int s2 = 0; s2 < 4; ++s2) {
                    const u32x2 lo = *(const u32x2*)(Vc + (dt * 16 + fr) * 136 + s2 * 32 + 4 * fq), hi = *(const u32x2*)(Vc + (dt * 16 + fr) * 136 + s2 * 32 + 16 + 4 * fq);
                    u32x4 t; t[0] = lo[0]; t[1] = lo[1]; t[2] = hi[0]; t[3] = hi[1];
                    oacc[dt] = __builtin_amdgcn_mfma_f32_16x16x32_bf16(__builtin_bit_cast(bf16x8, t), pf[hf * 4 + s2], oacc[dt], 0, 0, 0);
                }
            }
        }
    }
    if (valid) {
#pragma unroll
        for (int dt = 0; dt < 16; ++dt) {
            if (!samp || (dt >> 1) == wid) {
                const int d = h * 256 + dt * 16 + 4 * fq;
                const u32x2 g = *(const u32x2*)(ACT + (size_t)row * ACT_LD + C_SGM + d);
                u32x2 o; o[0] = cvt_pk_bf16(oacc[dt][0] * inv * bflo(g[0]), oacc[dt][1] * inv * bfhi(g[0])); o[1] = cvt_pk_bf16(oacc[dt][2] * inv * bflo(g[1]), oacc[dt][3] * inv * bfhi(g[1]));
                *(u32x2*)(Ymem + (size_t)row * 1024 + d) = o;
            }
        }
    }
}

__device__ void attn_sample_unit(const Params& p, unsigned char* smem, const int b, const int h) {
    const int tid = opaque_tid(), lane = tid & 63, wid = __builtin_amdgcn_readfirstlane(tid >> 6), fr = lane & 15, fq = lane >> 4;
    const bf16_t* ACT = (const bf16_t*)(p.ws + WS_ACT);
    bf16_t* Ymem = (bf16_t*)(p.ws + WS_YMEM);
    bf16_t* Kc = (bf16_t*)smem;
    float* Ored = (float*)smem;
    float* Pl = (float*)(smem + 69632);
    const int row = MP + b * 8 + (fr & 7);
    bf16x8 qf[8];
#pragma unroll
    for (int ks = 0; ks < 8; ++ks) qf[ks] = *(const bf16x8*)(ACT + (size_t)row * ACT_LD + C_QM + h * 256 + ks * 32 + fq * 8);
    const float* vbase = p.cache_v + ((size_t)(b * 256 + wid * 32) * 4 + h) * 256 + lane * 4;
    f32x4 vv[8];
#pragma unroll
    for (int i = 0; i < 8; ++i) vv[i] = *(const f32x4*)(vbase + (size_t)i * 1024);
    f32x4 sacc[16];
#pragma unroll
    for (int i = 0; i < 16; ++i) sacc[i] = (f32x4){0.f, 0.f, 0.f, 0.f};
#pragma unroll
    for (int hf = 0; hf < 2; ++hf) {
        __syncthreads();
#pragma unroll
        for (int i = 0; i < 8; ++i) {
            const int id = tid + i * NTHREADS, key = id >> 5, d = (id & 31) * 8;
            const float* s_ = p.cache_k + ((size_t)(b * 256 + hf * 128 + key) * 4 + h) * 256 + d; const f32x4 x0 = *(const f32x4*)s_, x1 = *(const f32x4*)(s_ + 4);
            u32x4 v; v[0] = cvt_pk_bf16(x0[0], x0[1]); v[1] = cvt_pk_bf16(x0[2], x0[3]); v[2] = cvt_pk_bf16(x1[0], x1[1]); v[3] = cvt_pk_bf16(x1[2], x1[3]);
            *(u32x4*)(Kc + key * 264 + d) = v;
        }
        __syncthreads();
#pragma unroll
        for (int kt = 0; kt < 8; ++kt)
#pragma unroll
            for (int ks = 0; ks < 8; ++ks) {
                const bf16x8 kf = *(const bf16x8*)(Kc + (kt * 16 + fr) * 264 + ks * 32 + fq * 8);
                sacc[hf * 8 + kt] = __builtin_amdgcn_mfma_f32_16x16x32_bf16(kf, qf[ks], sacc[hf * 8 + kt], 0, 0, 0);
            }
    }
    float mx = -3.0e38f;
#pragma unroll
    for (int i = 0; i < 16; ++i) mx = fmaxf(mx, fmaxf(fmaxf(sacc[i][0], sacc[i][1]), fmaxf(sacc[i][2], sacc[i][3])));
    mx = fmaxf(mx, __shfl_xor(mx, 16, 64)); mx = fmaxf(mx, __shfl_xor(mx, 32, 64));
    float sum = 0.f;
#pragma unroll
    for (int i = 0; i < 16; ++i)
#pragma unroll
        for (int e = 0; e < 4; ++e) { const float ex = __expf(sacc[i][e] - mx); sacc[i][e] = ex; sum += ex; }
    sum += __shfl_xor(sum, 16, 64); sum += __shfl_xor(sum, 32, 64);
    const float inv = fast_rcp(sum);
    if (wid == 0 && fr < 8) {
#pragma unroll
        for (int i = 0; i < 16; ++i)
#pragma unroll
            for (int e = 0; e < 4; ++e) Pl[(i * 16 + 4 * fq + e) * 8 + fr] = sacc[i][e] * inv;
    }
    __syncthreads();
    f32x4 o[8];
#pragma unroll
    for (int t = 0; t < 8; ++t) o[t] = (f32x4){0.f, 0.f, 0.f, 0.f};
#pragma unroll
    for (int half = 0; half < 4; ++half) {
        if (half >= 1) {
#pragma unroll
            for (int i = 0; i < 8; ++i) vv[i] = *(const f32x4*)(vbase + (size_t)(half * 8 + i) * 1024);
        }
#pragma unroll
        for (int i = 0; i < 8; ++i) {
            const float* pp = Pl + (wid * 32 + half * 8 + i) * 8;
            const f32x4 p0 = *(const f32x4*)pp, p1 = *(const f32x4*)(pp + 4);
#pragma unroll
            for (int t = 0; t < 4; ++t) { o[t] += vv[i] * p0[t]; o[4 + t] += vv[i] * p1[t]; }
        }
    }
#pragma unroll
    for (int t = 0; t < 8; ++t) *(f32x4*)(Ored + (wid * 8 + t) * 256 + lane * 4) = o[t];
    __syncthreads();
    {
        const int t = tid >> 6, d = (tid & 63) * 4;
        f32x4 acc = (f32x4){0.f, 0.f, 0.f, 0.f};
#pragma unroll
        for (int w = 0; w < 8; ++w) acc += *(const f32x4*)(Ored + (w * 8 + t) * 256 + d);
        const size_t orow = (size_t)(MP + b * 8 + t);
        const u32x2 g = *(const u32x2*)(ACT + orow * ACT_LD + C_SGM + h * 256 + d);
        u32x2 ov; ov[0] = cvt_pk_bf16(acc[0] * bflo(g[0]), acc[1] * bfhi(g[0])); ov[1] = cvt_pk_bf16(acc[2] * bflo(g[1]), acc[3] * bfhi(g[1]));
        *(u32x2*)(Ymem + orow * 1024 + h * 256 + d) = ov;
    }
}

__device__ void phase2_attn(const Params& p, unsigned char* smem) {
    __syncthreads();
    for (int u = blockIdx.x; u < 512; u += gridDim.x) attn_unit(p, smem, u);
    for (int u = blockIdx.x; u < 512; u += gridDim.x) attn_sample_unit(p, smem, u >> 2, u & 3);
}

__device__ __forceinline__ void ld16bf(const bf16_t* ptr, float (&o)[16]) {
    const u32x4 a = *(const u32x4*)ptr, b = *(const u32x4*)(ptr + 8);
#pragma unroll
    for (int e = 0; e < 4; ++e) { o[2 * e] = bflo(a[e]); o[2 * e + 1] = bfhi(a[e]); o[8 + 2 * e] = bflo(b[e]); o[8 + 2 * e + 1] = bfhi(b[e]); }
}
__device__ __forceinline__ void ld16f(const float* ptr, float (&o)[16]) {
#pragma unroll
    for (int q = 0; q < 4; ++q) { const f32x4 v = *(const f32x4*)(ptr + 4 * q); o[4 * q] = v[0]; o[4 * q + 1] = v[1]; o[4 * q + 2] = v[2]; o[4 * q + 3] = v[3]; }
}
__device__ __forceinline__ void st16bf(bf16_t* ptr, const float (&y)[16]) {
    u32x4 a, b;
#pragma unroll
    for (int e = 0; e < 4; ++e) { a[e] = cvt_pk_bf16(y[2 * e], y[2 * e + 1]); b[e] = cvt_pk_bf16(y[8 + 2 * e], y[8 + 2 * e + 1]); }
    *(u32x4*)ptr = a; *(u32x4*)(ptr + 8) = b;
}
__device__ __forceinline__ float quad_sum(float x) { x += dpp_f<0xB1>(x); x += dpp_f<0x4E>(x); return x; }
__device__ void phase2b(const Params& p, unsigned char* smem) {
    const int tid = opaque_tid(), lane = tid & 63, wid = tid >> 6;
    float* tab = (float*)smem;
    __syncthreads();
    for (int idx = tid; idx < 7168; idx += NTHREADS)
        tab[idx] = idx < 3072 ? p.conv_w[idx] : idx < 4096 ? p.conv_b[idx - 3072] : idx < 5120 ? p.shift_mu[2048 + idx - 4096] : idx < 6144 ? p.ln_g[idx - 5120] : p.ln_b[idx - 6144];
    __syncthreads();
    const bf16_t* U = (const bf16_t*)(p.ws + WS_U); const bf16_t* BG = (const bf16_t*)(p.ws + WS_BG); const bf16_t* ACT = (const bf16_t*)(p.ws + WS_ACT);
    const float* ORAW = p.out + OUT_Y; const float* C3 = (const float*)(p.ws + WS_C3);
    bf16_t* Yc = (bf16_t*)(p.ws + WS_YCONV); bf16_t* Yr = (bf16_t*)(p.ws + WS_YRWKV);
    const int ch = lane * 16;
    for (int row = blockIdx.x * 8 + wid; row < MALL; row += gridDim.x * 8) {
        int b, t; const bool samp = row >= MP;
        if (!samp) { b = row >> 11; t = row & 2047; } else { b = (row - MP) >> 3; t = (row - MP) & 7; }
        float u0[16], um1[16], um2[16], bg[16], o[16], vc[16], vq[16], sg[16];
        ld16bf(U + (size_t)row * 1024 + ch, u0); ld16bf(BG + (size_t)row * 1024 + ch, bg);
        if (t >= 1) ld16bf(U + (size_t)(row - 1) * 1024 + ch, um1);
        else if (samp) ld16f(p.state_conv + ((size_t)b * 2 + 1) * 1024 + ch, um1);
        else {
#pragma unroll
            for (int e = 0; e < 16; ++e) um1[e] = 0.f; }
        if (t >= 2) ld16bf(U + (size_t)(row - 2) * 1024 + ch, um2);
        else if (samp) ld16f(p.state_conv + ((size_t)b * 2 + t) * 1024 + ch, um2);
        else {
#pragma unroll
            for (int e = 0; e < 16; ++e) um2[e] = 0.f; }
        ld16f(ORAW + (size_t)row * 1024 + ch, o);
        ld16bf(ACT + (size_t)row * ACT_LD + C_PV + ch, vc);
        if (t >= 1) ld16bf(ACT + (size_t)(row - 1) * ACT_LD + C_PV + ch, vq);
        else if (samp) ld16f(p.state_shift + (size_t)b * DSHIFT + 2048 + ch, vq);
        else {
#pragma unroll
            for (int e = 0; e < 16; ++e) vq[e] = 0.f; }
        ld16bf(ACT + (size_t)row * ACT_LD + C_SGR + ch, sg);
        const float c3 = C3[(size_t)row * 16 + (lane >> 2)];
        float y[16];
#pragma unroll
        for (int q = 0; q < 4; ++q) {
            const f32x4 w0 = *(const f32x4*)(tab + ch + 4 * q), w1 = *(const f32x4*)(tab + 1024 + ch + 4 * q), w2 = *(const f32x4*)(tab + 2048 + ch + 4 * q), cb = *(const f32x4*)(tab + 3072 + ch + 4 * q);
#pragma unroll
            for (int e = 0; e < 4; ++e) { const int i = 4 * q + e; y[i] = bg[i] * (cb[e] + w0[e] * um2[i] + w1[e] * um1[i] + w2[e] * u0[i]); }
        }
        st16bf(Yc + (size_t)row * 1024 + ch, y);
        float sm_ = 0.f;
#pragma unroll
        for (int e = 0; e < 16; ++e) sm_ += o[e];
        const float mean = quad_sum(sm_) * (1.0f / 64.0f);
        float vr = 0.f;
#pragma unroll
        for (int e = 0; e < 16; ++e) { o[e] -= mean; vr += o[e] * o[e]; }
        const float rstd = rsqrtf(quad_sum(vr) * (1.0f / 64.0f) + 6.4e-4f);
#pragma unroll
        for (int q = 0; q < 4; ++q) {
            const f32x4 mv = *(const f32x4*)(tab + 4096 + ch + 4 * q), lg = *(const f32x4*)(tab + 5120 + ch + 4 * q), lb = *(const f32x4*)(tab + 6144 + ch + 4 * q);
#pragma unroll
            for (int e = 0; e < 4; ++e) { const int i = 4 * q + e; const float vs = vc[i] + mv[e] * (vq[i] - vc[i]); y[i] = (o[i] * rstd * lg[e] + lb[e] + c3 * vs) * sg[i]; }
        }
        st16bf(Yr + (size_t)row * 1024 + ch, y);
    }
}

struct SchedP3 {
    int G, c; const char* ws;
    __device__ __forceinline__ bool next(int i, Unit& u) const {
        const int tl = (i / 3) * G + c, seg = i % 3;
        if (tl >= 272) return false;
        u.x = tl >> 2; u.y = tl & 3; u.z = seg;
        u.a = ws + (seg == 0 ? WS_YCONV : seg == 1 ? WS_YRWKV : WS_YMEM) + (size_t)u.x * 256 * 2048; u.b = ws + WS_WB + ((size_t)seg * 1024 + (size_t)u.y * 256) * 2048;
        return true;
    }
};
struct EpiP3 {
    const bf16_t* ACT; bf16_t* MERGED;
    __device__ __forceinline__ bool operator()(f32x4 (&acc)[2][2][4][2], const Unit& u, int wr, int wc, int fr, int fq) const {
        const int seg = u.z, rbase = u.x * 256 + wr * 64 + fr, cb = u.y * 256 + wc * 32 + 8 * fq;
        const bf16_t* gbase = ACT + C_GATE + seg * 1024 + cb;
#pragma unroll
        for (int ai = 0; ai < 2; ++ai) {
            u32x4 g[4][2], g2[4][2];
#pragma unroll
            for (int m = 0; m < 4; ++m)
#pragma unroll
                for (int bj = 0; bj < 2; ++bj) {
                    const bf16_t* gp = gbase + (size_t)(rbase + ai * 128 + m * 16) * ACT_LD + 128 * bj;
                    g[m][bj] = *(const u32x4*)gp;
                    if (seg < 2) g2[m][bj] = *(const u32x4*)(gp + 1024);
                }
#pragma unroll
            for (int m = 0; m < 4; ++m)
#pragma unroll
                for (int bj = 0; bj < 2; ++bj) {
                    float f[8];
#pragma unroll
                    for (int e = 0; e < 4; ++e) { f[2 * e] = bflo(g[m][bj][e]); f[2 * e + 1] = bfhi(g[m][bj][e]); }
                    if (seg < 2) {
#pragma unroll
                        for (int e = 0; e < 4; ++e) { f[2 * e] *= fast_rcp(bflo(g2[m][bj][e])); f[2 * e + 1] *= fast_rcp(bfhi(g2[m][bj][e])); }
                    }
                    f32x4& v0 = acc[ai][bj][m][0]; f32x4& v1 = acc[ai][bj][m][1];
#pragma unroll
                    for (int e = 0; e < 4; ++e) { v0[e] *= f[e]; v1[e] *= f[4 + e]; }
                    if (seg == 2) {
                        u32x4 o; o[0] = cvt_pk_bf16(v0[0], v0[1]); o[1] = cvt_pk_bf16(v0[2], v0[3]); o[2] = cvt_pk_bf16(v1[0], v1[1]); o[3] = cvt_pk_bf16(v1[2], v1[3]);
                        *(u32x4*)(MERGED + (size_t)(rbase + ai * 128 + m * 16) * 1024 + cb + 128 * bj) = o;
                    }
                }
        }
        return seg < 2;
    }
};
struct SchedP4 {
    int G, c; const char* A; const char* B;
    __device__ __forceinline__ bool next(int i, Unit& u) const {
        const int tl = i * G + c;
        if (tl >= 272) return false;
        u.x = tl >> 2; u.y = tl & 3; u.z = 0;
        u.a = A + (size_t)u.x * 256 * 2048; u.b = B + (size_t)u.y * 256 * 2048;
        return true;
    }
};
struct EpiP4 {
    const float* xp; const float* xs; float* out; float* SUMSQ;
    __device__ __forceinline__ bool operator()(f32x4 (&acc)[2][2][4][2], const Unit& u, int wr, int wc, int fr, int fq) const {
        const int rbase = u.x * 256 + wr * 64 + fr, cbase = u.y * 256 + wc * 32 + fq * 4;
#pragma unroll
        for (int ai = 0; ai < 2; ++ai) {
            f32x4 xv[4][2][2];
#pragma unroll
            for (int m = 0; m < 4; ++m) {
                const int row = rbase + ai * 128 + m * 16;
                const float* xr = row < MP ? xp + (size_t)row * 1024 : xs + (size_t)(row - MP) * 1024;
#pragma unroll
                for (int bj = 0; bj < 2; ++bj)
#pragma unroll
                    for (int n = 0; n < 2; ++n) xv[m][bj][n] = *(const f32x4*)(xr + cbase + bj * 128 + n * 16);
            }
#pragma unroll
            for (int m = 0; m < 4; ++m) {
                const int row = rbase + ai * 128 + m * 16;
                float ss = 0.f;
#pragma unroll
                for (int bj = 0; bj < 2; ++bj)
#pragma unroll
                    for (int n = 0; n < 2; ++n) {
                        const f32x4 v = acc[ai][bj][m][n] + xv[m][bj][n];
                        ss += v[0] * v[0] + v[1] * v[1] + v[2] * v[2] + v[3] * v[3];
                        *(f32x4*)(out + OUT_Y + (size_t)row * 1024 + cbase + bj * 128 + n * 16) = v;
                    }
                ss += __shfl_xor(ss, 16, 64); ss += __shfl_xor(ss, 32, 64);
                if (fq == 0) SUMSQ[(size_t)row * 16 + u.y * 4 + wc] = ss;
            }
        }
        return false;
    }
};
__device__ void phase5(const Params& p) {
    const int tid5 = opaque_tid(); const int lane = tid5 & 63, wid = tid5 >> 6;
    const float* SUMSQ = (const float*)(p.ws + WS_SUMSQ);
    for (int row = blockIdx.x * 8 + wid; row < MALL; row += gridDim.x * 8) {
        float ss = lane < 16 ? SUMSQ[(size_t)row * 16 + lane] : 0.f;
        ss = wave_sum(ss);
        const float inv = rsqrtf(ss * (1.0f / 1024.0f) + 1e-6f);
        float* y = p.out + OUT_Y + (size_t)row * 1024;
#pragma unroll
        for (int i = 0; i < 4; ++i) {
            f32x4 v = *(const f32x4*)(y + i * 256 + lane * 4); const f32x4 g = *(const f32x4*)(p.norm_final + i * 256 + lane * 4);
            v = v * inv * g;
            *(f32x4*)(y + i * 256 + lane * 4) = v;
        }
    }
}

__global__ void __launch_bounds__(NTHREADS) fwd_megakernel(Params p) {
    extern __shared__ __attribute__((aligned(16))) unsigned char smem[];
    cg::grid_group grid = cg::this_grid();
    LAS unsigned char* lds = (LAS unsigned char*)smem;
#ifndef PROBE_REP
#define PROBE_REP 0
#endif
#define REP(k) for (int _r = 0; _r < ((PROBE_REP == (k)) ? 2 : 1); ++_r)
    volatile LAS unsigned* xst = (volatile LAS unsigned*)(lds + LDS_MAIN);
    if (threadIdx.x == 0) { xst[0] = 0u; xst[1] = 0u; xst[2] = 0u; xst[3] = 0u; }
    __syncthreads();
    (void)xcd_barrier_post((unsigned*)(p.ws + WS_BAR), xst);
#define XBAR() do { XcdBarrier _b; _b.bar = (unsigned*)(p.ws + WS_BAR); _b.x = xb_xcc_id(); _b.st = (volatile LAS unsigned*)(lds + LDS_MAIN); xcd_barrier(_b); } while (0)
    REP(1) { phase0(p, smem); if (PROBE_REP == 1 && _r == 0) XBAR(); }
    if (p.ws == nullptr) grid.sync();
    XBAR();
    REP(2) {
        SchedP1 S{(int)gridDim.x, (int)blockIdx.x, (const char*)(p.ws + WS_AALL), (const char*)(p.ws + WS_BALL)};
        EpiP1 E{(bf16_t*)(p.ws + WS_U), (bf16_t*)(p.ws + WS_BG), (bf16_t*)(p.ws + WS_ACT), p.out, (bf16_t*)(p.ws + WS_KBF), (bf16_t*)(p.ws + WS_VT)};
        gemm_phase(lds, 2048, 2048, 1024, S, E);
        XBAR();
        if (PROBE_REP == 9) { EpiNull EN{(float*)(p.ws + WS_SUMSQ)}; gemm_phase(lds, 2048, 2048, 1024, S, EN); XBAR(); }
    }
    REP(3) { phase2_scan(p, smem); if (PROBE_REP == 3) XBAR(); }
    REP(5) { phase2_attn(p, smem); if (PROBE_REP == 5) XBAR(); }
    XBAR();
    REP(6) { phase2b(p, smem); XBAR(); }
    REP(7) {
        SchedP3 S{(int)gridDim.x, (int)blockIdx.x, (const char*)p.ws};
        EpiP3 E{(const bf16_t*)(p.ws + WS_ACT), (bf16_t*)(p.ws + WS_MERGED)};
        gemm_phase(lds, 2048, 2048, 1024, S, E);
        XBAR();
    }
    REP(8) {
        SchedP4 S{(int)gridDim.x, (int)blockIdx.x, (const char*)(p.ws + WS_MERGED), (const char*)(p.ws + WS_WO)};
        EpiP4 E{p.x_prompt, p.x_sample, p.out, (float*)(p.ws + WS_SUMSQ)};
        gemm_phase(lds, 2048, 2048, 1024, S, E);
        XBAR();
    }
    phase5(p);
}

extern "C" void kernel_launch(void* const* d_in, const int* in_sizes, int n_in, void* d_out, int out_size, void* d_ws, size_t ws_size, hipStream_t stream) {
    static int grid_blocks = 0;
    if (!grid_blocks) {
        int dev = 0, cus = 0, per_cu = 0;
        hipGetDevice(&dev);
        hipDeviceGetAttribute(&cus, hipDeviceAttributeMultiprocessorCount, dev);
        if (hipFuncSetAttribute((const void*)fwd_megakernel, hipFuncAttributeMaxDynamicSharedMemorySize, LDS_BYTES) != hipSuccess) fprintf(stderr, "hipFuncSetAttribute failed\n");
        hipOccupancyMaxActiveBlocksPerMultiprocessor(&per_cu, (const void*)fwd_megakernel, NTHREADS, LDS_BYTES);
        if (per_cu < 1) { fprintf(stderr, "occupancy query returned %d\n", per_cu); per_cu = 1; }
        if (per_cu > 1) per_cu = 1;
        grid_blocks = cus * per_cu;
        if (grid_blocks > 256) grid_blocks = 256;
        grid_blocks &= ~31;
        if (grid_blocks < 32) grid_blocks = -1;
        if (ws_size < WS_END) { fprintf(stderr, "workspace too small: %zu < %zu\n", ws_size, (size_t)WS_END); grid_blocks = -1; }
    }
    if (grid_blocks < 0) return;
    Params p{};
    const float** pp = (const float**)&p;
    for (int i = 0; i < 27; ++i) pp[i] = (const float*)d_in[i];
    p.out = (float*)d_out; p.ws = (unsigned char*)d_ws;
    if (hipMemsetAsync((char*)d_ws + WS_BAR, 0, (size_t)XCD_BAR_WORDS_C * 4, stream) != hipSuccess) fprintf(stderr, "memset of barrier words failed\n");
    void* args[] = {&p};
    hipError_t e = hipLaunchCooperativeKernel((const void*)fwd_megakernel, dim3(grid_blocks), dim3(NTHREADS), args, LDS_BYTES, stream);
    if (e != hipSuccess) fprintf(stderr, "cooperative launch failed: %s (grid %d)\n", hipGetErrorString(e), grid_blocks);
}
```

```cpp
#include <hip/hip_runtime.h>
#include <hip/hip_cooperative_groups.h>
#include <cstdio>
namespace cg = cooperative_groups;

#define LAS __attribute__((address_space(3)))
typedef unsigned short bf16_t;
typedef short bf16x8 __attribute__((ext_vector_type(8)));
typedef float f32x4 __attribute__((ext_vector_type(4)));
typedef float f32x2 __attribute__((ext_vector_type(2)));
typedef unsigned u32x4 __attribute__((ext_vector_type(4)));
typedef unsigned u32x2 __attribute__((ext_vector_type(2)));

constexpr int DM = 1024, TP = 2048, BP = 8, MP = BP * TP, BS = 128, TS = 8, MS = BS * TS, MALL = MP + MS;
constexpr int NMEM = 256, DIN = 13440, DSHIFT = 3200;
constexpr int NPAD = 13568;
constexpr int ACT_LD = 9472;
constexpr int C_PR = 0, C_PK = 1024, C_PV = 2048, C_WD = 3072, C_AD = 3136, C_SGR = 3328, C_QM = 4352, C_SGM = 5376, C_GATE = 6400;
constexpr size_t OUT_Y = 0, OUT_MK = 17825792, OUT_MV = 19922944, OUT_CONV_P = 22020096, OUT_SHIFT_P = 22036480, OUT_WKV_P = 22062080,
                 OUT_CONV_S = 22586368, OUT_SHIFT_S = 22848512, OUT_WKV_S = 23258112;
constexpr size_t al256(size_t x) { return (x + 255) & ~(size_t)255; }
constexpr int XCD_BAR_WORDS_C = 3456;
constexpr size_t WS_AALL = 0;
constexpr size_t WS_BALL = al256(WS_AALL + (size_t)19456 * 1024 * 2);
constexpr size_t WS_YMEM = WS_AALL;
constexpr size_t WS_YCONV = WS_AALL + (size_t)MALL * 1024 * 2;
constexpr size_t WS_WB = al256(WS_BALL + (size_t)15616 * 1024 * 2);
constexpr size_t WS_WO = al256(WS_WB + (size_t)3072 * 1024 * 2);
constexpr size_t WS_U = al256(WS_WO + (size_t)1024 * 1024 * 2);
constexpr size_t WS_MERGED = WS_U;
constexpr size_t WS_BG = al256(WS_U + (size_t)MALL * 1024 * 2);
constexpr size_t WS_PART = WS_BG;
constexpr size_t WS_PRIV = WS_BG + (size_t)3 * 1024 * 1024 * 4;
constexpr size_t WS_ACT = al256(WS_BG + (size_t)MALL * 1024 * 2);
constexpr size_t WS_KBF = al256(WS_ACT + (size_t)MALL * ACT_LD * 2);
constexpr size_t WS_VT = al256(WS_KBF + (size_t)2048 * 1024 * 2);
constexpr size_t WS_YRWKV = al256(WS_VT + (size_t)2048 * 1024 * 2);
constexpr size_t WS_C3 = al256(WS_YRWKV + (size_t)MALL * 1024 * 2);
constexpr size_t WS_SUMSQ = al256(WS_C3 + (size_t)MALL * 16 * 4);
constexpr size_t WS_BAR = al256(WS_SUMSQ + (size_t)MALL * 16 * 4);
constexpr size_t WS_FRAG = al256(WS_BAR + (size_t)XCD_BAR_WORDS_C * 4);
constexpr size_t WS_END = al256(WS_FRAG + (size_t)16 * 2 * 8 * 64 * 16);
static_assert(WS_YCONV + (size_t)MALL * 1024 * 2 <= WS_WB, "alias overflow");
static_assert(WS_END <= 536870912, "workspace too large");
static_assert(WS_PRIV + (size_t)16 * 256 * 1024 * 2 <= WS_ACT, "tail scratch overflows BG");

constexpr int NTHREADS = 512;
constexpr int LDS_MAIN = 131072;
constexpr int LDS_BYTES = LDS_MAIN + 16;

struct Params {
    const float *x_prompt, *x_sample, *mem_prompt, *cache_k, *cache_v, *state_conv, *state_shift, *state_wkv, *norm_in, *w_in, *conv_w, *conv_b,
        *shift_mu, *decay_w0, *decay_up, *icl_a0, *icl_up, *k_k, *k_a, *r_k, *ln_g, *ln_b, *norm_mem, *w_mem_kv, *w_branch, *w_out, *norm_final;
    float* out;
    unsigned char* ws;
};

__device__ __forceinline__ int opaque_tid() { int t = threadIdx.x; asm volatile("" : "+v"(t)); return t; }
__device__ __forceinline__ float bf2f(bf16_t v) { return __uint_as_float(((unsigned)v) << 16); }
__device__ __forceinline__ unsigned cvt_pk_bf16(float lo, float hi) { unsigned r; asm volatile("v_cvt_pk_bf16_f32 %0, %1, %2" : "=v"(r) : "v"(lo), "v"(hi)); return r; }
__device__ __forceinline__ float bflo(unsigned u) { return __uint_as_float(u << 16); }
__device__ __forceinline__ float bfhi(unsigned u) { return __uint_as_float(u & 0xffff0000u); }
__device__ __forceinline__ float fast_rcp(float x) { return __builtin_amdgcn_rcpf(x); }
__device__ __forceinline__ float sigmoidf_(float x) { return fast_rcp(1.0f + __expf(-x)); }
__device__ __forceinline__ float siluf_(float x) { return x * sigmoidf_(x); }
__device__ __forceinline__ float wave_sum(float v) {
#pragma unroll
    for (int o = 32; o > 0; o >>= 1) v += __shfl_xor(v, o, 64);
    return v;
}
template <int CTRL> __device__ __forceinline__ float dpp_f(float x) {
    return __int_as_float(__builtin_amdgcn_update_dpp(0, __float_as_int(x), CTRL, 0xF, 0xF, true));
}
__device__ __forceinline__ float row16_sum(float x) {
    x += dpp_f<0xB1>(x);
    x += dpp_f<0x4E>(x);
    x += dpp_f<0x141>(x);
    x += dpp_f<0x140>(x);
    return x;
}


#define XB_TMO      128
#define XB_XCNT(j)  (256  + 64 * (j))
#define XB_XSUB(j)  (1280 + 64 * (j))
#define XB_XGEN(j)  (2304 + 64 * (j))
#define XB_TOP      3328
#define XB_TOPGEN   3392
#define XCD_BAR_WORDS 3456
#define XB_SPIN_CAP (1u << 22)
__device__ __forceinline__ unsigned xb_ld(unsigned* p)              { return __hip_atomic_load(p, __ATOMIC_RELAXED, __HIP_MEMORY_SCOPE_AGENT); }
__device__ __forceinline__ unsigned xb_add(unsigned* p, unsigned v) { return __hip_atomic_fetch_add(p, v, __ATOMIC_RELAXED, __HIP_MEMORY_SCOPE_AGENT); }
__device__ __forceinline__ unsigned xb_xcc_id() { return (unsigned)__builtin_amdgcn_s_getreg((3 << 11) | 20) & 0xFu; }
#define XB_SPIN(cond, bar) do { unsigned _sp = 0; while (cond) { __builtin_amdgcn_s_sleep(1); \
    if ((++_sp & 255u) == 0u) { if (xb_ld(&(bar)[XB_TMO])) break; if (_sp > XB_SPIN_CAP) { atomicAdd(&(bar)[XB_TMO], 1u); break; } } } } while (0)
struct XcdBarrier { unsigned* bar; unsigned x; volatile LAS unsigned* st; };
__device__ __forceinline__ XcdBarrier xcd_barrier_post(unsigned* bar, volatile LAS unsigned* st) {
    XcdBarrier b; b.bar = bar; b.x = xb_xcc_id(); b.st = st;
    if (threadIdx.x == 0) (void)xb_add(&bar[XB_XCNT(b.x)], 1u);
    return b;
}
__device__ __forceinline__ void xcd_barrier_complete(unsigned* bar, unsigned x, unsigned& nloc, unsigned& nx) {
    const unsigned G = gridDim.x * gridDim.y * gridDim.z;
    unsigned sum, cnt, mine, sp = 0u;
    for (;;) {
        sum = 0u; cnt = 0u; mine = 0u;
#pragma unroll
        for (unsigned j = 0; j < 16; ++j) { const unsigned c = xb_ld(&bar[XB_XCNT(j)]); sum += c; cnt += (c > 0u) ? 1u : 0u; mine = (j == x) ? c : mine; }
        if (sum == G) break;
        __builtin_amdgcn_s_sleep(1);
        if ((++sp & 255u) == 0u) { if (xb_ld(&bar[XB_TMO])) break; if (sp > XB_SPIN_CAP) { atomicAdd(&bar[XB_TMO], 1u); break; } }
    }
    nloc = mine > 0u ? mine : 1u; nx = cnt > 0u ? cnt : 1u;
}
__device__ __forceinline__ void xcd_barrier(const XcdBarrier& b) {
    asm volatile("s_waitcnt vmcnt(0)" ::: "memory");
    __syncthreads();
    if (threadIdx.x == 0) {
        unsigned* bar = b.bar;
        __builtin_amdgcn_s_waitcnt(0);
        unsigned nloc = b.st[0], nx = b.st[1];
        if (nloc == 0u) { xcd_barrier_complete(bar, b.x, nloc, nx); b.st[0] = nloc; b.st[1] = nx; }
        const unsigned old = xb_add(&bar[XB_XSUB(b.x)], 1u);
        const unsigned gen = old / nloc;
        if (old + 1u == (gen + 1u) * nloc) {
            __builtin_amdgcn_fence(__ATOMIC_RELEASE, "agent");
            asm volatile("s_waitcnt vmcnt(0)" ::: "memory");
            const unsigned og = xb_add(&bar[XB_TOP], 1u);
            const unsigned tg = og / nx;
            if (og + 1u == (tg + 1u) * nx) xb_add(&bar[XB_TOPGEN], 1u);
            else XB_SPIN(xb_ld(&bar[XB_TOPGEN]) == tg, bar);
            __builtin_amdgcn_fence(__ATOMIC_ACQUIRE, "agent");
            xb_add(&bar[XB_XGEN(b.x)], 1u);
            asm volatile("s_waitcnt vmcnt(0)" ::: "memory");
        } else {
            XB_SPIN(xb_ld(&bar[XB_XGEN(b.x)]) == gen, bar);
            __builtin_amdgcn_fence(__ATOMIC_ACQUIRE, "agent");
            asm volatile("s_waitcnt vmcnt(0)" ::: "memory");
        }
    }
    __syncthreads();
}

constexpr int BM = 256, BK = 64, HALF = 128, HTB = HALF * BK * 2;
__device__ __forceinline__ int lds_byte(int r, int c) { const int st = (r >> 4) * 2 + (c >> 5), rr = r & 15, cc = c & 31, ob = rr * 64 + cc * 2; return st * 1024 + (ob ^ (((ob >> 9) & 1) << 5)); }
__device__ __forceinline__ void stage_rc(int b, int& R, int& C) { const int st = b / 1024, sb = b % 1024, swz = sb ^ (((sb >> 9) & 1) << 5); R = (st >> 1) * 16 + swz / 64; C = (st & 1) * 32 + (swz % 64) / 2; }

struct Unit { const char* a; const char* b; int x, y, z; };

template <class Sched, class Epi>
__device__ __forceinline__ void gemm_phase(LAS unsigned char* lds, const int lda, const int ldb, const int K, const Sched& S, const Epi& E) {
    const int tid = opaque_tid(), wid = __builtin_amdgcn_readfirstlane(tid >> 6), lane = tid & 63, wr = wid >> 2, wc = wid & 3, fr = lane & 15, fq = lane >> 4;
    const int nt = K / BK;
    unsigned voffA[2], voffB[2];
#pragma unroll
    for (int i = 0; i < 2; ++i) { int R, C; stage_rc(tid * 16 + i * 8192, R, C); voffA[i] = (unsigned)(R * lda + C * 2); voffB[i] = (unsigned)(R * ldb + C * 2); }
    const size_t kstep = (size_t)(BK * 2);
    const size_t hA = (size_t)HALF * lda, hB = (size_t)HALF * ldb;
    const unsigned ldsw = (unsigned)wid * 1024u;
    const int aoff = lds_byte(wr * 64 + fr, fq * 8), boff = lds_byte(wc * 32 + fr, fq * 8);
#define G_SA(b, h) (((b) * 2 + (h)) * HTB)
#define G_SB(b, h) ((4 + (b) * 2 + (h)) * HTB)
#define G_STAGE(bufoff, gbase, voff) do { _Pragma("unroll") for (int _i = 0; _i < 2; ++_i) \
        __builtin_amdgcn_global_load_lds((const unsigned*)((const char*)(gbase) + (voff)[_i]), (LAS unsigned*)(lds + (bufoff) + ldsw + _i * 8192), 16, 0, 0); } while (0)
#define G_LDA(dst, b, h) do { _Pragma("unroll") for (int m = 0; m < 4; ++m) _Pragma("unroll") for (int k = 0; k < 2; ++k) dst[m][k] = *(const LAS bf16x8*)(lds + G_SA(b, h) + aoff + m * 2048 + k * 1024); } while (0)
#define G_LDB(dst, b, h) do { _Pragma("unroll") for (int n = 0; n < 2; ++n) _Pragma("unroll") for (int k = 0; k < 2; ++k) dst[n][k] = *(const LAS bf16x8*)(lds + G_SB(b, h) + boff + n * 2048 + k * 1024); } while (0)
#define G_MMA(ai, bj, At, Bt) do { __builtin_amdgcn_s_setprio(1); _Pragma("unroll") for (int m = 0; m < 4; ++m) _Pragma("unroll") for (int n = 0; n < 2; ++n) _Pragma("unroll") for (int k = 0; k < 2; ++k) \
        acc[ai][bj][m][n] = __builtin_amdgcn_mfma_f32_16x16x32_bf16(Bt[n][k], At[m][k], acc[ai][bj][m][n], 0, 0, 0); __builtin_amdgcn_s_setprio(0); } while (0)
#define G_WAIT_V(n) asm volatile("s_waitcnt vmcnt(" #n ")" ::: "memory")
#define G_WAIT_L(n) asm volatile("s_waitcnt lgkmcnt(" #n ")" ::: "memory")
#define G_BAR __builtin_amdgcn_s_barrier()
#define G_SCHED __builtin_amdgcn_sched_barrier(0)
    Unit cur, nxt; int ui = 0;
    if (!S.next(0, cur)) return;
    f32x4 acc[2][2][4][2];
#pragma unroll
    for (int a = 0; a < 2; ++a)
#pragma unroll
        for (int b = 0; b < 2; ++b)
#pragma unroll
            for (int m = 0; m < 4; ++m)
#pragma unroll
                for (int n = 0; n < 2; ++n) acc[a][b][m][n] = (f32x4){0.f, 0.f, 0.f, 0.f};
    bf16x8 At[4][2], B0[2][2], B1[2][2];
    const char* cA = cur.a; const char* cB = cur.b;
    G_STAGE(G_SB(0, 0), cB, voffB); G_STAGE(G_SA(0, 0), cA, voffA); G_STAGE(G_SB(0, 1), cB + hB, voffB); G_STAGE(G_SA(0, 1), cA + hA, voffA);
    if (wr == 1) G_BAR;
    G_WAIT_V(4); G_BAR;
    G_STAGE(G_SB(1, 0), cB + kstep, voffB); G_STAGE(G_SA(1, 0), cA + kstep, voffA); G_STAGE(G_SB(1, 1), cB + hB + kstep, voffB);
    G_WAIT_V(6); G_BAR;
    for (;;) {
        const bool has_next = S.next(ui + 1, nxt);
        const char* nA = has_next ? nxt.a : cA; const char* nB = has_next ? nxt.b : cB;
        for (int t = 0; t < nt; t += 2) {
            const bool last = (t == nt - 2);
            const char* a1 = cA + (size_t)(t + 1) * kstep;
            const char* a2 = last ? nA : cA + (size_t)(t + 2) * kstep; const char* b2 = last ? nB : cB + (size_t)(t + 2) * kstep;
            const char* a3 = a2 + kstep; const char* b3 = b2 + kstep;
            G_LDB(B0, 0, 0); G_SCHED; G_LDA(At, 0, 0); G_STAGE(G_SA(1, 1), a1 + hA, voffA);
            G_WAIT_L(8); G_BAR; G_WAIT_L(0); G_MMA(0, 0, At, B0); G_BAR; G_SCHED;
            G_LDB(B1, 0, 1); G_STAGE(G_SB(0, 0), b2, voffB);
            G_BAR; G_WAIT_L(0); G_MMA(0, 1, At, B1); G_BAR;
            G_LDA(At, 0, 1); G_STAGE(G_SA(0, 0), a2, voffA);
            G_BAR; G_WAIT_L(0); G_MMA(1, 0, At, B0); G_BAR; G_SCHED;
            G_STAGE(G_SB(0, 1), b2 + hB, voffB);
            G_WAIT_V(6); G_BAR; G_MMA(1, 1, At, B1); G_BAR;
            G_LDB(B0, 1, 0); G_SCHED; G_LDA(At, 1, 0); G_STAGE(G_SA(0, 1), a2 + hA, voffA);
            G_WAIT_L(8); G_BAR; G_WAIT_L(0); G_MMA(0, 0, At, B0); G_BAR; G_SCHED;
            G_LDB(B1, 1, 1); G_STAGE(G_SB(1, 0), b3, voffB);
            G_BAR; G_WAIT_L(0); G_MMA(0, 1, At, B1); G_BAR;
            G_LDA(At, 1, 1); G_STAGE(G_SA(1, 0), a3, voffA);
            G_BAR; G_WAIT_L(0); G_MMA(1, 0, At, B0); G_BAR; G_SCHED;
            G_STAGE(G_SB(1, 1), b3 + hB, voffB);
            G_WAIT_V(6); G_BAR; G_MMA(1, 1, At, B1); G_BAR;
        }
        const bool keep = E(acc, cur, wr, wc, fr, fq);
        if (!has_next) break;
        if (!keep) {
#pragma unroll
            for (int a = 0; a < 2; ++a)
#pragma unroll
                for (int b = 0; b < 2; ++b)
#pragma unroll
                    for (int m = 0; m < 4; ++m)
#pragma unroll
                        for (int n = 0; n < 2; ++n) acc[a][b][m][n] = (f32x4){0.f, 0.f, 0.f, 0.f};
        }
        cur = nxt; cA = nA; cB = nB; ++ui;
    }
    G_WAIT_V(0);
    if (wr == 0) G_BAR;
    G_BAR;
#undef G_SA
#undef G_SB
#undef G_STAGE
#undef G_LDA
#undef G_LDB
#undef G_MMA
#undef G_WAIT_V
#undef G_WAIT_L
#undef G_BAR
#undef G_SCHED
}

__device__ __forceinline__ int perm8_local(int c) {
    const int bj = c >> 7, wc = (c >> 5) & 3, n = (c >> 4) & 1, fq = (c >> 2) & 3, e = c & 3;
    return 128 * bj + 32 * wc + 8 * fq + 4 * n + e;
}
__device__ __forceinline__ int colmap_in(int np) {
    const int j = np >> 8, c = np & 255;
    if (j < 16) {
        const int bj = c >> 7, wc = (c >> 5) & 3, n = (c >> 4) & 1, fq = (c >> 2) & 3, e = c & 3;
        return (2 * bj + n) * 1024 + j * 64 + wc * 16 + fq * 4 + e;
    }
    const int L = (j - 16) * 256 + perm8_local(c);
    if (L < 3200) return 4096 + L;
    if (L < 3328) return -1;
    return L + 3968;
}

__device__ void phase0(const Params& p, unsigned char* smem) {
    const int tid = opaque_tid(), lane = tid & 63, wid = tid >> 6;
    bf16_t* Aall = (bf16_t*)(p.ws + WS_AALL);
    for (int row = blockIdx.x * 8 + wid; row < 19456; row += gridDim.x * 8) {
        const float* src; const float* g;
        if (row < MP) { src = p.x_prompt + (size_t)row * 1024; g = p.norm_in; }
        else if (row < MALL) { src = p.x_sample + (size_t)(row - MP) * 1024; g = p.norm_in; }
        else { src = p.mem_prompt + (size_t)(row - MALL) * 1024; g = p.norm_mem; }
        f32x4 v[4]; float ss = 0.f;
#pragma unroll
        for (int i = 0; i < 4; ++i) { v[i] = *(const f32x4*)(src + i * 256 + lane * 4); ss += v[i][0] * v[i][0] + v[i][1] * v[i][1] + v[i][2] * v[i][2] + v[i][3] * v[i][3]; }
        ss = wave_sum(ss);
        const float inv = rsqrtf(ss * (1.0f / 1024.0f) + 1e-6f);
#pragma unroll
        for (int i = 0; i < 4; ++i) {
            const f32x4 gg = *(const f32x4*)(g + i * 256 + lane * 4);
            u32x2 o; o[0] = cvt_pk_bf16(v[i][0] * inv * gg[0], v[i][1] * inv * gg[1]); o[1] = cvt_pk_bf16(v[i][2] * inv * gg[2], v[i][3] * inv * gg[3]);
            *(u32x2*)(Aall + (size_t)row * 1024 + i * 256 + lane * 4) = o;
        }
    }
    for (int idx = blockIdx.x * NTHREADS + tid; idx < 16 * 2 * 8 * 64; idx += gridDim.x * NTHREADS) {
        const int ln = idx & 63, f = (idx >> 6) & 7, mat = (idx >> 9) & 1, hh = idx >> 10;
        const int it = f >> 1, ks = f & 1, fr = ln & 15, fq = ln >> 4;
        const float* src = mat ? p.icl_up : p.decay_up;
        float w[8];
#pragma unroll
        for (int jj = 0; jj < 8; ++jj) w[jj] = src[(size_t)(ks * 32 + fq * 8 + jj) * 1024 + hh * 64 + it * 16 + fr];
        u32x4 pk; pk[0] = cvt_pk_bf16(w[0], w[1]); pk[1] = cvt_pk_bf16(w[2], w[3]); pk[2] = cvt_pk_bf16(w[4], w[5]); pk[3] = cvt_pk_bf16(w[6], w[7]);
        *(u32x4*)(p.ws + WS_FRAG + (size_t)idx * 16) = pk;
    }
    bf16_t* T = (bf16_t*)smem;
    const int NT_IN = 212 * 16, NT_KV = 32 * 16, NT_WB = 3 * 16 * 16, NT_WO = 16 * 16;
    const int total = NT_IN + NT_KV + NT_WB + NT_WO;
    for (int tix = blockIdx.x; tix < total; tix += gridDim.x) {
        const float* src; int src_ld; bf16_t* dst; int n0, k0, mode;
        if (tix < NT_IN) { src = p.w_in; src_ld = DIN; dst = (bf16_t*)(p.ws + WS_BALL); n0 = (tix >> 4) * 64; k0 = (tix & 15) * 64; mode = 0; }
        else if (tix < NT_IN + NT_KV) { const int t2 = tix - NT_IN; src = p.w_mem_kv; src_ld = 2048; dst = (bf16_t*)(p.ws + WS_BALL) + (size_t)NPAD * 1024; n0 = (t2 >> 4) * 64; k0 = (t2 & 15) * 64; mode = 1; }
        else if (tix < NT_IN + NT_KV + NT_WB) { const int t2 = tix - NT_IN - NT_KV; const int i = t2 >> 8, t3 = t2 & 255; src = p.w_branch + (size_t)i * 1024 * 1024; src_ld = 1024;
            dst = (bf16_t*)(p.ws + WS_WB) + (size_t)i * 1024 * 1024; n0 = (t3 >> 4) * 64; k0 = (t3 & 15) * 64; mode = 2; }
        else { const int t3 = tix - NT_IN - NT_KV - NT_WB; src = p.w_out; src_ld = 1024; dst = (bf16_t*)(p.ws + WS_WO); n0 = (t3 >> 4) * 64; k0 = (t3 & 15) * 64; mode = 1; }
        {
            const int kk = tid >> 3, seg = tid & 7;
#pragma unroll
            for (int q = 0; q < 2; ++q) {
                const int nl = seg * 8 + q * 4, np = n0 + nl;
                int sc;
                if (mode == 0) sc = colmap_in(np);
                else if (mode == 1) sc = np;
                else sc = (np & ~255) + perm8_local(np & 255);
                f32x4 v = (f32x4){0.f, 0.f, 0.f, 0.f};
                if (sc >= 0) v = *(const f32x4*)(src + (size_t)(k0 + kk) * src_ld + sc);
                const unsigned a = cvt_pk_bf16(v[0], v[1]), b = cvt_pk_bf16(v[2], v[3]);
                T[(nl + 0) * 66 + kk] = (bf16_t)(a & 0xffff); T[(nl + 1) * 66 + kk] = (bf16_t)(a >> 16);
                T[(nl + 2) * 66 + kk] = (bf16_t)(b & 0xffff); T[(nl + 3) * 66 + kk] = (bf16_t)(b >> 16);
            }
        }
        __syncthreads();
        {
            const int nl = tid >> 3, ks = tid & 7;
            const unsigned* tp = (const unsigned*)(T + nl * 66 + ks * 8);
            u32x4 v; v[0] = tp[0]; v[1] = tp[1]; v[2] = tp[2]; v[3] = tp[3];
            *(u32x4*)(dst + (size_t)(n0 + nl) * 1024 + k0 + ks * 8) = v;
        }
        __syncthreads();
    }
}

struct SchedP1 {
    int G, c; const char* Aall; const char* Ball;
    __device__ __forceinline__ bool next(int i, Unit& u) const {
        const int L = i * G + c;
        constexpr int nM = 68, nN = 53, nwg = nM * nN, WGM = 8;
        if (L >= nwg + 96) return false;
        if (L < nwg) {
            int wgid = L; { const int q = nwg / 8, r = nwg % 8, xcd = wgid % 8, off = wgid / 8; wgid = (xcd < r ? xcd * (q + 1) : r * (q + 1) + (xcd - r) * q) + off; }
            const int nig = WGM * nN, gid = wgid / nig, fm = gid * WGM, gsz = (nM - fm) < WGM ? (nM - fm) : WGM;
            u.x = fm + ((wgid % nig) % gsz); u.y = (wgid % nig) / gsz; u.z = 0;
            u.a = Aall + (size_t)u.x * 256 * 2048; u.b = Ball + (size_t)u.y * 256 * 2048;
        } else {
            int k = L - nwg;
            if (k < 32) { u.x = k >> 2; u.y = k & 3; u.z = 1; u.a = Aall + (size_t)(68 + u.x) * 256 * 2048; u.b = Ball + (size_t)(53 + u.y) * 256 * 2048; }
            else if (k < 64) { k -= 32; u.x = k >> 2; u.y = k & 3; u.z = 2; u.a = Aall + (size_t)(68 + u.x) * 256 * 2048; u.b = Ball + (size_t)(57 + u.y) * 256 * 2048; }
            else { k -= 64; u.x = k >> 3; u.y = k & 7; u.z = 3; u.a = Ball + (size_t)(57 + u.x) * 256 * 2048; u.b = Aall + (size_t)(68 + u.y) * 256 * 2048; }
        }
        return true;
    }
};

struct EpiNull { __device__ __forceinline__ bool operator()(f32x4 (&acc)[2][2][4][2], const Unit& u, int wr, int wc, int fr, int fq) const { float t = 0.f;
#pragma unroll
        for (int a = 0; a < 2; ++a)
#pragma unroll
            for (int b = 0; b < 2; ++b)
#pragma unroll
                for (int m = 0; m < 4; ++m)
#pragma unroll
                    for (int n = 0; n < 2; ++n) t += acc[a][b][m][n][0] + acc[a][b][m][n][1] + acc[a][b][m][n][2] + acc[a][b][m][n][3];
        if (t == 123.456f) sink[0] = t; return false; }
    float* sink; };
struct EpiP1 {
    bf16_t* U; bf16_t* BG; bf16_t* ACT; float* out; bf16_t* Kbf; bf16_t* Vt;
    __device__ __forceinline__ bool operator()(f32x4 (&acc)[2][2][4][2], const Unit& u, int wr, int wc, int fr, int fq) const {
        const int type = u.z;
        if (type == 0) {
            const int pn = u.y, rbase = u.x * 256 + wr * 64 + fr;
            if (pn < 16) {
                const int ch0 = pn * 64 + wc * 16 + fq * 4;
#pragma unroll
                for (int ai = 0; ai < 2; ++ai)
#pragma unroll
                    for (int m = 0; m < 4; ++m) {
                        const int row = rbase + ai * 128 + m * 16;
                        const f32x4 h = acc[ai][0][m][0], Bv = acc[ai][0][m][1], Cv = acc[ai][1][m][0], g = acc[ai][1][m][1];
                        const f32x4 u4 = Cv * h;
                        f32x4 bg;
#pragma unroll
                        for (int e = 0; e < 4; ++e) bg[e] = Bv[e] * siluf_(g[e]);
                        u32x2 o; o[0] = cvt_pk_bf16(u4[0], u4[1]); o[1] = cvt_pk_bf16(u4[2], u4[3]);
                        *(u32x2*)(U + (size_t)row * 1024 + ch0) = o;
                        o[0] = cvt_pk_bf16(bg[0], bg[1]); o[1] = cvt_pk_bf16(bg[2], bg[3]);
                        *(u32x2*)(BG + (size_t)row * 1024 + ch0) = o;
                        if (row < MP) { const int t = row & 2047; if (t >= 2046) *(f32x4*)(out + OUT_CONV_P + (size_t)((row >> 11) * 2 + (t - 2046)) * 1024 + ch0) = u4; }
                        else { const int rs = row - MP, t = rs & 7; if (t >= 6) *(f32x4*)(out + OUT_CONV_S + (size_t)((rs >> 3) * 2 + (t - 6)) * 1024 + ch0) = u4; }
                    }
            } else {
                const int L0 = (pn - 16) * 256;
                const int kind = pn <= 28 ? 0 : pn <= 32 ? 1 : pn <= 36 ? 2 : pn <= 40 ? 1 : 3;
#pragma unroll
                for (int ai = 0; ai < 2; ++ai)
#pragma unroll
                    for (int m = 0; m < 4; ++m) {
                        const int row = rbase + ai * 128 + m * 16;
#pragma unroll
                        for (int bj = 0; bj < 2; ++bj) {
                            const int L = L0 + 128 * bj + 32 * wc + 8 * fq;
                            f32x4 v0 = acc[ai][bj][m][0], v1 = acc[ai][bj][m][1];
                            if (kind == 0) {
                                if (L < DSHIFT) {
                                    if (row < MP) { if ((row & 2047) == 2047) { float* d = out + OUT_SHIFT_P + (size_t)(row >> 11) * DSHIFT + L; *(f32x4*)d = v0; *(f32x4*)(d + 4) = v1; } }
                                    else { const int rs = row - MP; if ((rs & 7) == 7) { float* d = out + OUT_SHIFT_S + (size_t)(rs >> 3) * DSHIFT + L; *(f32x4*)d = v0; *(f32x4*)(d + 4) = v1; } }
                                }
                            } else if (kind == 1) {
#pragma unroll
                                for (int e = 0; e < 4; ++e) { v0[e] = siluf_(v0[e]); v1[e] = siluf_(v1[e]); }
                            } else if (kind == 2) { v0 *= 0.0625f; v1 *= 0.0625f; }
                            else {
#pragma unroll
                                for (int e = 0; e < 4; ++e) { v0[e] = sigmoidf_(v0[e]); v1[e] = sigmoidf_(v1[e]); }
                            }
                            u32x4 o; o[0] = cvt_pk_bf16(v0[0], v0[1]); o[1] = cvt_pk_bf16(v0[2], v0[3]); o[2] = cvt_pk_bf16(v1[0], v1[1]); o[3] = cvt_pk_bf16(v1[2], v1[3]);
                            *(u32x4*)(ACT + (size_t)row * ACT_LD + L) = o;
                        }
                    }
            }
        } else {
            const int rbase = u.x * 256 + wr * 64 + fr, cbase = u.y * 256 + wc * 32 + fq * 4;
#pragma unroll
            for (int ai = 0; ai < 2; ++ai)
#pragma unroll
                for (int m = 0; m < 4; ++m) {
                    const int row = rbase + ai * 128 + m * 16;
#pragma unroll
                    for (int bj = 0; bj < 2; ++bj)
#pragma unroll
                        for (int n = 0; n < 2; ++n) {
                            const int col = cbase + bj * 128 + n * 16;
                            const f32x4 v = acc[ai][bj][m][n];
                            if (type == 1) { *(f32x4*)(out + OUT_MK + (size_t)row * 1024 + col) = v;
                                u32x2 o; o[0] = cvt_pk_bf16(v[0], v[1]); o[1] = cvt_pk_bf16(v[2], v[3]); *(u32x2*)(Kbf + (size_t)row * 1024 + col) = o; }
                            else if (type == 2) { *(f32x4*)(out + OUT_MV + (size_t)row * 1024 + col) = v; }
                            else { u32x2 o; o[0] = cvt_pk_bf16(v[0], v[1]); o[1] = cvt_pk_bf16(v[2], v[3]); *(u32x2*)(Vt + (size_t)row * 2048 + col) = o; }
                        }
                }
        }
        return false;
    }
};

struct ChunkDesc { int r0, b, h, half, samp, t0, n, first, last, bstep; };
__device__ __forceinline__ int n_chunks(const int bid, const int G) {
    const int n_long = bid < 256 ? (255 - bid) / G + 1 : 0, n_samp = bid < 4096 ? (4095 - bid) / G + 1 : 0;
    return n_long * 64 + ((n_samp + 3) >> 2);
}
__device__ __forceinline__ bool chunk_desc(const int ci, const int bid, const int G, ChunkDesc& d) {
    const int n_long = bid < 256 ? (255 - bid) / G + 1 : 0;
    const int n_samp = bid < 4096 ? (4095 - bid) / G + 1 : 0;
    const int nc_long = n_long * 64;
    if (ci < nc_long) { const int k = ci >> 6, it = bid + k * G, chain = it >> 1; d.b = chain >> 4; d.h = chain & 15; d.half = it & 1; d.samp = 0; d.r0 = d.b * TP; d.bstep = 0;
        d.t0 = (ci & 63) * 32; d.n = 32; d.first = (ci & 63) == 0; d.last = (ci & 63) == 63; return true; }
    const int k0 = (ci - nc_long) * 4; if (ci < 0 || k0 >= n_samp) return false;
    const int it = bid + k0 * G, chain = it >> 1; d.b = chain >> 4; d.h = chain & 15; d.half = it & 1; d.samp = 1; d.r0 = 0; d.t0 = 0; d.bstep = G >> 5;
    const int ni = n_samp - k0 < 4 ? n_samp - k0 : 4; d.n = ni * 8; d.first = 1; d.last = 1; return true;
}
__device__ __forceinline__ int cd_batch(const ChunkDesc& d, const int t) { return d.samp ? d.b + (t >> 3) * d.bstep : d.b; }
__device__ __forceinline__ int cd_row(const ChunkDesc& d, const int t) { return d.samp ? MP + (d.b + (t >> 3) * d.bstep) * 8 + (t & 7) : d.r0 + d.t0 + t; }
__device__ __forceinline__ bool cd_first(const ChunkDesc& d, const int t) { return d.samp ? (t & 7) == 0 : (d.t0 + t) == 0; }
constexpr int SROW = 68;
constexpr int SBUF = 6 * 32 * SROW + 64;
__device__ __forceinline__ f32x2 lo2(const f32x4 v) { return __builtin_shufflevector(v, v, 0, 1); }
__device__ __forceinline__ f32x2 hi2(const f32x4 v) { return __builtin_shufflevector(v, v, 2, 3); }
__device__ __forceinline__ float tanh_fast(float x) { return 1.0f - 2.0f * fast_rcp(1.0f + __expf(2.0f * x)); }

__device__ __forceinline__ void unpack4(const u32x2 v, float (&o)[4]) { o[0] = bflo(v[0]); o[1] = bfhi(v[0]); o[2] = bflo(v[1]); o[3] = bfhi(v[1]); }

struct OpSet { f32x4 kk, wr, w, b, k; f32x2 v, cc; };
__device__ __forceinline__ void reduce4_row16(float a0, float a1, float b0, float b1, float c0, float c1, float d0, float d1, float& A, float& B, float& C, float& D) {
    asm volatile(
        "v_add_f32 %0, %4, %5\n\tv_add_f32 %1, %6, %7\n\tv_add_f32 %2, %8, %9\n\tv_add_f32 %3, %10, %11\n\t"
        "v_add_f32_dpp %0, %0, %0 quad_perm:[1,0,3,2] row_mask:0xf bank_mask:0xf\n\tv_add_f32_dpp %1, %1, %1 quad_perm:[1,0,3,2] row_mask:0xf bank_mask:0xf\n\t"
        "v_add_f32_dpp %2, %2, %2 quad_perm:[1,0,3,2] row_mask:0xf bank_mask:0xf\n\tv_add_f32_dpp %3, %3, %3 quad_perm:[1,0,3,2] row_mask:0xf bank_mask:0xf\n\t"
        "v_add_f32_dpp %0, %0, %0 quad_perm:[2,3,0,1] row_mask:0xf bank_mask:0xf\n\tv_add_f32_dpp %1, %1, %1 quad_perm:[2,3,0,1] row_mask:0xf bank_mask:0xf\n\t"
        "v_add_f32_dpp %2, %2, %2 quad_perm:[2,3,0,1] row_mask:0xf bank_mask:0xf\n\tv_add_f32_dpp %3, %3, %3 quad_perm:[2,3,0,1] row_mask:0xf bank_mask:0xf\n\t"
        "v_add_f32_dpp %0, %0, %0 row_half_mirror row_mask:0xf bank_mask:0xf\n\tv_add_f32_dpp %1, %1, %1 row_half_mirror row_mask:0xf bank_mask:0xf\n\t"
        "v_add_f32_dpp %2, %2, %2 row_half_mirror row_mask:0xf bank_mask:0xf\n\tv_add_f32_dpp %3, %3, %3 row_half_mirror row_mask:0xf bank_mask:0xf\n\t"
        "v_add_f32_dpp %0, %0, %0 row_mirror row_mask:0xf bank_mask:0xf\n\tv_add_f32_dpp %1, %1, %1 row_mirror row_mask:0xf bank_mask:0xf\n\t"
        "v_add_f32_dpp %2, %2, %2 row_mirror row_mask:0xf bank_mask:0xf\n\tv_add_f32_dpp %3, %3, %3 row_mirror row_mask:0xf bank_mask:0xf\n\t"
        "s_nop 1"
        : "=&v"(A), "=&v"(B), "=&v"(C), "=&v"(D)
        : "v"(a0), "v"(a1), "v"(b0), "v"(b1), "v"(c0), "v"(c1), "v"(d0), "v"(d1));
}
struct PrepState { f32x4 aw[4], aa[4]; float ksf[16]; float rn; };

struct PrepRaw { u32x4 wdc[2], wdp[2], adc[2], adp[2]; u32x2 kc[4], kp[4]; };
struct PrepRaw2 { u32x2 rc[4], rp[4], vc[4], vp[4]; };
__device__ __forceinline__ void prep_load(const Params& p, const ChunkDesc& d, const int tb, const int lane, PrepRaw& R) {
    const int fr = lane & 15, fq = lane >> 4;
    const int t = tb + fr; const int tt = t < d.n ? t : d.n - 1;
    const size_t row = (size_t)cd_row(d, tt);
    const bool isfirst = cd_first(d, tt);
    const bf16_t* cur = (const bf16_t*)(p.ws + WS_ACT) + row * ACT_LD;
    const bf16_t* prv = isfirst ? cur : cur - ACT_LD;
    const int hc = d.h * 64 + 4 * fq;
#pragma unroll
    for (int ks = 0; ks < 2; ++ks) {
        R.wdc[ks] = *(const u32x4*)(cur + C_WD + ks * 32 + fq * 8); R.wdp[ks] = *(const u32x4*)(prv + C_WD + ks * 32 + fq * 8);
        R.adc[ks] = *(const u32x4*)(cur + C_AD + ks * 32 + fq * 8); R.adp[ks] = *(const u32x4*)(prv + C_AD + ks * 32 + fq * 8);
    }
#pragma unroll
    for (int it = 0; it < 4; ++it) { R.kc[it] = *(const u32x2*)(cur + C_PK + hc + it * 16); R.kp[it] = *(const u32x2*)(prv + C_PK + hc + it * 16); }
}
__device__ __forceinline__ void prep_load2(const Params& p, const ChunkDesc& d, const int tb, const int lane, PrepRaw2& R) {
    const int fr = lane & 15, fq = lane >> 4;
    const int t = tb + fr; const int tt = t < d.n ? t : d.n - 1;
    const size_t row = (size_t)cd_row(d, tt);
    const bool isfirst = cd_first(d, tt);
    const bf16_t* cur = (const bf16_t*)(p.ws + WS_ACT) + row * ACT_LD;
    const bf16_t* prv = isfirst ? cur : cur - ACT_LD;
    const int hc = d.h * 64 + 4 * fq;
#pragma unroll
    for (int it = 0; it < 4; ++it) {
        R.rc[it] = *(const u32x2*)(cur + C_PR + hc + it * 16); R.rp[it] = *(const u32x2*)(prv + C_PR + hc + it * 16);
        R.vc[it] = *(const u32x2*)(cur + C_PV + hc + it * 16); R.vp[it] = *(const u32x2*)(prv + C_PV + hc + it * 16);
    }
}
__device__ __forceinline__ void shift4(const u32x2 cu, const u32x2 pr, const float* st, const bool isfirst, const bool samp, const int col, const f32x4 mu, float (&o)[4]) {
    float c[4], q[4];
    unpack4(cu, c); unpack4(pr, q);
    if (isfirst) {
        if (samp) { const f32x4 v = *(const f32x4*)(st + col); q[0] = v[0]; q[1] = v[1]; q[2] = v[2]; q[3] = v[3]; }
        else { q[0] = 0.f; q[1] = 0.f; q[2] = 0.f; q[3] = 0.f; }
    }
#pragma unroll
    for (int e = 0; e < 4; ++e) o[e] = c[e] + mu[e] * (q[e] - c[e]);
}

__device__ __forceinline__ void prep_stage1(const Params& p, const ChunkDesc& d, const int tb, const float* par, const int lane, const PrepRaw& R, PrepState& S) {
    const int fr = lane & 15, fq = lane >> 4;
    const int t = tb + fr; const int tt = t < d.n ? t : d.n - 1;
    const bool isfirst = cd_first(d, tt), samp = d.samp != 0;
    const float* st = p.state_shift + (size_t)cd_batch(d, tt) * DSHIFT;
    bf16x8 bw[2], ba[2];
#pragma unroll
    for (int ks = 0; ks < 2; ++ks) {
#pragma unroll
        for (int which = 0; which < 2; ++which) {
            const int col = (which ? C_AD : C_WD) + ks * 32 + fq * 8;
            const u32x4 cu = which ? R.adc[ks] : R.wdc[ks], pr = which ? R.adp[ks] : R.wdp[ks];
            float x0[4], x1[4];
            shift4((u32x2){cu[0], cu[1]}, (u32x2){pr[0], pr[1]}, st, isfirst, samp, col, *(const f32x4*)(par + 512 + which * 64 + ks * 32 + fq * 8), x0);
            shift4((u32x2){cu[2], cu[3]}, (u32x2){pr[2], pr[3]}, st, isfirst, samp, col + 4, *(const f32x4*)(par + 512 + which * 64 + ks * 32 + fq * 8 + 4), x1);
            if (!which) {
#pragma unroll
                for (int e = 0; e < 4; ++e) { x0[e] = tanh_fast(x0[e]); x1[e] = tanh_fast(x1[e]); }
            }
            u32x4 pk; pk[0] = cvt_pk_bf16(x0[0], x0[1]); pk[1] = cvt_pk_bf16(x0[2], x0[3]); pk[2] = cvt_pk_bf16(x1[0], x1[1]); pk[3] = cvt_pk_bf16(x1[2], x1[3]);
            if (which) ba[ks] = __builtin_bit_cast(bf16x8, pk); else bw[ks] = __builtin_bit_cast(bf16x8, pk);
        }
    }
    const bf16x8* ft = (const bf16x8*)(p.ws + WS_FRAG) + (size_t)d.h * 1024 + lane;
    __builtin_amdgcn_sched_barrier(0);
#pragma unroll
    for (int it = 0; it < 4; ++it) {
        S.aw[it] = (f32x4){0.f, 0.f, 0.f, 0.f}; S.aa[it] = S.aw[it];
#pragma unroll
        for (int ks = 0; ks < 2; ++ks) {
            S.aw[it] = __builtin_amdgcn_mfma_f32_16x16x32_bf16(ft[(it * 2 + ks) * 64], bw[ks], S.aw[it], 0, 0, 0);
            S.aa[it] = __builtin_amdgcn_mfma_f32_16x16x32_bf16(ft[(8 + it * 2 + ks) * 64], ba[ks], S.aa[it], 0, 0, 0);
        }
        if (it & 1) __builtin_amdgcn_sched_barrier(0);
    }
    const int hc = d.h * 64 + 4 * fq;
    float ss = 0.f;
#pragma unroll
    for (int it = 0; it < 4; ++it) {
        const int po = it * 16 + 4 * fq;
        float k4[4];
        shift4(R.kc[it], R.kp[it], st, isfirst, samp, C_PK + hc + it * 16, *(const f32x4*)(par + 64 + po), k4);
        const f32x4 kkp = *(const f32x4*)(par + 5 * 64 + po);
#pragma unroll
        for (int e = 0; e < 4; ++e) { S.ksf[it * 4 + e] = k4[e]; const float kr = k4[e] * kkp[e]; ss += kr * kr; }
        __builtin_amdgcn_sched_barrier(0);
    }
    ss += __shfl_xor(ss, 16, 64); ss += __shfl_xor(ss, 32, 64);
    S.rn = rsqrtf(ss + 1e-12f);
}

__device__ __forceinline__ void prep_stage2(const Params& p, const ChunkDesc& d, const int tb, float* buf, const float* par, const int lane, const PrepRaw2& R, const PrepState& S) {
    const int fr = lane & 15, fq = lane >> 4;
    const int t = tb + fr; const bool valid = t < d.n; const int tt = valid ? t : d.n - 1;
    const bool isfirst = cd_first(d, tt), samp = d.samp != 0;
    const float* st = p.state_shift + (size_t)cd_batch(d, tt) * DSHIFT;
    const int hc = d.h * 64 + 4 * fq;
    float c1 = 0.f, c2 = 0.f, c3 = 0.f;
    float* kkA = buf; float* wrA = buf + 32 * SROW; float* wA = buf + 2 * 32 * SROW; float* bA = buf + 3 * 32 * SROW; float* kpA = buf + 4 * 32 * SROW; float* vsA = buf + 5 * 32 * SROW; float* c12 = buf + 6 * 32 * SROW;
#pragma unroll
    for (int it = 0; it < 4; ++it) {
        const int po = it * 16 + 4 * fq;
        const f32x4 w0 = *(const f32x4*)(par + 3 * 64 + po), a0 = *(const f32x4*)(par + 4 * 64 + po), kkp = *(const f32x4*)(par + 5 * 64 + po), ka = *(const f32x4*)(par + 6 * 64 + po), rk = *(const f32x4*)(par + 7 * 64 + po);
        f32x4 o_kk, o_wr, o_w, o_b, o_kp, o_vs;
        float r4[4], v4[4];
        shift4(R.rc[it], R.rp[it], st, isfirst, samp, C_PR + hc + it * 16, *(const f32x4*)(par + po), r4);
        shift4(R.vc[it], R.vp[it], st, isfirst, samp, C_PV + hc + it * 16, *(const f32x4*)(par + 128 + po), v4);
#pragma unroll
        for (int e = 0; e < 4; ++e) {
            const float r_ = r4[e], k_ = S.ksf[it * 4 + e];
            const float dec = __expf(-0.6065306597f * sigmoidf_(S.aw[it][e] + w0[e]));
            const float a = sigmoidf_(S.aa[it][e] + a0[e]);
            const float kn = k_ * kkp[e] * S.rn;
            const float kpv = k_ * (1.0f + (a - 1.0f) * ka[e]);
            const float bv = kn * a;
            c1 += bv * r_; c2 += kpv * r_; c3 += r_ * kpv * rk[e];
            o_kk[e] = kn; o_wr[e] = dec * r_; o_w[e] = dec; o_b[e] = bv; o_kp[e] = kpv; o_vs[e] = v4[e];
        }
        if (valid) {
            const int o = t * SROW + po;
            *(f32x4*)(kkA + o) = o_kk; *(f32x4*)(wrA + o) = o_wr; *(f32x4*)(wA + o) = o_w; *(f32x4*)(bA + o) = o_b; *(f32x4*)(kpA + o) = o_kp; *(f32x4*)(vsA + o) = o_vs;
        }
        __builtin_amdgcn_sched_barrier(0);
    }
    c1 += __shfl_xor(c1, 16, 64); c1 += __shfl_xor(c1, 32, 64);
    c2 += __shfl_xor(c2, 16, 64); c2 += __shfl_xor(c2, 32, 64);
    c3 += __shfl_xor(c3, 16, 64); c3 += __shfl_xor(c3, 32, 64);
    if (valid && fq == 0) { c12[t * 2] = c1; c12[t * 2 + 1] = c2; if (d.half == 0) ((float*)(p.ws + WS_C3))[(size_t)cd_row(d, t) * 16 + d.h] = c3; }
}

__device__ void phase2_scan(const Params& p, unsigned char* smem) {
    const int tid = opaque_tid(), lane = tid & 63, wid = __builtin_amdgcn_readfirstlane(tid >> 6);
    const int bid = blockIdx.x, G = gridDim.x;
    float* sm = (float*)smem;
    float* bufs = sm;
    float* obuf = sm + 2 * SBUF;
    float* parb = obuf + 2 * 1024;
    const int NC = n_chunks(bid, G);
    float* ORAW = p.out + OUT_Y;
    __syncthreads();
    if (NC == 0) return;
    if (wid < 4) {
        __builtin_amdgcn_s_setprio(3);
        const int c = lane & 15, rg = lane >> 4, rl = wid * 8 + rg * 2;
        f32x2 s00 = (f32x2){0.f, 0.f}, s01 = s00, s10 = s00, s11 = s00;
        __syncthreads();
        __syncthreads();
        for (int ci = 0; ci < NC; ++ci) {
            ChunkDesc d; chunk_desc(ci, bid, G, d);
            const float* buf = bufs + (ci & 1) * SBUF;
            const float* kkA = buf + 4 * c; const float* vsA = buf + 5 * 32 * SROW + d.half * 32 + rl; const float* c12 = buf + 6 * 32 * SROW;
            float* ob = obuf + (ci & 1) * 1024 + rl;
            const int nsub = d.samp ? (d.n >> 3) : 1, slen = d.samp ? 8 : d.n;
            OpSet A, B;
            auto ld = [&](OpSet& o, const int t) {
                o.kk = *(const f32x4*)(kkA + t * SROW); o.wr = *(const f32x4*)(kkA + 32 * SROW + t * SROW); o.w = *(const f32x4*)(kkA + 2 * 32 * SROW + t * SROW);
                o.b = *(const f32x4*)(kkA + 3 * 32 * SROW + t * SROW); o.k = *(const f32x4*)(kkA + 4 * 32 * SROW + t * SROW);
                o.v = *(const f32x2*)(vsA + t * SROW); o.cc = *(const f32x2*)(c12 + t * 2);
            };
            auto step = [&](const OpSet& o, const int t) {
                const f32x2 pd0 = s00 * lo2(o.kk) + s01 * hi2(o.kk), pd1 = s10 * lo2(o.kk) + s11 * hi2(o.kk);
                const f32x2 pe0 = s00 * lo2(o.wr) + s01 * hi2(o.wr), pe1 = s10 * lo2(o.wr) + s11 * hi2(o.wr);
                float d0, d1, e0, e1;
                reduce4_row16(pd0[0], pd0[1], pd1[0], pd1[1], pe0[0], pe0[1], pe1[0], pe1[1], d0, d1, e0, e1);
                const f32x2 vv0 = (f32x2){o.v[0], o.v[0]}, vv1 = (f32x2){o.v[1], o.v[1]}, dd0 = (f32x2){d0, d0}, dd1 = (f32x2){d1, d1};
                s00 = s00 * lo2(o.w) + (lo2(o.k) * vv0 - lo2(o.b) * dd0);
                s01 = s01 * hi2(o.w) + (hi2(o.k) * vv0 - hi2(o.b) * dd0);
                s10 = s10 * lo2(o.w) + (lo2(o.k) * vv1 - lo2(o.b) * dd1);
                s11 = s11 * hi2(o.w) + (hi2(o.k) * vv1 - hi2(o.b) * dd1);
                if (c == 0) { f32x2 ov; ov[0] = e0 - d0 * o.cc[0] + o.v[0] * o.cc[1]; ov[1] = e1 - d1 * o.cc[0] + o.v[1] * o.cc[1]; *(f32x2*)(ob + t * 32) = ov; }
            };
            for (int sub = 0; sub < nsub; ++sub) {
                const int tbeg = sub * slen, tend = tbeg + slen;
                const size_t st_off = ((size_t)(cd_batch(d, tbeg) * 16 + d.h) * 64 + d.half * 32 + rl) * 64 + 4 * c;
                if (d.samp) { const f32x4 a = *(const f32x4*)(p.state_wkv + st_off), b2 = *(const f32x4*)(p.state_wkv + st_off + 64); s00 = lo2(a); s01 = hi2(a); s10 = lo2(b2); s11 = hi2(b2); }
                else if (d.first) { s00 = (f32x2){0.f, 0.f}; s01 = s00; s10 = s00; s11 = s00; }
                ld(A, tbeg);
                for (int t = tbeg; t < tend; t += 2) {
                    ld(B, t + 1);
                    step(A, t);
                    ld(A, (t + 2 < tend) ? t + 2 : t);
                    step(B, t + 1);
                }
                if (d.samp || d.last) {
                    float* so = p.out + (d.samp ? OUT_WKV_S : OUT_WKV_P) + st_off;
                    f32x4 a, b2; a[0] = s00[0]; a[1] = s00[1]; a[2] = s01[0]; a[3] = s01[1]; b2[0] = s10[0]; b2[1] = s10[1]; b2[2] = s11[0]; b2[3] = s11[1];
                    *(f32x4*)so = a; *(f32x4*)(so + 64) = b2;
                }
            }
            __syncthreads();
        }
        __syncthreads();
        __builtin_amdgcn_s_setprio(0);
    } else {
        const int q = (wid >> 1) & 1, tb = (wid & 1) * 16;
        float* par = parb + (wid & 3) * 640;
        PrepState S;
        int cur_h = -1;
        for (int i = -2; i <= NC; ++i) {
            if ((i & 1) == q) {
                ChunkDesc d;
                int ck = i + 2; ck = ck < 0 ? 0 : (ck > NC - 1 ? NC - 1 : ck);
                chunk_desc(ck, bid, G, d);
                if (d.h != cur_h) {
                    cur_h = d.h;
                    const int ch = d.h * 64 + lane;
                    par[lane] = p.shift_mu[ch]; par[64 + lane] = p.shift_mu[1024 + ch]; par[128 + lane] = p.shift_mu[2048 + ch]; par[192 + lane] = p.decay_w0[ch];
                    par[256 + lane] = p.icl_a0[ch]; par[320 + lane] = p.k_k[ch]; par[384 + lane] = p.k_a[ch]; par[448 + lane] = p.r_k[ch];
                    par[512 + lane] = p.shift_mu[C_WD + lane]; par[576 + lane] = p.shift_mu[C_AD + lane];
                }
                PrepRaw R;
                prep_load(p, d, tb, lane, R);
                prep_stage1(p, d, tb, par, lane, R, S);
            } else {
                ChunkDesc d, d2;
                PrepRaw2 R2;
                const bool has2 = i >= -1 && i + 1 < NC && chunk_desc(i + 1, bid, G, d2) && tb < d2.n;
                if (has2) prep_load2(p, d2, tb, lane, R2);
                if (i >= 1 && chunk_desc(i - 1, bid, G, d)) {
                    const float* ob = obuf + ((i - 1) & 1) * 1024;
                    for (int idx = (wid & 1) * 64 + lane; idx < d.n * 8; idx += 128) { const int t = idx >> 3, j = (idx & 7) * 4; *(f32x4*)(ORAW + (size_t)cd_row(d, t) * 1024 + d.h * 64 + d.half * 32 + j) = *(const f32x4*)(ob + t * 32 + j); }
                }
                if (has2) prep_stage2(p, d2, tb, bufs + ((i + 1) & 1) * SBUF, par, lane, R2, S);
            }
            __syncthreads();
        }
    }
}

__device__ void attn_unit(const Params& p, unsigned char* smem, const int unit) {
    const int tid = opaque_tid(), lane = tid & 63, wid = __builtin_amdgcn_readfirstlane(tid >> 6), fr = lane & 15, fq = lane >> 4;
    const int b = unit >> 6, h = (unit >> 4) & 3, tile = unit & 15;
    const bf16_t* ACT = (const bf16_t*)(p.ws + WS_ACT);
    const bf16_t* Kbf = (const bf16_t*)(p.ws + WS_KBF);
    const bf16_t* Vt = (const bf16_t*)(p.ws + WS_VT);
    bf16_t* Ymem = (bf16_t*)(p.ws + WS_YMEM);
    bf16_t* Kc = (bf16_t*)smem;
    bf16_t* Vc = (bf16_t*)smem;
    const int row = b * 2048 + tile * 128 + wid * 16 + fr;
    u32x4 st[8];
    auto ldK = [&](const int hf) {
#pragma unroll
        for (int i = 0; i < 8; ++i) { const int id = tid + i * NTHREADS, key = id >> 5, d = (id & 31) * 8; st[i] = *(const u32x4*)(Kbf + (size_t)(b * 256 + hf * 128 + key) * 1024 + h * 256 + d); }
    };
    auto stK = [&]() {
#pragma unroll
        for (int i = 0; i < 8; ++i) { const int id = tid + i * NTHREADS, key = id >> 5, d = (id & 31) * 8; *(u32x4*)(Kc + key * 264 + d) = st[i]; }
    };
    auto ldV = [&](const int hf) {
#pragma unroll
        for (int i = 0; i < 8; ++i) { const int id = tid + i * NTHREADS, d = id >> 4, kc = (id & 15) * 8; st[i] = *(const u32x4*)(Vt + (size_t)(h * 256 + d) * 2048 + b * 256 + hf * 128 + kc); }
    };
    auto stV = [&]() {
#pragma unroll
        for (int i = 0; i < 8; ++i) { const int id = tid + i * NTHREADS, d = id >> 4, kc = (id & 15) * 8; *(u32x4*)(Vc + d * 136 + kc) = st[i]; }
    };
    ldK(0);
    bf16x8 qf[8];
#pragma unroll
    for (int ks = 0; ks < 8; ++ks) qf[ks] = *(const bf16x8*)(ACT + (size_t)row * ACT_LD + C_QM + h * 256 + ks * 32 + fq * 8);
    f32x4 sacc[16];
#pragma unroll
    for (int i = 0; i < 16; ++i) sacc[i] = (f32x4){0.f, 0.f, 0.f, 0.f};
#pragma unroll
    for (int hf = 0; hf < 2; ++hf) {
        __syncthreads();
        stK();
        __syncthreads();
        if (hf == 0) ldK(1); else ldV(0);
#pragma unroll
        for (int kt = 0; kt < 8; ++kt)
#pragma unroll
            for (int ks = 0; ks < 8; ++ks) {
                const bf16x8 kf = *(const bf16x8*)(Kc + (kt * 16 + fr) * 264 + ks * 32 + fq * 8);
                sacc[hf * 8 + kt] = __builtin_amdgcn_mfma_f32_16x16x32_bf16(kf, qf[ks], sacc[hf * 8 + kt], 0, 0, 0);
            }
    }
    float mx = -3.0e38f;
#pragma unroll
    for (int i = 0; i < 16; ++i) mx = fmaxf(mx, fmaxf(fmaxf(sacc[i][0], sacc[i][1]), fmaxf(sacc[i][2], sacc[i][3])));
    mx = fmaxf(mx, __shfl_xor(mx, 16, 64)); mx = fmaxf(mx, __shfl_xor(mx, 32, 64));
    float sum = 0.f;
#pragma unroll
    for (int i = 0; i < 16; ++i)
#pragma unroll
        for (int e = 0; e < 4; ++e) { const float ex = __expf(sacc[i][e] - mx); sacc[i][e] = ex; sum += ex; }
    sum += __shfl_xor(sum, 16, 64); sum += __shfl_xor(sum, 32, 64);
    const float inv = fast_rcp(sum);
    bf16x8 pf[8];
#pragma unroll
    for (int s2 = 0; s2 < 8; ++s2) {
        u32x4 t; t[0] = cvt_pk_bf16(sacc[2 * s2][0], sacc[2 * s2][1]); t[1] = cvt_pk_bf16(sacc[2 * s2][2], sacc[2 * s2][3]);
        t[2] = cvt_pk_bf16(sacc[2 * s2 + 1][0], sacc[2 * s2 + 1][1]); t[3] = cvt_pk_bf16(sacc[2 * s2 + 1][2], sacc[2 * s2 + 1][3]);
        pf[s2] = __builtin_bit_cast(bf16x8, t);
    }
    f32x4 oacc[16];
#pragma unroll
    for (int i = 0; i < 16; ++i) oacc[i] = (f32x4){0.f, 0.f, 0.f, 0.f};
#pragma unroll
    for (int hf = 0; hf < 2; ++hf) {
        __syncthreads();
        stV();
        __syncthreads();
        if (hf == 0) ldV(1);
#pragma unroll
        for (int dt = 0; dt < 16; ++dt)
#pragma unroll
            for (int s2 = 0; s2 < 4; ++s2) {
                const u32x2 lo = *(const u32x2*)(Vc + (dt * 16 + fr) * 136 + s2 * 32 + 4 * fq), hi = *(const u32x2*)(Vc + (dt * 16 + fr) * 136 + s2 * 32 + 16 + 4 * fq);
                u32x4 t; t[0] = lo[0]; t[1] = lo[1]; t[2] = hi[0]; t[3] = hi[1];
                oacc[dt] = __builtin_amdgcn_mfma_f32_16x16x32_bf16(__builtin_bit_cast(bf16x8, t), pf[hf * 4 + s2], oacc[dt], 0, 0, 0);
            }
    }
#pragma unroll
    for (int dt = 0; dt < 16; ++dt) {
        const int d = h * 256 + dt * 16 + 4 * fq;
        const u32x2 g = *(const u32x2*)(ACT + (size_t)row * ACT_LD + C_SGM + d);
        u32x2 o; o[0] = cvt_pk_bf16(oacc[dt][0] * inv * bflo(g[0]), oacc[dt][1] * inv * bfhi(g[0])); o[1] = cvt_pk_bf16(oacc[dt][2] * inv * bflo(g[1]), oacc[dt][3] * inv * bfhi(g[1]));
        *(u32x2*)(Ymem + (size_t)row * 1024 + d) = o;
    }
}

__device__ void attn_sample_unit(const Params& p, unsigned char* smem, const int b, const int h) {
    const int tid = opaque_tid(), lane = tid & 63, wid = __builtin_amdgcn_readfirstlane(tid >> 6), fr = lane & 15, fq = lane >> 4;
    const bf16_t* ACT = (const bf16_t*)(p.ws + WS_ACT);
    bf16_t* Ymem = (bf16_t*)(p.ws + WS_YMEM);
    bf16_t* Kc = (bf16_t*)smem;
    float* Ored = (float*)smem;
    float* Pl = (float*)(smem + 69632);
    const int row = MP + b * 8 + (fr & 7);
    bf16x8 qf[8];
#pragma unroll
    for (int ks = 0; ks < 8; ++ks) qf[ks] = *(const bf16x8*)(ACT + (size_t)row * ACT_LD + C_QM + h * 256 + ks * 32 + fq * 8);
    const float* vbase = p.cache_v + ((size_t)(b * 256 + wid * 32) * 4 + h) * 256 + lane * 4;
    f32x4 vv[8];
#pragma unroll
    for (int i = 0; i < 8; ++i) vv[i] = *(const f32x4*)(vbase + (size_t)i * 1024);
    f32x4 sacc[16];
#pragma unroll
    for (int i = 0; i < 16; ++i) sacc[i] = (f32x4){0.f, 0.f, 0.f, 0.f};
#pragma unroll
    for (int hf = 0; hf < 2; ++hf) {
        __syncthreads();
#pragma unroll
        for (int i = 0; i < 8; ++i) {
            const int id = tid + i * NTHREADS, key = id >> 5, d = (id & 31) * 8;
            const float* s_ = p.cache_k + ((size_t)(b * 256 + hf * 128 + key) * 4 + h) * 256 + d; const f32x4 x0 = *(const f32x4*)s_, x1 = *(const f32x4*)(s_ + 4);
            u32x4 v; v[0] = cvt_pk_bf16(x0[0], x0[1]); v[1] = cvt_pk_bf16(x0[2], x0[3]); v[2] = cvt_pk_bf16(x1[0], x1[1]); v[3] = cvt_pk_bf16(x1[2], x1[3]);
            *(u32x4*)(Kc + key * 264 + d) = v;
        }
        __syncthreads();
#pragma unroll
        for (int kt = 0; kt < 8; ++kt)
#pragma unroll
            for (int ks = 0; ks < 8; ++ks) {
                const bf16x8 kf = *(const bf16x8*)(Kc + (kt * 16 + fr) * 264 + ks * 32 + fq * 8);
                sacc[hf * 8 + kt] = __builtin_amdgcn_mfma_f32_16x16x32_bf16(kf, qf[ks], sacc[hf * 8 + kt], 0, 0, 0);
            }
    }
    float mx = -3.0e38f;
#pragma unroll
    for (int i = 0; i < 16; ++i) mx = fmaxf(mx, fmaxf(fmaxf(sacc[i][0], sacc[i][1]), fmaxf(sacc[i][2], sacc[i][3])));
    mx = fmaxf(mx, __shfl_xor(mx, 16, 64)); mx = fmaxf(mx, __shfl_xor(mx, 32, 64));
    float sum = 0.f;
#pragma unroll
    for (int i = 0; i < 16; ++i)
#pragma unroll
        for (int e = 0; e < 4; ++e) { const float ex = __expf(sacc[i][e] - mx); sacc[i][e] = ex; sum += ex; }
    sum += __shfl_xor(sum, 16, 64); sum += __shfl_xor(sum, 32, 64);
    const float inv = fast_rcp(sum);
    if (wid == 0 && fr < 8) {
#pragma unroll
        for (int i = 0; i < 16; ++i)
#pragma unroll
            for (int e = 0; e < 4; ++e) Pl[(i * 16 + 4 * fq + e) * 8 + fr] = sacc[i][e] * inv;
    }
    __syncthreads();
    f32x4 o[8];
#pragma unroll
    for (int t = 0; t < 8; ++t) o[t] = (f32x4){0.f, 0.f, 0.f, 0.f};
#pragma unroll
    for (int half = 0; half < 4; ++half) {
        if (half >= 1) {
#pragma unroll
            for (int i = 0; i < 8; ++i) vv[i] = *(const f32x4*)(vbase + (size_t)(half * 8 + i) * 1024);
        }
#pragma unroll
        for (int i = 0; i < 8; ++i) {
            const float* pp = Pl + (wid * 32 + half * 8 + i) * 8;
            const f32x4 p0 = *(const f32x4*)pp, p1 = *(const f32x4*)(pp + 4);
#pragma unroll
            for (int t = 0; t < 4; ++t) { o[t] += vv[i] * p0[t]; o[4 + t] += vv[i] * p1[t]; }
        }
    }
#pragma unroll
    for (int t = 0; t < 8; ++t) *(f32x4*)(Ored + (wid * 8 + t) * 256 + lane * 4) = o[t];
    __syncthreads();
    {
        const int t = tid >> 6, d = (tid & 63) * 4;
        f32x4 acc = (f32x4){0.f, 0.f, 0.f, 0.f};
#pragma unroll
        for (int w = 0; w < 8; ++w) acc += *(const f32x4*)(Ored + (w * 8 + t) * 256 + d);
        const size_t orow = (size_t)(MP + b * 8 + t);
        const u32x2 g = *(const u32x2*)(ACT + orow * ACT_LD + C_SGM + h * 256 + d);
        u32x2 ov; ov[0] = cvt_pk_bf16(acc[0] * bflo(g[0]), acc[1] * bfhi(g[0])); ov[1] = cvt_pk_bf16(acc[2] * bflo(g[1]), acc[3] * bfhi(g[1]));
        *(u32x2*)(Ymem + orow * 1024 + h * 256 + d) = ov;
    }
}

__device__ void phase2_attn(const Params& p, unsigned char* smem) {
    __syncthreads();
    for (int k = blockIdx.x; k < 1024; k += gridDim.x) {
        const int u = (k + ((blockIdx.x & 1) << 9)) & 1023;
        if (u < 512) attn_unit(p, smem, u); else attn_sample_unit(p, smem, (u - 512) >> 2, u & 3);
    }
}

__device__ __forceinline__ void ld16bf(const bf16_t* ptr, float (&o)[16]) {
    const u32x4 a = *(const u32x4*)ptr, b = *(const u32x4*)(ptr + 8);
#pragma unroll
    for (int e = 0; e < 4; ++e) { o[2 * e] = bflo(a[e]); o[2 * e + 1] = bfhi(a[e]); o[8 + 2 * e] = bflo(b[e]); o[8 + 2 * e + 1] = bfhi(b[e]); }
}
__device__ __forceinline__ void ld16f(const float* ptr, float (&o)[16]) {
#pragma unroll
    for (int q = 0; q < 4; ++q) { const f32x4 v = *(const f32x4*)(ptr + 4 * q); o[4 * q] = v[0]; o[4 * q + 1] = v[1]; o[4 * q + 2] = v[2]; o[4 * q + 3] = v[3]; }
}
__device__ __forceinline__ void st16bf(bf16_t* ptr, const float (&y)[16]) {
    u32x4 a, b;
#pragma unroll
    for (int e = 0; e < 4; ++e) { a[e] = cvt_pk_bf16(y[2 * e], y[2 * e + 1]); b[e] = cvt_pk_bf16(y[8 + 2 * e], y[8 + 2 * e + 1]); }
    *(u32x4*)ptr = a; *(u32x4*)(ptr + 8) = b;
}
__device__ __forceinline__ float quad_sum(float x) { x += dpp_f<0xB1>(x); x += dpp_f<0x4E>(x); return x; }
__device__ void phase2b(const Params& p, unsigned char* smem) {
    const int tid = opaque_tid(), lane = tid & 63, wid = tid >> 6;
    float* tab = (float*)smem;
    __syncthreads();
    for (int idx = tid; idx < 7168; idx += NTHREADS)
        tab[idx] = idx < 3072 ? p.conv_w[idx] : idx < 4096 ? p.conv_b[idx - 3072] : idx < 5120 ? p.shift_mu[2048 + idx - 4096] : idx < 6144 ? p.ln_g[idx - 5120] : p.ln_b[idx - 6144];
    __syncthreads();
    const bf16_t* U = (const bf16_t*)(p.ws + WS_U); const bf16_t* BG = (const bf16_t*)(p.ws + WS_BG); const bf16_t* ACT = (const bf16_t*)(p.ws + WS_ACT);
    const float* ORAW = p.out + OUT_Y; const float* C3 = (const float*)(p.ws + WS_C3);
    bf16_t* Yc = (bf16_t*)(p.ws + WS_YCONV); bf16_t* Yr = (bf16_t*)(p.ws + WS_YRWKV);
    const int ch = lane * 16;
    for (int row = blockIdx.x * 8 + wid; row < MALL; row += gridDim.x * 8) {
        int b, t; const bool samp = row >= MP;
        if (!samp) { b = row >> 11; t = row & 2047; } else { b = (row - MP) >> 3; t = (row - MP) & 7; }
        float u0[16], um1[16], um2[16], bg[16], o[16], vc[16], vq[16], sg[16];
        ld16bf(U + (size_t)row * 1024 + ch, u0); ld16bf(BG + (size_t)row * 1024 + ch, bg);
        if (t >= 1) ld16bf(U + (size_t)(row - 1) * 1024 + ch, um1);
        else if (samp) ld16f(p.state_conv + ((size_t)b * 2 + 1) * 1024 + ch, um1);
        else {
#pragma unroll
            for (int e = 0; e < 16; ++e) um1[e] = 0.f; }
        if (t >= 2) ld16bf(U + (size_t)(row - 2) * 1024 + ch, um2);
        else if (samp) ld16f(p.state_conv + ((size_t)b * 2 + t) * 1024 + ch, um2);
        else {
#pragma unroll
            for (int e = 0; e < 16; ++e) um2[e] = 0.f; }
        ld16f(ORAW + (size_t)row * 1024 + ch, o);
        ld16bf(ACT + (size_t)row * ACT_LD + C_PV + ch, vc);
        if (t >= 1) ld16bf(ACT + (size_t)(row - 1) * ACT_LD + C_PV + ch, vq);
        else if (samp) ld16f(p.state_shift + (size_t)b * DSHIFT + 2048 + ch, vq);
        else {
#pragma unroll
            for (int e = 0; e < 16; ++e) vq[e] = 0.f; }
        ld16bf(ACT + (size_t)row * ACT_LD + C_SGR + ch, sg);
        const float c3 = C3[(size_t)row * 16 + (lane >> 2)];
        float y[16];
#pragma unroll
        for (int q = 0; q < 4; ++q) {
            const f32x4 w0 = *(const f32x4*)(tab + ch + 4 * q), w1 = *(const f32x4*)(tab + 1024 + ch + 4 * q), w2 = *(const f32x4*)(tab + 2048 + ch + 4 * q), cb = *(const f32x4*)(tab + 3072 + ch + 4 * q);
#pragma unroll
            for (int e = 0; e < 4; ++e) { const int i = 4 * q + e; y[i] = bg[i] * (cb[e] + w0[e] * um2[i] + w1[e] * um1[i] + w2[e] * u0[i]); }
        }
        st16bf(Yc + (size_t)row * 1024 + ch, y);
        float sm_ = 0.f;
#pragma unroll
        for (int e = 0; e < 16; ++e) sm_ += o[e];
        const float mean = quad_sum(sm_) * (1.0f / 64.0f);
        float vr = 0.f;
#pragma unroll
        for (int e = 0; e < 16; ++e) { o[e] -= mean; vr += o[e] * o[e]; }
        const float rstd = rsqrtf(quad_sum(vr) * (1.0f / 64.0f) + 6.4e-4f);
#pragma unroll
        for (int q = 0; q < 4; ++q) {
            const f32x4 mv = *(const f32x4*)(tab + 4096 + ch + 4 * q), lg = *(const f32x4*)(tab + 5120 + ch + 4 * q), lb = *(const f32x4*)(tab + 6144 + ch + 4 * q);
#pragma unroll
            for (int e = 0; e < 4; ++e) { const int i = 4 * q + e; const float vs = vc[i] + mv[e] * (vq[i] - vc[i]); y[i] = (o[i] * rstd * lg[e] + lb[e] + c3 * vs) * sg[i]; }
        }
        st16bf(Yr + (size_t)row * 1024 + ch, y);
    }
}

struct SchedP3 {
    int G, c; const char* ws;
    __device__ __forceinline__ bool next(int i, Unit& u) const {
        const int tl = (i / 3) * G + c, seg = i % 3;
        if (tl >= 256) return false;
        u.x = tl >> 2; u.y = tl & 3; u.z = seg;
        u.a = ws + (seg == 0 ? WS_YCONV : seg == 1 ? WS_YRWKV : WS_YMEM) + (size_t)u.x * 256 * 2048; u.b = ws + WS_WB + ((size_t)seg * 1024 + (size_t)u.y * 256) * 2048;
        return true;
    }
};
struct SchedP3T {
    int G, c; const char* ws;
    __device__ __forceinline__ bool next(int i, Unit& u) const {
        const int e = i * G + c;
        if (e >= 48) return false;
        const int tt = e / 3, seg = e % 3;
        u.x = 64 + (tt >> 2); u.y = tt & 3; u.z = seg;
        u.a = ws + (seg == 0 ? WS_YCONV : seg == 1 ? WS_YRWKV : WS_YMEM) + (size_t)u.x * 256 * 2048; u.b = ws + WS_WB + ((size_t)seg * 1024 + (size_t)u.y * 256) * 2048;
        return true;
    }
};
struct EpiP3T {
    const bf16_t* ACT; float* PART;
    __device__ __forceinline__ bool operator()(f32x4 (&acc)[2][2][4][2], const Unit& u, int wr, int wc, int fr, int fq) const {
        const int seg = u.z, rbase = u.x * 256 + wr * 64 + fr, cb = u.y * 256 + wc * 32 + 8 * fq;
        const bf16_t* gbase = ACT + C_GATE + seg * 1024 + cb;
#pragma unroll
        for (int ai = 0; ai < 2; ++ai) {
            u32x4 g[4][2];
#pragma unroll
            for (int m = 0; m < 4; ++m)
#pragma unroll
                for (int bj = 0; bj < 2; ++bj) g[m][bj] = *(const u32x4*)(gbase + (size_t)(rbase + ai * 128 + m * 16) * ACT_LD + 128 * bj);
#pragma unroll
            for (int m = 0; m < 4; ++m)
#pragma unroll
                for (int bj = 0; bj < 2; ++bj) {
                    f32x4 v0 = acc[ai][bj][m][0], v1 = acc[ai][bj][m][1];
                    v0[0] *= bflo(g[m][bj][0]); v0[1] *= bfhi(g[m][bj][0]); v0[2] *= bflo(g[m][bj][1]); v0[3] *= bfhi(g[m][bj][1]);
                    v1[0] *= bflo(g[m][bj][2]); v1[1] *= bfhi(g[m][bj][2]); v1[2] *= bflo(g[m][bj][3]); v1[3] *= bfhi(g[m][bj][3]);
                    float* dst = PART + ((size_t)seg * 1024 + (size_t)(rbase + ai * 128 + m * 16 - MP)) * 1024 + cb + 128 * bj;
                    *(f32x4*)dst = v0; *(f32x4*)(dst + 4) = v1;
                }
        }
        return false;
    }
};
struct EpiP3 {
    const bf16_t* ACT; bf16_t* MERGED;
    __device__ __forceinline__ bool operator()(f32x4 (&acc)[2][2][4][2], const Unit& u, int wr, int wc, int fr, int fq) const {
        const int seg = u.z, rbase = u.x * 256 + wr * 64 + fr, cb = u.y * 256 + wc * 32 + 8 * fq;
        const bf16_t* gbase = ACT + C_GATE + seg * 1024 + cb;
#pragma unroll
        for (int ai = 0; ai < 2; ++ai) {
            u32x4 g[4][2], g2[4][2];
#pragma unroll
            for (int m = 0; m < 4; ++m)
#pragma unroll
                for (int bj = 0; bj < 2; ++bj) {
                    const bf16_t* gp = gbase + (size_t)(rbase + ai * 128 + m * 16) * ACT_LD + 128 * bj;
                    g[m][bj] = *(const u32x4*)gp;
                    if (seg < 2) g2[m][bj] = *(const u32x4*)(gp + 1024);
                }
#pragma unroll
            for (int m = 0; m < 4; ++m)
#pragma unroll
                for (int bj = 0; bj < 2; ++bj) {
                    float f[8];
#pragma unroll
                    for (int e = 0; e < 4; ++e) { f[2 * e] = bflo(g[m][bj][e]); f[2 * e + 1] = bfhi(g[m][bj][e]); }
                    if (seg < 2) {
#pragma unroll
                        for (int e = 0; e < 4; ++e) { f[2 * e] *= fast_rcp(bflo(g2[m][bj][e])); f[2 * e + 1] *= fast_rcp(bfhi(g2[m][bj][e])); }
                    }
                    f32x4& v0 = acc[ai][bj][m][0]; f32x4& v1 = acc[ai][bj][m][1];
#pragma unroll
                    for (int e = 0; e < 4; ++e) { v0[e] *= f[e]; v1[e] *= f[4 + e]; }
                    if (seg == 2) {
                        u32x4 o; o[0] = cvt_pk_bf16(v0[0], v0[1]); o[1] = cvt_pk_bf16(v0[2], v0[3]); o[2] = cvt_pk_bf16(v1[0], v1[1]); o[3] = cvt_pk_bf16(v1[2], v1[3]);
                        *(u32x4*)(MERGED + (size_t)(rbase + ai * 128 + m * 16) * 1024 + cb + 128 * bj) = o;
                    }
                }
        }
        return seg < 2;
    }
};
struct SchedP4 {
    int G, c; const char* A; const char* B;
    __device__ __forceinline__ bool next(int i, Unit& u) const {
        const int tl = i * G + c;
        if (tl >= 272) return false;
        u.x = tl >> 2; u.y = tl & 3; u.z = 0;
        u.a = A + (size_t)u.x * 256 * 2048; u.b = B + (size_t)u.y * 256 * 2048;
        return true;
    }
};
__device__ void p3_tail_fixup(const Params& p) {
    const int tid = opaque_tid();
    const float* P0 = (const float*)(p.ws + WS_PART);
    bf16_t* dst = (bf16_t*)(p.ws + WS_MERGED) + (size_t)MP * 1024;
    for (int idx = blockIdx.x * NTHREADS + tid; idx < 1024 * 128; idx += gridDim.x * NTHREADS) {
        const size_t o = (size_t)idx * 8;
        f32x4 a0 = *(const f32x4*)(P0 + o), a1 = *(const f32x4*)(P0 + o + 4);
        a0 += *(const f32x4*)(P0 + (size_t)1024 * 1024 + o); a1 += *(const f32x4*)(P0 + (size_t)1024 * 1024 + o + 4);
        a0 += *(const f32x4*)(P0 + (size_t)2 * 1024 * 1024 + o); a1 += *(const f32x4*)(P0 + (size_t)2 * 1024 * 1024 + o + 4);
        u32x4 w; w[0] = cvt_pk_bf16(a0[0], a0[1]); w[1] = cvt_pk_bf16(a0[2], a0[3]); w[2] = cvt_pk_bf16(a1[0], a1[1]); w[3] = cvt_pk_bf16(a1[2], a1[3]);
        *(u32x4*)(dst + o) = w;
    }
}
struct EpiP4 {
    const float* xp; const float* xs; float* out; float* SUMSQ;
    __device__ __forceinline__ bool operator()(f32x4 (&acc)[2][2][4][2], const Unit& u, int wr, int wc, int fr, int fq) const {
        const int rbase = u.x * 256 + wr * 64 + fr, cbase = u.y * 256 + wc * 32 + fq * 4;
#pragma unroll
        for (int ai = 0; ai < 2; ++ai) {
            f32x4 xv[4][2][2];
#pragma unroll
            for (int m = 0; m < 4; ++m) {
                const int row = rbase + ai * 128 + m * 16;
                const float* xr = row < MP ? xp + (size_t)row * 1024 : xs + (size_t)(row - MP) * 1024;
#pragma unroll
                for (int bj = 0; bj < 2; ++bj)
#pragma unroll
                    for (int n = 0; n < 2; ++n) xv[m][bj][n] = *(const f32x4*)(xr + cbase + bj * 128 + n * 16);
            }
#pragma unroll
            for (int m = 0; m < 4; ++m) {
                const int row = rbase + ai * 128 + m * 16;
                float ss = 0.f;
#pragma unroll
                for (int bj = 0; bj < 2; ++bj)
#pragma unroll
                    for (int n = 0; n < 2; ++n) {
                        const f32x4 v = acc[ai][bj][m][n] + xv[m][bj][n];
                        ss += v[0] * v[0] + v[1] * v[1] + v[2] * v[2] + v[3] * v[3];
                        *(f32x4*)(out + OUT_Y + (size_t)row * 1024 + cbase + bj * 128 + n * 16) = v;
                    }
                ss += __shfl_xor(ss, 16, 64); ss += __shfl_xor(ss, 32, 64);
                if (fq == 0) SUMSQ[(size_t)row * 16 + u.y * 4 + wc] = ss;
            }
        }
        return false;
    }
};
__device__ void phase5(const Params& p) {
    const int tid5 = opaque_tid(); const int lane = tid5 & 63, wid = tid5 >> 6;
    const float* SUMSQ = (const float*)(p.ws + WS_SUMSQ);
    for (int row = blockIdx.x * 8 + wid; row < MALL; row += gridDim.x * 8) {
        float ss = lane < 16 ? SUMSQ[(size_t)row * 16 + lane] : 0.f;
        ss = wave_sum(ss);
        const float inv = rsqrtf(ss * (1.0f / 1024.0f) + 1e-6f);
        float* y = p.out + OUT_Y + (size_t)row * 1024;
#pragma unroll
        for (int i = 0; i < 4; ++i) {
            f32x4 v = *(const f32x4*)(y + i * 256 + lane * 4); const f32x4 g = *(const f32x4*)(p.norm_final + i * 256 + lane * 4);
            v = v * inv * g;
            *(f32x4*)(y + i * 256 + lane * 4) = v;
        }
    }
}

__global__ void __launch_bounds__(NTHREADS) fwd_megakernel(Params p) {
    extern __shared__ __attribute__((aligned(16))) unsigned char smem[];
    cg::grid_group grid = cg::this_grid();
    LAS unsigned char* lds = (LAS unsigned char*)smem;
#ifndef PROBE_REP
#define PROBE_REP 0
#endif
#define REP(k) for (int _r = 0; _r < ((PROBE_REP == (k)) ? 2 : 1); ++_r)
    volatile LAS unsigned* xst = (volatile LAS unsigned*)(lds + LDS_MAIN);
    if (threadIdx.x == 0) { xst[0] = 0u; xst[1] = 0u; xst[2] = 0u; xst[3] = 0u; }
    __syncthreads();
    (void)xcd_barrier_post((unsigned*)(p.ws + WS_BAR), xst);
#define XBAR() do { XcdBarrier _b; _b.bar = (unsigned*)(p.ws + WS_BAR); _b.x = xb_xcc_id(); _b.st = (volatile LAS unsigned*)(lds + LDS_MAIN); xcd_barrier(_b); } while (0)
    REP(1) { phase0(p, smem); if (PROBE_REP == 1 && _r == 0) XBAR(); }
    if (p.ws == nullptr) grid.sync();
    XBAR();
    REP(2) {
        SchedP1 S{(int)gridDim.x, (int)blockIdx.x, (const char*)(p.ws + WS_AALL), (const char*)(p.ws + WS_BALL)};
        EpiP1 E{(bf16_t*)(p.ws + WS_U), (bf16_t*)(p.ws + WS_BG), (bf16_t*)(p.ws + WS_ACT), p.out, (bf16_t*)(p.ws + WS_KBF), (bf16_t*)(p.ws + WS_VT)};
        gemm_phase(lds, 2048, 2048, 1024, S, E);
        XBAR();
        if (PROBE_REP == 9) { EpiNull EN{(float*)(p.ws + WS_SUMSQ)}; gemm_phase(lds, 2048, 2048, 1024, S, EN); XBAR(); }
    }
    REP(3) { phase2_scan(p, smem); if (PROBE_REP == 3) XBAR(); }
    REP(5) { phase2_attn(p, smem); if (PROBE_REP == 5) XBAR(); }
    XBAR();
    REP(6) { phase2b(p, smem); XBAR(); }
    REP(7) {
        SchedP3 S{(int)gridDim.x, (int)blockIdx.x, (const char*)p.ws};
        EpiP3 E{(const bf16_t*)(p.ws + WS_ACT), (bf16_t*)(p.ws + WS_MERGED)};
        gemm_phase(lds, 2048, 2048, 1024, S, E);
        SchedP3T ST{(int)gridDim.x, (int)blockIdx.x, (const char*)p.ws};
        EpiP3T ET{(const bf16_t*)(p.ws + WS_ACT), (float*)(p.ws + WS_PART)};
        gemm_phase(lds, 2048, 2048, 1024, ST, ET);
        XBAR();
        if (_r == 0) { p3_tail_fixup(p); XBAR(); }
    }
    REP(8) {
        SchedP4 S{(int)gridDim.x, (int)blockIdx.x, (const char*)(p.ws + WS_MERGED), (const char*)(p.ws + WS_WO)};
        EpiP4 E{p.x_prompt, p.x_sample, p.out, (float*)(p.ws + WS_SUMSQ)};
        gemm_phase(lds, 2048, 2048, 1024, S, E);
        XBAR();
    }
    phase5(p);
}

extern "C" void kernel_launch(void* const* d_in, const int* in_sizes, int n_in, void* d_out, int out_size, void* d_ws, size_t ws_size, hipStream_t stream) {
    static int grid_blocks = 0;
    if (!grid_blocks) {
        int dev = 0, cus = 0, per_cu = 0;
        hipGetDevice(&dev);
        hipDeviceGetAttribute(&cus, hipDeviceAttributeMultiprocessorCount, dev);
        if (hipFuncSetAttribute((const void*)fwd_megakernel, hipFuncAttributeMaxDynamicSharedMemorySize, LDS_BYTES) != hipSuccess) fprintf(stderr, "hipFuncSetAttribute failed\n");
        hipOccupancyMaxActiveBlocksPerMultiprocessor(&per_cu, (const void*)fwd_megakernel, NTHREADS, LDS_BYTES);
        if (per_cu < 1) { fprintf(stderr, "occupancy query returned %d\n", per_cu); per_cu = 1; }
        if (per_cu > 1) per_cu = 1;
        grid_blocks = cus * per_cu;
        if (grid_blocks > 256) grid_blocks = 256;
        grid_blocks &= ~31;
        if (grid_blocks < 64) grid_blocks = -1;
        if (ws_size < WS_END) { fprintf(stderr, "workspace too small: %zu < %zu\n", ws_size, (size_t)WS_END); grid_blocks = -1; }
    }
    if (grid_blocks < 0) return;
    Params p{};
    const float** pp = (const float**)&p;
    for (int i = 0; i < 27; ++i) pp[i] = (const float*)d_in[i];
    p.out = (float*)d_out; p.ws = (unsigned char*)d_ws;
    if (hipMemsetAsync((char*)d_ws + WS_BAR, 0, (size_t)XCD_BAR_WORDS_C * 4, stream) != hipSuccess) fprintf(stderr, "memset of barrier words failed\n");
    void* args[] = {&p};
    hipError_t e = hipLaunchCooperativeKernel((const void*)fwd_megakernel, dim3(grid_blocks), dim3(NTHREADS), args, LDS_BYTES, stream);
    if (e != hipSuccess) fprintf(stderr, "cooperative launch failed: %s (grid %d)\n", hipGetErrorString(e), grid_blocks);
}
```

```cpp
#include <hip/hip_runtime.h>
#include <hip/hip_cooperative_groups.h>
#include <cstdio>
namespace cg = cooperative_groups;

#define LAS __attribute__((address_space(3)))
typedef unsigned short bf16_t;
typedef short bf16x8 __attribute__((ext_vector_type(8)));
typedef float f32x4 __attribute__((ext_vector_type(4)));
typedef float f32x2 __attribute__((ext_vector_type(2)));
typedef unsigned u32x4 __attribute__((ext_vector_type(4)));
typedef unsigned u32x2 __attribute__((ext_vector_type(2)));

constexpr int DM = 1024, TP = 2048, BP = 8, MP = BP * TP, BS = 128, TS = 8, MS = BS * TS, MALL = MP + MS;
constexpr int NMEM = 256, DIN = 13440, DSHIFT = 3200;
constexpr int NPAD = 13568;
constexpr int ACT_LD = 9472;
constexpr int C_PR = 0, C_PK = 1024, C_PV = 2048, C_WD = 3072, C_AD = 3136, C_SGR = 3328, C_QM = 4352, C_SGM = 5376, C_GATE = 6400;
constexpr size_t OUT_Y = 0, OUT_MK = 17825792, OUT_MV = 19922944, OUT_CONV_P = 22020096, OUT_SHIFT_P = 22036480, OUT_WKV_P = 22062080,
                 OUT_CONV_S = 22586368, OUT_SHIFT_S = 22848512, OUT_WKV_S = 23258112;
constexpr size_t al256(size_t x) { return (x + 255) & ~(size_t)255; }
constexpr int XCD_BAR_WORDS_C = 3456;
constexpr size_t WS_AALL = 0;
constexpr size_t WS_BALL = al256(WS_AALL + (size_t)19456 * 1024 * 2);
constexpr size_t WS_YMEM = WS_AALL;
constexpr size_t WS_YCONV = WS_AALL + (size_t)MALL * 1024 * 2;
constexpr size_t WS_WB = al256(WS_BALL + (size_t)15616 * 1024 * 2);
constexpr size_t WS_WO = al256(WS_WB + (size_t)3072 * 1024 * 2);
constexpr size_t WS_U = al256(WS_WO + (size_t)1024 * 1024 * 2);
constexpr size_t WS_MERGED = WS_U;
constexpr size_t WS_BG = al256(WS_U + (size_t)MALL * 1024 * 2);
constexpr size_t WS_PART = WS_BG;
constexpr size_t WS_PRIV = WS_BG + (size_t)6 * 1024 * 1024 * 4;
constexpr size_t WS_ACT = al256(WS_BG + (size_t)MALL * 1024 * 2);
constexpr size_t WS_KBF = al256(WS_ACT + (size_t)MALL * ACT_LD * 2);
constexpr size_t WS_VT = al256(WS_KBF + (size_t)2048 * 1024 * 2);
constexpr size_t WS_YRWKV = al256(WS_VT + (size_t)2048 * 1024 * 2);
constexpr size_t WS_C3 = al256(WS_YRWKV + (size_t)MALL * 1024 * 2);
constexpr size_t WS_SUMSQ = al256(WS_C3 + (size_t)MALL * 16 * 4);
constexpr size_t WS_BAR = al256(WS_SUMSQ + (size_t)MALL * 16 * 4);
constexpr size_t WS_FRAG = al256(WS_BAR + (size_t)XCD_BAR_WORDS_C * 4);
constexpr size_t WS_END = al256(WS_FRAG + (size_t)16 * 2 * 8 * 64 * 16);
static_assert(WS_YCONV + (size_t)MALL * 1024 * 2 <= WS_WB, "alias overflow");
static_assert(WS_END <= 536870912, "workspace too large");
static_assert(WS_PRIV + (size_t)16 * 256 * 1024 * 2 <= WS_ACT, "tail scratch overflows BG");

constexpr int NTHREADS = 512;
constexpr int LDS_MAIN = 131072;
constexpr int LDS_BYTES = LDS_MAIN + 16;

struct Params {
    const float *x_prompt, *x_sample, *mem_prompt, *cache_k, *cache_v, *state_conv, *state_shift, *state_wkv, *norm_in, *w_in, *conv_w, *conv_b,
        *shift_mu, *decay_w0, *decay_up, *icl_a0, *icl_up, *k_k, *k_a, *r_k, *ln_g, *ln_b, *norm_mem, *w_mem_kv, *w_branch, *w_out, *norm_final;
    float* out;
    unsigned char* ws;
};

__device__ __forceinline__ int opaque_tid() { int t = threadIdx.x; asm volatile("" : "+v"(t)); return t; }
__device__ __forceinline__ float bf2f(bf16_t v) { return __uint_as_float(((unsigned)v) << 16); }
__device__ __forceinline__ unsigned cvt_pk_bf16(float lo, float hi) { unsigned r; asm volatile("v_cvt_pk_bf16_f32 %0, %1, %2" : "=v"(r) : "v"(lo), "v"(hi)); return r; }
__device__ __forceinline__ float bflo(unsigned u) { return __uint_as_float(u << 16); }
__device__ __forceinline__ float bfhi(unsigned u) { return __uint_as_float(u & 0xffff0000u); }
__device__ __forceinline__ float fast_rcp(float x) { return __builtin_amdgcn_rcpf(x); }
__device__ __forceinline__ float sigmoidf_(float x) { return fast_rcp(1.0f + __expf(-x)); }
__device__ __forceinline__ float siluf_(float x) { return x * sigmoidf_(x); }
__device__ __forceinline__ float wave_sum(float v) {
#pragma unroll
    for (int o = 32; o > 0; o >>= 1) v += __shfl_xor(v, o, 64);
    return v;
}
template <int CTRL> __device__ __forceinline__ float dpp_f(float x) {
    return __int_as_float(__builtin_amdgcn_update_dpp(0, __float_as_int(x), CTRL, 0xF, 0xF, true));
}
__device__ __forceinline__ float row16_sum(float x) {
    x += dpp_f<0xB1>(x);
    x += dpp_f<0x4E>(x);
    x += dpp_f<0x141>(x);
    x += dpp_f<0x140>(x);
    return x;
}


#define XB_TMO      128
#define XB_XCNT(j)  (256  + 64 * (j))
#define XB_XSUB(j)  (1280 + 64 * (j))
#define XB_XGEN(j)  (2304 + 64 * (j))
#define XB_TOP      3328
#define XB_TOPGEN   3392
#define XCD_BAR_WORDS 3456
#define XB_SPIN_CAP (1u << 22)
__device__ __forceinline__ unsigned xb_ld(unsigned* p)              { return __hip_atomic_load(p, __ATOMIC_RELAXED, __HIP_MEMORY_SCOPE_AGENT); }
__device__ __forceinline__ unsigned xb_add(unsigned* p, unsigned v) { return __hip_atomic_fetch_add(p, v, __ATOMIC_RELAXED, __HIP_MEMORY_SCOPE_AGENT); }
__device__ __forceinline__ unsigned xb_xcc_id() { return (unsigned)__builtin_amdgcn_s_getreg((3 << 11) | 20) & 0xFu; }
#define XB_SPIN(cond, bar) do { unsigned _sp = 0; while (cond) { __builtin_amdgcn_s_sleep(1); \
    if ((++_sp & 255u) == 0u) { if (xb_ld(&(bar)[XB_TMO])) break; if (_sp > XB_SPIN_CAP) { atomicAdd(&(bar)[XB_TMO], 1u); break; } } } } while (0)
struct XcdBarrier { unsigned* bar; unsigned x; volatile LAS unsigned* st; };
__device__ __forceinline__ XcdBarrier xcd_barrier_post(unsigned* bar, volatile LAS unsigned* st) {
    XcdBarrier b; b.bar = bar; b.x = xb_xcc_id(); b.st = st;
    if (threadIdx.x == 0) (void)xb_add(&bar[XB_XCNT(b.x)], 1u);
    return b;
}
__device__ __forceinline__ void xcd_barrier_complete(unsigned* bar, unsigned x, unsigned& nloc, unsigned& nx) {
    const unsigned G = gridDim.x * gridDim.y * gridDim.z;
    unsigned sum, cnt, mine, sp = 0u;
    for (;;) {
        sum = 0u; cnt = 0u; mine = 0u;
#pragma unroll
        for (unsigned j = 0; j < 16; ++j) { const unsigned c = xb_ld(&bar[XB_XCNT(j)]); sum += c; cnt += (c > 0u) ? 1u : 0u; mine = (j == x) ? c : mine; }
        if (sum == G) break;
        __builtin_amdgcn_s_sleep(1);
        if ((++sp & 255u) == 0u) { if (xb_ld(&bar[XB_TMO])) break; if (sp > XB_SPIN_CAP) { atomicAdd(&bar[XB_TMO], 1u); break; } }
    }
    nloc = mine > 0u ? mine : 1u; nx = cnt > 0u ? cnt : 1u;
}
__device__ __forceinline__ void xcd_barrier(const XcdBarrier& b) {
    asm volatile("s_waitcnt vmcnt(0)" ::: "memory");
    __syncthreads();
    if (threadIdx.x == 0) {
        unsigned* bar = b.bar;
        __builtin_amdgcn_s_waitcnt(0);
        unsigned nloc = b.st[0], nx = b.st[1];
        if (nloc == 0u) { xcd_barrier_complete(bar, b.x, nloc, nx); b.st[0] = nloc; b.st[1] = nx; }
        const unsigned old = xb_add(&bar[XB_XSUB(b.x)], 1u);
        const unsigned gen = old / nloc;
        if (old + 1u == (gen + 1u) * nloc) {
            __builtin_amdgcn_fence(__ATOMIC_RELEASE, "agent");
            asm volatile("s_waitcnt vmcnt(0)" ::: "memory");
            const unsigned og = xb_add(&bar[XB_TOP], 1u);
            const unsigned tg = og / nx;
            if (og + 1u == (tg + 1u) * nx) xb_add(&bar[XB_TOPGEN], 1u);
            else XB_SPIN(xb_ld(&bar[XB_TOPGEN]) == tg, bar);
            __builtin_amdgcn_fence(__ATOMIC_ACQUIRE, "agent");
            xb_add(&bar[XB_XGEN(b.x)], 1u);
            asm volatile("s_waitcnt vmcnt(0)" ::: "memory");
        } else {
            XB_SPIN(xb_ld(&bar[XB_XGEN(b.x)]) == gen, bar);
            __builtin_amdgcn_fence(__ATOMIC_ACQUIRE, "agent");
            asm volatile("s_waitcnt vmcnt(0)" ::: "memory");
        }
    }
    __syncthreads();
}

constexpr int BM = 256, BK = 64, HALF = 128, HTB = HALF * BK * 2;
__device__ __forceinline__ int lds_byte(int r, int c) { const int st = (r >> 4) * 2 + (c >> 5), rr = r & 15, cc = c & 31, ob = rr * 64 + cc * 2; return st * 1024 + (ob ^ (((ob >> 9) & 1) << 5)); }
__device__ __forceinline__ void stage_rc(int b, int& R, int& C) { const int st = b / 1024, sb = b % 1024, swz = sb ^ (((sb >> 9) & 1) << 5); R = (st >> 1) * 16 + swz / 64; C = (st & 1) * 32 + (swz % 64) / 2; }

struct Unit { const char* a; const char* b; int x, y, z; };

template <class Sched, class Epi>
__device__ __forceinline__ void gemm_phase(LAS unsigned char* lds, const int lda, const int ldb, const int K, const Sched& S, const Epi& E) {
    const int tid = opaque_tid(), wid = __builtin_amdgcn_readfirstlane(tid >> 6), lane = tid & 63, wr = wid >> 2, wc = wid & 3, fr = lane & 15, fq = lane >> 4;
    const int nt = K / BK;
    unsigned voffA[2], voffB[2];
#pragma unroll
    for (int i = 0; i < 2; ++i) { int R, C; stage_rc(tid * 16 + i * 8192, R, C); voffA[i] = (unsigned)(R * lda + C * 2); voffB[i] = (unsigned)(R * ldb + C * 2); }
    const size_t kstep = (size_t)(BK * 2);
    const size_t hA = (size_t)HALF * lda, hB = (size_t)HALF * ldb;
    const unsigned ldsw = (unsigned)wid * 1024u;
    const int aoff = lds_byte(wr * 64 + fr, fq * 8), boff = lds_byte(wc * 32 + fr, fq * 8);
#define G_SA(b, h) (((b) * 2 + (h)) * HTB)
#define G_SB(b, h) ((4 + (b) * 2 + (h)) * HTB)
#define G_STAGE(bufoff, gbase, voff) do { _Pragma("unroll") for (int _i = 0; _i < 2; ++_i) \
        __builtin_amdgcn_global_load_lds((const unsigned*)((const char*)(gbase) + (voff)[_i]), (LAS unsigned*)(lds + (bufoff) + ldsw + _i * 8192), 16, 0, 0); } while (0)
#define G_LDA(dst, b, h) do { _Pragma("unroll") for (int m = 0; m < 4; ++m) _Pragma("unroll") for (int k = 0; k < 2; ++k) dst[m][k] = *(const LAS bf16x8*)(lds + G_SA(b, h) + aoff + m * 2048 + k * 1024); } while (0)
#define G_LDB(dst, b, h) do { _Pragma("unroll") for (int n = 0; n < 2; ++n) _Pragma("unroll") for (int k = 0; k < 2; ++k) dst[n][k] = *(const LAS bf16x8*)(lds + G_SB(b, h) + boff + n * 2048 + k * 1024); } while (0)
#define G_MMA(ai, bj, At, Bt) do { __builtin_amdgcn_s_setprio(1); _Pragma("unroll") for (int m = 0; m < 4; ++m) _Pragma("unroll") for (int n = 0; n < 2; ++n) _Pragma("unroll") for (int k = 0; k < 2; ++k) \
        acc[ai][bj][m][n] = __builtin_amdgcn_mfma_f32_16x16x32_bf16(Bt[n][k], At[m][k], acc[ai][bj][m][n], 0, 0, 0); __builtin_amdgcn_s_setprio(0); } while (0)
#define G_WAIT_V(n) asm volatile("s_waitcnt vmcnt(" #n ")" ::: "memory")
#define G_WAIT_L(n) asm volatile("s_waitcnt lgkmcnt(" #n ")" ::: "memory")
#define G_BAR __builtin_amdgcn_s_barrier()
#define G_SCHED __builtin_amdgcn_sched_barrier(0)
    Unit cur, nxt; int ui = 0;
    if (!S.next(0, cur)) return;
    f32x4 acc[2][2][4][2];
#pragma unroll
    for (int a = 0; a < 2; ++a)
#pragma unroll
        for (int b = 0; b < 2; ++b)
#pragma unroll
            for (int m = 0; m < 4; ++m)
#pragma unroll
                for (int n = 0; n < 2; ++n) acc[a][b][m][n] = (f32x4){0.f, 0.f, 0.f, 0.f};
    bf16x8 At[4][2], B0[2][2], B1[2][2];
    const char* cA = cur.a; const char* cB = cur.b;
    G_STAGE(G_SB(0, 0), cB, voffB); G_STAGE(G_SA(0, 0), cA, voffA); G_STAGE(G_SB(0, 1), cB + hB, voffB); G_STAGE(G_SA(0, 1), cA + hA, voffA);
    if (wr == 1) G_BAR;
    G_WAIT_V(4); G_BAR;
    G_STAGE(G_SB(1, 0), cB + kstep, voffB); G_STAGE(G_SA(1, 0), cA + kstep, voffA); G_STAGE(G_SB(1, 1), cB + hB + kstep, voffB);
    G_WAIT_V(6); G_BAR;
    for (;;) {
        const bool has_next = S.next(ui + 1, nxt);
        const char* nA = has_next ? nxt.a : cA; const char* nB = has_next ? nxt.b : cB;
        for (int t = 0; t < nt; t += 2) {
            const bool last = (t == nt - 2);
            const char* a1 = cA + (size_t)(t + 1) * kstep;
            const char* a2 = last ? nA : cA + (size_t)(t + 2) * kstep; const char* b2 = last ? nB : cB + (size_t)(t + 2) * kstep;
            const char* a3 = a2 + kstep; const char* b3 = b2 + kstep;
            G_LDB(B0, 0, 0); G_SCHED; G_LDA(At, 0, 0); G_STAGE(G_SA(1, 1), a1 + hA, voffA);
            G_WAIT_L(8); G_BAR; G_WAIT_L(0); G_MMA(0, 0, At, B0); G_BAR; G_SCHED;
            G_LDB(B1, 0, 1); G_STAGE(G_SB(0, 0), b2, voffB);
            G_BAR; G_WAIT_L(0); G_MMA(0, 1, At, B1); G_BAR;
            G_LDA(At, 0, 1); G_STAGE(G_SA(0, 0), a2, voffA);
            G_BAR; G_WAIT_L(0); G_MMA(1, 0, At, B0); G_BAR; G_SCHED;
            G_STAGE(G_SB(0, 1), b2 + hB, voffB);
            G_WAIT_V(6); G_BAR; G_MMA(1, 1, At, B1); G_BAR;
            G_LDB(B0, 1, 0); G_SCHED; G_LDA(At, 1, 0); G_STAGE(G_SA(0, 1), a2 + hA, voffA);
            G_WAIT_L(8); G_BAR; G_WAIT_L(0); G_MMA(0, 0, At, B0); G_BAR; G_SCHED;
            G_LDB(B1, 1, 1); G_STAGE(G_SB(1, 0), b3, voffB);
            G_BAR; G_WAIT_L(0); G_MMA(0, 1, At, B1); G_BAR;
            G_LDA(At, 1, 1); G_STAGE(G_SA(1, 0), a3, voffA);
            G_BAR; G_WAIT_L(0); G_MMA(1, 0, At, B0); G_BAR; G_SCHED;
            G_STAGE(G_SB(1, 1), b3 + hB, voffB);
            G_WAIT_V(6); G_BAR; G_MMA(1, 1, At, B1); G_BAR;
        }
        const bool keep = E(acc, cur, wr, wc, fr, fq);
        if (!has_next) break;
        if (!keep) {
#pragma unroll
            for (int a = 0; a < 2; ++a)
#pragma unroll
                for (int b = 0; b < 2; ++b)
#pragma unroll
                    for (int m = 0; m < 4; ++m)
#pragma unroll
                        for (int n = 0; n < 2; ++n) acc[a][b][m][n] = (f32x4){0.f, 0.f, 0.f, 0.f};
        }
        cur = nxt; cA = nA; cB = nB; ++ui;
    }
    G_WAIT_V(0);
    if (wr == 0) G_BAR;
    G_BAR;
#undef G_SA
#undef G_SB
#undef G_STAGE
#undef G_LDA
#undef G_LDB
#undef G_MMA
#undef G_WAIT_V
#undef G_WAIT_L
#undef G_BAR
#undef G_SCHED
}

__device__ __forceinline__ int perm8_local(int c) {
    const int bj = c >> 7, wc = (c >> 5) & 3, n = (c >> 4) & 1, fq = (c >> 2) & 3, e = c & 3;
    return 128 * bj + 32 * wc + 8 * fq + 4 * n + e;
}
__device__ __forceinline__ int colmap_in(int np) {
    const int j = np >> 8, c = np & 255;
    if (j < 16) {
        const int bj = c >> 7, wc = (c >> 5) & 3, n = (c >> 4) & 1, fq = (c >> 2) & 3, e = c & 3;
        return (2 * bj + n) * 1024 + j * 64 + wc * 16 + fq * 4 + e;
    }
    const int L = (j - 16) * 256 + perm8_local(c);
    if (L < 3200) return 4096 + L;
    if (L < 3328) return -1;
    return L + 3968;
}

__device__ void phase0(const Params& p, unsigned char* smem) {
    const int tid = opaque_tid(), lane = tid & 63, wid = tid >> 6;
    bf16_t* Aall = (bf16_t*)(p.ws + WS_AALL);
    for (int row = blockIdx.x * 8 + wid; row < 19456; row += gridDim.x * 8) {
        const float* src; const float* g;
        if (row < MP) { src = p.x_prompt + (size_t)row * 1024; g = p.norm_in; }
        else if (row < MALL) { src = p.x_sample + (size_t)(row - MP) * 1024; g = p.norm_in; }
        else { src = p.mem_prompt + (size_t)(row - MALL) * 1024; g = p.norm_mem; }
        f32x4 v[4]; float ss = 0.f;
#pragma unroll
        for (int i = 0; i < 4; ++i) { v[i] = *(const f32x4*)(src + i * 256 + lane * 4); ss += v[i][0] * v[i][0] + v[i][1] * v[i][1] + v[i][2] * v[i][2] + v[i][3] * v[i][3]; }
        ss = wave_sum(ss);
        const float inv = rsqrtf(ss * (1.0f / 1024.0f) + 1e-6f);
#pragma unroll
        for (int i = 0; i < 4; ++i) {
            const f32x4 gg = *(const f32x4*)(g + i * 256 + lane * 4);
            u32x2 o; o[0] = cvt_pk_bf16(v[i][0] * inv * gg[0], v[i][1] * inv * gg[1]); o[1] = cvt_pk_bf16(v[i][2] * inv * gg[2], v[i][3] * inv * gg[3]);
            *(u32x2*)(Aall + (size_t)row * 1024 + i * 256 + lane * 4) = o;
        }
    }
    for (int idx = blockIdx.x * NTHREADS + tid; idx < 16 * 2 * 8 * 64; idx += gridDim.x * NTHREADS) {
        const int ln = idx & 63, f = (idx >> 6) & 7, mat = (idx >> 9) & 1, hh = idx >> 10;
        const int it = f >> 1, ks = f & 1, fr = ln & 15, fq = ln >> 4;
        const float* src = mat ? p.icl_up : p.decay_up;
        float w[8];
#pragma unroll
        for (int jj = 0; jj < 8; ++jj) w[jj] = src[(size_t)(ks * 32 + fq * 8 + jj) * 1024 + hh * 64 + it * 16 + fr];
        u32x4 pk; pk[0] = cvt_pk_bf16(w[0], w[1]); pk[1] = cvt_pk_bf16(w[2], w[3]); pk[2] = cvt_pk_bf16(w[4], w[5]); pk[3] = cvt_pk_bf16(w[6], w[7]);
        *(u32x4*)(p.ws + WS_FRAG + (size_t)idx * 16) = pk;
    }
    bf16_t* T = (bf16_t*)smem;
    const int NT_IN = 212 * 16, NT_KV = 32 * 16, NT_WB = 3 * 16 * 16, NT_WO = 16 * 16;
    const int total = NT_IN + NT_KV + NT_WB + NT_WO;
    for (int tix = blockIdx.x; tix < total; tix += gridDim.x) {
        const float* src; int src_ld; bf16_t* dst; int n0, k0, mode;
        if (tix < NT_IN) { src = p.w_in; src_ld = DIN; dst = (bf16_t*)(p.ws + WS_BALL); n0 = (tix >> 4) * 64; k0 = (tix & 15) * 64; mode = 0; }
        else if (tix < NT_IN + NT_KV) { const int t2 = tix - NT_IN; src = p.w_mem_kv; src_ld = 2048; dst = (bf16_t*)(p.ws + WS_BALL) + (size_t)NPAD * 1024; n0 = (t2 >> 4) * 64; k0 = (t2 & 15) * 64; mode = 1; }
        else if (tix < NT_IN + NT_KV + NT_WB) { const int t2 = tix - NT_IN - NT_KV; const int i = t2 >> 8, t3 = t2 & 255; src = p.w_branch + (size_t)i * 1024 * 1024; src_ld = 1024;
            dst = (bf16_t*)(p.ws + WS_WB) + (size_t)i * 1024 * 1024; n0 = (t3 >> 4) * 64; k0 = (t3 & 15) * 64; mode = 2; }
        else { const int t3 = tix - NT_IN - NT_KV - NT_WB; src = p.w_out; src_ld = 1024; dst = (bf16_t*)(p.ws + WS_WO); n0 = (t3 >> 4) * 64; k0 = (t3 & 15) * 64; mode = 1; }
        {
            const int kk = tid >> 3, seg = tid & 7;
#pragma unroll
            for (int q = 0; q < 2; ++q) {
                const int nl = seg * 8 + q * 4, np = n0 + nl;
                int sc;
                if (mode == 0) sc = colmap_in(np);
                else if (mode == 1) sc = np;
                else sc = (np & ~255) + perm8_local(np & 255);
                f32x4 v = (f32x4){0.f, 0.f, 0.f, 0.f};
                if (sc >= 0) v = *(const f32x4*)(src + (size_t)(k0 + kk) * src_ld + sc);
                const unsigned a = cvt_pk_bf16(v[0], v[1]), b = cvt_pk_bf16(v[2], v[3]);
                T[(nl + 0) * 66 + kk] = (bf16_t)(a & 0xffff); T[(nl + 1) * 66 + kk] = (bf16_t)(a >> 16);
                T[(nl + 2) * 66 + kk] = (bf16_t)(b & 0xffff); T[(nl + 3) * 66 + kk] = (bf16_t)(b >> 16);
            }
        }
        __syncthreads();
        {
            const int nl = tid >> 3, ks = tid & 7;
            const unsigned* tp = (const unsigned*)(T + nl * 66 + ks * 8);
            u32x4 v; v[0] = tp[0]; v[1] = tp[1]; v[2] = tp[2]; v[3] = tp[3];
            *(u32x4*)(dst + (size_t)(n0 + nl) * 1024 + k0 + ks * 8) = v;
        }
        __syncthreads();
    }
}

struct SchedP1 {
    int G, c; const char* Aall; const char* Ball;
    __device__ __forceinline__ bool next(int i, Unit& u) const {
        const int L = i * G + c;
        constexpr int nM = 68, nN = 53, nwg = nM * nN, WGM = 8;
        if (L >= nwg + 96) return false;
        if (L < nwg) {
            int wgid = L; { const int q = nwg / 8, r = nwg % 8, xcd = wgid % 8, off = wgid / 8; wgid = (xcd < r ? xcd * (q + 1) : r * (q + 1) + (xcd - r) * q) + off; }
            const int nig = WGM * nN, gid = wgid / nig, fm = gid * WGM, gsz = (nM - fm) < WGM ? (nM - fm) : WGM;
            u.x = fm + ((wgid % nig) % gsz); u.y = (wgid % nig) / gsz; u.z = 0;
            u.a = Aall + (size_t)u.x * 256 * 2048; u.b = Ball + (size_t)u.y * 256 * 2048;
        } else {
            int k = L - nwg;
            if (k < 32) { u.x = k >> 2; u.y = k & 3; u.z = 1; u.a = Aall + (size_t)(68 + u.x) * 256 * 2048; u.b = Ball + (size_t)(53 + u.y) * 256 * 2048; }
            else if (k < 64) { k -= 32; u.x = k >> 2; u.y = k & 3; u.z = 2; u.a = Aall + (size_t)(68 + u.x) * 256 * 2048; u.b = Ball + (size_t)(57 + u.y) * 256 * 2048; }
            else { k -= 64; u.x = k >> 3; u.y = k & 7; u.z = 3; u.a = Ball + (size_t)(57 + u.x) * 256 * 2048; u.b = Aall + (size_t)(68 + u.y) * 256 * 2048; }
        }
        return true;
    }
};

struct EpiNull { __device__ __forceinline__ bool operator()(f32x4 (&acc)[2][2][4][2], const Unit& u, int wr, int wc, int fr, int fq) const { float t = 0.f;
#pragma unroll
        for (int a = 0; a < 2; ++a)
#pragma unroll
            for (int b = 0; b < 2; ++b)
#pragma unroll
                for (int m = 0; m < 4; ++m)
#pragma unroll
                    for (int n = 0; n < 2; ++n) t += acc[a][b][m][n][0] + acc[a][b][m][n][1] + acc[a][b][m][n][2] + acc[a][b][m][n][3];
        if (t == 123.456f) sink[0] = t; return false; }
    float* sink; };
struct EpiP1 {
    bf16_t* U; bf16_t* BG; bf16_t* ACT; float* out; bf16_t* Kbf; bf16_t* Vt;
    __device__ __forceinline__ bool operator()(f32x4 (&acc)[2][2][4][2], const Unit& u, int wr, int wc, int fr, int fq) const {
        const int type = u.z;
        if (type == 0) {
            const int pn = u.y, rbase = u.x * 256 + wr * 64 + fr;
            if (pn < 16) {
                const int ch0 = pn * 64 + wc * 16 + fq * 4;
#pragma unroll
                for (int ai = 0; ai < 2; ++ai)
#pragma unroll
                    for (int m = 0; m < 4; ++m) {
                        const int row = rbase + ai * 128 + m * 16;
                        const f32x4 h = acc[ai][0][m][0], Bv = acc[ai][0][m][1], Cv = acc[ai][1][m][0], g = acc[ai][1][m][1];
                        const f32x4 u4 = Cv * h;
                        f32x4 bg;
#pragma unroll
                        for (int e = 0; e < 4; ++e) bg[e] = Bv[e] * siluf_(g[e]);
                        u32x2 o; o[0] = cvt_pk_bf16(u4[0], u4[1]); o[1] = cvt_pk_bf16(u4[2], u4[3]);
                        *(u32x2*)(U + (size_t)row * 1024 + ch0) = o;
                        o[0] = cvt_pk_bf16(bg[0], bg[1]); o[1] = cvt_pk_bf16(bg[2], bg[3]);
                        *(u32x2*)(BG + (size_t)row * 1024 + ch0) = o;
                        if (row < MP) { const int t = row & 2047; if (t >= 2046) *(f32x4*)(out + OUT_CONV_P + (size_t)((row >> 11) * 2 + (t - 2046)) * 1024 + ch0) = u4; }
                        else { const int rs = row - MP, t = rs & 7; if (t >= 6) *(f32x4*)(out + OUT_CONV_S + (size_t)((rs >> 3) * 2 + (t - 6)) * 1024 + ch0) = u4; }
                    }
            } else {
                const int L0 = (pn - 16) * 256;
                const int kind = pn <= 28 ? 0 : pn <= 32 ? 1 : pn <= 36 ? 2 : pn <= 40 ? 1 : 3;
#pragma unroll
                for (int ai = 0; ai < 2; ++ai)
#pragma unroll
                    for (int m = 0; m < 4; ++m) {
                        const int row = rbase + ai * 128 + m * 16;
#pragma unroll
                        for (int bj = 0; bj < 2; ++bj) {
                            const int L = L0 + 128 * bj + 32 * wc + 8 * fq;
                            f32x4 v0 = acc[ai][bj][m][0], v1 = acc[ai][bj][m][1];
                            if (kind == 0) {
                                if (L < DSHIFT) {
                                    if (row < MP) { if ((row & 2047) == 2047) { float* d = out + OUT_SHIFT_P + (size_t)(row >> 11) * DSHIFT + L; *(f32x4*)d = v0; *(f32x4*)(d + 4) = v1; } }
                                    else { const int rs = row - MP; if ((rs & 7) == 7) { float* d = out + OUT_SHIFT_S + (size_t)(rs >> 3) * DSHIFT + L; *(f32x4*)d = v0; *(f32x4*)(d + 4) = v1; } }
                                }
                            } else if (kind == 1) {
#pragma unroll
                                for (int e = 0; e < 4; ++e) { v0[e] = siluf_(v0[e]); v1[e] = siluf_(v1[e]); }
                            } else if (kind == 2) { v0 *= 0.0625f; v1 *= 0.0625f; }
                            else {
#pragma unroll
                                for (int e = 0; e < 4; ++e) { v0[e] = sigmoidf_(v0[e]); v1[e] = sigmoidf_(v1[e]); }
                            }
                            u32x4 o; o[0] = cvt_pk_bf16(v0[0], v0[1]); o[1] = cvt_pk_bf16(v0[2], v0[3]); o[2] = cvt_pk_bf16(v1[0], v1[1]); o[3] = cvt_pk_bf16(v1[2], v1[3]);
                            *(u32x4*)(ACT + (size_t)row * ACT_LD + L) = o;
                        }
                    }
            }
        } else {
            const int rbase = u.x * 256 + wr * 64 + fr, cbase = u.y * 256 + wc * 32 + fq * 4;
#pragma unroll
            for (int ai = 0; ai < 2; ++ai)
#pragma unroll
                for (int m = 0; m < 4; ++m) {
                    const int row = rbase + ai * 128 + m * 16;
#pragma unroll
                    for (int bj = 0; bj < 2; ++bj)
#pragma unroll
                        for (int n = 0; n < 2; ++n) {
                            const int col = cbase + bj * 128 + n * 16;
                            const f32x4 v = acc[ai][bj][m][n];
                            if (type == 1) { *(f32x4*)(out + OUT_MK + (size_t)row * 1024 + col) = v;
                                u32x2 o; o[0] = cvt_pk_bf16(v[0], v[1]); o[1] = cvt_pk_bf16(v[2], v[3]); *(u32x2*)(Kbf + (size_t)row * 1024 + col) = o; }
                            else if (type == 2) { *(f32x4*)(out + OUT_MV + (size_t)row * 1024 + col) = v; }
                            else { u32x2 o; o[0] = cvt_pk_bf16(v[0], v[1]); o[1] = cvt_pk_bf16(v[2], v[3]); *(u32x2*)(Vt + (size_t)row * 2048 + col) = o; }
                        }
                }
        }
        return false;
    }
};

struct ChunkDesc { int r0, b, h, half, samp, t0, n, first, last, bstep; };
__device__ __forceinline__ int n_chunks(const int bid, const int G) {
    const int n_long = bid < 256 ? (255 - bid) / G + 1 : 0, n_samp = bid < 4096 ? (4095 - bid) / G + 1 : 0;
    return n_long * 64 + ((n_samp + 3) >> 2);
}
__device__ __forceinline__ bool chunk_desc(const int ci, const int bid, const int G, ChunkDesc& d) {
    const int n_long = bid < 256 ? (255 - bid) / G + 1 : 0;
    const int n_samp = bid < 4096 ? (4095 - bid) / G + 1 : 0;
    const int nc_long = n_long * 64;
    if (ci < nc_long) { const int k = ci >> 6, it = bid + k * G, chain = it >> 1; d.b = chain >> 4; d.h = chain & 15; d.half = it & 1; d.samp = 0; d.r0 = d.b * TP; d.bstep = 0;
        d.t0 = (ci & 63) * 32; d.n = 32; d.first = (ci & 63) == 0; d.last = (ci & 63) == 63; return true; }
    const int k0 = (ci - nc_long) * 4; if (ci < 0 || k0 >= n_samp) return false;
    const int it = bid + k0 * G, chain = it >> 1; d.b = chain >> 4; d.h = chain & 15; d.half = it & 1; d.samp = 1; d.r0 = 0; d.t0 = 0; d.bstep = G >> 5;
    const int ni = n_samp - k0 < 4 ? n_samp - k0 : 4; d.n = ni * 8; d.first = 1; d.last = 1; return true;
}
__device__ __forceinline__ int cd_batch(const ChunkDesc& d, const int t) { return d.samp ? d.b + (t >> 3) * d.bstep : d.b; }
__device__ __forceinline__ int cd_row(const ChunkDesc& d, const int t) { return d.samp ? MP + (d.b + (t >> 3) * d.bstep) * 8 + (t & 7) : d.r0 + d.t0 + t; }
__device__ __forceinline__ bool cd_first(const ChunkDesc& d, const int t) { return d.samp ? (t & 7) == 0 : (d.t0 + t) == 0; }
constexpr int SROW = 68;
constexpr int SBUF = 6 * 32 * SROW + 64;
__device__ __forceinline__ f32x2 lo2(const f32x4 v) { return __builtin_shufflevector(v, v, 0, 1); }
__device__ __forceinline__ f32x2 hi2(const f32x4 v) { return __builtin_shufflevector(v, v, 2, 3); }
__device__ __forceinline__ float tanh_fast(float x) { return 1.0f - 2.0f * fast_rcp(1.0f + __expf(2.0f * x)); }

__device__ __forceinline__ void unpack4(const u32x2 v, float (&o)[4]) { o[0] = bflo(v[0]); o[1] = bfhi(v[0]); o[2] = bflo(v[1]); o[3] = bfhi(v[1]); }

struct OpSet { f32x4 kk, wr, w, b, k; f32x2 v, cc; };
__device__ __forceinline__ void reduce4_row16(float a0, float a1, float b0, float b1, float c0, float c1, float d0, float d1, float& A, float& B, float& C, float& D) {
    asm volatile(
        "v_add_f32 %0, %4, %5\n\tv_add_f32 %1, %6, %7\n\tv_add_f32 %2, %8, %9\n\tv_add_f32 %3, %10, %11\n\t"
        "v_add_f32_dpp %0, %0, %0 quad_perm:[1,0,3,2] row_mask:0xf bank_mask:0xf\n\tv_add_f32_dpp %1, %1, %1 quad_perm:[1,0,3,2] row_mask:0xf bank_mask:0xf\n\t"
        "v_add_f32_dpp %2, %2, %2 quad_perm:[1,0,3,2] row_mask:0xf bank_mask:0xf\n\tv_add_f32_dpp %3, %3, %3 quad_perm:[1,0,3,2] row_mask:0xf bank_mask:0xf\n\t"
        "v_add_f32_dpp %0, %0, %0 quad_perm:[2,3,0,1] row_mask:0xf bank_mask:0xf\n\tv_add_f32_dpp %1, %1, %1 quad_perm:[2,3,0,1] row_mask:0xf bank_mask:0xf\n\t"
        "v_add_f32_dpp %2, %2, %2 quad_perm:[2,3,0,1] row_mask:0xf bank_mask:0xf\n\tv_add_f32_dpp %3, %3, %3 quad_perm:[2,3,0,1] row_mask:0xf bank_mask:0xf\n\t"
        "v_add_f32_dpp %0, %0, %0 row_half_mirror row_mask:0xf bank_mask:0xf\n\tv_add_f32_dpp %1, %1, %1 row_half_mirror row_mask:0xf bank_mask:0xf\n\t"
        "v_add_f32_dpp %2, %2, %2 row_half_mirror row_mask:0xf bank_mask:0xf\n\tv_add_f32_dpp %3, %3, %3 row_half_mirror row_mask:0xf bank_mask:0xf\n\t"
        "v_add_f32_dpp %0, %0, %0 row_mirror row_mask:0xf bank_mask:0xf\n\tv_add_f32_dpp %1, %1, %1 row_mirror row_mask:0xf bank_mask:0xf\n\t"
        "v_add_f32_dpp %2, %2, %2 row_mirror row_mask:0xf bank_mask:0xf\n\tv_add_f32_dpp %3, %3, %3 row_mirror row_mask:0xf bank_mask:0xf\n\t"
        "s_nop 1"
        : "=&v"(A), "=&v"(B), "=&v"(C), "=&v"(D)
        : "v"(a0), "v"(a1), "v"(b0), "v"(b1), "v"(c0), "v"(c1), "v"(d0), "v"(d1));
}
struct PrepState { f32x4 aw[4], aa[4]; float ksf[16]; float rn; };

struct PrepRaw { u32x4 wdc[2], wdp[2], adc[2], adp[2]; u32x2 kc[4], kp[4]; };
struct PrepRaw2 { u32x2 rc[4], rp[4], vc[4], vp[4]; };
__device__ __forceinline__ void prep_load(const Params& p, const ChunkDesc& d, const int tb, const int lane, PrepRaw& R) {
    const int fr = lane & 15, fq = lane >> 4;
    const int t = tb + fr; const int tt = t < d.n ? t : d.n - 1;
    const size_t row = (size_t)cd_row(d, tt);
    const bool isfirst = cd_first(d, tt);
    const bf16_t* cur = (const bf16_t*)(p.ws + WS_ACT) + row * ACT_LD;
    const bf16_t* prv = isfirst ? cur : cur - ACT_LD;
    const int hc = d.h * 64 + 4 * fq;
#pragma unroll
    for (int ks = 0; ks < 2; ++ks) {
        R.wdc[ks] = *(const u32x4*)(cur + C_WD + ks * 32 + fq * 8); R.wdp[ks] = *(const u32x4*)(prv + C_WD + ks * 32 + fq * 8);
        R.adc[ks] = *(const u32x4*)(cur + C_AD + ks * 32 + fq * 8); R.adp[ks] = *(const u32x4*)(prv + C_AD + ks * 32 + fq * 8);
    }
#pragma unroll
    for (int it = 0; it < 4; ++it) { R.kc[it] = *(const u32x2*)(cur + C_PK + hc + it * 16); R.kp[it] = *(const u32x2*)(prv + C_PK + hc + it * 16); }
}
__device__ __forceinline__ void prep_load2(const Params& p, const ChunkDesc& d, const int tb, const int lane, PrepRaw2& R) {
    const int fr = lane & 15, fq = lane >> 4;
    const int t = tb + fr; const int tt = t < d.n ? t : d.n - 1;
    const size_t row = (size_t)cd_row(d, tt);
    const bool isfirst = cd_first(d, tt);
    const bf16_t* cur = (const bf16_t*)(p.ws + WS_ACT) + row * ACT_LD;
    const bf16_t* prv = isfirst ? cur : cur - ACT_LD;
    const int hc = d.h * 64 + 4 * fq;
#pragma unroll
    for (int it = 0; it < 4; ++it) {
        R.rc[it] = *(const u32x2*)(cur + C_PR + hc + it * 16); R.rp[it] = *(const u32x2*)(prv + C_PR + hc + it * 16);
        R.vc[it] = *(const u32x2*)(cur + C_PV + hc + it * 16); R.vp[it] = *(const u32x2*)(prv + C_PV + hc + it * 16);
    }
}
__device__ __forceinline__ void shift4(const u32x2 cu, const u32x2 pr, const float* st, const bool isfirst, const bool samp, const int col, const f32x4 mu, float (&o)[4]) {
    float c[4], q[4];
    unpack4(cu, c); unpack4(pr, q);
    if (isfirst) {
        if (samp) { const f32x4 v = *(const f32x4*)(st + col); q[0] = v[0]; q[1] = v[1]; q[2] = v[2]; q[3] = v[3]; }
        else { q[0] = 0.f; q[1] = 0.f; q[2] = 0.f; q[3] = 0.f; }
    }
#pragma unroll
    for (int e = 0; e < 4; ++e) o[e] = c[e] + mu[e] * (q[e] - c[e]);
}

__device__ __forceinline__ void prep_stage1(const Params& p, const ChunkDesc& d, const int tb, const float* par, const int lane, const PrepRaw& R, PrepState& S) {
    const int fr = lane & 15, fq = lane >> 4;
    const int t = tb + fr; const int tt = t < d.n ? t : d.n - 1;
    const bool isfirst = cd_first(d, tt), samp = d.samp != 0;
    const float* st = p.state_shift + (size_t)cd_batch(d, tt) * DSHIFT;
    bf16x8 bw[2], ba[2];
#pragma unroll
    for (int ks = 0; ks < 2; ++ks) {
#pragma unroll
        for (int which = 0; which < 2; ++which) {
            const int col = (which ? C_AD : C_WD) + ks * 32 + fq * 8;
            const u32x4 cu = which ? R.adc[ks] : R.wdc[ks], pr = which ? R.adp[ks] : R.wdp[ks];
            float x0[4], x1[4];
            shift4((u32x2){cu[0], cu[1]}, (u32x2){pr[0], pr[1]}, st, isfirst, samp, col, *(const f32x4*)(par + 512 + which * 64 + ks * 32 + fq * 8), x0);
            shift4((u32x2){cu[2], cu[3]}, (u32x2){pr[2], pr[3]}, st, isfirst, samp, col + 4, *(const f32x4*)(par + 512 + which * 64 + ks * 32 + fq * 8 + 4), x1);
            if (!which) {
#pragma unroll
                for (int e = 0; e < 4; ++e) { x0[e] = tanh_fast(x0[e]); x1[e] = tanh_fast(x1[e]); }
            }
            u32x4 pk; pk[0] = cvt_pk_bf16(x0[0], x0[1]); pk[1] = cvt_pk_bf16(x0[2], x0[3]); pk[2] = cvt_pk_bf16(x1[0], x1[1]); pk[3] = cvt_pk_bf16(x1[2], x1[3]);
            if (which) ba[ks] = __builtin_bit_cast(bf16x8, pk); else bw[ks] = __builtin_bit_cast(bf16x8, pk);
        }
    }
    const bf16x8* ft = (const bf16x8*)(p.ws + WS_FRAG) + (size_t)d.h * 1024 + lane;
    __builtin_amdgcn_sched_barrier(0);
#pragma unroll
    for (int it = 0; it < 4; ++it) {
        S.aw[it] = (f32x4){0.f, 0.f, 0.f, 0.f}; S.aa[it] = S.aw[it];
#pragma unroll
        for (int ks = 0; ks < 2; ++ks) {
            S.aw[it] = __builtin_amdgcn_mfma_f32_16x16x32_bf16(ft[(it * 2 + ks) * 64], bw[ks], S.aw[it], 0, 0, 0);
            S.aa[it] = __builtin_amdgcn_mfma_f32_16x16x32_bf16(ft[(8 + it * 2 + ks) * 64], ba[ks], S.aa[it], 0, 0, 0);
        }
        if (it & 1) __builtin_amdgcn_sched_barrier(0);
    }
    const int hc = d.h * 64 + 4 * fq;
    float ss = 0.f;
#pragma unroll
    for (int it = 0; it < 4; ++it) {
        const int po = it * 16 + 4 * fq;
        float k4[4];
        shift4(R.kc[it], R.kp[it], st, isfirst, samp, C_PK + hc + it * 16, *(const f32x4*)(par + 64 + po), k4);
        const f32x4 kkp = *(const f32x4*)(par + 5 * 64 + po);
#pragma unroll
        for (int e = 0; e < 4; ++e) { S.ksf[it * 4 + e] = k4[e]; const float kr = k4[e] * kkp[e]; ss += kr * kr; }
        __builtin_amdgcn_sched_barrier(0);
    }
    ss += __shfl_xor(ss, 16, 64); ss += __shfl_xor(ss, 32, 64);
    S.rn = rsqrtf(ss + 1e-12f);
}

__device__ __forceinline__ void prep_stage2(const Params& p, const ChunkDesc& d, const int tb, float* buf, const float* par, const int lane, const PrepRaw2& R, const PrepState& S) {
    const int fr = lane & 15, fq = lane >> 4;
    const int t = tb + fr; const bool valid = t < d.n; const int tt = valid ? t : d.n - 1;
    const bool isfirst = cd_first(d, tt), samp = d.samp != 0;
    const float* st = p.state_shift + (size_t)cd_batch(d, tt) * DSHIFT;
    const int hc = d.h * 64 + 4 * fq;
    float c1 = 0.f, c2 = 0.f, c3 = 0.f;
    float* kkA = buf; float* wrA = buf + 32 * SROW; float* wA = buf + 2 * 32 * SROW; float* bA = buf + 3 * 32 * SROW; float* kpA = buf + 4 * 32 * SROW; float* vsA = buf + 5 * 32 * SROW; float* c12 = buf + 6 * 32 * SROW;
#pragma unroll
    for (int it = 0; it < 4; ++it) {
        const int po = it * 16 + 4 * fq;
        const f32x4 w0 = *(const f32x4*)(par + 3 * 64 + po), a0 = *(const f32x4*)(par + 4 * 64 + po), kkp = *(const f32x4*)(par + 5 * 64 + po), ka = *(const f32x4*)(par + 6 * 64 + po), rk = *(const f32x4*)(par + 7 * 64 + po);
        f32x4 o_kk, o_wr, o_w, o_b, o_kp, o_vs;
        float r4[4], v4[4];
        shift4(R.rc[it], R.rp[it], st, isfirst, samp, C_PR + hc + it * 16, *(const f32x4*)(par + po), r4);
        shift4(R.vc[it], R.vp[it], st, isfirst, samp, C_PV + hc + it * 16, *(const f32x4*)(par + 128 + po), v4);
#pragma unroll
        for (int e = 0; e < 4; ++e) {
            const float r_ = r4[e], k_ = S.ksf[it * 4 + e];
            const float dec = __expf(-0.6065306597f * sigmoidf_(S.aw[it][e] + w0[e]));
            const float a = sigmoidf_(S.aa[it][e] + a0[e]);
            const float kn = k_ * kkp[e] * S.rn;
            const float kpv = k_ * (1.0f + (a - 1.0f) * ka[e]);
            const float bv = kn * a;
            c1 += bv * r_; c2 += kpv * r_; c3 += r_ * kpv * rk[e];
            o_kk[e] = kn; o_wr[e] = dec * r_; o_w[e] = dec; o_b[e] = bv; o_kp[e] = kpv; o_vs[e] = v4[e];
        }
        if (valid) {
            const int o = t * SROW + po;
            *(f32x4*)(kkA + o) = o_kk; *(f32x4*)(wrA + o) = o_wr; *(f32x4*)(wA + o) = o_w; *(f32x4*)(bA + o) = o_b; *(f32x4*)(kpA + o) = o_kp; *(f32x4*)(vsA + o) = o_vs;
        }
        __builtin_amdgcn_sched_barrier(0);
    }
    c1 += __shfl_xor(c1, 16, 64); c1 += __shfl_xor(c1, 32, 64);
    c2 += __shfl_xor(c2, 16, 64); c2 += __shfl_xor(c2, 32, 64);
    c3 += __shfl_xor(c3, 16, 64); c3 += __shfl_xor(c3, 32, 64);
    if (valid && fq == 0) { c12[t * 2] = c1; c12[t * 2 + 1] = c2; if (d.half == 0) ((float*)(p.ws + WS_C3))[(size_t)cd_row(d, t) * 16 + d.h] = c3; }
}

__device__ void phase2_scan(const Params& p, unsigned char* smem) {
    const int tid = opaque_tid(), lane = tid & 63, wid = __builtin_amdgcn_readfirstlane(tid >> 6);
    const int bid = blockIdx.x, G = gridDim.x;
    float* sm = (float*)smem;
    float* bufs = sm;
    float* obuf = sm + 2 * SBUF;
    float* parb = obuf + 2 * 1024;
    const int NC = n_chunks(bid, G);
    float* ORAW = p.out + OUT_Y;
    __syncthreads();
    if (NC == 0) return;
    if (wid < 4) {
        __builtin_amdgcn_s_setprio(3);
        const int c = lane & 15, rg = lane >> 4, rl = wid * 8 + rg * 2;
        f32x2 s00 = (f32x2){0.f, 0.f}, s01 = s00, s10 = s00, s11 = s00;
        __syncthreads();
        __syncthreads();
        for (int ci = 0; ci < NC; ++ci) {
            ChunkDesc d; chunk_desc(ci, bid, G, d);
            const float* buf = bufs + (ci & 1) * SBUF;
            const float* kkA = buf + 4 * c; const float* vsA = buf + 5 * 32 * SROW + d.half * 32 + rl; const float* c12 = buf + 6 * 32 * SROW;
            float* ob = obuf + (ci & 1) * 1024 + rl;
            const int nsub = d.samp ? (d.n >> 3) : 1, slen = d.samp ? 8 : d.n;
            OpSet A, B;
            auto ld = [&](OpSet& o, const int t) {
                o.kk = *(const f32x4*)(kkA + t * SROW); o.wr = *(const f32x4*)(kkA + 32 * SROW + t * SROW); o.w = *(const f32x4*)(kkA + 2 * 32 * SROW + t * SROW);
                o.b = *(const f32x4*)(kkA + 3 * 32 * SROW + t * SROW); o.k = *(const f32x4*)(kkA + 4 * 32 * SROW + t * SROW);
                o.v = *(const f32x2*)(vsA + t * SROW); o.cc = *(const f32x2*)(c12 + t * 2);
            };
            auto step = [&](const OpSet& o, const int t) {
                const f32x2 pd0 = s00 * lo2(o.kk) + s01 * hi2(o.kk), pd1 = s10 * lo2(o.kk) + s11 * hi2(o.kk);
                const f32x2 pe0 = s00 * lo2(o.wr) + s01 * hi2(o.wr), pe1 = s10 * lo2(o.wr) + s11 * hi2(o.wr);
                float d0, d1, e0, e1;
                reduce4_row16(pd0[0], pd0[1], pd1[0], pd1[1], pe0[0], pe0[1], pe1[0], pe1[1], d0, d1, e0, e1);
                const f32x2 vv0 = (f32x2){o.v[0], o.v[0]}, vv1 = (f32x2){o.v[1], o.v[1]}, dd0 = (f32x2){d0, d0}, dd1 = (f32x2){d1, d1};
                s00 = s00 * lo2(o.w) + (lo2(o.k) * vv0 - lo2(o.b) * dd0);
                s01 = s01 * hi2(o.w) + (hi2(o.k) * vv0 - hi2(o.b) * dd0);
                s10 = s10 * lo2(o.w) + (lo2(o.k) * vv1 - lo2(o.b) * dd1);
                s11 = s11 * hi2(o.w) + (hi2(o.k) * vv1 - hi2(o.b) * dd1);
                if (c == 0) { f32x2 ov; ov[0] = e0 - d0 * o.cc[0] + o.v[0] * o.cc[1]; ov[1] = e1 - d1 * o.cc[0] + o.v[1] * o.cc[1]; *(f32x2*)(ob + t * 32) = ov; }
            };
            for (int sub = 0; sub < nsub; ++sub) {
                const int tbeg = sub * slen, tend = tbeg + slen;
                const size_t st_off = ((size_t)(cd_batch(d, tbeg) * 16 + d.h) * 64 + d.half * 32 + rl) * 64 + 4 * c;
                if (d.samp) { const f32x4 a = *(const f32x4*)(p.state_wkv + st_off), b2 = *(const f32x4*)(p.state_wkv + st_off + 64); s00 = lo2(a); s01 = hi2(a); s10 = lo2(b2); s11 = hi2(b2); }
                else if (d.first) { s00 = (f32x2){0.f, 0.f}; s01 = s00; s10 = s00; s11 = s00; }
                ld(A, tbeg);
                for (int t = tbeg; t < tend; t += 2) {
                    ld(B, t + 1);
                    step(A, t);
                    ld(A, (t + 2 < tend) ? t + 2 : t);
                    step(B, t + 1);
                }
                if (d.samp || d.last) {
                    float* so = p.out + (d.samp ? OUT_WKV_S : OUT_WKV_P) + st_off;
                    f32x4 a, b2; a[0] = s00[0]; a[1] = s00[1]; a[2] = s01[0]; a[3] = s01[1]; b2[0] = s10[0]; b2[1] = s10[1]; b2[2] = s11[0]; b2[3] = s11[1];
                    *(f32x4*)so = a; *(f32x4*)(so + 64) = b2;
                }
            }
            __syncthreads();
        }
        __syncthreads();
        __builtin_amdgcn_s_setprio(0);
    } else {
        const int q = (wid >> 1) & 1, tb = (wid & 1) * 16;
        float* par = parb + (wid & 3) * 640;
        PrepState S;
        int cur_h = -1;
        for (int i = -2; i <= NC; ++i) {
            if ((i & 1) == q) {
                ChunkDesc d;
                int ck = i + 2; ck = ck < 0 ? 0 : (ck > NC - 1 ? NC - 1 : ck);
                chunk_desc(ck, bid, G, d);
                if (d.h != cur_h) {
                    cur_h = d.h;
                    const int ch = d.h * 64 + lane;
                    par[lane] = p.shift_mu[ch]; par[64 + lane] = p.shift_mu[1024 + ch]; par[128 + lane] = p.shift_mu[2048 + ch]; par[192 + lane] = p.decay_w0[ch];
                    par[256 + lane] = p.icl_a0[ch]; par[320 + lane] = p.k_k[ch]; par[384 + lane] = p.k_a[ch]; par[448 + lane] = p.r_k[ch];
                    par[512 + lane] = p.shift_mu[C_WD + lane]; par[576 + lane] = p.shift_mu[C_AD + lane];
                }
                PrepRaw R;
                prep_load(p, d, tb, lane, R);
                prep_stage1(p, d, tb, par, lane, R, S);
            } else {
                ChunkDesc d, d2;
                PrepRaw2 R2;
                const bool has2 = i >= -1 && i + 1 < NC && chunk_desc(i + 1, bid, G, d2) && tb < d2.n;
                if (has2) prep_load2(p, d2, tb, lane, R2);
                if (i >= 1 && chunk_desc(i - 1, bid, G, d)) {
                    const float* ob = obuf + ((i - 1) & 1) * 1024;
                    for (int idx = (wid & 1) * 64 + lane; idx < d.n * 8; idx += 128) { const int t = idx >> 3, j = (idx & 7) * 4; *(f32x4*)(ORAW + (size_t)cd_row(d, t) * 1024 + d.h * 64 + d.half * 32 + j) = *(const f32x4*)(ob + t * 32 + j); }
                }
                if (has2) prep_stage2(p, d2, tb, bufs + ((i + 1) & 1) * SBUF, par, lane, R2, S);
            }
            __syncthreads();
        }
    }
}

__device__ void attn_unit(const Params& p, unsigned char* smem, const int unit) {
    const int tid = opaque_tid(), lane = tid & 63, wid = __builtin_amdgcn_readfirstlane(tid >> 6), fr = lane & 15, fq = lane >> 4;
    const int b = unit >> 6, h = (unit >> 4) & 3, tile = unit & 15;
    const bf16_t* ACT = (const bf16_t*)(p.ws + WS_ACT);
    const bf16_t* Kbf = (const bf16_t*)(p.ws + WS_KBF);
    const bf16_t* Vt = (const bf16_t*)(p.ws + WS_VT);
    bf16_t* Ymem = (bf16_t*)(p.ws + WS_YMEM);
    bf16_t* Kc = (bf16_t*)smem;
    bf16_t* Vc = (bf16_t*)smem;
    const int row = b * 2048 + tile * 128 + wid * 16 + fr;
    u32x4 st[8];
    auto ldK = [&](const int hf) {
#pragma unroll
        for (int i = 0; i < 8; ++i) { const int id = tid + i * NTHREADS, key = id >> 5, d = (id & 31) * 8; st[i] = *(const u32x4*)(Kbf + (size_t)(b * 256 + hf * 128 + key) * 1024 + h * 256 + d); }
    };
    auto stK = [&]() {
#pragma unroll
        for (int i = 0; i < 8; ++i) { const int id = tid + i * NTHREADS, key = id >> 5, d = (id & 31) * 8; *(u32x4*)(Kc + key * 264 + d) = st[i]; }
    };
    auto ldV = [&](const int hf) {
#pragma unroll
        for (int i = 0; i < 8; ++i) { const int id = tid + i * NTHREADS, d = id >> 4, kc = (id & 15) * 8; st[i] = *(const u32x4*)(Vt + (size_t)(h * 256 + d) * 2048 + b * 256 + hf * 128 + kc); }
    };
    auto stV = [&]() {
#pragma unroll
        for (int i = 0; i < 8; ++i) { const int id = tid + i * NTHREADS, d = id >> 4, kc = (id & 15) * 8; *(u32x4*)(Vc + d * 136 + kc) = st[i]; }
    };
    ldK(0);
    bf16x8 qf[8];
#pragma unroll
    for (int ks = 0; ks < 8; ++ks) qf[ks] = *(const bf16x8*)(ACT + (size_t)row * ACT_LD + C_QM + h * 256 + ks * 32 + fq * 8);
    f32x4 sacc[16];
#pragma unroll
    for (int i = 0; i < 16; ++i) sacc[i] = (f32x4){0.f, 0.f, 0.f, 0.f};
#pragma unroll
    for (int hf = 0; hf < 2; ++hf) {
        __syncthreads();
        stK();
        __syncthreads();
        if (hf == 0) ldK(1); else ldV(0);
#pragma unroll
        for (int kt = 0; kt < 8; ++kt)
#pragma unroll
            for (int ks = 0; ks < 8; ++ks) {
                const bf16x8 kf = *(const bf16x8*)(Kc + (kt * 16 + fr) * 264 + ks * 32 + fq * 8);
                sacc[hf * 8 + kt] = __builtin_amdgcn_mfma_f32_16x16x32_bf16(kf, qf[ks], sacc[hf * 8 + kt], 0, 0, 0);
            }
    }
    float mx = -3.0e38f;
#pragma unroll
    for (int i = 0; i < 16; ++i) mx = fmaxf(mx, fmaxf(fmaxf(sacc[i][0], sacc[i][1]), fmaxf(sacc[i][2], sacc[i][3])));
    mx = fmaxf(mx, __shfl_xor(mx, 16, 64)); mx = fmaxf(mx, __shfl_xor(mx, 32, 64));
    float sum = 0.f;
#pragma unroll
    for (int i = 0; i < 16; ++i)
#pragma unroll
        for (int e = 0; e < 4; ++e) { const float ex = __expf(sacc[i][e] - mx); sacc[i][e] = ex; sum += ex; }
    sum += __shfl_xor(sum, 16, 64); sum += __shfl_xor(sum, 32, 64);
    const float inv = fast_rcp(sum);
    bf16x8 pf[8];
#pragma unroll
    for (int s2 = 0; s2 < 8; ++s2) {
        u32x4 t; t[0] = cvt_pk_bf16(sacc[2 * s2][0], sacc[2 * s2][1]); t[1] = cvt_pk_bf16(sacc[2 * s2][2], sacc[2 * s2][3]);
        t[2] = cvt_pk_bf16(sacc[2 * s2 + 1][0], sacc[2 * s2 + 1][1]); t[3] = cvt_pk_bf16(sacc[2 * s2 + 1][2], sacc[2 * s2 + 1][3]);
        pf[s2] = __builtin_bit_cast(bf16x8, t);
    }
    f32x4 oacc[16];
#pragma unroll
    for (int i = 0; i < 16; ++i) oacc[i] = (f32x4){0.f, 0.f, 0.f, 0.f};
#pragma unroll
    for (int hf = 0; hf < 2; ++hf) {
        __syncthreads();
        stV();
        __syncthreads();
        if (hf == 0) ldV(1);
#pragma unroll
        for (int dt = 0; dt < 16; ++dt)
#pragma unroll
            for (int s2 = 0; s2 < 4; ++s2) {
                const u32x2 lo = *(const u32x2*)(Vc + (dt * 16 + fr) * 136 + s2 * 32 + 4 * fq), hi = *(const u32x2*)(Vc + (dt * 16 + fr) * 136 + s2 * 32 + 16 + 4 * fq);
                u32x4 t; t[0] = lo[0]; t[1] = lo[1]; t[2] = hi[0]; t[3] = hi[1];
                oacc[dt] = __builtin_amdgcn_mfma_f32_16x16x32_bf16(__builtin_bit_cast(bf16x8, t), pf[hf * 4 + s2], oacc[dt], 0, 0, 0);
            }
    }
#pragma unroll
    for (int dt = 0; dt < 16; ++dt) {
        const int d = h * 256 + dt * 16 + 4 * fq;
        const u32x2 g = *(const u32x2*)(ACT + (size_t)row * ACT_LD + C_SGM + d);
        u32x2 o; o[0] = cvt_pk_bf16(oacc[dt][0] * inv * bflo(g[0]), oacc[dt][1] * inv * bfhi(g[0])); o[1] = cvt_pk_bf16(oacc[dt][2] * inv * bflo(g[1]), oacc[dt][3] * inv * bfhi(g[1]));
        *(u32x2*)(Ymem + (size_t)row * 1024 + d) = o;
    }
}

__device__ void attn_sample_unit(const Params& p, unsigned char* smem, const int b, const int h) {
    const int tid = opaque_tid(), lane = tid & 63, wid = __builtin_amdgcn_readfirstlane(tid >> 6), fr = lane & 15, fq = lane >> 4;
    const bf16_t* ACT = (const bf16_t*)(p.ws + WS_ACT);
    bf16_t* Ymem = (bf16_t*)(p.ws + WS_YMEM);
    bf16_t* Kc = (bf16_t*)smem;
    float* Ored = (float*)smem;
    float* Pl = (float*)(smem + 69632);
    const int row = MP + b * 8 + (fr & 7);
    bf16x8 qf[8];
#pragma unroll
    for (int ks = 0; ks < 8; ++ks) qf[ks] = *(const bf16x8*)(ACT + (size_t)row * ACT_LD + C_QM + h * 256 + ks * 32 + fq * 8);
    const float* vbase = p.cache_v + ((size_t)(b * 256 + wid * 32) * 4 + h) * 256 + lane * 4;
    f32x4 vv[8];
#pragma unroll
    for (int i = 0; i < 8; ++i) vv[i] = *(const f32x4*)(vbase + (size_t)i * 1024);
    f32x4 sacc[16];
#pragma unroll
    for (int i = 0; i < 16; ++i) sacc[i] = (f32x4){0.f, 0.f, 0.f, 0.f};
#pragma unroll
    for (int hf = 0; hf < 2; ++hf) {
        __syncthreads();
#pragma unroll
        for (int i = 0; i < 8; ++i) {
            const int id = tid + i * NTHREADS, key = id >> 5, d = (id & 31) * 8;
            const float* s_ = p.cache_k + ((size_t)(b * 256 + hf * 128 + key) * 4 + h) * 256 + d; const f32x4 x0 = *(const f32x4*)s_, x1 = *(const f32x4*)(s_ + 4);
            u32x4 v; v[0] = cvt_pk_bf16(x0[0], x0[1]); v[1] = cvt_pk_bf16(x0[2], x0[3]); v[2] = cvt_pk_bf16(x1[0], x1[1]); v[3] = cvt_pk_bf16(x1[2], x1[3]);
            *(u32x4*)(Kc + key * 264 + d) = v;
        }
        __syncthreads();
#pragma unroll
        for (int kt = 0; kt < 8; ++kt)
#pragma unroll
            for (int ks = 0; ks < 8; ++ks) {
                const bf16x8 kf = *(const bf16x8*)(Kc + (kt * 16 + fr) * 264 + ks * 32 + fq * 8);
                sacc[hf * 8 + kt] = __builtin_amdgcn_mfma_f32_16x16x32_bf16(kf, qf[ks], sacc[hf * 8 + kt], 0, 0, 0);
            }
    }
    float mx = -3.0e38f;
#pragma unroll
    for (int i = 0; i < 16; ++i) mx = fmaxf(mx, fmaxf(fmaxf(sacc[i][0], sacc[i][1]), fmaxf(sacc[i][2], sacc[i][3])));
    mx = fmaxf(mx, __shfl_xor(mx, 16, 64)); mx = fmaxf(mx, __shfl_xor(mx, 32, 64));
    float sum = 0.f;
#pragma unroll
    for (int i = 0; i < 16; ++i)
#pragma unroll
        for (int e = 0; e < 4; ++e) { const float ex = __expf(sacc[i][e] - mx); sacc[i][e] = ex; sum += ex; }
    sum += __shfl_xor(sum, 16, 64); sum += __shfl_xor(sum, 32, 64);
    const float inv = fast_rcp(sum);
    if (wid == 0 && fr < 8) {
#pragma unroll
        for (int i = 0; i < 16; ++i)
#pragma unroll
            for (int e = 0; e < 4; ++e) Pl[(i * 16 + 4 * fq + e) * 8 + fr] = sacc[i][e] * inv;
    }
    __syncthreads();
    f32x4 o[8];
#pragma unroll
    for (int t = 0; t < 8; ++t) o[t] = (f32x4){0.f, 0.f, 0.f, 0.f};
#pragma unroll
    for (int half = 0; half < 4; ++half) {
        if (half >= 1) {
#pragma unroll
            for (int i = 0; i < 8; ++i) vv[i] = *(const f32x4*)(vbase + (size_t)(half * 8 + i) * 1024);
        }
#pragma unroll
        for (int i = 0; i < 8; ++i) {
            const float* pp = Pl + (wid * 32 + half * 8 + i) * 8;
            const f32x4 p0 = *(const f32x4*)pp, p1 = *(const f32x4*)(pp + 4);
#pragma unroll
            for (int t = 0; t < 4; ++t) { o[t] += vv[i] * p0[t]; o[4 + t] += vv[i] * p1[t]; }
        }
    }
#pragma unroll
    for (int t = 0; t < 8; ++t) *(f32x4*)(Ored + (wid * 8 + t) * 256 + lane * 4) = o[t];
    __syncthreads();
    {
        const int t = tid >> 6, d = (tid & 63) * 4;
        f32x4 acc = (f32x4){0.f, 0.f, 0.f, 0.f};
#pragma unroll
        for (int w = 0; w < 8; ++w) acc += *(const f32x4*)(Ored + (w * 8 + t) * 256 + d);
        const size_t orow = (size_t)(MP + b * 8 + t);
        const u32x2 g = *(const u32x2*)(ACT + orow * ACT_LD + C_SGM + h * 256 + d);
        u32x2 ov; ov[0] = cvt_pk_bf16(acc[0] * bflo(g[0]), acc[1] * bfhi(g[0])); ov[1] = cvt_pk_bf16(acc[2] * bflo(g[1]), acc[3] * bfhi(g[1]));
        *(u32x2*)(Ymem + orow * 1024 + h * 256 + d) = ov;
    }
}

__device__ void phase2_attn(const Params& p, unsigned char* smem) {
    __syncthreads();
    for (int k = blockIdx.x; k < 1024; k += gridDim.x) {
        const int u = (k + ((blockIdx.x & 1) << 9)) & 1023;
        if (u < 512) attn_unit(p, smem, u); else attn_sample_unit(p, smem, (u - 512) >> 2, u & 3);
    }
}

__device__ __forceinline__ void ld16bf(const bf16_t* ptr, float (&o)[16]) {
    const u32x4 a = *(const u32x4*)ptr, b = *(const u32x4*)(ptr + 8);
#pragma unroll
    for (int e = 0; e < 4; ++e) { o[2 * e] = bflo(a[e]); o[2 * e + 1] = bfhi(a[e]); o[8 + 2 * e] = bflo(b[e]); o[8 + 2 * e + 1] = bfhi(b[e]); }
}
__device__ __forceinline__ void ld16f(const float* ptr, float (&o)[16]) {
#pragma unroll
    for (int q = 0; q < 4; ++q) { const f32x4 v = *(const f32x4*)(ptr + 4 * q); o[4 * q] = v[0]; o[4 * q + 1] = v[1]; o[4 * q + 2] = v[2]; o[4 * q + 3] = v[3]; }
}
__device__ __forceinline__ void st16bf(bf16_t* ptr, const float (&y)[16]) {
    u32x4 a, b;
#pragma unroll
    for (int e = 0; e < 4; ++e) { a[e] = cvt_pk_bf16(y[2 * e], y[2 * e + 1]); b[e] = cvt_pk_bf16(y[8 + 2 * e], y[8 + 2 * e + 1]); }
    *(u32x4*)ptr = a; *(u32x4*)(ptr + 8) = b;
}
__device__ __forceinline__ float quad_sum(float x) { x += dpp_f<0xB1>(x); x += dpp_f<0x4E>(x); return x; }
struct RowRaw { u32x4 u0[2], u1[2], u2[2], bg[2], vc[2], vq[2], sg[2]; f32x4 o[4]; float c3; };
__device__ __forceinline__ void up16(const u32x4 (&r)[2], float (&o)[16]) {
#pragma unroll
    for (int e = 0; e < 4; ++e) { o[2 * e] = bflo(r[0][e]); o[2 * e + 1] = bfhi(r[0][e]); o[8 + 2 * e] = bflo(r[1][e]); o[8 + 2 * e + 1] = bfhi(r[1][e]); }
}
__device__ __forceinline__ float bfe16(const u32x4 (&r)[2], const int i) { const unsigned w = r[i >> 3][(i >> 1) & 3]; return (i & 1) ? bfhi(w) : bflo(w); }
__device__ void phase2b(const Params& p, unsigned char* smem) {
    const int tid = opaque_tid(), lane = tid & 63, wid = tid >> 6;
    float* tab = (float*)smem;
    __syncthreads();
    for (int idx = tid; idx < 7168; idx += NTHREADS)
        tab[idx] = idx < 3072 ? p.conv_w[idx] : idx < 4096 ? p.conv_b[idx - 3072] : idx < 5120 ? p.shift_mu[2048 + idx - 4096] : idx < 6144 ? p.ln_g[idx - 5120] : p.ln_b[idx - 6144];
    __syncthreads();
    const bf16_t* U = (const bf16_t*)(p.ws + WS_U); const bf16_t* BG = (const bf16_t*)(p.ws + WS_BG); const bf16_t* ACT = (const bf16_t*)(p.ws + WS_ACT);
    const float* ORAW = p.out + OUT_Y; const float* C3 = (const float*)(p.ws + WS_C3);
    bf16_t* Yc = (bf16_t*)(p.ws + WS_YCONV); bf16_t* Yr = (bf16_t*)(p.ws + WS_YRWKV);
    const int ch = lane * 16;
    auto load_row = [&](const int row, RowRaw& R) {
        const bool samp = row >= MP; const int t = samp ? ((row - MP) & 7) : (row & 2047);
        const int r1 = t >= 1 ? row - 1 : row, r2 = t >= 2 ? row - 2 : row;
#pragma unroll
        for (int q = 0; q < 2; ++q) {
            R.u0[q] = *(const u32x4*)(U + (size_t)row * 1024 + ch + 8 * q); R.u1[q] = *(const u32x4*)(U + (size_t)r1 * 1024 + ch + 8 * q); R.u2[q] = *(const u32x4*)(U + (size_t)r2 * 1024 + ch + 8 * q);
            R.bg[q] = *(const u32x4*)(BG + (size_t)row * 1024 + ch + 8 * q);
            R.vc[q] = *(const u32x4*)(ACT + (size_t)row * ACT_LD + C_PV + ch + 8 * q); R.vq[q] = *(const u32x4*)(ACT + (size_t)r1 * ACT_LD + C_PV + ch + 8 * q);
            R.sg[q] = *(const u32x4*)(ACT + (size_t)row * ACT_LD + C_SGR + ch + 8 * q);
        }
#pragma unroll
        for (int q = 0; q < 4; ++q) R.o[q] = *(const f32x4*)(ORAW + (size_t)row * 1024 + ch + 4 * q);
        R.c3 = C3[(size_t)row * 16 + (lane >> 2)];
    };
    auto process_row = [&](const int row, const RowRaw& R) {
        int b, t; const bool samp = row >= MP;
        if (!samp) { b = row >> 11; t = row & 2047; } else { b = (row - MP) >> 3; t = (row - MP) & 7; }
        const bool z1 = t < 1, z2 = t < 2;
        u32x4 yo[2];
#pragma unroll
        for (int q = 0; q < 4; ++q) {
            const f32x4 w0 = *(const f32x4*)(tab + ch + 4 * q), w1 = *(const f32x4*)(tab + 1024 + ch + 4 * q), w2 = *(const f32x4*)(tab + 2048 + ch + 4 * q), cb = *(const f32x4*)(tab + 3072 + ch + 4 * q);
            f32x4 m1 = (f32x4){0.f, 0.f, 0.f, 0.f}, m2 = m1;
            if (z1) { if (samp) m1 = *(const f32x4*)(p.state_conv + ((size_t)b * 2 + 1) * 1024 + ch + 4 * q); }
            else { m1[0] = bfe16(R.u1, 4 * q); m1[1] = bfe16(R.u1, 4 * q + 1); m1[2] = bfe16(R.u1, 4 * q + 2); m1[3] = bfe16(R.u1, 4 * q + 3); }
            if (z2) { if (samp) m2 = *(const f32x4*)(p.state_conv + ((size_t)b * 2 + t) * 1024 + ch + 4 * q); }
            else { m2[0] = bfe16(R.u2, 4 * q); m2[1] = bfe16(R.u2, 4 * q + 1); m2[2] = bfe16(R.u2, 4 * q + 2); m2[3] = bfe16(R.u2, 4 * q + 3); }
            float y[4];
#pragma unroll
            for (int e = 0; e < 4; ++e) { const int i = 4 * q + e; y[e] = bfe16(R.bg, i) * (cb[e] + w0[e] * m2[e] + w1[e] * m1[e] + w2[e] * bfe16(R.u0, i)); }
            yo[q >> 1][(q & 1) * 2] = cvt_pk_bf16(y[0], y[1]); yo[q >> 1][(q & 1) * 2 + 1] = cvt_pk_bf16(y[2], y[3]);
        }
        *(u32x4*)(Yc + (size_t)row * 1024 + ch) = yo[0]; *(u32x4*)(Yc + (size_t)row * 1024 + ch + 8) = yo[1];
        float sm_ = 0.f;
#pragma unroll
        for (int q = 0; q < 4; ++q) sm_ += R.o[q][0] + R.o[q][1] + R.o[q][2] + R.o[q][3];
        const float mean = quad_sum(sm_) * (1.0f / 64.0f);
        float vr = 0.f;
#pragma unroll
        for (int q = 0; q < 4; ++q)
#pragma unroll
            for (int e = 0; e < 4; ++e) { const float dl = R.o[q][e] - mean; vr += dl * dl; }
        const float rstd = rsqrtf(quad_sum(vr) * (1.0f / 64.0f) + 6.4e-4f);
#pragma unroll
        for (int q = 0; q < 4; ++q) {
            const f32x4 mv = *(const f32x4*)(tab + 4096 + ch + 4 * q), lg = *(const f32x4*)(tab + 5120 + ch + 4 * q), lb = *(const f32x4*)(tab + 6144 + ch + 4 * q);
            f32x4 pq = (f32x4){0.f, 0.f, 0.f, 0.f};
            if (z1) { if (samp) pq = *(const f32x4*)(p.state_shift + (size_t)b * DSHIFT + 2048 + ch + 4 * q); }
            else { pq[0] = bfe16(R.vq, 4 * q); pq[1] = bfe16(R.vq, 4 * q + 1); pq[2] = bfe16(R.vq, 4 * q + 2); pq[3] = bfe16(R.vq, 4 * q + 3); }
            float y[4];
#pragma unroll
            for (int e = 0; e < 4; ++e) { const int i = 4 * q + e; const float vcu = bfe16(R.vc, i); const float vs = vcu + mv[e] * (pq[e] - vcu); y[e] = ((R.o[q][e] - mean) * rstd * lg[e] + lb[e] + R.c3 * vs) * bfe16(R.sg, i); }
            yo[q >> 1][(q & 1) * 2] = cvt_pk_bf16(y[0], y[1]); yo[q >> 1][(q & 1) * 2 + 1] = cvt_pk_bf16(y[2], y[3]);
        }
        *(u32x4*)(Yr + (size_t)row * 1024 + ch) = yo[0]; *(u32x4*)(Yr + (size_t)row * 1024 + ch + 8) = yo[1];
    };
    for (int row = blockIdx.x * 8 + wid; row < MALL; row += gridDim.x * 8) {
        RowRaw Ra;
        load_row(row, Ra);
        process_row(row, Ra);
    }
}

struct SchedP3 {
    int G, c; const char* ws;
    __device__ __forceinline__ bool next(int i, Unit& u) const {
        const int tl = (i / 3) * G + c, seg = i % 3;
        if (tl >= 256) return false;
        u.x = tl >> 2; u.y = tl & 3; u.z = seg;
        u.a = ws + (seg == 0 ? WS_YCONV : seg == 1 ? WS_YRWKV : WS_YMEM) + (size_t)u.x * 256 * 2048; u.b = ws + WS_WB + ((size_t)seg * 1024 + (size_t)u.y * 256) * 2048;
        return true;
    }
};
struct SchedP3T {
    int G, c; const char* ws;
    __device__ __forceinline__ bool next(int i, Unit& u) const {
        const int e = i * G + c;
        if (e >= 96) return false;
        const int tt = e / 6, r = e % 6, seg = r >> 1, kh = r & 1;
        u.x = 64 + (tt >> 2); u.y = tt & 3; u.z = r;
        u.a = ws + (seg == 0 ? WS_YCONV : seg == 1 ? WS_YRWKV : WS_YMEM) + (size_t)u.x * 256 * 2048 + kh * 1024;
        u.b = ws + WS_WB + ((size_t)seg * 1024 + (size_t)u.y * 256) * 2048 + kh * 1024;
        return true;
    }
};
struct EpiP3T {
    const bf16_t* ACT; float* PART;
    __device__ __forceinline__ bool operator()(f32x4 (&acc)[2][2][4][2], const Unit& u, int wr, int wc, int fr, int fq) const {
        const int seg = u.z >> 1, rbase = u.x * 256 + wr * 64 + fr, cb = u.y * 256 + wc * 32 + 8 * fq;
        const bf16_t* gbase = ACT + C_GATE + seg * 1024 + cb;
#pragma unroll
        for (int ai = 0; ai < 2; ++ai) {
            u32x4 g[4][2];
#pragma unroll
            for (int m = 0; m < 4; ++m)
#pragma unroll
                for (int bj = 0; bj < 2; ++bj) g[m][bj] = *(const u32x4*)(gbase + (size_t)(rbase + ai * 128 + m * 16) * ACT_LD + 128 * bj);
#pragma unroll
            for (int m = 0; m < 4; ++m)
#pragma unroll
                for (int bj = 0; bj < 2; ++bj) {
                    f32x4 v0 = acc[ai][bj][m][0], v1 = acc[ai][bj][m][1];
                    v0[0] *= bflo(g[m][bj][0]); v0[1] *= bfhi(g[m][bj][0]); v0[2] *= bflo(g[m][bj][1]); v0[3] *= bfhi(g[m][bj][1]);
                    v1[0] *= bflo(g[m][bj][2]); v1[1] *= bfhi(g[m][bj][2]); v1[2] *= bflo(g[m][bj][3]); v1[3] *= bfhi(g[m][bj][3]);
                    float* dst = PART + ((size_t)u.z * 1024 + (size_t)(rbase + ai * 128 + m * 16 - MP)) * 1024 + cb + 128 * bj;
                    *(f32x4*)dst = v0; *(f32x4*)(dst + 4) = v1;
                }
        }
        return false;
    }
};
struct EpiP3 {
    const bf16_t* ACT; bf16_t* MERGED;
    __device__ __forceinline__ bool operator()(f32x4 (&acc)[2][2][4][2], const Unit& u, int wr, int wc, int fr, int fq) const {
        const int seg = u.z, rbase = u.x * 256 + wr * 64 + fr, cb = u.y * 256 + wc * 32 + 8 * fq;
        const bf16_t* gbase = ACT + C_GATE + seg * 1024 + cb;
#pragma unroll
        for (int ai = 0; ai < 2; ++ai) {
            u32x4 g[4][2], g2[4][2];
#pragma unroll
            for (int m = 0; m < 4; ++m)
#pragma unroll
                for (int bj = 0; bj < 2; ++bj) {
                    const bf16_t* gp = gbase + (size_t)(rbase + ai * 128 + m * 16) * ACT_LD + 128 * bj;
                    g[m][bj] = *(const u32x4*)gp;
                    if (seg < 2) g2[m][bj] = *(const u32x4*)(gp + 1024);
                }
#pragma unroll
            for (int m = 0; m < 4; ++m)
#pragma unroll
                for (int bj = 0; bj < 2; ++bj) {
                    float f[8];
#pragma unroll
                    for (int e = 0; e < 4; ++e) { f[2 * e] = bflo(g[m][bj][e]); f[2 * e + 1] = bfhi(g[m][bj][e]); }
                    if (seg < 2) {
#pragma unroll
                        for (int e = 0; e < 4; ++e) { f[2 * e] *= fast_rcp(bflo(g2[m][bj][e])); f[2 * e + 1] *= fast_rcp(bfhi(g2[m][bj][e])); }
                    }
                    f32x4& v0 = acc[ai][bj][m][0]; f32x4& v1 = acc[ai][bj][m][1];
#pragma unroll
                    for (int e = 0; e < 4; ++e) { v0[e] *= f[e]; v1[e] *= f[4 + e]; }
                    if (seg == 2) {
                        u32x4 o; o[0] = cvt_pk_bf16(v0[0], v0[1]); o[1] = cvt_pk_bf16(v0[2], v0[3]); o[2] = cvt_pk_bf16(v1[0], v1[1]); o[3] = cvt_pk_bf16(v1[2], v1[3]);
                        *(u32x4*)(MERGED + (size_t)(rbase + ai * 128 + m * 16) * 1024 + cb + 128 * bj) = o;
                    }
                }
        }
        return seg < 2;
    }
};
struct SchedP4 {
    int G, c; const char* A; const char* B;
    __device__ __forceinline__ bool next(int i, Unit& u) const {
        const int tl = i * G + c;
        if (tl >= 256) return false;
        u.x = tl >> 2; u.y = tl & 3; u.z = 0;
        u.a = A + (size_t)u.x * 256 * 2048; u.b = B + (size_t)u.y * 256 * 2048;
        return true;
    }
};
struct SchedP4T {
    int G, c; const char* A; const char* B;
    __device__ __forceinline__ bool next(int i, Unit& u) const {
        const int e = i * G + c;
        if (e >= 64) return false;
        const int tt = e >> 2, kq = e & 3;
        u.x = 64 + (tt >> 2); u.y = tt & 3; u.z = kq;
        u.a = A + (size_t)u.x * 256 * 2048 + kq * 512; u.b = B + (size_t)u.y * 256 * 2048 + kq * 512;
        return true;
    }
};
struct EpiP4T {
    float* PART;
    __device__ __forceinline__ bool operator()(f32x4 (&acc)[2][2][4][2], const Unit& u, int wr, int wc, int fr, int fq) const {
        const int rbase = u.x * 256 + wr * 64 + fr - MP, cbase = u.y * 256 + wc * 32 + fq * 4;
#pragma unroll
        for (int ai = 0; ai < 2; ++ai)
#pragma unroll
            for (int m = 0; m < 4; ++m)
#pragma unroll
                for (int bj = 0; bj < 2; ++bj)
#pragma unroll
                    for (int n = 0; n < 2; ++n)
                        *(f32x4*)(PART + ((size_t)u.z * 1024 + (size_t)(rbase + ai * 128 + m * 16)) * 1024 + cbase + bj * 128 + n * 16) = acc[ai][bj][m][n];
        return false;
    }
};
__device__ void p3_tail_fixup(const Params& p) {
    const int tid = opaque_tid();
    const float* P0 = (const float*)(p.ws + WS_PART);
    bf16_t* dst = (bf16_t*)(p.ws + WS_MERGED) + (size_t)MP * 1024;
    for (int idx = blockIdx.x * NTHREADS + tid; idx < 1024 * 128; idx += gridDim.x * NTHREADS) {
        const size_t o = (size_t)idx * 8;
        f32x4 a0 = *(const f32x4*)(P0 + o), a1 = *(const f32x4*)(P0 + o + 4);
#pragma unroll
        for (int q = 1; q < 6; ++q) { a0 += *(const f32x4*)(P0 + (size_t)q * 1024 * 1024 + o); a1 += *(const f32x4*)(P0 + (size_t)q * 1024 * 1024 + o + 4); }
        u32x4 w; w[0] = cvt_pk_bf16(a0[0], a0[1]); w[1] = cvt_pk_bf16(a0[2], a0[3]); w[2] = cvt_pk_bf16(a1[0], a1[1]); w[3] = cvt_pk_bf16(a1[2], a1[3]);
        *(u32x4*)(dst + o) = w;
    }
}
struct EpiP4 {
    const float* xp; const float* xs; float* out; float* SUMSQ;
    __device__ __forceinline__ bool operator()(f32x4 (&acc)[2][2][4][2], const Unit& u, int wr, int wc, int fr, int fq) const {
        const int rbase = u.x * 256 + wr * 64 + fr, cbase = u.y * 256 + wc * 32 + fq * 4;
#pragma unroll
        for (int ai = 0; ai < 2; ++ai) {
            f32x4 xv[4][2][2];
#pragma unroll
            for (int m = 0; m < 4; ++m) {
                const int row = rbase + ai * 128 + m * 16;
                const float* xr = row < MP ? xp + (size_t)row * 1024 : xs + (size_t)(row - MP) * 1024;
#pragma unroll
                for (int bj = 0; bj < 2; ++bj)
#pragma unroll
                    for (int n = 0; n < 2; ++n) xv[m][bj][n] = *(const f32x4*)(xr + cbase + bj * 128 + n * 16);
            }
#pragma unroll
            for (int m = 0; m < 4; ++m) {
                const int row = rbase + ai * 128 + m * 16;
                float ss = 0.f;
#pragma unroll
                for (int bj = 0; bj < 2; ++bj)
#pragma unroll
                    for (int n = 0; n < 2; ++n) {
                        const f32x4 v = acc[ai][bj][m][n] + xv[m][bj][n];
                        ss += v[0] * v[0] + v[1] * v[1] + v[2] * v[2] + v[3] * v[3];
                        *(f32x4*)(out + OUT_Y + (size_t)row * 1024 + cbase + bj * 128 + n * 16) = v;
                    }
                ss += __shfl_xor(ss, 16, 64); ss += __shfl_xor(ss, 32, 64);
                if (fq == 0) SUMSQ[(size_t)row * 16 + u.y * 4 + wc] = ss;
            }
        }
        return false;
    }
};
__device__ void phase5(const Params& p) {
    const int tid5 = opaque_tid(); const int lane = tid5 & 63, wid = tid5 >> 6;
    const float* SUMSQ = (const float*)(p.ws + WS_SUMSQ);
    const float* PART = (const float*)(p.ws + WS_PART);
    for (int row = blockIdx.x * 8 + wid; row < MALL; row += gridDim.x * 8) {
        float* y = p.out + OUT_Y + (size_t)row * 1024;
        f32x4 v[4]; float ss;
        if (row < MP) {
            ss = lane < 16 ? SUMSQ[(size_t)row * 16 + lane] : 0.f;
#pragma unroll
            for (int i = 0; i < 4; ++i) v[i] = *(const f32x4*)(y + i * 256 + lane * 4);
        } else {
            const float* xr = p.x_sample + (size_t)(row - MP) * 1024; ss = 0.f;
#pragma unroll
            for (int i = 0; i < 4; ++i) {
                v[i] = *(const f32x4*)(xr + i * 256 + lane * 4);
#pragma unroll
                for (int q = 0; q < 4; ++q) v[i] += *(const f32x4*)(PART + ((size_t)q * 1024 + (size_t)(row - MP)) * 1024 + i * 256 + lane * 4);
                ss += v[i][0] * v[i][0] + v[i][1] * v[i][1] + v[i][2] * v[i][2] + v[i][3] * v[i][3];
            }
        }
        ss = wave_sum(ss);
        const float inv = rsqrtf(ss * (1.0f / 1024.0f) + 1e-6f);
#pragma unroll
        for (int i = 0; i < 4; ++i) {
            const f32x4 g = *(const f32x4*)(p.norm_final + i * 256 + lane * 4);
            *(f32x4*)(y + i * 256 + lane * 4) = v[i] * inv * g;
        }
    }
}

__global__ void __launch_bounds__(NTHREADS) fwd_megakernel(Params p) {
    extern __shared__ __attribute__((aligned(16))) unsigned char smem[];
    cg::grid_group grid = cg::this_grid();
    LAS unsigned char* lds = (LAS unsigned char*)smem;
#ifndef PROBE_REP
#define PROBE_REP 0
#endif
#define REP(k) for (int _r = 0; _r < ((PROBE_REP == (k)) ? 2 : 1); ++_r)
    volatile LAS unsigned* xst = (volatile LAS unsigned*)(lds + LDS_MAIN);
    if (threadIdx.x == 0) { xst[0] = 0u; xst[1] = 0u; xst[2] = 0u; xst[3] = 0u; }
    __syncthreads();
    (void)xcd_barrier_post((unsigned*)(p.ws + WS_BAR), xst);
#define XBAR() do { XcdBarrier _b; _b.bar = (unsigned*)(p.ws + WS_BAR); _b.x = xb_xcc_id(); _b.st = (volatile LAS unsigned*)(lds + LDS_MAIN); xcd_barrier(_b); } while (0)
    REP(1) { phase0(p, smem); if (PROBE_REP == 1 && _r == 0) XBAR(); }
    if (p.ws == nullptr) grid.sync();
    XBAR();
    REP(2) {
        SchedP1 S{(int)gridDim.x, (int)blockIdx.x, (const char*)(p.ws + WS_AALL), (const char*)(p.ws + WS_BALL)};
        EpiP1 E{(bf16_t*)(p.ws + WS_U), (bf16_t*)(p.ws + WS_BG), (bf16_t*)(p.ws + WS_ACT), p.out, (bf16_t*)(p.ws + WS_KBF), (bf16_t*)(p.ws + WS_VT)};
        gemm_phase(lds, 2048, 2048, 1024, S, E);
        XBAR();
        if (PROBE_REP == 9) { EpiNull EN{(float*)(p.ws + WS_SUMSQ)}; gemm_phase(lds, 2048, 2048, 1024, S, EN); XBAR(); }
    }
    REP(3) { phase2_scan(p, smem); if (PROBE_REP == 3) XBAR(); }
    REP(5) { phase2_attn(p, smem); if (PROBE_REP == 5) XBAR(); }
    XBAR();
    REP(6) { phase2b(p, smem); XBAR(); }
    REP(7) {
        SchedP3 S{(int)gridDim.x, (int)blockIdx.x, (const char*)p.ws};
        EpiP3 E{(const bf16_t*)(p.ws + WS_ACT), (bf16_t*)(p.ws + WS_MERGED)};
        gemm_phase(lds, 2048, 2048, 1024, S, E);
        SchedP3T ST{(int)gridDim.x, (int)blockIdx.x, (const char*)p.ws};
        EpiP3T ET{(const bf16_t*)(p.ws + WS_ACT), (float*)(p.ws + WS_PART)};
        gemm_phase(lds, 2048, 2048, 512, ST, ET);
        XBAR();
        if (_r == 0) { p3_tail_fixup(p); XBAR(); }
    }
    REP(8) {
        SchedP4 S{(int)gridDim.x, (int)blockIdx.x, (const char*)(p.ws + WS_MERGED), (const char*)(p.ws + WS_WO)};
        EpiP4 E{p.x_prompt, p.x_sample, p.out, (float*)(p.ws + WS_SUMSQ)};
        gemm_phase(lds, 2048, 2048, 1024, S, E);
        SchedP4T ST{(int)gridDim.x, (int)blockIdx.x, (const char*)(p.ws + WS_MERGED), (const char*)(p.ws + WS_WO)};
        EpiP4T ET{(float*)(p.ws + WS_PART)};
        gemm_phase(lds, 2048, 2048, 256, ST, ET);
        XBAR();
    }
    phase5(p);
}

extern "C" void kernel_launch(void* const* d_in, const int* in_sizes, int n_in, void* d_out, int out_size, void* d_ws, size_t ws_size, hipStream_t stream) {
    static int grid_blocks = 0;
    if (!grid_blocks) {
        int dev = 0, cus = 0, per_cu = 0;
        hipGetDevice(&dev);
        hipDeviceGetAttribute(&cus, hipDeviceAttributeMultiprocessorCount, dev);
        if (hipFuncSetAttribute((const void*)fwd_megakernel, hipFuncAttributeMaxDynamicSharedMemorySize, LDS_BYTES) != hipSuccess) fprintf(stderr, "hipFuncSetAttribute failed\n");
        hipOccupancyMaxActiveBlocksPerMultiprocessor(&per_cu, (const void*)fwd_megakernel, NTHREADS, LDS_BYTES);
        if (per_cu < 1) { fprintf(stderr, "occupancy query returned %d\n", per_cu); per_cu = 1; }
        if (per_cu > 1) per_cu = 1;
        grid_blocks = cus * per_cu;
        if (grid_blocks > 256) grid_blocks = 256;
        grid_blocks &= ~31;
        if (grid_blocks < 64) grid_blocks = -1;
        if (ws_size < WS_END) { fprintf(stderr, "workspace too small: %zu < %zu\n", ws_size, (size_t)WS_END); grid_blocks = -1; }
    }
    if (grid_blocks < 0) return;
    Params p{};
    const float** pp = (const float**)&p;
    for (int i = 0; i < 27; ++i) pp[i] = (const float*)d_in[i];
    p.out = (float*)d_out; p.ws = (unsigned char*)d_ws;
    if (hipMemsetAsync((char*)d_ws + WS_BAR, 0, (size_t)XCD_BAR_WORDS_C * 4, stream) != hipSuccess) fprintf(stderr, "memset of barrier words failed\n");
    void* args[] = {&p};
    hipError_t e = hipLaunchCooperativeKernel((const void*)fwd_megakernel, dim3(grid_blocks), dim3(NTHREADS), args, LDS_BYTES, stream);
    if (e != hipSuccess) fprintf(stderr, "cooperative launch failed: %s (grid %d)\n", hipGetErrorString(e), grid_blocks);
}
```

```cpp
#include <hip/hip_runtime.h>
#include <hip/hip_cooperative_groups.h>
#include <cstdio>
namespace cg = cooperative_groups;

#define LAS __attribute__((address_space(3)))
typedef unsigned short bf16_t;
typedef short bf16x8 __attribute__((ext_vector_type(8)));
typedef float f32x4 __attribute__((ext_vector_type(4)));
typedef float f32x2 __attribute__((ext_vector_type(2)));
typedef unsigned u32x4 __attribute__((ext_vector_type(4)));
typedef unsigned u32x2 __attribute__((ext_vector_type(2)));

constexpr int DM = 1024, TP = 2048, BP = 8, MP = BP * TP, BS = 128, TS = 8, MS = BS * TS, MALL = MP + MS;
constexpr int NMEM = 256, DIN = 13440, DSHIFT = 3200;
constexpr int NPAD = 13568;
constexpr int ACT_LD = 9472;
constexpr int C_PR = 0, C_PK = 1024, C_PV = 2048, C_WD = 3072, C_AD = 3136, C_SGR = 3328, C_QM = 4352, C_SGM = 5376, C_GATE = 6400;
constexpr size_t OUT_Y = 0, OUT_MK = 17825792, OUT_MV = 19922944, OUT_CONV_P = 22020096, OUT_SHIFT_P = 22036480, OUT_WKV_P = 22062080,
                 OUT_CONV_S = 22586368, OUT_SHIFT_S = 22848512, OUT_WKV_S = 23258112;
constexpr size_t al256(size_t x) { return (x + 255) & ~(size_t)255; }
constexpr int XCD_BAR_WORDS_C = 3456;
constexpr size_t WS_AALL = 0;
constexpr size_t WS_BALL = al256(WS_AALL + (size_t)19456 * 1024 * 2);
constexpr size_t WS_YMEM = WS_AALL;
constexpr size_t WS_YCONV = WS_AALL + (size_t)MALL * 1024 * 2;
constexpr size_t WS_WB = al256(WS_BALL + (size_t)15616 * 1024 * 2);
constexpr size_t WS_WO = al256(WS_WB + (size_t)3072 * 1024 * 2);
constexpr size_t WS_U = al256(WS_WO + (size_t)1024 * 1024 * 2);
constexpr size_t WS_MERGED = WS_U;
constexpr size_t WS_BG = al256(WS_U + (size_t)MALL * 1024 * 2);
constexpr size_t WS_PART = WS_BG;
constexpr size_t WS_PRIV = WS_BG + (size_t)6 * 1024 * 1024 * 4;
constexpr size_t WS_ACT = al256(WS_BG + (size_t)MALL * 1024 * 2);
constexpr size_t WS_KBF = al256(WS_ACT + (size_t)MALL * ACT_LD * 2);
constexpr size_t WS_VT = al256(WS_KBF + (size_t)2048 * 1024 * 2);
constexpr size_t WS_YRWKV = al256(WS_VT + (size_t)2048 * 1024 * 2);
constexpr size_t WS_C3 = al256(WS_YRWKV + (size_t)MALL * 1024 * 2);
constexpr size_t WS_SUMSQ = al256(WS_C3 + (size_t)MALL * 16 * 4);
constexpr size_t WS_BAR = al256(WS_SUMSQ + (size_t)MALL * 16 * 4);
constexpr size_t WS_FRAG = al256(WS_BAR + (size_t)XCD_BAR_WORDS_C * 4);
constexpr size_t WS_END = al256(WS_FRAG + (size_t)16 * 2 * 8 * 64 * 16);
static_assert(WS_YCONV + (size_t)MALL * 1024 * 2 <= WS_WB, "alias overflow");
static_assert(WS_END <= 536870912, "workspace too large");
static_assert(WS_PRIV + (size_t)16 * 256 * 1024 * 2 <= WS_ACT, "tail scratch overflows BG");

constexpr int NTHREADS = 512;
constexpr int LDS_MAIN = 131072;
constexpr int LDS_BYTES = LDS_MAIN + 16;

struct Params {
    const float *x_prompt, *x_sample, *mem_prompt, *cache_k, *cache_v, *state_conv, *state_shift, *state_wkv, *norm_in, *w_in, *conv_w, *conv_b,
        *shift_mu, *decay_w0, *decay_up, *icl_a0, *icl_up, *k_k, *k_a, *r_k, *ln_g, *ln_b, *norm_mem, *w_mem_kv, *w_branch, *w_out, *norm_final;
    float* out;
    unsigned char* ws;
};

__device__ __forceinline__ int opaque_tid() { int t = threadIdx.x; asm volatile("" : "+v"(t)); return t; }
__device__ __forceinline__ float bf2f(bf16_t v) { return __uint_as_float(((unsigned)v) << 16); }
__device__ __forceinline__ unsigned cvt_pk_bf16(float lo, float hi) { unsigned r; asm volatile("v_cvt_pk_bf16_f32 %0, %1, %2" : "=v"(r) : "v"(lo), "v"(hi)); return r; }
__device__ __forceinline__ float bflo(unsigned u) { return __uint_as_float(u << 16); }
__device__ __forceinline__ float bfhi(unsigned u) { return __uint_as_float(u & 0xffff0000u); }
__device__ __forceinline__ float fast_rcp(float x) { return __builtin_amdgcn_rcpf(x); }
__device__ __forceinline__ float sigmoidf_(float x) { return fast_rcp(1.0f + __expf(-x)); }
__device__ __forceinline__ float siluf_(float x) { return x * sigmoidf_(x); }
__device__ __forceinline__ float wave_sum(float v) {
#pragma unroll
    for (int o = 32; o > 0; o >>= 1) v += __shfl_xor(v, o, 64);
    return v;
}
template <int CTRL> __device__ __forceinline__ float dpp_f(float x) {
    return __int_as_float(__builtin_amdgcn_update_dpp(0, __float_as_int(x), CTRL, 0xF, 0xF, true));
}
__device__ __forceinline__ float row16_sum(float x) {
    x += dpp_f<0xB1>(x);
    x += dpp_f<0x4E>(x);
    x += dpp_f<0x141>(x);
    x += dpp_f<0x140>(x);
    return x;
}


#define XB_TMO      128
#define XB_XCNT(j)  (256  + 64 * (j))
#define XB_XSUB(j)  (1280 + 64 * (j))
#define XB_XGEN(j)  (2304 + 64 * (j))
#define XB_TOP      3328
#define XB_TOPGEN   3392
#define XCD_BAR_WORDS 3456
#define XB_SPIN_CAP (1u << 22)
__device__ __forceinline__ unsigned xb_ld(unsigned* p)              { return __hip_atomic_load(p, __ATOMIC_RELAXED, __HIP_MEMORY_SCOPE_AGENT); }
__device__ __forceinline__ unsigned xb_add(unsigned* p, unsigned v) { return __hip_atomic_fetch_add(p, v, __ATOMIC_RELAXED, __HIP_MEMORY_SCOPE_AGENT); }
__device__ __forceinline__ unsigned xb_xcc_id() { return (unsigned)__builtin_amdgcn_s_getreg((3 << 11) | 20) & 0xFu; }
#define XB_SPIN(cond, bar) do { unsigned _sp = 0; while (cond) { __builtin_amdgcn_s_sleep(1); \
    if ((++_sp & 255u) == 0u) { if (xb_ld(&(bar)[XB_TMO])) break; if (_sp > XB_SPIN_CAP) { atomicAdd(&(bar)[XB_TMO], 1u); break; } } } } while (0)
struct XcdBarrier { unsigned* bar; unsigned x; volatile LAS unsigned* st; };
__device__ __forceinline__ XcdBarrier xcd_barrier_post(unsigned* bar, volatile LAS unsigned* st) {
    XcdBarrier b; b.bar = bar; b.x = xb_xcc_id(); b.st = st;
    if (threadIdx.x == 0) (void)xb_add(&bar[XB_XCNT(b.x)], 1u);
    return b;
}
__device__ __forceinline__ void xcd_barrier_complete(unsigned* bar, unsigned x, unsigned& nloc, unsigned& nx) {
    const unsigned G = gridDim.x * gridDim.y * gridDim.z;
    unsigned sum, cnt, mine, sp = 0u;
    for (;;) {
        sum = 0u; cnt = 0u; mine = 0u;
#pragma unroll
        for (unsigned j = 0; j < 16; ++j) { const unsigned c = xb_ld(&bar[XB_XCNT(j)]); sum += c; cnt += (c > 0u) ? 1u : 0u; mine = (j == x) ? c : mine; }
        if (sum == G) break;
        __builtin_amdgcn_s_sleep(1);
        if ((++sp & 255u) == 0u) { if (xb_ld(&bar[XB_TMO])) break; if (sp > XB_SPIN_CAP) { atomicAdd(&bar[XB_TMO], 1u); break; } }
    }
    nloc = mine > 0u ? mine : 1u; nx = cnt > 0u ? cnt : 1u;
}
__device__ __forceinline__ void xcd_barrier(const XcdBarrier& b) {
    asm volatile("s_waitcnt vmcnt(0)" ::: "memory");
    __syncthreads();
    if (threadIdx.x == 0) {
        unsigned* bar = b.bar;
        __builtin_amdgcn_s_waitcnt(0);
        unsigned nloc = b.st[0], nx = b.st[1];
        if (nloc == 0u) { xcd_barrier_complete(bar, b.x, nloc, nx); b.st[0] = nloc; b.st[1] = nx; }
        const unsigned old = xb_add(&bar[XB_XSUB(b.x)], 1u);
        const unsigned gen = old / nloc;
        if (old + 1u == (gen + 1u) * nloc) {
            __builtin_amdgcn_fence(__ATOMIC_RELEASE, "agent");
            asm volatile("s_waitcnt vmcnt(0)" ::: "memory");
            const unsigned og = xb_add(&bar[XB_TOP], 1u);
            const unsigned tg = og / nx;
            if (og + 1u == (tg + 1u) * nx) xb_add(&bar[XB_TOPGEN], 1u);
            else XB_SPIN(xb_ld(&bar[XB_TOPGEN]) == tg, bar);
            __builtin_amdgcn_fence(__ATOMIC_ACQUIRE, "agent");
            xb_add(&bar[XB_XGEN(b.x)], 1u);
            asm volatile("s_waitcnt vmcnt(0)" ::: "memory");
        } else {
            XB_SPIN(xb_ld(&bar[XB_XGEN(b.x)]) == gen, bar);
            __builtin_amdgcn_fence(__ATOMIC_ACQUIRE, "agent");
            asm volatile("s_waitcnt vmcnt(0)" ::: "memory");
        }
    }
    __syncthreads();
}

constexpr int BM = 256, BK = 64, HALF = 128, HTB = HALF * BK * 2;
__device__ __forceinline__ int lds_byte(int r, int c) { const int st = (r >> 4) * 2 + (c >> 5), rr = r & 15, cc = c & 31, ob = rr * 64 + cc * 2; return st * 1024 + (ob ^ (((ob >> 9) & 1) << 5)); }
__device__ __forceinline__ void stage_rc(int b, int& R, int& C) { const int st = b / 1024, sb = b % 1024, swz = sb ^ (((sb >> 9) & 1) << 5); R = (st >> 1) * 16 + swz / 64; C = (st & 1) * 32 + (swz % 64) / 2; }

struct Unit { const char* a; const char* b; int x, y, z; };

template <class Sched, class Epi>
__device__ __forceinline__ void gemm_phase(LAS unsigned char* lds, const int lda, const int ldb, const int K, const Sched& S, const Epi& E) {
    const int tid = opaque_tid(), wid = __builtin_amdgcn_readfirstlane(tid >> 6), lane = tid & 63, wr = wid >> 2, wc = wid & 3, fr = lane & 15, fq = lane >> 4;
    const int nt = K / BK;
    unsigned voffA[2], voffB[2];
#pragma unroll
    for (int i = 0; i < 2; ++i) { int R, C; stage_rc(tid * 16 + i * 8192, R, C); voffA[i] = (unsigned)(R * lda + C * 2); voffB[i] = (unsigned)(R * ldb + C * 2); }
    const size_t kstep = (size_t)(BK * 2);
    const size_t hA = (size_t)HALF * lda, hB = (size_t)HALF * ldb;
    const unsigned ldsw = (unsigned)wid * 1024u;
    const int aoff = lds_byte(wr * 64 + fr, fq * 8), boff = lds_byte(wc * 32 + fr, fq * 8);
#define G_SA(b, h) (((b) * 2 + (h)) * HTB)
#define G_SB(b, h) ((4 + (b) * 2 + (h)) * HTB)
#define G_STAGE(bufoff, gbase, voff) do { _Pragma("unroll") for (int _i = 0; _i < 2; ++_i) \
        __builtin_amdgcn_global_load_lds((const unsigned*)((const char*)(gbase) + (voff)[_i]), (LAS unsigned*)(lds + (bufoff) + ldsw + _i * 8192), 16, 0, 0); } while (0)
#define G_LDA(dst, b, h) do { _Pragma("unroll") for (int m = 0; m < 4; ++m) _Pragma("unroll") for (int k = 0; k < 2; ++k) dst[m][k] = *(const LAS bf16x8*)(lds + G_SA(b, h) + aoff + m * 2048 + k * 1024); } while (0)
#define G_LDB(dst, b, h) do { _Pragma("unroll") for (int n = 0; n < 2; ++n) _Pragma("unroll") for (int k = 0; k < 2; ++k) dst[n][k] = *(const LAS bf16x8*)(lds + G_SB(b, h) + boff + n * 2048 + k * 1024); } while (0)
#define G_MMA(ai, bj, At, Bt) do { __builtin_amdgcn_s_setprio(1); _Pragma("unroll") for (int m = 0; m < 4; ++m) _Pragma("unroll") for (int n = 0; n < 2; ++n) _Pragma("unroll") for (int k = 0; k < 2; ++k) \
        acc[ai][bj][m][n] = __builtin_amdgcn_mfma_f32_16x16x32_bf16(Bt[n][k], At[m][k], acc[ai][bj][m][n], 0, 0, 0); __builtin_amdgcn_s_setprio(0); } while (0)
#define G_WAIT_V(n) asm volatile("s_waitcnt vmcnt(" #n ")" ::: "memory")
#define G_WAIT_L(n) asm volatile("s_waitcnt lgkmcnt(" #n ")" ::: "memory")
#define G_BAR __builtin_amdgcn_s_barrier()
#define G_SCHED __builtin_amdgcn_sched_barrier(0)
    Unit cur, nxt; int ui = 0;
    if (!S.next(0, cur)) return;
    f32x4 acc[2][2][4][2];
#pragma unroll
    for (int a = 0; a < 2; ++a)
#pragma unroll
        for (int b = 0; b < 2; ++b)
#pragma unroll
            for (int m = 0; m < 4; ++m)
#pragma unroll
                for (int n = 0; n < 2; ++n) acc[a][b][m][n] = (f32x4){0.f, 0.f, 0.f, 0.f};
    bf16x8 At[4][2], B0[2][2], B1[2][2];
    const char* cA = cur.a; const char* cB = cur.b;
    G_STAGE(G_SB(0, 0), cB, voffB); G_STAGE(G_SA(0, 0), cA, voffA); G_STAGE(G_SB(0, 1), cB + hB, voffB); G_STAGE(G_SA(0, 1), cA + hA, voffA);
    if (wr == 1) G_BAR;
    G_WAIT_V(4); G_BAR;
    G_STAGE(G_SB(1, 0), cB + kstep, voffB); G_STAGE(G_SA(1, 0), cA + kstep, voffA); G_STAGE(G_SB(1, 1), cB + hB + kstep, voffB);
    G_WAIT_V(6); G_BAR;
    for (;;) {
        const bool has_next = S.next(ui + 1, nxt);
        const char* nA = has_next ? nxt.a : cA; const char* nB = has_next ? nxt.b : cB;
        for (int t = 0; t < nt; t += 2) {
            const bool last = (t == nt - 2);
            const char* a1 = cA + (size_t)(t + 1) * kstep;
            const char* a2 = last ? nA : cA + (size_t)(t + 2) * kstep; const char* b2 = last ? nB : cB + (size_t)(t + 2) * kstep;
            const char* a3 = a2 + kstep; const char* b3 = b2 + kstep;
            G_LDB(B0, 0, 0); G_SCHED; G_LDA(At, 0, 0); G_STAGE(G_SA(1, 1), a1 + hA, voffA);
            G_WAIT_L(8); G_BAR; G_WAIT_L(0); G_MMA(0, 0, At, B0); G_BAR; G_SCHED;
            G_LDB(B1, 0, 1); G_STAGE(G_SB(0, 0), b2, voffB);
            G_BAR; G_WAIT_L(0); G_MMA(0, 1, At, B1); G_BAR;
            G_LDA(At, 0, 1); G_STAGE(G_SA(0, 0), a2, voffA);
            G_BAR; G_WAIT_L(0); G_MMA(1, 0, At, B0); G_BAR; G_SCHED;
            G_STAGE(G_SB(0, 1), b2 + hB, voffB);
            G_WAIT_V(6); G_BAR; G_MMA(1, 1, At, B1); G_BAR;
            G_LDB(B0, 1, 0); G_SCHED; G_LDA(At, 1, 0); G_STAGE(G_SA(0, 1), a2 + hA, voffA);
            G_WAIT_L(8); G_BAR; G_WAIT_L(0); G_MMA(0, 0, At, B0); G_BAR; G_SCHED;
            G_LDB(B1, 1, 1); G_STAGE(G_SB(1, 0), b3, voffB);
            G_BAR; G_WAIT_L(0); G_MMA(0, 1, At, B1); G_BAR;
            G_LDA(At, 1, 1); G_STAGE(G_SA(1, 0), a3, voffA);
            G_BAR; G_WAIT_L(0); G_MMA(1, 0, At, B0); G_BAR; G_SCHED;
            G_STAGE(G_SB(1, 1), b3 + hB, voffB);
            G_WAIT_V(6); G_BAR; G_MMA(1, 1, At, B1); G_BAR;
        }
        const bool keep = E(acc, cur, wr, wc, fr, fq);
        if (!has_next) break;
        if (!keep) {
#pragma unroll
            for (int a = 0; a < 2; ++a)
#pragma unroll
                for (int b = 0; b < 2; ++b)
#pragma unroll
                    for (int m = 0; m < 4; ++m)
#pragma unroll
                        for (int n = 0; n < 2; ++n) acc[a][b][m][n] = (f32x4){0.f, 0.f, 0.f, 0.f};
        }
        cur = nxt; cA = nA; cB = nB; ++ui;
    }
    G_WAIT_V(0);
    if (wr == 0) G_BAR;
    G_BAR;
#undef G_SA
#undef G_SB
#undef G_STAGE
#undef G_LDA
#undef G_LDB
#undef G_MMA
#undef G_WAIT_V
#undef G_WAIT_L
#undef G_BAR
#undef G_SCHED
}

__device__ __forceinline__ int perm8_local(int c) {
    const int bj = c >> 7, wc = (c >> 5) & 3, n = (c >> 4) & 1, fq = (c >> 2) & 3, e = c & 3;
    return 128 * bj + 32 * wc + 8 * fq + 4 * n + e;
}
__device__ __forceinline__ int colmap_in(int np) {
    const int j = np >> 8, c = np & 255;
    if (j < 16) {
        const int bj = c >> 7, wc = (c >> 5) & 3, n = (c >> 4) & 1, fq = (c >> 2) & 3, e = c & 3;
        return (2 * bj + n) * 1024 + j * 64 + wc * 16 + fq * 4 + e;
    }
    const int L = (j - 16) * 256 + perm8_local(c);
    if (L < 3200) return 4096 + L;
    if (L < 3328) return -1;
    return L + 3968;
}

__device__ void phase0(const Params& p, unsigned char* smem) {
    const int tid = opaque_tid(), lane = tid & 63, wid = tid >> 6;
    bf16_t* Aall = (bf16_t*)(p.ws + WS_AALL);
    for (int row = blockIdx.x * 8 + wid; row < 19456; row += gridDim.x * 8) {
        const float* src; const float* g;
        if (row < MP) { src = p.x_prompt + (size_t)row * 1024; g = p.norm_in; }
        else if (row < MALL) { src = p.x_sample + (size_t)(row - MP) * 1024; g = p.norm_in; }
        else { src = p.mem_prompt + (size_t)(row - MALL) * 1024; g = p.norm_mem; }
        f32x4 v[4]; float ss = 0.f;
#pragma unroll
        for (int i = 0; i < 4; ++i) { v[i] = *(const f32x4*)(src + i * 256 + lane * 4); ss += v[i][0] * v[i][0] + v[i][1] * v[i][1] + v[i][2] * v[i][2] + v[i][3] * v[i][3]; }
        ss = wave_sum(ss);
        const float inv = rsqrtf(ss * (1.0f / 1024.0f) + 1e-6f);
#pragma unroll
        for (int i = 0; i < 4; ++i) {
            const f32x4 gg = *(const f32x4*)(g + i * 256 + lane * 4);
            u32x2 o; o[0] = cvt_pk_bf16(v[i][0] * inv * gg[0], v[i][1] * inv * gg[1]); o[1] = cvt_pk_bf16(v[i][2] * inv * gg[2], v[i][3] * inv * gg[3]);
            *(u32x2*)(Aall + (size_t)row * 1024 + i * 256 + lane * 4) = o;
        }
    }
    for (int idx = blockIdx.x * NTHREADS + tid; idx < 16 * 2 * 8 * 64; idx += gridDim.x * NTHREADS) {
        const int ln = idx & 63, f = (idx >> 6) & 7, mat = (idx >> 9) & 1, hh = idx >> 10;
        const int it = f >> 1, ks = f & 1, fr = ln & 15, fq = ln >> 4;
        const float* src = mat ? p.icl_up : p.decay_up;
        float w[8];
#pragma unroll
        for (int jj = 0; jj < 8; ++jj) w[jj] = src[(size_t)(ks * 32 + fq * 8 + jj) * 1024 + hh * 64 + it * 16 + fr];
        u32x4 pk; pk[0] = cvt_pk_bf16(w[0], w[1]); pk[1] = cvt_pk_bf16(w[2], w[3]); pk[2] = cvt_pk_bf16(w[4], w[5]); pk[3] = cvt_pk_bf16(w[6], w[7]);
        *(u32x4*)(p.ws + WS_FRAG + (size_t)idx * 16) = pk;
    }
    bf16_t* T = (bf16_t*)smem;
    const int NT_IN = 212 * 16, NT_KV = 32 * 16, NT_WB = 3 * 16 * 16, NT_WO = 16 * 16;
    const int total = NT_IN + NT_KV + NT_WB + NT_WO;
    for (int tix = blockIdx.x; tix < total; tix += gridDim.x) {
        const float* src; int src_ld; bf16_t* dst; int n0, k0, mode;
        if (tix < NT_IN) { src = p.w_in; src_ld = DIN; dst = (bf16_t*)(p.ws + WS_BALL); n0 = (tix >> 4) * 64; k0 = (tix & 15) * 64; mode = 0; }
        else if (tix < NT_IN + NT_KV) { const int t2 = tix - NT_IN; src = p.w_mem_kv; src_ld = 2048; dst = (bf16_t*)(p.ws + WS_BALL) + (size_t)NPAD * 1024; n0 = (t2 >> 4) * 64; k0 = (t2 & 15) * 64; mode = 1; }
        else if (tix < NT_IN + NT_KV + NT_WB) { const int t2 = tix - NT_IN - NT_KV; const int i = t2 >> 8, t3 = t2 & 255; src = p.w_branch + (size_t)i * 1024 * 1024; src_ld = 1024;
            dst = (bf16_t*)(p.ws + WS_WB) + (size_t)i * 1024 * 1024; n0 = (t3 >> 4) * 64; k0 = (t3 & 15) * 64; mode = 2; }
        else { const int t3 = tix - NT_IN - NT_KV - NT_WB; src = p.w_out; src_ld = 1024; dst = (bf16_t*)(p.ws + WS_WO); n0 = (t3 >> 4) * 64; k0 = (t3 & 15) * 64; mode = 1; }
        {
            const int kk = tid >> 3, seg = tid & 7;
#pragma unroll
            for (int q = 0; q < 2; ++q) {
                const int nl = seg * 8 + q * 4, np = n0 + nl;
                int sc;
                if (mode == 0) sc = colmap_in(np);
                else if (mode == 1) sc = np;
                else sc = (np & ~255) + perm8_local(np & 255);
                f32x4 v = (f32x4){0.f, 0.f, 0.f, 0.f};
                if (sc >= 0) v = *(const f32x4*)(src + (size_t)(k0 + kk) * src_ld + sc);
                const unsigned a = cvt_pk_bf16(v[0], v[1]), b = cvt_pk_bf16(v[2], v[3]);
                T[(nl + 0) * 66 + kk] = (bf16_t)(a & 0xffff); T[(nl + 1) * 66 + kk] = (bf16_t)(a >> 16);
                T[(nl + 2) * 66 + kk] = (bf16_t)(b & 0xffff); T[(nl + 3) * 66 + kk] = (bf16_t)(b >> 16);
            }
        }
        __syncthreads();
        {
            const int nl = tid >> 3, ks = tid & 7;
            const unsigned* tp = (const unsigned*)(T + nl * 66 + ks * 8);
            u32x4 v; v[0] = tp[0]; v[1] = tp[1]; v[2] = tp[2]; v[3] = tp[3];
            *(u32x4*)(dst + (size_t)(n0 + nl) * 1024 + k0 + ks * 8) = v;
        }
        __syncthreads();
    }
}

struct SchedP1 {
    int G, c; const char* Aall; const char* Ball;
    __device__ __forceinline__ bool next(int i, Unit& u) const {
        const int L = i * G + c;
        constexpr int nM = 68, nN = 53, nwg = nM * nN, WGM = 8;
        if (L >= nwg + 96) return false;
        if (L < nwg) {
            int wgid = L; { const int q = nwg / 8, r = nwg % 8, xcd = wgid % 8, off = wgid / 8; wgid = (xcd < r ? xcd * (q + 1) : r * (q + 1) + (xcd - r) * q) + off; }
            const int nig = WGM * nN, gid = wgid / nig, fm = gid * WGM, gsz = (nM - fm) < WGM ? (nM - fm) : WGM;
            u.x = fm + ((wgid % nig) % gsz); u.y = (wgid % nig) / gsz; u.z = 0;
            u.a = Aall + (size_t)u.x * 256 * 2048; u.b = Ball + (size_t)u.y * 256 * 2048;
        } else {
            int k = L - nwg;
            if (k < 32) { u.x = k >> 2; u.y = k & 3; u.z = 1; u.a = Aall + (size_t)(68 + u.x) * 256 * 2048; u.b = Ball + (size_t)(53 + u.y) * 256 * 2048; }
            else if (k < 64) { k -= 32; u.x = k >> 2; u.y = k & 3; u.z = 2; u.a = Aall + (size_t)(68 + u.x) * 256 * 2048; u.b = Ball + (size_t)(57 + u.y) * 256 * 2048; }
            else { k -= 64; u.x = k >> 3; u.y = k & 7; u.z = 3; u.a = Ball + (size_t)(57 + u.x) * 256 * 2048; u.b = Aall + (size_t)(68 + u.y) * 256 * 2048; }
        }
        return true;
    }
};

struct EpiNull { __device__ __forceinline__ bool operator()(f32x4 (&acc)[2][2][4][2], const Unit& u, int wr, int wc, int fr, int fq) const { float t = 0.f;
#pragma unroll
        for (int a = 0; a < 2; ++a)
#pragma unroll
            for (int b = 0; b < 2; ++b)
#pragma unroll
                for (int m = 0; m < 4; ++m)
#pragma unroll
                    for (int n = 0; n < 2; ++n) t += acc[a][b][m][n][0] + acc[a][b][m][n][1] + acc[a][b][m][n][2] + acc[a][b][m][n][3];
        if (t == 123.456f) sink[0] = t; return false; }
    float* sink; };
struct EpiP1 {
    bf16_t* U; bf16_t* BG; bf16_t* ACT; float* out; bf16_t* Kbf; bf16_t* Vt;
    __device__ __forceinline__ bool operator()(f32x4 (&acc)[2][2][4][2], const Unit& u, int wr, int wc, int fr, int fq) const {
        const int type = u.z;
        if (type == 0) {
            const int pn = u.y, rbase = u.x * 256 + wr * 64 + fr;
            if (pn < 16) {
                const int ch0 = pn * 64 + wc * 16 + fq * 4;
#pragma unroll
                for (int ai = 0; ai < 2; ++ai)
#pragma unroll
                    for (int m = 0; m < 4; ++m) {
                        const int row = rbase + ai * 128 + m * 16;
                        const f32x4 h = acc[ai][0][m][0], Bv = acc[ai][0][m][1], Cv = acc[ai][1][m][0], g = acc[ai][1][m][1];
                        const f32x4 u4 = Cv * h;
                        f32x4 bg;
#pragma unroll
                        for (int e = 0; e < 4; ++e) bg[e] = Bv[e] * siluf_(g[e]);
                        u32x2 o; o[0] = cvt_pk_bf16(u4[0], u4[1]); o[1] = cvt_pk_bf16(u4[2], u4[3]);
                        *(u32x2*)(U + (size_t)row * 1024 + ch0) = o;
                        o[0] = cvt_pk_bf16(bg[0], bg[1]); o[1] = cvt_pk_bf16(bg[2], bg[3]);
                        *(u32x2*)(BG + (size_t)row * 1024 + ch0) = o;
                        if (row < MP) { const int t = row & 2047; if (t >= 2046) *(f32x4*)(out + OUT_CONV_P + (size_t)((row >> 11) * 2 + (t - 2046)) * 1024 + ch0) = u4; }
                        else { const int rs = row - MP, t = rs & 7; if (t >= 6) *(f32x4*)(out + OUT_CONV_S + (size_t)((rs >> 3) * 2 + (t - 6)) * 1024 + ch0) = u4; }
                    }
            } else {
                const int L0 = (pn - 16) * 256;
                const int kind = pn <= 28 ? 0 : pn <= 32 ? 1 : pn <= 36 ? 2 : pn <= 40 ? 1 : 3;
#pragma unroll
                for (int ai = 0; ai < 2; ++ai)
#pragma unroll
                    for (int m = 0; m < 4; ++m) {
                        const int row = rbase + ai * 128 + m * 16;
#pragma unroll
                        for (int bj = 0; bj < 2; ++bj) {
                            const int L = L0 + 128 * bj + 32 * wc + 8 * fq;
                            f32x4 v0 = acc[ai][bj][m][0], v1 = acc[ai][bj][m][1];
                            if (kind == 0) {
                                if (L < DSHIFT) {
                                    if (row < MP) { if ((row & 2047) == 2047) { float* d = out + OUT_SHIFT_P + (size_t)(row >> 11) * DSHIFT + L; *(f32x4*)d = v0; *(f32x4*)(d + 4) = v1; } }
                                    else { const int rs = row - MP; if ((rs & 7) == 7) { float* d = out + OUT_SHIFT_S + (size_t)(rs >> 3) * DSHIFT + L; *(f32x4*)d = v0; *(f32x4*)(d + 4) = v1; } }
                                }
                            } else if (kind == 1) {
#pragma unroll
                                for (int e = 0; e < 4; ++e) { v0[e] = siluf_(v0[e]); v1[e] = siluf_(v1[e]); }
                            } else if (kind == 2) { v0 *= 0.0625f; v1 *= 0.0625f; }
                            else {
#pragma unroll
                                for (int e = 0; e < 4; ++e) { v0[e] = sigmoidf_(v0[e]); v1[e] = sigmoidf_(v1[e]); }
                            }
                            u32x4 o; o[0] = cvt_pk_bf16(v0[0], v0[1]); o[1] = cvt_pk_bf16(v0[2], v0[3]); o[2] = cvt_pk_bf16(v1[0], v1[1]); o[3] = cvt_pk_bf16(v1[2], v1[3]);
                            *(u32x4*)(ACT + (size_t)row * ACT_LD + L) = o;
                        }
                    }
            }
        } else {
            const int rbase = u.x * 256 + wr * 64 + fr, cbase = u.y * 256 + wc * 32 + fq * 4;
#pragma unroll
            for (int ai = 0; ai < 2; ++ai)
#pragma unroll
                for (int m = 0; m < 4; ++m) {
                    const int row = rbase + ai * 128 + m * 16;
#pragma unroll
                    for (int bj = 0; bj < 2; ++bj)
#pragma unroll
                        for (int n = 0; n < 2; ++n) {
                            const int col = cbase + bj * 128 + n * 16;
                            const f32x4 v = acc[ai][bj][m][n];
                            if (type == 1) { *(f32x4*)(out + OUT_MK + (size_t)row * 1024 + col) = v;
                                u32x2 o; o[0] = cvt_pk_bf16(v[0], v[1]); o[1] = cvt_pk_bf16(v[2], v[3]); *(u32x2*)(Kbf + (size_t)row * 1024 + col) = o; }
                            else if (type == 2) { *(f32x4*)(out + OUT_MV + (size_t)row * 1024 + col) = v; }
                            else { u32x2 o; o[0] = cvt_pk_bf16(v[0], v[1]); o[1] = cvt_pk_bf16(v[2], v[3]); *(u32x2*)(Vt + (size_t)row * 2048 + col) = o; }
                        }
                }
        }
        return false;
    }
};

struct ChunkDesc { int r0, b, h, half, samp, t0, n, first, last, bstep; };
__device__ __forceinline__ int n_chunks(const int bid, const int G) {
    const int n_long = bid < 256 ? (255 - bid) / G + 1 : 0, n_samp = bid < 4096 ? (4095 - bid) / G + 1 : 0;
    return n_long * 64 + ((n_samp + 3) >> 2);
}
__device__ __forceinline__ bool chunk_desc(const int ci, const int bid, const int G, ChunkDesc& d) {
    const int n_long = bid < 256 ? (255 - bid) / G + 1 : 0;
    const int n_samp = bid < 4096 ? (4095 - bid) / G + 1 : 0;
    const int nc_long = n_long * 64;
    if (ci < nc_long) { const int k = ci >> 6, it = bid + k * G, chain = it >> 1; d.b = chain >> 4; d.h = chain & 15; d.half = it & 1; d.samp = 0; d.r0 = d.b * TP; d.bstep = 0;
        d.t0 = (ci & 63) * 32; d.n = 32; d.first = (ci & 63) == 0; d.last = (ci & 63) == 63; return true; }
    const int k0 = (ci - nc_long) * 4; if (ci < 0 || k0 >= n_samp) return false;
    const int it = bid + k0 * G, chain = it >> 1; d.b = chain >> 4; d.h = chain & 15; d.half = it & 1; d.samp = 1; d.r0 = 0; d.t0 = 0; d.bstep = G >> 5;
    const int ni = n_samp - k0 < 4 ? n_samp - k0 : 4; d.n = ni * 8; d.first = 1; d.last = 1; return true;
}
__device__ __forceinline__ int cd_batch(const ChunkDesc& d, const int t) { return d.samp ? d.b + (t >> 3) * d.bstep : d.b; }
__device__ __forceinline__ int cd_row(const ChunkDesc& d, const int t) { return d.samp ? MP + (d.b + (t >> 3) * d.bstep) * 8 + (t & 7) : d.r0 + d.t0 + t; }
__device__ __forceinline__ bool cd_first(const ChunkDesc& d, const int t) { return d.samp ? (t & 7) == 0 : (d.t0 + t) == 0; }
constexpr int SROW = 68;
constexpr int SBUF = 6 * 32 * SROW + 64;
__device__ __forceinline__ f32x2 lo2(const f32x4 v) { return __builtin_shufflevector(v, v, 0, 1); }
__device__ __forceinline__ f32x2 hi2(const f32x4 v) { return __builtin_shufflevector(v, v, 2, 3); }
__device__ __forceinline__ float tanh_fast(float x) { return 1.0f - 2.0f * fast_rcp(1.0f + __expf(2.0f * x)); }

__device__ __forceinline__ void unpack4(const u32x2 v, float (&o)[4]) { o[0] = bflo(v[0]); o[1] = bfhi(v[0]); o[2] = bflo(v[1]); o[3] = bfhi(v[1]); }

struct OpSet { f32x4 kk, wr, w, b, k; f32x2 v, cc; };
__device__ __forceinline__ void reduce4_row16(float a0, float a1, float b0, float b1, float c0, float c1, float d0, float d1, float& A, float& B, float& C, float& D) {
    asm volatile(
        "v_add_f32 %0, %4, %5\n\tv_add_f32 %1, %6, %7\n\tv_add_f32 %2, %8, %9\n\tv_add_f32 %3, %10, %11\n\t"
        "v_add_f32_dpp %0, %0, %0 quad_perm:[1,0,3,2] row_mask:0xf bank_mask:0xf\n\tv_add_f32_dpp %1, %1, %1 quad_perm:[1,0,3,2] row_mask:0xf bank_mask:0xf\n\t"
        "v_add_f32_dpp %2, %2, %2 quad_perm:[1,0,3,2] row_mask:0xf bank_mask:0xf\n\tv_add_f32_dpp %3, %3, %3 quad_perm:[1,0,3,2] row_mask:0xf bank_mask:0xf\n\t"
        "v_add_f32_dpp %0, %0, %0 quad_perm:[2,3,0,1] row_mask:0xf bank_mask:0xf\n\tv_add_f32_dpp %1, %1, %1 quad_perm:[2,3,0,1] row_mask:0xf bank_mask:0xf\n\t"
        "v_add_f32_dpp %2, %2, %2 quad_perm:[2,3,0,1] row_mask:0xf bank_mask:0xf\n\tv_add_f32_dpp %3, %3, %3 quad_perm:[2,3,0,1] row_mask:0xf bank_mask:0xf\n\t"
        "v_add_f32_dpp %0, %0, %0 row_half_mirror row_mask:0xf bank_mask:0xf\n\tv_add_f32_dpp %1, %1, %1 row_half_mirror row_mask:0xf bank_mask:0xf\n\t"
        "v_add_f32_dpp %2, %2, %2 row_half_mirror row_mask:0xf bank_mask:0xf\n\tv_add_f32_dpp %3, %3, %3 row_half_mirror row_mask:0xf bank_mask:0xf\n\t"
        "v_add_f32_dpp %0, %0, %0 row_mirror row_mask:0xf bank_mask:0xf\n\tv_add_f32_dpp %1, %1, %1 row_mirror row_mask:0xf bank_mask:0xf\n\t"
        "v_add_f32_dpp %2, %2, %2 row_mirror row_mask:0xf bank_mask:0xf\n\tv_add_f32_dpp %3, %3, %3 row_mirror row_mask:0xf bank_mask:0xf\n\t"
        "s_nop 1"
        : "=&v"(A), "=&v"(B), "=&v"(C), "=&v"(D)
        : "v"(a0), "v"(a1), "v"(b0), "v"(b1), "v"(c0), "v"(c1), "v"(d0), "v"(d1));
}
struct PrepState { f32x4 aw[4], aa[4]; float ksf[16]; float rn; };

struct PrepRaw { u32x4 wdc[2], wdp[2], adc[2], adp[2]; u32x2 kc[4], kp[4]; };
struct PrepRaw2 { u32x2 rc[4], rp[4], vc[4], vp[4]; };
__device__ __forceinline__ void prep_load(const Params& p, const ChunkDesc& d, const int tb, const int lane, PrepRaw& R) {
    const int fr = lane & 15, fq = lane >> 4;
    const int t = tb + fr; const int tt = t < d.n ? t : d.n - 1;
    const size_t row = (size_t)cd_row(d, tt);
    const bool isfirst = cd_first(d, tt);
    const bf16_t* cur = (const bf16_t*)(p.ws + WS_ACT) + row * ACT_LD;
    const bf16_t* prv = isfirst ? cur : cur - ACT_LD;
    const int hc = d.h * 64 + 4 * fq;
#pragma unroll
    for (int ks = 0; ks < 2; ++ks) {
        R.wdc[ks] = *(const u32x4*)(cur + C_WD + ks * 32 + fq * 8); R.wdp[ks] = *(const u32x4*)(prv + C_WD + ks * 32 + fq * 8);
        R.adc[ks] = *(const u32x4*)(cur + C_AD + ks * 32 + fq * 8); R.adp[ks] = *(const u32x4*)(prv + C_AD + ks * 32 + fq * 8);
    }
#pragma unroll
    for (int it = 0; it < 4; ++it) { R.kc[it] = *(const u32x2*)(cur + C_PK + hc + it * 16); R.kp[it] = *(const u32x2*)(prv + C_PK + hc + it * 16); }
}
__device__ __forceinline__ void prep_load2(const Params& p, const ChunkDesc& d, const int tb, const int lane, PrepRaw2& R) {
    const int fr = lane & 15, fq = lane >> 4;
    const int t = tb + fr; const int tt = t < d.n ? t : d.n - 1;
    const size_t row = (size_t)cd_row(d, tt);
    const bool isfirst = cd_first(d, tt);
    const bf16_t* cur = (const bf16_t*)(p.ws + WS_ACT) + row * ACT_LD;
    const bf16_t* prv = isfirst ? cur : cur - ACT_LD;
    const int hc = d.h * 64 + 4 * fq;
#pragma unroll
    for (int it = 0; it < 4; ++it) {
        R.rc[it] = *(const u32x2*)(cur + C_PR + hc + it * 16); R.rp[it] = *(const u32x2*)(prv + C_PR + hc + it * 16);
        R.vc[it] = *(const u32x2*)(cur + C_PV + hc + it * 16); R.vp[it] = *(const u32x2*)(prv + C_PV + hc + it * 16);
    }
}
__device__ __forceinline__ void shift4(const u32x2 cu, const u32x2 pr, const float* st, const bool isfirst, const bool samp, const int col, const f32x4 mu, float (&o)[4]) {
    float c[4], q[4];
    unpack4(cu, c); unpack4(pr, q);
    if (isfirst) {
        if (samp) { const f32x4 v = *(const f32x4*)(st + col); q[0] = v[0]; q[1] = v[1]; q[2] = v[2]; q[3] = v[3]; }
        else { q[0] = 0.f; q[1] = 0.f; q[2] = 0.f; q[3] = 0.f; }
    }
#pragma unroll
    for (int e = 0; e < 4; ++e) o[e] = c[e] + mu[e] * (q[e] - c[e]);
}

__device__ __forceinline__ void prep_stage1(const Params& p, const ChunkDesc& d, const int tb, const float* par, const int lane, const PrepRaw& R, PrepState& S) {
    const int fr = lane & 15, fq = lane >> 4;
    const int t = tb + fr; const int tt = t < d.n ? t : d.n - 1;
    const bool isfirst = cd_first(d, tt), samp = d.samp != 0;
    const float* st = p.state_shift + (size_t)cd_batch(d, tt) * DSHIFT;
    bf16x8 bw[2], ba[2];
#pragma unroll
    for (int ks = 0; ks < 2; ++ks) {
#pragma unroll
        for (int which = 0; which < 2; ++which) {
            const int col = (which ? C_AD : C_WD) + ks * 32 + fq * 8;
            const u32x4 cu = which ? R.adc[ks] : R.wdc[ks], pr = which ? R.adp[ks] : R.wdp[ks];
            float x0[4], x1[4];
            shift4((u32x2){cu[0], cu[1]}, (u32x2){pr[0], pr[1]}, st, isfirst, samp, col, *(const f32x4*)(par + 512 + which * 64 + ks * 32 + fq * 8), x0);
            shift4((u32x2){cu[2], cu[3]}, (u32x2){pr[2], pr[3]}, st, isfirst, samp, col + 4, *(const f32x4*)(par + 512 + which * 64 + ks * 32 + fq * 8 + 4), x1);
            if (!which) {
#pragma unroll
                for (int e = 0; e < 4; ++e) { x0[e] = tanh_fast(x0[e]); x1[e] = tanh_fast(x1[e]); }
            }
            u32x4 pk; pk[0] = cvt_pk_bf16(x0[0], x0[1]); pk[1] = cvt_pk_bf16(x0[2], x0[3]); pk[2] = cvt_pk_bf16(x1[0], x1[1]); pk[3] = cvt_pk_bf16(x1[2], x1[3]);
            if (which) ba[ks] = __builtin_bit_cast(bf16x8, pk); else bw[ks] = __builtin_bit_cast(bf16x8, pk);
        }
    }
    const bf16x8* ft = (const bf16x8*)(p.ws + WS_FRAG) + (size_t)d.h * 1024 + lane;
    __builtin_amdgcn_sched_barrier(0);
#pragma unroll
    for (int it = 0; it < 4; ++it) {
        S.aw[it] = (f32x4){0.f, 0.f, 0.f, 0.f}; S.aa[it] = S.aw[it];
#pragma unroll
        for (int ks = 0; ks < 2; ++ks) {
            S.aw[it] = __builtin_amdgcn_mfma_f32_16x16x32_bf16(ft[(it * 2 + ks) * 64], bw[ks], S.aw[it], 0, 0, 0);
            S.aa[it] = __builtin_amdgcn_mfma_f32_16x16x32_bf16(ft[(8 + it * 2 + ks) * 64], ba[ks], S.aa[it], 0, 0, 0);
        }
        if (it & 1) __builtin_amdgcn_sched_barrier(0);
    }
    const int hc = d.h * 64 + 4 * fq;
    float ss = 0.f;
#pragma unroll
    for (int it = 0; it < 4; ++it) {
        const int po = it * 16 + 4 * fq;
        float k4[4];
        shift4(R.kc[it], R.kp[it], st, isfirst, samp, C_PK + hc + it * 16, *(const f32x4*)(par + 64 + po), k4);
        const f32x4 kkp = *(const f32x4*)(par + 5 * 64 + po);
#pragma unroll
        for (int e = 0; e < 4; ++e) { S.ksf[it * 4 + e] = k4[e]; const float kr = k4[e] * kkp[e]; ss += kr * kr; }
        __builtin_amdgcn_sched_barrier(0);
    }
    ss += __shfl_xor(ss, 16, 64); ss += __shfl_xor(ss, 32, 64);
    S.rn = rsqrtf(ss + 1e-12f);
}

__device__ __forceinline__ void prep_stage2(const Params& p, const ChunkDesc& d, const int tb, float* buf, const float* par, const int lane, const PrepRaw2& R, const PrepState& S) {
    const int fr = lane & 15, fq = lane >> 4;
    const int t = tb + fr; const bool valid = t < d.n; const int tt = valid ? t : d.n - 1;
    const bool isfirst = cd_first(d, tt), samp = d.samp != 0;
    const float* st = p.state_shift + (size_t)cd_batch(d, tt) * DSHIFT;
    const int hc = d.h * 64 + 4 * fq;
    float c1 = 0.f, c2 = 0.f, c3 = 0.f;
    float* kkA = buf; float* wrA = buf + 32 * SROW; float* wA = buf + 2 * 32 * SROW; float* bA = buf + 3 * 32 * SROW; float* kpA = buf + 4 * 32 * SROW; float* vsA = buf + 5 * 32 * SROW; float* c12 = buf + 6 * 32 * SROW;
#pragma unroll
    for (int it = 0; it < 4; ++it) {
        const int po = it * 16 + 4 * fq;
        const f32x4 w0 = *(const f32x4*)(par + 3 * 64 + po), a0 = *(const f32x4*)(par + 4 * 64 + po), kkp = *(const f32x4*)(par + 5 * 64 + po), ka = *(const f32x4*)(par + 6 * 64 + po), rk = *(const f32x4*)(par + 7 * 64 + po);
        f32x4 o_kk, o_wr, o_w, o_b, o_kp, o_vs;
        float r4[4], v4[4];
        shift4(R.rc[it], R.rp[it], st, isfirst, samp, C_PR + hc + it * 16, *(const f32x4*)(par + po), r4);
        shift4(R.vc[it], R.vp[it], st, isfirst, samp, C_PV + hc + it * 16, *(const f32x4*)(par + 128 + po), v4);
#pragma unroll
        for (int e = 0; e < 4; ++e) {
            const float r_ = r4[e], k_ = S.ksf[it * 4 + e];
            const float dec = __expf(-0.6065306597f * sigmoidf_(S.aw[it][e] + w0[e]));
            const float a = sigmoidf_(S.aa[it][e] + a0[e]);
            const float kn = k_ * kkp[e] * S.rn;
            const float kpv = k_ * (1.0f + (a - 1.0f) * ka[e]);
            const float bv = kn * a;
            c1 += bv * r_; c2 += kpv * r_; c3 += r_ * kpv * rk[e];
            o_kk[e] = kn; o_wr[e] = dec * r_; o_w[e] = dec; o_b[e] = bv; o_kp[e] = kpv; o_vs[e] = v4[e];
        }
        if (valid) {
            const int o = t * SROW + po;
            *(f32x4*)(kkA + o) = o_kk; *(f32x4*)(wrA + o) = o_wr; *(f32x4*)(wA + o) = o_w; *(f32x4*)(bA + o) = o_b; *(f32x4*)(kpA + o) = o_kp; *(f32x4*)(vsA + o) = o_vs;
        }
        __builtin_amdgcn_sched_barrier(0);
    }
    c1 += __shfl_xor(c1, 16, 64); c1 += __shfl_xor(c1, 32, 64);
    c2 += __shfl_xor(c2, 16, 64); c2 += __shfl_xor(c2, 32, 64);
    c3 += __shfl_xor(c3, 16, 64); c3 += __shfl_xor(c3, 32, 64);
    if (valid && fq == 0) { c12[t * 2] = c1; c12[t * 2 + 1] = c2; if (d.half == 0) ((float*)(p.ws + WS_C3))[(size_t)cd_row(d, t) * 16 + d.h] = c3; }
}

__device__ void phase2_scan(const Params& p, unsigned char* smem) {
    const int tid = opaque_tid(), lane = tid & 63, wid = __builtin_amdgcn_readfirstlane(tid >> 6);
    const int bid = blockIdx.x, G = gridDim.x;
    float* sm = (float*)smem;
    float* bufs = sm;
    float* obuf = sm + 2 * SBUF;
    float* parb = obuf + 2 * 1024;
    const int NC = n_chunks(bid, G);
    float* ORAW = p.out + OUT_Y;
    __syncthreads();
    if (NC == 0) return;
    if (wid < 4) {
        __builtin_amdgcn_s_setprio(3);
        const int c = lane & 15, rg = lane >> 4, rl = wid * 8 + rg * 2;
        f32x2 s00 = (f32x2){0.f, 0.f}, s01 = s00, s10 = s00, s11 = s00;
        __syncthreads();
        __syncthreads();
        for (int ci = 0; ci < NC; ++ci) {
            ChunkDesc d; chunk_desc(ci, bid, G, d);
            const float* buf = bufs + (ci & 1) * SBUF;
            const float* kkA = buf + 4 * c; const float* vsA = buf + 5 * 32 * SROW + d.half * 32 + rl; const float* c12 = buf + 6 * 32 * SROW;
            float* ob = obuf + (ci & 1) * 1024 + rl;
            const int nsub = d.samp ? (d.n >> 3) : 1;
            OpSet A, B;
            auto ld = [&](OpSet& o, const int t) {
                o.kk = *(const f32x4*)(kkA + t * SROW); o.wr = *(const f32x4*)(kkA + 32 * SROW + t * SROW); o.w = *(const f32x4*)(kkA + 2 * 32 * SROW + t * SROW);
                o.b = *(const f32x4*)(kkA + 3 * 32 * SROW + t * SROW); o.k = *(const f32x4*)(kkA + 4 * 32 * SROW + t * SROW);
                o.v = *(const f32x2*)(vsA + t * SROW); o.cc = *(const f32x2*)(c12 + t * 2);
            };
            auto step = [&](const OpSet& o, const int t) {
                const f32x2 pd0 = s00 * lo2(o.kk) + s01 * hi2(o.kk), pd1 = s10 * lo2(o.kk) + s11 * hi2(o.kk);
                const f32x2 pe0 = s00 * lo2(o.wr) + s01 * hi2(o.wr), pe1 = s10 * lo2(o.wr) + s11 * hi2(o.wr);
                float d0, d1, e0, e1;
                reduce4_row16(pd0[0], pd0[1], pd1[0], pd1[1], pe0[0], pe0[1], pe1[0], pe1[1], d0, d1, e0, e1);
                const f32x2 vv0 = (f32x2){o.v[0], o.v[0]}, vv1 = (f32x2){o.v[1], o.v[1]}, dd0 = (f32x2){d0, d0}, dd1 = (f32x2){d1, d1};
                s00 = s00 * lo2(o.w) + (lo2(o.k) * vv0 - lo2(o.b) * dd0);
                s01 = s01 * hi2(o.w) + (hi2(o.k) * vv0 - hi2(o.b) * dd0);
                s10 = s10 * lo2(o.w) + (lo2(o.k) * vv1 - lo2(o.b) * dd1);
                s11 = s11 * hi2(o.w) + (hi2(o.k) * vv1 - hi2(o.b) * dd1);
                if (c == 0) { f32x2 ov; ov[0] = e0 - d0 * o.cc[0] + o.v[0] * o.cc[1]; ov[1] = e1 - d1 * o.cc[0] + o.v[1] * o.cc[1]; *(f32x2*)(ob + t * 32) = ov; }
            };
            auto run = [&](const int tbeg, const int tend) {
                ld(A, tbeg);
                for (int t = tbeg; t < tend; t += 2) {
                    ld(B, t + 1);
                    step(A, t);
                    ld(A, (t + 2 < tend) ? t + 2 : t);
                    step(B, t + 1);
                }
            };
            auto put_state = [&](float* so) {
                f32x4 a, b2; a[0] = s00[0]; a[1] = s00[1]; a[2] = s01[0]; a[3] = s01[1]; b2[0] = s10[0]; b2[1] = s10[1]; b2[2] = s11[0]; b2[3] = s11[1];
                *(f32x4*)so = a; *(f32x4*)(so + 64) = b2;
            };
            if (d.samp) {
                f32x4 ia[4], ib[4]; size_t off[4];
#pragma unroll
                for (int sub = 0; sub < 4; ++sub) {
                    const int sb = sub < nsub ? sub : nsub - 1;
                    off[sub] = ((size_t)(cd_batch(d, sb * 8) * 16 + d.h) * 64 + d.half * 32 + rl) * 64 + 4 * c;
                    ia[sub] = *(const f32x4*)(p.state_wkv + off[sub]); ib[sub] = *(const f32x4*)(p.state_wkv + off[sub] + 64);
                }
#pragma unroll
                for (int sub = 0; sub < 4; ++sub) {
                    if (sub < nsub) {
                        s00 = lo2(ia[sub]); s01 = hi2(ia[sub]); s10 = lo2(ib[sub]); s11 = hi2(ib[sub]);
                        run(sub * 8, sub * 8 + 8);
                        put_state(p.out + OUT_WKV_S + off[sub]);
                    }
                }
            } else {
                if (d.first) { s00 = (f32x2){0.f, 0.f}; s01 = s00; s10 = s00; s11 = s00; }
                run(0, d.n);
                if (d.last) put_state(p.out + OUT_WKV_P + ((size_t)(d.b * 16 + d.h) * 64 + d.half * 32 + rl) * 64 + 4 * c);
            }
            __syncthreads();
        }
        __syncthreads();
        __builtin_amdgcn_s_setprio(0);
    } else {
        const int q = (wid >> 1) & 1, tb = (wid & 1) * 16;
        float* par = parb + (wid & 3) * 640;
        PrepState S;
        int cur_h = -1;
        for (int i = -2; i <= NC; ++i) {
            if ((i & 1) == q) {
                ChunkDesc d;
                int ck = i + 2; ck = ck < 0 ? 0 : (ck > NC - 1 ? NC - 1 : ck);
                chunk_desc(ck, bid, G, d);
                if (d.h != cur_h) {
                    cur_h = d.h;
                    const int ch = d.h * 64 + lane;
                    par[lane] = p.shift_mu[ch]; par[64 + lane] = p.shift_mu[1024 + ch]; par[128 + lane] = p.shift_mu[2048 + ch]; par[192 + lane] = p.decay_w0[ch];
                    par[256 + lane] = p.icl_a0[ch]; par[320 + lane] = p.k_k[ch]; par[384 + lane] = p.k_a[ch]; par[448 + lane] = p.r_k[ch];
                    par[512 + lane] = p.shift_mu[C_WD + lane]; par[576 + lane] = p.shift_mu[C_AD + lane];
                }
                PrepRaw R;
                prep_load(p, d, tb, lane, R);
                prep_stage1(p, d, tb, par, lane, R, S);
            } else {
                ChunkDesc d, d2;
                PrepRaw2 R2;
                const bool has2 = i >= -1 && i + 1 < NC && chunk_desc(i + 1, bid, G, d2) && tb < d2.n;
                if (has2) prep_load2(p, d2, tb, lane, R2);
                if (i >= 1 && chunk_desc(i - 1, bid, G, d)) {
                    const float* ob = obuf + ((i - 1) & 1) * 1024;
                    for (int idx = (wid & 1) * 64 + lane; idx < d.n * 8; idx += 128) { const int t = idx >> 3, j = (idx & 7) * 4; *(f32x4*)(ORAW + (size_t)cd_row(d, t) * 1024 + d.h * 64 + d.half * 32 + j) = *(const f32x4*)(ob + t * 32 + j); }
                }
                if (has2) prep_stage2(p, d2, tb, bufs + ((i + 1) & 1) * SBUF, par, lane, R2, S);
            }
            __syncthreads();
        }
    }
}

__device__ void attn_unit(const Params& p, unsigned char* smem, const int unit) {
    const int tid = opaque_tid(), lane = tid & 63, wid = __builtin_amdgcn_readfirstlane(tid >> 6), fr = lane & 15, fq = lane >> 4;
    const int b = unit >> 6, h = (unit >> 4) & 3, tile = unit & 15;
    const bf16_t* ACT = (const bf16_t*)(p.ws + WS_ACT);
    const bf16_t* Kbf = (const bf16_t*)(p.ws + WS_KBF);
    const bf16_t* Vt = (const bf16_t*)(p.ws + WS_VT);
    bf16_t* Ymem = (bf16_t*)(p.ws + WS_YMEM);
    bf16_t* Kc = (bf16_t*)smem;
    bf16_t* Vc = (bf16_t*)smem;
    const int row = b * 2048 + tile * 128 + wid * 16 + fr;
    u32x4 st[8];
    auto ldK = [&](const int hf) {
#pragma unroll
        for (int i = 0; i < 8; ++i) { const int id = tid + i * NTHREADS, key = id >> 5, d = (id & 31) * 8; st[i] = *(const u32x4*)(Kbf + (size_t)(b * 256 + hf * 128 + key) * 1024 + h * 256 + d); }
    };
    auto stK = [&]() {
#pragma unroll
        for (int i = 0; i < 8; ++i) { const int id = tid + i * NTHREADS, key = id >> 5, d = (id & 31) * 8; *(u32x4*)(Kc + key * 264 + d) = st[i]; }
    };
    auto ldV = [&](const int hf) {
#pragma unroll
        for (int i = 0; i < 8; ++i) { const int id = tid + i * NTHREADS, d = id >> 4, kc = (id & 15) * 8; st[i] = *(const u32x4*)(Vt + (size_t)(h * 256 + d) * 2048 + b * 256 + hf * 128 + kc); }
    };
    auto stV = [&]() {
#pragma unroll
        for (int i = 0; i < 8; ++i) { const int id = tid + i * NTHREADS, d = id >> 4, kc = (id & 15) * 8; *(u32x4*)(Vc + d * 136 + kc) = st[i]; }
    };
    ldK(0);
    bf16x8 qf[8];
#pragma unroll
    for (int ks = 0; ks < 8; ++ks) qf[ks] = *(const bf16x8*)(ACT + (size_t)row * ACT_LD + C_QM + h * 256 + ks * 32 + fq * 8);
    f32x4 sacc[16];
#pragma unroll
    for (int i = 0; i < 16; ++i) sacc[i] = (f32x4){0.f, 0.f, 0.f, 0.f};
#pragma unroll
    for (int hf = 0; hf < 2; ++hf) {
        __syncthreads();
        stK();
        __syncthreads();
        if (hf == 0) ldK(1); else ldV(0);
#pragma unroll
        for (int kt = 0; kt < 8; ++kt)
#pragma unroll
            for (int ks = 0; ks < 8; ++ks) {
                const bf16x8 kf = *(const bf16x8*)(Kc + (kt * 16 + fr) * 264 + ks * 32 + fq * 8);
                sacc[hf * 8 + kt] = __builtin_amdgcn_mfma_f32_16x16x32_bf16(kf, qf[ks], sacc[hf * 8 + kt], 0, 0, 0);
            }
    }
    float mx = -3.0e38f;
#pragma unroll
    for (int i = 0; i < 16; ++i) mx = fmaxf(mx, fmaxf(fmaxf(sacc[i][0], sacc[i][1]), fmaxf(sacc[i][2], sacc[i][3])));
    mx = fmaxf(mx, __shfl_xor(mx, 16, 64)); mx = fmaxf(mx, __shfl_xor(mx, 32, 64));
    float sum = 0.f;
#pragma unroll
    for (int i = 0; i < 16; ++i)
#pragma unroll
        for (int e = 0; e < 4; ++e) { const float ex = __expf(sacc[i][e] - mx); sacc[i][e] = ex; sum += ex; }
    sum += __shfl_xor(sum, 16, 64); sum += __shfl_xor(sum, 32, 64);
    const float inv = fast_rcp(sum);
    bf16x8 pf[8];
#pragma unroll
    for (int s2 = 0; s2 < 8; ++s2) {
        u32x4 t; t[0] = cvt_pk_bf16(sacc[2 * s2][0], sacc[2 * s2][1]); t[1] = cvt_pk_bf16(sacc[2 * s2][2], sacc[2 * s2][3]);
        t[2] = cvt_pk_bf16(sacc[2 * s2 + 1][0], sacc[2 * s2 + 1][1]); t[3] = cvt_pk_bf16(sacc[2 * s2 + 1][2], sacc[2 * s2 + 1][3]);
        pf[s2] = __builtin_bit_cast(bf16x8, t);
    }
    f32x4 oacc[16];
#pragma unroll
    for (int i = 0; i < 16; ++i) oacc[i] = (f32x4){0.f, 0.f, 0.f, 0.f};
#pragma unroll
    for (int hf = 0; hf < 2; ++hf) {
        __syncthreads();
        stV();
        __syncthreads();
        if (hf == 0) ldV(1);
#pragma unroll
        for (int dt = 0; dt < 16; ++dt)
#pragma unroll
            for (int s2 = 0; s2 < 4; ++s2) {
                const u32x2 lo = *(const u32x2*)(Vc + (dt * 16 + fr) * 136 + s2 * 32 + 4 * fq), hi = *(const u32x2*)(Vc + (dt * 16 + fr) * 136 + s2 * 32 + 16 + 4 * fq);
                u32x4 t; t[0] = lo[0]; t[1] = lo[1]; t[2] = hi[0]; t[3] = hi[1];
                oacc[dt] = __builtin_amdgcn_mfma_f32_16x16x32_bf16(__builtin_bit_cast(bf16x8, t), pf[hf * 4 + s2], oacc[dt], 0, 0, 0);
            }
    }
#pragma unroll
    for (int dt = 0; dt < 16; ++dt) {
        const int d = h * 256 + dt * 16 + 4 * fq;
        const u32x2 g = *(const u32x2*)(ACT + (size_t)row * ACT_LD + C_SGM + d);
        u32x2 o; o[0] = cvt_pk_bf16(oacc[dt][0] * inv * bflo(g[0]), oacc[dt][1] * inv * bfhi(g[0])); o[1] = cvt_pk_bf16(oacc[dt][2] * inv * bflo(g[1]), oacc[dt][3] * inv * bfhi(g[1]));
        *(u32x2*)(Ymem + (size_t)row * 1024 + d) = o;
    }
}

__device__ void attn_sample_unit(const Params& p, unsigned char* smem, const int b, const int h) {
    const int tid = opaque_tid(), lane = tid & 63, wid = __builtin_amdgcn_readfirstlane(tid >> 6), fr = lane & 15, fq = lane >> 4;
    const bf16_t* ACT = (const bf16_t*)(p.ws + WS_ACT);
    bf16_t* Ymem = (bf16_t*)(p.ws + WS_YMEM);
    bf16_t* Kc = (bf16_t*)smem;
    float* Ored = (float*)smem;
    float* Pl = (float*)(smem + 69632);
    const int row = MP + b * 8 + (fr & 7);
    bf16x8 qf[8];
#pragma unroll
    for (int ks = 0; ks < 8; ++ks) qf[ks] = *(const bf16x8*)(ACT + (size_t)row * ACT_LD + C_QM + h * 256 + ks * 32 + fq * 8);
    const float* vbase = p.cache_v + ((size_t)(b * 256 + wid * 32) * 4 + h) * 256 + lane * 4;
    f32x4 vv[8];
#pragma unroll
    for (int i = 0; i < 8; ++i) vv[i] = *(const f32x4*)(vbase + (size_t)i * 1024);
    f32x4 sacc[16];
#pragma unroll
    for (int i = 0; i < 16; ++i) sacc[i] = (f32x4){0.f, 0.f, 0.f, 0.f};
#pragma unroll
    for (int hf = 0; hf < 2; ++hf) {
        __syncthreads();
#pragma unroll
        for (int i = 0; i < 8; ++i) {
            const int id = tid + i * NTHREADS, key = id >> 5, d = (id & 31) * 8;
            const float* s_ = p.cache_k + ((size_t)(b * 256 + hf * 128 + key) * 4 + h) * 256 + d; const f32x4 x0 = *(const f32x4*)s_, x1 = *(const f32x4*)(s_ + 4);
            u32x4 v; v[0] = cvt_pk_bf16(x0[0], x0[1]); v[1] = cvt_pk_bf16(x0[2], x0[3]); v[2] = cvt_pk_bf16(x1[0], x1[1]); v[3] = cvt_pk_bf16(x1[2], x1[3]);
            *(u32x4*)(Kc + key * 264 + d) = v;
        }
        __syncthreads();
#pragma unroll
        for (int kt = 0; kt < 8; ++kt)
#pragma unroll
            for (int ks = 0; ks < 8; ++ks) {
                const bf16x8 kf = *(const bf16x8*)(Kc + (kt * 16 + fr) * 264 + ks * 32 + fq * 8);
                sacc[hf * 8 + kt] = __builtin_amdgcn_mfma_f32_16x16x32_bf16(kf, qf[ks], sacc[hf * 8 + kt], 0, 0, 0);
            }
    }
    float mx = -3.0e38f;
#pragma unroll
    for (int i = 0; i < 16; ++i) mx = fmaxf(mx, fmaxf(fmaxf(sacc[i][0], sacc[i][1]), fmaxf(sacc[i][2], sacc[i][3])));
    mx = fmaxf(mx, __shfl_xor(mx, 16, 64)); mx = fmaxf(mx, __shfl_xor(mx, 32, 64));
    float sum = 0.f;
#pragma unroll
    for (int i = 0; i < 16; ++i)
#pragma unroll
        for (int e = 0; e < 4; ++e) { const float ex = __expf(sacc[i][e] - mx); sacc[i][e] = ex; sum += ex; }
    sum += __shfl_xor(sum, 16, 64); sum += __shfl_xor(sum, 32, 64);
    const float inv = fast_rcp(sum);
    if (wid == 0 && fr < 8) {
#pragma unroll
        for (int i = 0; i < 16; ++i)
#pragma unroll
            for (int e = 0; e < 4; ++e) Pl[(i * 16 + 4 * fq + e) * 8 + fr] = sacc[i][e] * inv;
    }
    __syncthreads();
    f32x4 o[8];
#pragma unroll
    for (int t = 0; t < 8; ++t) o[t] = (f32x4){0.f, 0.f, 0.f, 0.f};
#pragma unroll
    for (int half = 0; half < 4; ++half) {
        if (half >= 1) {
#pragma unroll
            for (int i = 0; i < 8; ++i) vv[i] = *(const f32x4*)(vbase + (size_t)(half * 8 + i) * 1024);
        }
#pragma unroll
        for (int i = 0; i < 8; ++i) {
            const float* pp = Pl + (wid * 32 + half * 8 + i) * 8;
            const f32x4 p0 = *(const f32x4*)pp, p1 = *(const f32x4*)(pp + 4);
#pragma unroll
            for (int t = 0; t < 4; ++t) { o[t] += vv[i] * p0[t]; o[4 + t] += vv[i] * p1[t]; }
        }
    }
#pragma unroll
    for (int t = 0; t < 8; ++t) *(f32x4*)(Ored + (wid * 8 + t) * 256 + lane * 4) = o[t];
    __syncthreads();
    {
        const int t = tid >> 6, d = (tid & 63) * 4;
        f32x4 acc = (f32x4){0.f, 0.f, 0.f, 0.f};
#pragma unroll
        for (int w = 0; w < 8; ++w) acc += *(const f32x4*)(Ored + (w * 8 + t) * 256 + d);
        const size_t orow = (size_t)(MP + b * 8 + t);
        const u32x2 g = *(const u32x2*)(ACT + orow * ACT_LD + C_SGM + h * 256 + d);
        u32x2 ov; ov[0] = cvt_pk_bf16(acc[0] * bflo(g[0]), acc[1] * bfhi(g[0])); ov[1] = cvt_pk_bf16(acc[2] * bflo(g[1]), acc[3] * bfhi(g[1]));
        *(u32x2*)(Ymem + orow * 1024 + h * 256 + d) = ov;
    }
}

__device__ void phase2_attn(const Params& p, unsigned char* smem) {
    __syncthreads();
    for (int k = blockIdx.x; k < 1024; k += gridDim.x) {
        const int u = (k + ((blockIdx.x & 1) << 9)) & 1023;
        if (u < 512) attn_unit(p, smem, u); else attn_sample_unit(p, smem, (u - 512) >> 2, u & 3);
    }
}

__device__ __forceinline__ void ld16bf(const bf16_t* ptr, float (&o)[16]) {
    const u32x4 a = *(const u32x4*)ptr, b = *(const u32x4*)(ptr + 8);
#pragma unroll
    for (int e = 0; e < 4; ++e) { o[2 * e] = bflo(a[e]); o[2 * e + 1] = bfhi(a[e]); o[8 + 2 * e] = bflo(b[e]); o[8 + 2 * e + 1] = bfhi(b[e]); }
}
__device__ __forceinline__ void ld16f(const float* ptr, float (&o)[16]) {
#pragma unroll
    for (int q = 0; q < 4; ++q) { const f32x4 v = *(const f32x4*)(ptr + 4 * q); o[4 * q] = v[0]; o[4 * q + 1] = v[1]; o[4 * q + 2] = v[2]; o[4 * q + 3] = v[3]; }
}
__device__ __forceinline__ void st16bf(bf16_t* ptr, const float (&y)[16]) {
    u32x4 a, b;
#pragma unroll
    for (int e = 0; e < 4; ++e) { a[e] = cvt_pk_bf16(y[2 * e], y[2 * e + 1]); b[e] = cvt_pk_bf16(y[8 + 2 * e], y[8 + 2 * e + 1]); }
    *(u32x4*)ptr = a; *(u32x4*)(ptr + 8) = b;
}
__device__ __forceinline__ float quad_sum(float x) { x += dpp_f<0xB1>(x); x += dpp_f<0x4E>(x); return x; }
struct RowRaw { u32x4 u0[2], u1[2], u2[2], bg[2], vc[2], vq[2], sg[2]; f32x4 o[4]; float c3; };
__device__ __forceinline__ void up16(const u32x4 (&r)[2], float (&o)[16]) {
#pragma unroll
    for (int e = 0; e < 4; ++e) { o[2 * e] = bflo(r[0][e]); o[2 * e + 1] = bfhi(r[0][e]); o[8 + 2 * e] = bflo(r[1][e]); o[8 + 2 * e + 1] = bfhi(r[1][e]); }
}
__device__ __forceinline__ float bfe16(const u32x4 (&r)[2], const int i) { const unsigned w = r[i >> 3][(i >> 1) & 3]; return (i & 1) ? bfhi(w) : bflo(w); }
__device__ void phase2b(const Params& p, unsigned char* smem) {
    const int tid = opaque_tid(), lane = tid & 63, wid = tid >> 6;
    float* tab = (float*)smem;
    __syncthreads();
    for (int idx = tid; idx < 7168; idx += NTHREADS)
        tab[idx] = idx < 3072 ? p.conv_w[idx] : idx < 4096 ? p.conv_b[idx - 3072] : idx < 5120 ? p.shift_mu[2048 + idx - 4096] : idx < 6144 ? p.ln_g[idx - 5120] : p.ln_b[idx - 6144];
    __syncthreads();
    const bf16_t* U = (const bf16_t*)(p.ws + WS_U); const bf16_t* BG = (const bf16_t*)(p.ws + WS_BG); const bf16_t* ACT = (const bf16_t*)(p.ws + WS_ACT);
    const float* ORAW = p.out + OUT_Y; const float* C3 = (const float*)(p.ws + WS_C3);
    bf16_t* Yc = (bf16_t*)(p.ws + WS_YCONV); bf16_t* Yr = (bf16_t*)(p.ws + WS_YRWKV);
    const int ch = lane * 16;
    auto load_row = [&](const int row, RowRaw& R) {
        const bool samp = row >= MP; const int t = samp ? ((row - MP) & 7) : (row & 2047);
        const int r1 = t >= 1 ? row - 1 : row, r2 = t >= 2 ? row - 2 : row;
#pragma unroll
        for (int q = 0; q < 2; ++q) {
            R.u0[q] = *(const u32x4*)(U + (size_t)row * 1024 + ch + 8 * q); R.u1[q] = *(const u32x4*)(U + (size_t)r1 * 1024 + ch + 8 * q); R.u2[q] = *(const u32x4*)(U + (size_t)r2 * 1024 + ch + 8 * q);
            R.bg[q] = *(const u32x4*)(BG + (size_t)row * 1024 + ch + 8 * q);
            R.vc[q] = *(const u32x4*)(ACT + (size_t)row * ACT_LD + C_PV + ch + 8 * q); R.vq[q] = *(const u32x4*)(ACT + (size_t)r1 * ACT_LD + C_PV + ch + 8 * q);
            R.sg[q] = *(const u32x4*)(ACT + (size_t)row * ACT_LD + C_SGR + ch + 8 * q);
        }
#pragma unroll
        for (int q = 0; q < 4; ++q) R.o[q] = *(const f32x4*)(ORAW + (size_t)row * 1024 + ch + 4 * q);
        R.c3 = C3[(size_t)row * 16 + (lane >> 2)];
    };
    auto process_row = [&](const int row, const RowRaw& R) {
        int b, t; const bool samp = row >= MP;
        if (!samp) { b = row >> 11; t = row & 2047; } else { b = (row - MP) >> 3; t = (row - MP) & 7; }
        const bool z1 = t < 1, z2 = t < 2;
        u32x4 yo[2];
#pragma unroll
        for (int q = 0; q < 4; ++q) {
            const f32x4 w0 = *(const f32x4*)(tab + ch + 4 * q), w1 = *(const f32x4*)(tab + 1024 + ch + 4 * q), w2 = *(const f32x4*)(tab + 2048 + ch + 4 * q), cb = *(const f32x4*)(tab + 3072 + ch + 4 * q);
            f32x4 m1 = (f32x4){0.f, 0.f, 0.f, 0.f}, m2 = m1;
            if (z1) { if (samp) m1 = *(const f32x4*)(p.state_conv + ((size_t)b * 2 + 1) * 1024 + ch + 4 * q); }
            else { m1[0] = bfe16(R.u1, 4 * q); m1[1] = bfe16(R.u1, 4 * q + 1); m1[2] = bfe16(R.u1, 4 * q + 2); m1[3] = bfe16(R.u1, 4 * q + 3); }
            if (z2) { if (samp) m2 = *(const f32x4*)(p.state_conv + ((size_t)b * 2 + t) * 1024 + ch + 4 * q); }
            else { m2[0] = bfe16(R.u2, 4 * q); m2[1] = bfe16(R.u2, 4 * q + 1); m2[2] = bfe16(R.u2, 4 * q + 2); m2[3] = bfe16(R.u2, 4 * q + 3); }
            float y[4];
#pragma unroll
            for (int e = 0; e < 4; ++e) { const int i = 4 * q + e; y[e] = bfe16(R.bg, i) * (cb[e] + w0[e] * m2[e] + w1[e] * m1[e] + w2[e] * bfe16(R.u0, i)); }
            yo[q >> 1][(q & 1) * 2] = cvt_pk_bf16(y[0], y[1]); yo[q >> 1][(q & 1) * 2 + 1] = cvt_pk_bf16(y[2], y[3]);
        }
        *(u32x4*)(Yc + (size_t)row * 1024 + ch) = yo[0]; *(u32x4*)(Yc + (size_t)row * 1024 + ch + 8) = yo[1];
        float sm_ = 0.f;
#pragma unroll
        for (int q = 0; q < 4; ++q) sm_ += R.o[q][0] + R.o[q][1] + R.o[q][2] + R.o[q][3];
        const float mean = quad_sum(sm_) * (1.0f / 64.0f);
        float vr = 0.f;
#pragma unroll
        for (int q = 0; q < 4; ++q)
#pragma unroll
            for (int e = 0; e < 4; ++e) { const float dl = R.o[q][e] - mean; vr += dl * dl; }
        const float rstd = rsqrtf(quad_sum(vr) * (1.0f / 64.0f) + 6.4e-4f);
#pragma unroll
        for (int q = 0; q < 4; ++q) {
            const f32x4 mv = *(const f32x4*)(tab + 4096 + ch + 4 * q), lg = *(const f32x4*)(tab + 5120 + ch + 4 * q), lb = *(const f32x4*)(tab + 6144 + ch + 4 * q);
            f32x4 pq = (f32x4){0.f, 0.f, 0.f, 0.f};
            if (z1) { if (samp) pq = *(const f32x4*)(p.state_shift + (size_t)b * DSHIFT + 2048 + ch + 4 * q); }
            else { pq[0] = bfe16(R.vq, 4 * q); pq[1] = bfe16(R.vq, 4 * q + 1); pq[2] = bfe16(R.vq, 4 * q + 2); pq[3] = bfe16(R.vq, 4 * q + 3); }
            float y[4];
#pragma unroll
            for (int e = 0; e < 4; ++e) { const int i = 4 * q + e; const float vcu = bfe16(R.vc, i); const float vs = vcu + mv[e] * (pq[e] - vcu); y[e] = ((R.o[q][e] - mean) * rstd * lg[e] + lb[e] + R.c3 * vs) * bfe16(R.sg, i); }
            yo[q >> 1][(q & 1) * 2] = cvt_pk_bf16(y[0], y[1]); yo[q >> 1][(q & 1) * 2 + 1] = cvt_pk_bf16(y[2], y[3]);
        }
        *(u32x4*)(Yr + (size_t)row * 1024 + ch) = yo[0]; *(u32x4*)(Yr + (size_t)row * 1024 + ch + 8) = yo[1];
    };
    for (int row = blockIdx.x * 8 + wid; row < MALL; row += gridDim.x * 8) {
        RowRaw Ra;
        load_row(row, Ra);
        process_row(row, Ra);
    }
}

struct SchedP3 {
    int G, c; const char* ws;
    __device__ __forceinline__ bool next(int i, Unit& u) const {
        const int tl = (i / 3) * G + c, seg = i % 3;
        if (tl >= 256) return false;
        u.x = tl >> 2; u.y = tl & 3; u.z = seg;
        u.a = ws + (seg == 0 ? WS_YCONV : seg == 1 ? WS_YRWKV : WS_YMEM) + (size_t)u.x * 256 * 2048; u.b = ws + WS_WB + ((size_t)seg * 1024 + (size_t)u.y * 256) * 2048;
        return true;
    }
};
struct SchedP3T {
    int G, c; const char* ws;
    __device__ __forceinline__ bool next(int i, Unit& u) const {
        const int e = i * G + c;
        if (e >= 96) return false;
        const int tt = e / 6, r = e % 6, seg = r >> 1, kh = r & 1;
        u.x = 64 + (tt >> 2); u.y = tt & 3; u.z = r;
        u.a = ws + (seg == 0 ? WS_YCONV : seg == 1 ? WS_YRWKV : WS_YMEM) + (size_t)u.x * 256 * 2048 + kh * 1024;
        u.b = ws + WS_WB + ((size_t)seg * 1024 + (size_t)u.y * 256) * 2048 + kh * 1024;
        return true;
    }
};
struct EpiP3T {
    const bf16_t* ACT; float* PART;
    __device__ __forceinline__ bool operator()(f32x4 (&acc)[2][2][4][2], const Unit& u, int wr, int wc, int fr, int fq) const {
        const int seg = u.z >> 1, rbase = u.x * 256 + wr * 64 + fr, cb = u.y * 256 + wc * 32 + 8 * fq;
        const bf16_t* gbase = ACT + C_GATE + seg * 1024 + cb;
#pragma unroll
        for (int ai = 0; ai < 2; ++ai) {
            u32x4 g[4][2];
#pragma unroll
            for (int m = 0; m < 4; ++m)
#pragma unroll
                for (int bj = 0; bj < 2; ++bj) g[m][bj] = *(const u32x4*)(gbase + (size_t)(rbase + ai * 128 + m * 16) * ACT_LD + 128 * bj);
#pragma unroll
            for (int m = 0; m < 4; ++m)
#pragma unroll
                for (int bj = 0; bj < 2; ++bj) {
                    f32x4 v0 = acc[ai][bj][m][0], v1 = acc[ai][bj][m][1];
                    v0[0] *= bflo(g[m][bj][0]); v0[1] *= bfhi(g[m][bj][0]); v0[2] *= bflo(g[m][bj][1]); v0[3] *= bfhi(g[m][bj][1]);
                    v1[0] *= bflo(g[m][bj][2]); v1[1] *= bfhi(g[m][bj][2]); v1[2] *= bflo(g[m][bj][3]); v1[3] *= bfhi(g[m][bj][3]);
                    float* dst = PART + ((size_t)u.z * 1024 + (size_t)(rbase + ai * 128 + m * 16 - MP)) * 1024 + cb + 128 * bj;
                    *(f32x4*)dst = v0; *(f32x4*)(dst + 4) = v1;
                }
        }
        return false;
    }
};
struct EpiP3 {
    const bf16_t* ACT; bf16_t* MERGED;
    __device__ __forceinline__ bool operator()(f32x4 (&acc)[2][2][4][2], const Unit& u, int wr, int wc, int fr, int fq) const {
        const int seg = u.z, rbase = u.x * 256 + wr * 64 + fr, cb = u.y * 256 + wc * 32 + 8 * fq;
        const bf16_t* gbase = ACT + C_GATE + seg * 1024 + cb;
#pragma unroll
        for (int ai = 0; ai < 2; ++ai) {
            u32x4 g[4][2], g2[4][2];
#pragma unroll
            for (int m = 0; m < 4; ++m)
#pragma unroll
                for (int bj = 0; bj < 2; ++bj) {
                    const bf16_t* gp = gbase + (size_t)(rbase + ai * 128 + m * 16) * ACT_LD + 128 * bj;
                    g[m][bj] = *(const u32x4*)gp;
                    if (seg < 2) g2[m][bj] = *(const u32x4*)(gp + 1024);
                }
#pragma unroll
            for (int m = 0; m < 4; ++m)
#pragma unroll
                for (int bj = 0; bj < 2; ++bj) {
                    float f[8];
#pragma unroll
                    for (int e = 0; e < 4; ++e) { f[2 * e] = bflo(g[m][bj][e]); f[2 * e + 1] = bfhi(g[m][bj][e]); }
                    if (seg < 2) {
#pragma unroll
                        for (int e = 0; e < 4; ++e) { f[2 * e] *= fast_rcp(bflo(g2[m][bj][e])); f[2 * e + 1] *= fast_rcp(bfhi(g2[m][bj][e])); }
                    }
                    f32x4& v0 = acc[ai][bj][m][0]; f32x4& v1 = acc[ai][bj][m][1];
#pragma unroll
                    for (int e = 0; e < 4; ++e) { v0[e] *= f[e]; v1[e] *= f[4 + e]; }
                    if (seg == 2) {
                        u32x4 o; o[0] = cvt_pk_bf16(v0[0], v0[1]); o[1] = cvt_pk_bf16(v0[2], v0[3]); o[2] = cvt_pk_bf16(v1[0], v1[1]); o[3] = cvt_pk_bf16(v1[2], v1[3]);
                        *(u32x4*)(MERGED + (size_t)(rbase + ai * 128 + m * 16) * 1024 + cb + 128 * bj) = o;
                    }
                }
        }
        return seg < 2;
    }
};
struct SchedP4 {
    int G, c; const char* A; const char* B;
    __device__ __forceinline__ bool next(int i, Unit& u) const {
        const int tl = i * G + c;
        if (tl >= 256) return false;
        u.x = tl >> 2; u.y = tl & 3; u.z = 0;
        u.a = A + (size_t)u.x * 256 * 2048; u.b = B + (size_t)u.y * 256 * 2048;
        return true;
    }
};
struct SchedP4T {
    int G, c; const char* A; const char* B;
    __device__ __forceinline__ bool next(int i, Unit& u) const {
        const int e = i * G + c;
        if (e >= 64) return false;
        const int tt = e >> 2, kq = e & 3;
        u.x = 64 + (tt >> 2); u.y = tt & 3; u.z = kq;
        u.a = A + (size_t)u.x * 256 * 2048 + kq * 512; u.b = B + (size_t)u.y * 256 * 2048 + kq * 512;
        return true;
    }
};
struct EpiP4T {
    float* PART;
    __device__ __forceinline__ bool operator()(f32x4 (&acc)[2][2][4][2], const Unit& u, int wr, int wc, int fr, int fq) const {
        const int rbase = u.x * 256 + wr * 64 + fr - MP, cbase = u.y * 256 + wc * 32 + fq * 4;
#pragma unroll
        for (int ai = 0; ai < 2; ++ai)
#pragma unroll
            for (int m = 0; m < 4; ++m)
#pragma unroll
                for (int bj = 0; bj < 2; ++bj)
#pragma unroll
                    for (int n = 0; n < 2; ++n)
                        *(f32x4*)(PART + ((size_t)u.z * 1024 + (size_t)(rbase + ai * 128 + m * 16)) * 1024 + cbase + bj * 128 + n * 16) = acc[ai][bj][m][n];
        return false;
    }
};
__device__ void p3_tail_fixup(const Params& p) {
    const int tid = opaque_tid();
    const float* P0 = (const float*)(p.ws + WS_PART);
    bf16_t* dst = (bf16_t*)(p.ws + WS_MERGED) + (size_t)MP * 1024;
    for (int idx = blockIdx.x * NTHREADS + tid; idx < 1024 * 128; idx += gridDim.x * NTHREADS) {
        const size_t o = (size_t)idx * 8;
        f32x4 a0 = *(const f32x4*)(P0 + o), a1 = *(const f32x4*)(P0 + o + 4);
#pragma unroll
        for (int q = 1; q < 6; ++q) { a0 += *(const f32x4*)(P0 + (size_t)q * 1024 * 1024 + o); a1 += *(const f32x4*)(P0 + (size_t)q * 1024 * 1024 + o + 4); }
        u32x4 w; w[0] = cvt_pk_bf16(a0[0], a0[1]); w[1] = cvt_pk_bf16(a0[2], a0[3]); w[2] = cvt_pk_bf16(a1[0], a1[1]); w[3] = cvt_pk_bf16(a1[2], a1[3]);
        *(u32x4*)(dst + o) = w;
    }
}
struct EpiP4 {
    const float* xp; const float* xs; float* out; float* SUMSQ;
    __device__ __forceinline__ bool operator()(f32x4 (&acc)[2][2][4][2], const Unit& u, int wr, int wc, int fr, int fq) const {
        const int rbase = u.x * 256 + wr * 64 + fr, cbase = u.y * 256 + wc * 32 + fq * 4;
#pragma unroll
        for (int ai = 0; ai < 2; ++ai) {
            f32x4 xv[4][2][2];
#pragma unroll
            for (int m = 0; m < 4; ++m) {
                const int row = rbase + ai * 128 + m * 16;
                const float* xr = row < MP ? xp + (size_t)row * 1024 : xs + (size_t)(row - MP) * 1024;
#pragma unroll
                for (int bj = 0; bj < 2; ++bj)
#pragma unroll
                    for (int n = 0; n < 2; ++n) xv[m][bj][n] = *(const f32x4*)(xr + cbase + bj * 128 + n * 16);
            }
#pragma unroll
            for (int m = 0; m < 4; ++m) {
                const int row = rbase + ai * 128 + m * 16;
                float ss = 0.f;
#pragma unroll
                for (int bj = 0; bj < 2; ++bj)
#pragma unroll
                    for (int n = 0; n < 2; ++n) {
                        const f32x4 v = acc[ai][bj][m][n] + xv[m][bj][n];
                        ss += v[0] * v[0] + v[1] * v[1] + v[2] * v[2] + v[3] * v[3];
                        *(f32x4*)(out + OUT_Y + (size_t)row * 1024 + cbase + bj * 128 + n * 16) = v;
                    }
                ss += __shfl_xor(ss, 16, 64); ss += __shfl_xor(ss, 32, 64);
                if (fq == 0) SUMSQ[(size_t)row * 16 + u.y * 4 + wc] = ss;
            }
        }
        return false;
    }
};
__device__ void phase5(const Params& p) {
    const int tid5 = opaque_tid(); const int lane = tid5 & 63, wid = tid5 >> 6;
    const float* SUMSQ = (const float*)(p.ws + WS_SUMSQ);
    const float* PART = (const float*)(p.ws + WS_PART);
    for (int row = blockIdx.x * 8 + wid; row < MALL; row += gridDim.x * 8) {
        float* y = p.out + OUT_Y + (size_t)row * 1024;
        f32x4 v[4]; float ss;
        if (row < MP) {
            ss = lane < 16 ? SUMSQ[(size_t)row * 16 + lane] : 0.f;
#pragma unroll
            for (int i = 0; i < 4; ++i) v[i] = *(const f32x4*)(y + i * 256 + lane * 4);
        } else {
            const float* xr = p.x_sample + (size_t)(row - MP) * 1024; ss = 0.f;
#pragma unroll
            for (int i = 0; i < 4; ++i) {
                v[i] = *(const f32x4*)(xr + i * 256 + lane * 4);
#pragma unroll
                for (int q = 0; q < 4; ++q) v[i] += *(const f32x4*)(PART + ((size_t)q * 1024 + (size_t)(row - MP)) * 1024 + i * 256 + lane * 4);
                ss += v[i][0] * v[i][0] + v[i][1] * v[i][1] + v[i][2] * v[i][2] + v[i][3] * v[i][3];
            }
        }
        ss = wave_sum(ss);
        const float inv = rsqrtf(ss * (1.0f / 1024.0f) + 1e-6f);
#pragma unroll
        for (int i = 0; i < 4; ++i) {
            const f32x4 g = *(const f32x4*)(p.norm_final + i * 256 + lane * 4);
            *(f32x4*)(y + i * 256 + lane * 4) = v[i] * inv * g;
        }
    }
}

__global__ void __launch_bounds__(NTHREADS) fwd_megakernel(Params p) {
    extern __shared__ __attribute__((aligned(16))) unsigned char smem[];
    cg::grid_group grid = cg::this_grid();
    LAS unsigned char* lds = (LAS unsigned char*)smem;
#ifndef PROBE_REP
#define PROBE_REP 0
#endif
#define REP(k) for (int _r = 0; _r < ((PROBE_REP == (k)) ? 2 : 1); ++_r)
    volatile LAS unsigned* xst = (volatile LAS unsigned*)(lds + LDS_MAIN);
    if (threadIdx.x == 0) { xst[0] = 0u; xst[1] = 0u; xst[2] = 0u; xst[3] = 0u; }
    __syncthreads();
    (void)xcd_barrier_post((unsigned*)(p.ws + WS_BAR), xst);
#define XBAR() do { XcdBarrier _b; _b.bar = (unsigned*)(p.ws + WS_BAR); _b.x = xb_xcc_id(); _b.st = (volatile LAS unsigned*)(lds + LDS_MAIN); xcd_barrier(_b); } while (0)
    REP(1) { phase0(p, smem); if (PROBE_REP == 1 && _r == 0) XBAR(); }
    if (p.ws == nullptr) grid.sync();
    XBAR();
    REP(2) {
        SchedP1 S{(int)gridDim.x, (int)blockIdx.x, (const char*)(p.ws + WS_AALL), (const char*)(p.ws + WS_BALL)};
        EpiP1 E{(bf16_t*)(p.ws + WS_U), (bf16_t*)(p.ws + WS_BG), (bf16_t*)(p.ws + WS_ACT), p.out, (bf16_t*)(p.ws + WS_KBF), (bf16_t*)(p.ws + WS_VT)};
        gemm_phase(lds, 2048, 2048, 1024, S, E);
        XBAR();
        if (PROBE_REP == 9) { EpiNull EN{(float*)(p.ws + WS_SUMSQ)}; gemm_phase(lds, 2048, 2048, 1024, S, EN); XBAR(); }
    }
    REP(3) { phase2_scan(p, smem); if (PROBE_REP == 3) XBAR(); }
    REP(5) { phase2_attn(p, smem); if (PROBE_REP == 5) XBAR(); }
    XBAR();
    REP(6) { phase2b(p, smem); XBAR(); }
    REP(7) {
        SchedP3 S{(int)gridDim.x, (int)blockIdx.x, (const char*)p.ws};
        EpiP3 E{(const bf16_t*)(p.ws + WS_ACT), (bf16_t*)(p.ws + WS_MERGED)};
        gemm_phase(lds, 2048, 2048, 1024, S, E);
        SchedP3T ST{(int)gridDim.x, (int)blockIdx.x, (const char*)p.ws};
        EpiP3T ET{(const bf16_t*)(p.ws + WS_ACT), (float*)(p.ws + WS_PART)};
        gemm_phase(lds, 2048, 2048, 512, ST, ET);
        XBAR();
        if (_r == 0) { p3_tail_fixup(p); XBAR(); }
    }
    REP(8) {
        SchedP4 S{(int)gridDim.x, (int)blockIdx.x, (const char*)(p.ws + WS_MERGED), (const char*)(p.ws + WS_WO)};
        EpiP4 E{p.x_prompt, p.x_sample, p.out, (float*)(p.ws + WS_SUMSQ)};
        gemm_phase(lds, 2048, 2048, 1024, S, E);
        SchedP4T ST{(int)gridDim.x, (int)blockIdx.x, (const char*)(p.ws + WS_MERGED), (const char*)(p.ws + WS_WO)};
        EpiP4T ET{(float*)(p.ws + WS_PART)};
        gemm_phase(lds, 2048, 2048, 256, ST, ET);
        XBAR();
    }
    phase5(p);
}

extern "C" void kernel_launch(void* const* d_in, const int* in_sizes, int n_in, void* d_out, int out_size, void* d_ws, size_t ws_size, hipStream_t stream) {
    static int grid_blocks = 0;
    if (!grid_blocks) {
        int dev = 0, cus = 0, per_cu = 0;
        hipGetDevice(&dev);
        hipDeviceGetAttribute(&cus, hipDeviceAttributeMultiprocessorCount, dev);
        if (hipFuncSetAttribute((const void*)fwd_megakernel, hipFuncAttributeMaxDynamicSharedMemorySize, LDS_BYTES) != hipSuccess) fprintf(stderr, "hipFuncSetAttribute failed\n");
        hipOccupancyMaxActiveBlocksPerMultiprocessor(&per_cu, (const void*)fwd_megakernel, NTHREADS, LDS_BYTES);
        if (per_cu < 1) { fprintf(stderr, "occupancy query returned %d\n", per_cu); per_cu = 1; }
        if (per_cu > 1) per_cu = 1;
        grid_blocks = cus * per_cu;
        if (grid_blocks > 256) grid_blocks = 256;
        grid_blocks &= ~31;
        if (grid_blocks < 64) grid_blocks = -1;
        if (ws_size < WS_END) { fprintf(stderr, "workspace too small: %zu < %zu\n", ws_size, (size_t)WS_END); grid_blocks = -1; }
    }
    if (grid_blocks < 0) return;
    Params p{};
    const float** pp = (const float**)&p;
    for (int i = 0; i < 27; ++i) pp[i] = (const float*)d_in[i];
    p.out = (float*)d_out; p.ws = (unsigned char*)d_ws;
    if (hipMemsetAsync((char*)d_ws + WS_BAR, 0, (size_t)XCD_BAR_WORDS_C * 4, stream) != hipSuccess) fprintf(stderr, "memset of barrier words failed\n");
    void* args[] = {&p};
    hipError_t e = hipLaunchCooperativeKernel((const void*)fwd_megakernel, dim3(grid_blocks), dim3(NTHREADS), args, LDS_BYTES, stream);
    if (e != hipSuccess) fprintf(stderr, "cooperative launch failed: %s (grid %d)\n", hipGetErrorString(e), grid_blocks);
}
```

```cpp
#include <hip/hip_runtime.h>
#include <hip/hip_cooperative_groups.h>
#include <cstdio>
namespace cg = cooperative_groups;

#define LAS __attribute__((address_space(3)))
typedef unsigned short bf16_t;
typedef short bf16x8 __attribute__((ext_vector_type(8)));
typedef float f32x4 __attribute__((ext_vector_type(4)));
typedef float f32x2 __attribute__((ext_vector_type(2)));
typedef unsigned u32x4 __attribute__((ext_vector_type(4)));
typedef unsigned u32x2 __attribute__((ext_vector_type(2)));

constexpr int DM = 1024, TP = 2048, BP = 8, MP = BP * TP, BS = 128, TS = 8, MS = BS * TS, MALL = MP + MS;
constexpr int NMEM = 256, DIN = 13440, DSHIFT = 3200;
constexpr int NPAD = 13568;
constexpr int ACT_LD = 9472;
constexpr int C_PR = 0, C_PK = 1024, C_PV = 2048, C_WD = 3072, C_AD = 3136, C_SGR = 3328, C_QM = 4352, C_SGM = 5376, C_GATE = 6400;
constexpr size_t OUT_Y = 0, OUT_MK = 17825792, OUT_MV = 19922944, OUT_CONV_P = 22020096, OUT_SHIFT_P = 22036480, OUT_WKV_P = 22062080,
                 OUT_CONV_S = 22586368, OUT_SHIFT_S = 22848512, OUT_WKV_S = 23258112;
constexpr size_t al256(size_t x) { return (x + 255) & ~(size_t)255; }
constexpr int XCD_BAR_WORDS_C = 3456;
constexpr size_t WS_AALL = 0;
constexpr size_t WS_BALL = al256(WS_AALL + (size_t)19456 * 1024 * 2);
constexpr size_t WS_YMEM = WS_AALL;
constexpr size_t WS_YCONV = WS_AALL + (size_t)MALL * 1024 * 2;
constexpr size_t WS_WB = al256(WS_BALL + (size_t)15616 * 1024 * 2);
constexpr size_t WS_WO = al256(WS_WB + (size_t)3072 * 1024 * 2);
constexpr size_t WS_U = al256(WS_WO + (size_t)1024 * 1024 * 2);
constexpr size_t WS_MERGED = WS_U;
constexpr size_t WS_BG = al256(WS_U + (size_t)MALL * 1024 * 2);
constexpr size_t WS_PART = WS_BG;
constexpr size_t WS_PRIV = WS_BG + (size_t)6 * 1024 * 1024 * 4;
constexpr size_t WS_ACT = al256(WS_BG + (size_t)MALL * 1024 * 2);
constexpr size_t WS_KBF = al256(WS_ACT + (size_t)MALL * ACT_LD * 2);
constexpr size_t WS_VT = al256(WS_KBF + (size_t)2048 * 1024 * 2);
constexpr size_t WS_YRWKV = al256(WS_VT + (size_t)2048 * 1024 * 2);
constexpr size_t WS_C3 = al256(WS_YRWKV + (size_t)MALL * 1024 * 2);
constexpr size_t WS_SUMSQ = al256(WS_C3 + (size_t)MALL * 16 * 4);
constexpr size_t WS_BAR = al256(WS_SUMSQ + (size_t)MALL * 16 * 4);
constexpr size_t WS_FRAG = al256(WS_BAR + (size_t)XCD_BAR_WORDS_C * 4);
constexpr size_t WS_END = al256(WS_FRAG + (size_t)16 * 2 * 8 * 64 * 16);
static_assert(WS_YCONV + (size_t)MALL * 1024 * 2 <= WS_WB, "alias overflow");
static_assert(WS_END <= 536870912, "workspace too large");
static_assert(WS_PRIV + (size_t)16 * 256 * 1024 * 2 <= WS_ACT, "tail scratch overflows BG");

constexpr int NTHREADS = 512;
constexpr int LDS_MAIN = 131072;
constexpr int LDS_BYTES = LDS_MAIN + 16;

struct Params {
    const float *x_prompt, *x_sample, *mem_prompt, *cache_k, *cache_v, *state_conv, *state_shift, *state_wkv, *norm_in, *w_in, *conv_w, *conv_b,
        *shift_mu, *decay_w0, *decay_up, *icl_a0, *icl_up, *k_k, *k_a, *r_k, *ln_g, *ln_b, *norm_mem, *w_mem_kv, *w_branch, *w_out, *norm_final;
    float* out;
    unsigned char* ws;
};

__device__ __forceinline__ int opaque_tid() { int t = threadIdx.x; asm volatile("" : "+v"(t)); return t; }
__device__ __forceinline__ float bf2f(bf16_t v) { return __uint_as_float(((unsigned)v) << 16); }
__device__ __forceinline__ unsigned cvt_pk_bf16(float lo, float hi) { unsigned r; asm volatile("v_cvt_pk_bf16_f32 %0, %1, %2" : "=v"(r) : "v"(lo), "v"(hi)); return r; }
__device__ __forceinline__ float bflo(unsigned u) { return __uint_as_float(u << 16); }
__device__ __forceinline__ float bfhi(unsigned u) { return __uint_as_float(u & 0xffff0000u); }
__device__ __forceinline__ float fast_rcp(float x) { return __builtin_amdgcn_rcpf(x); }
__device__ __forceinline__ float sigmoidf_(float x) { return fast_rcp(1.0f + __expf(-x)); }
__device__ __forceinline__ float siluf_(float x) { return x * sigmoidf_(x); }
__device__ __forceinline__ float wave_sum(float v) {
#pragma unroll
    for (int o = 32; o > 0; o >>= 1) v += __shfl_xor(v, o, 64);
    return v;
}
template <int CTRL> __device__ __forceinline__ float dpp_f(float x) {
    return __int_as_float(__builtin_amdgcn_update_dpp(0, __float_as_int(x), CTRL, 0xF, 0xF, true));
}
__device__ __forceinline__ float row16_sum(float x) {
    x += dpp_f<0xB1>(x);
    x += dpp_f<0x4E>(x);
    x += dpp_f<0x141>(x);
    x += dpp_f<0x140>(x);
    return x;
}


#define XB_TMO      128
#define XB_XCNT(j)  (256  + 64 * (j))
#define XB_XSUB(j)  (1280 + 64 * (j))
#define XB_XGEN(j)  (2304 + 64 * (j))
#define XB_TOP      3328
#define XB_TOPGEN   3392
#define XCD_BAR_WORDS 3456
#define XB_SPIN_CAP (1u << 22)
__device__ __forceinline__ unsigned xb_ld(unsigned* p)              { return __hip_atomic_load(p, __ATOMIC_RELAXED, __HIP_MEMORY_SCOPE_AGENT); }
__device__ __forceinline__ unsigned xb_add(unsigned* p, unsigned v) { return __hip_atomic_fetch_add(p, v, __ATOMIC_RELAXED, __HIP_MEMORY_SCOPE_AGENT); }
__device__ __forceinline__ unsigned xb_xcc_id() { return (unsigned)__builtin_amdgcn_s_getreg((3 << 11) | 20) & 0xFu; }
#define XB_SPIN(cond, bar) do { unsigned _sp = 0; while (cond) { __builtin_amdgcn_s_sleep(1); \
    if ((++_sp & 255u) == 0u) { if (xb_ld(&(bar)[XB_TMO])) break; if (_sp > XB_SPIN_CAP) { atomicAdd(&(bar)[XB_TMO], 1u); break; } } } } while (0)
struct XcdBarrier { unsigned* bar; unsigned x; volatile LAS unsigned* st; };
__device__ __forceinline__ XcdBarrier xcd_barrier_post(unsigned* bar, volatile LAS unsigned* st) {
    XcdBarrier b; b.bar = bar; b.x = xb_xcc_id(); b.st = st;
    if (threadIdx.x == 0) (void)xb_add(&bar[XB_XCNT(b.x)], 1u);
    return b;
}
__device__ __forceinline__ void xcd_barrier_complete(unsigned* bar, unsigned x, unsigned& nloc, unsigned& nx) {
    const unsigned G = gridDim.x * gridDim.y * gridDim.z;
    unsigned sum, cnt, mine, sp = 0u;
    for (;;) {
        sum = 0u; cnt = 0u; mine = 0u;
#pragma unroll
        for (unsigned j = 0; j < 16; ++j) { const unsigned c = xb_ld(&bar[XB_XCNT(j)]); sum += c; cnt += (c > 0u) ? 1u : 0u; mine = (j == x) ? c : mine; }
        if (sum == G) break;
        __builtin_amdgcn_s_sleep(1);
        if ((++sp & 255u) == 0u) { if (xb_ld(&bar[XB_TMO])) break; if (sp > XB_SPIN_CAP) { atomicAdd(&bar[XB_TMO], 1u); break; } }
    }
    nloc = mine > 0u ? mine : 1u; nx = cnt > 0u ? cnt : 1u;
}
__device__ __forceinline__ void xcd_barrier(const XcdBarrier& b) {
    asm volatile("s_waitcnt vmcnt(0)" ::: "memory");
    __syncthreads();
    if (threadIdx.x == 0) {
        unsigned* bar = b.bar;
        __builtin_amdgcn_s_waitcnt(0);
        unsigned nloc = b.st[0], nx = b.st[1];
        if (nloc == 0u) { xcd_barrier_complete(bar, b.x, nloc, nx); b.st[0] = nloc; b.st[1] = nx; }
        const unsigned old = xb_add(&bar[XB_XSUB(b.x)], 1u);
        const unsigned gen = old / nloc;
        if (old + 1u == (gen + 1u) * nloc) {
            __builtin_amdgcn_fence(__ATOMIC_RELEASE, "agent");
            asm volatile("s_waitcnt vmcnt(0)" ::: "memory");
            const unsigned og = xb_add(&bar[XB_TOP], 1u);
            const unsigned tg = og / nx;
            if (og + 1u == (tg + 1u) * nx) xb_add(&bar[XB_TOPGEN], 1u);
            else XB_SPIN(xb_ld(&bar[XB_TOPGEN]) == tg, bar);
            __builtin_amdgcn_fence(__ATOMIC_ACQUIRE, "agent");
            xb_add(&bar[XB_XGEN(b.x)], 1u);
            asm volatile("s_waitcnt vmcnt(0)" ::: "memory");
        } else {
            XB_SPIN(xb_ld(&bar[XB_XGEN(b.x)]) == gen, bar);
            __builtin_amdgcn_fence(__ATOMIC_ACQUIRE, "agent");
            asm volatile("s_waitcnt vmcnt(0)" ::: "memory");
        }
    }
    __syncthreads();
}

constexpr int BM = 256, BK = 64, HALF = 128, HTB = HALF * BK * 2;
__device__ __forceinline__ int lds_byte(int r, int c) { const int st = (r >> 4) * 2 + (c >> 5), rr = r & 15, cc = c & 31, ob = rr * 64 + cc * 2; return st * 1024 + (ob ^ (((ob >> 9) & 1) << 5)); }
__device__ __forceinline__ void stage_rc(int b, int& R, int& C) { const int st = b / 1024, sb = b % 1024, swz = sb ^ (((sb >> 9) & 1) << 5); R = (st >> 1) * 16 + swz / 64; C = (st & 1) * 32 + (swz % 64) / 2; }

struct Unit { const char* a; const char* b; int x, y, z; };

template <class Sched, class Epi>
__device__ __forceinline__ void gemm_phase(LAS unsigned char* lds, const int lda, const int ldb, const int K, const Sched& S, const Epi& E) {
    const int tid = opaque_tid(), wid = __builtin_amdgcn_readfirstlane(tid >> 6), lane = tid & 63, wr = wid >> 2, wc = wid & 3, fr = lane & 15, fq = lane >> 4;
    const int nt = K / BK;
    unsigned voffA[2], voffB[2];
#pragma unroll
    for (int i = 0; i < 2; ++i) { int R, C; stage_rc(tid * 16 + i * 8192, R, C); voffA[i] = (unsigned)(R * lda + C * 2); voffB[i] = (unsigned)(R * ldb + C * 2); }
    const size_t kstep = (size_t)(BK * 2);
    const size_t hA = (size_t)HALF * lda, hB = (size_t)HALF * ldb;
    const unsigned ldsw = (unsigned)wid * 1024u;
    const int aoff = lds_byte(wr * 64 + fr, fq * 8), boff = lds_byte(wc * 32 + fr, fq * 8);
#define G_SA(b, h) (((b) * 2 + (h)) * HTB)
#define G_SB(b, h) ((4 + (b) * 2 + (h)) * HTB)
#define G_STAGE(bufoff, gbase, voff) do { _Pragma("unroll") for (int _i = 0; _i < 2; ++_i) \
        __builtin_amdgcn_global_load_lds((const unsigned*)((const char*)(gbase) + (voff)[_i]), (LAS unsigned*)(lds + (bufoff) + ldsw + _i * 8192), 16, 0, 0); } while (0)
#define G_LDA(dst, b, h) do { _Pragma("unroll") for (int m = 0; m < 4; ++m) _Pragma("unroll") for (int k = 0; k < 2; ++k) dst[m][k] = *(const LAS bf16x8*)(lds + G_SA(b, h) + aoff + m * 2048 + k * 1024); } while (0)
#define G_LDB(dst, b, h) do { _Pragma("unroll") for (int n = 0; n < 2; ++n) _Pragma("unroll") for (int k = 0; k < 2; ++k) dst[n][k] = *(const LAS bf16x8*)(lds + G_SB(b, h) + boff + n * 2048 + k * 1024); } while (0)
#define G_MMA(ai, bj, At, Bt) do { __builtin_amdgcn_s_setprio(1); _Pragma("unroll") for (int m = 0; m < 4; ++m) _Pragma("unroll") for (int n = 0; n < 2; ++n) _Pragma("unroll") for (int k = 0; k < 2; ++k) \
        acc[ai][bj][m][n] = __builtin_amdgcn_mfma_f32_16x16x32_bf16(Bt[n][k], At[m][k], acc[ai][bj][m][n], 0, 0, 0); __builtin_amdgcn_s_setprio(0); } while (0)
#define G_WAIT_V(n) asm volatile("s_waitcnt vmcnt(" #n ")" ::: "memory")
#define G_WAIT_L(n) asm volatile("s_waitcnt lgkmcnt(" #n ")" ::: "memory")
#define G_BAR __builtin_amdgcn_s_barrier()
#define G_SCHED __builtin_amdgcn_sched_barrier(0)
    Unit cur, nxt; int ui = 0;
    if (!S.next(0, cur)) return;
    f32x4 acc[2][2][4][2];
#pragma unroll
    for (int a = 0; a < 2; ++a)
#pragma unroll
        for (int b = 0; b < 2; ++b)
#pragma unroll
            for (int m = 0; m < 4; ++m)
#pragma unroll
                for (int n = 0; n < 2; ++n) acc[a][b][m][n] = (f32x4){0.f, 0.f, 0.f, 0.f};
    bf16x8 At[4][2], B0[2][2], B1[2][2];
    const char* cA = cur.a; const char* cB = cur.b;
    G_STAGE(G_SB(0, 0), cB, voffB); G_STAGE(G_SA(0, 0), cA, voffA); G_STAGE(G_SB(0, 1), cB + hB, voffB); G_STAGE(G_SA(0, 1), cA + hA, voffA);
    if (wr == 1) G_BAR;
    G_WAIT_V(4); G_BAR;
    G_STAGE(G_SB(1, 0), cB + kstep, voffB); G_STAGE(G_SA(1, 0), cA + kstep, voffA); G_STAGE(G_SB(1, 1), cB + hB + kstep, voffB);
    G_WAIT_V(6); G_BAR;
    for (;;) {
        const bool has_next = S.next(ui + 1, nxt);
        const char* nA = has_next ? nxt.a : cA; const char* nB = has_next ? nxt.b : cB;
        for (int t = 0; t < nt; t += 2) {
            const bool last = (t == nt - 2);
            const char* a1 = cA + (size_t)(t + 1) * kstep;
            const char* a2 = last ? nA : cA + (size_t)(t + 2) * kstep; const char* b2 = last ? nB : cB + (size_t)(t + 2) * kstep;
            const char* a3 = a2 + kstep; const char* b3 = b2 + kstep;
            G_LDB(B0, 0, 0); G_SCHED; G_LDA(At, 0, 0); G_STAGE(G_SA(1, 1), a1 + hA, voffA);
            G_WAIT_L(8); G_BAR; G_WAIT_L(0); G_MMA(0, 0, At, B0); G_BAR; G_SCHED;
            G_LDB(B1, 0, 1); G_STAGE(G_SB(0, 0), b2, voffB);
            G_BAR; G_WAIT_L(0); G_MMA(0, 1, At, B1); G_BAR;
            G_LDA(At, 0, 1); G_STAGE(G_SA(0, 0), a2, voffA);
            G_BAR; G_WAIT_L(0); G_MMA(1, 0, At, B0); G_BAR; G_SCHED;
            G_STAGE(G_SB(0, 1), b2 + hB, voffB);
            G_WAIT_V(6); G_BAR; G_MMA(1, 1, At, B1); G_BAR;
            G_LDB(B0, 1, 0); G_SCHED; G_LDA(At, 1, 0); G_STAGE(G_SA(0, 1), a2 + hA, voffA);
            G_WAIT_L(8); G_BAR; G_WAIT_L(0); G_MMA(0, 0, At, B0); G_BAR; G_SCHED;
            G_LDB(B1, 1, 1); G_STAGE(G_SB(1, 0), b3, voffB);
            G_BAR; G_WAIT_L(0); G_MMA(0, 1, At, B1); G_BAR;
            G_LDA(At, 1, 1); G_STAGE(G_SA(1, 0), a3, voffA);
            G_BAR; G_WAIT_L(0); G_MMA(1, 0, At, B0); G_BAR; G_SCHED;
            G_STAGE(G_SB(1, 1), b3 + hB, voffB);
            G_WAIT_V(6); G_BAR; G_MMA(1, 1, At, B1); G_BAR;
        }
        const bool keep = E(acc, cur, wr, wc, fr, fq);
        if (!has_next) break;
        if (!keep) {
#pragma unroll
            for (int a = 0; a < 2; ++a)
#pragma unroll
                for (int b = 0; b < 2; ++b)
#pragma unroll
                    for (int m = 0; m < 4; ++m)
#pragma unroll
                        for (int n = 0; n < 2; ++n) acc[a][b][m][n] = (f32x4){0.f, 0.f, 0.f, 0.f};
        }
        cur = nxt; cA = nA; cB = nB; ++ui;
    }
    G_WAIT_V(0);
    if (wr == 0) G_BAR;
    G_BAR;
#undef G_SA
#undef G_SB
#undef G_STAGE
#undef G_LDA
#undef G_LDB
#undef G_MMA
#undef G_WAIT_V
#undef G_WAIT_L
#undef G_BAR
#undef G_SCHED
}

__device__ __forceinline__ int perm8_local(int c) {
    const int bj = c >> 7, wc = (c >> 5) & 3, n = (c >> 4) & 1, fq = (c >> 2) & 3, e = c & 3;
    return 128 * bj + 32 * wc + 8 * fq + 4 * n + e;
}
__device__ __forceinline__ int colmap_in(int np) {
    const int j = np >> 8, c = np & 255;
    if (j < 16) {
        const int bj = c >> 7, wc = (c >> 5) & 3, n = (c >> 4) & 1, fq = (c >> 2) & 3, e = c & 3;
        return (2 * bj + n) * 1024 + j * 64 + wc * 16 + fq * 4 + e;
    }
    const int L = (j - 16) * 256 + perm8_local(c);
    if (L < 3200) return 4096 + L;
    if (L < 3328) return -1;
    return L + 3968;
}

__device__ void phase0(const Params& p, unsigned char* smem) {
    const int tid = opaque_tid(), lane = tid & 63, wid = tid >> 6;
    bf16_t* Aall = (bf16_t*)(p.ws + WS_AALL);
    for (int row = blockIdx.x * 8 + wid; row < 19456; row += gridDim.x * 8) {
        const float* src; const float* g;
        if (row < MP) { src = p.x_prompt + (size_t)row * 1024; g = p.norm_in; }
        else if (row < MALL) { src = p.x_sample + (size_t)(row - MP) * 1024; g = p.norm_in; }
        else { src = p.mem_prompt + (size_t)(row - MALL) * 1024; g = p.norm_mem; }
        f32x4 v[4]; float ss = 0.f;
#pragma unroll
        for (int i = 0; i < 4; ++i) { v[i] = *(const f32x4*)(src + i * 256 + lane * 4); ss += v[i][0] * v[i][0] + v[i][1] * v[i][1] + v[i][2] * v[i][2] + v[i][3] * v[i][3]; }
        ss = wave_sum(ss);
        const float inv = rsqrtf(ss * (1.0f / 1024.0f) + 1e-6f);
#pragma unroll
        for (int i = 0; i < 4; ++i) {
            const f32x4 gg = *(const f32x4*)(g + i * 256 + lane * 4);
            u32x2 o; o[0] = cvt_pk_bf16(v[i][0] * inv * gg[0], v[i][1] * inv * gg[1]); o[1] = cvt_pk_bf16(v[i][2] * inv * gg[2], v[i][3] * inv * gg[3]);
            *(u32x2*)(Aall + (size_t)row * 1024 + i * 256 + lane * 4) = o;
        }
    }
    for (int idx = blockIdx.x * NTHREADS + tid; idx < 16 * 2 * 8 * 64; idx += gridDim.x * NTHREADS) {
        const int ln = idx & 63, f = (idx >> 6) & 7, mat = (idx >> 9) & 1, hh = idx >> 10;
        const int it = f >> 1, ks = f & 1, fr = ln & 15, fq = ln >> 4;
        const float* src = mat ? p.icl_up : p.decay_up;
        float w[8];
#pragma unroll
        for (int jj = 0; jj < 8; ++jj) w[jj] = src[(size_t)(ks * 32 + fq * 8 + jj) * 1024 + hh * 64 + it * 16 + fr];
        u32x4 pk; pk[0] = cvt_pk_bf16(w[0], w[1]); pk[1] = cvt_pk_bf16(w[2], w[3]); pk[2] = cvt_pk_bf16(w[4], w[5]); pk[3] = cvt_pk_bf16(w[6], w[7]);
        *(u32x4*)(p.ws + WS_FRAG + (size_t)idx * 16) = pk;
    }
    bf16_t* T = (bf16_t*)smem;
    const int NT_IN = 212 * 16, NT_KV = 32 * 16, NT_WB = 3 * 16 * 16, NT_WO = 16 * 16;
    const int total = NT_IN + NT_KV + NT_WB + NT_WO;
    for (int tix = blockIdx.x; tix < total; tix += gridDim.x) {
        const float* src; int src_ld; bf16_t* dst; int n0, k0, mode;
        if (tix < NT_IN) { src = p.w_in; src_ld = DIN; dst = (bf16_t*)(p.ws + WS_BALL); n0 = (tix >> 4) * 64; k0 = (tix & 15) * 64; mode = 0; }
        else if (tix < NT_IN + NT_KV) { const int t2 = tix - NT_IN; src = p.w_mem_kv; src_ld = 2048; dst = (bf16_t*)(p.ws + WS_BALL) + (size_t)NPAD * 1024; n0 = (t2 >> 4) * 64; k0 = (t2 & 15) * 64; mode = 1; }
        else if (tix < NT_IN + NT_KV + NT_WB) { const int t2 = tix - NT_IN - NT_KV; const int i = t2 >> 8, t3 = t2 & 255; src = p.w_branch + (size_t)i * 1024 * 1024; src_ld = 1024;
            dst = (bf16_t*)(p.ws + WS_WB) + (size_t)i * 1024 * 1024; n0 = (t3 >> 4) * 64; k0 = (t3 & 15) * 64; mode = 2; }
        else { const int t3 = tix - NT_IN - NT_KV - NT_WB; src = p.w_out; src_ld = 1024; dst = (bf16_t*)(p.ws + WS_WO); n0 = (t3 >> 4) * 64; k0 = (t3 & 15) * 64; mode = 2; }
        {
            const int kk = tid >> 3, seg = tid & 7;
#pragma unroll
            for (int q = 0; q < 2; ++q) {
                const int nl = seg * 8 + q * 4, np = n0 + nl;
                int sc;
                if (mode == 0) sc = colmap_in(np);
                else if (mode == 1) sc = np;
                else sc = (np & ~255) + perm8_local(np & 255);
                f32x4 v = (f32x4){0.f, 0.f, 0.f, 0.f};
                if (sc >= 0) v = *(const f32x4*)(src + (size_t)(k0 + kk) * src_ld + sc);
                const unsigned a = cvt_pk_bf16(v[0], v[1]), b = cvt_pk_bf16(v[2], v[3]);
                T[(nl + 0) * 66 + kk] = (bf16_t)(a & 0xffff); T[(nl + 1) * 66 + kk] = (bf16_t)(a >> 16);
                T[(nl + 2) * 66 + kk] = (bf16_t)(b & 0xffff); T[(nl + 3) * 66 + kk] = (bf16_t)(b >> 16);
            }
        }
        __syncthreads();
        {
            const int nl = tid >> 3, ks = tid & 7;
            const unsigned* tp = (const unsigned*)(T + nl * 66 + ks * 8);
            u32x4 v; v[0] = tp[0]; v[1] = tp[1]; v[2] = tp[2]; v[3] = tp[3];
            *(u32x4*)(dst + (size_t)(n0 + nl) * 1024 + k0 + ks * 8) = v;
        }
        __syncthreads();
    }
}

struct SchedP1 {
    int G, c; const char* Aall; const char* Ball;
    __device__ __forceinline__ bool next(int i, Unit& u) const {
        const int L = i * G + c;
        constexpr int nM = 68, nN = 53, nwg = nM * nN, WGM = 8;
        if (L >= nwg + 96) return false;
        if (L < nwg) {
            int wgid = L; { const int q = nwg / 8, r = nwg % 8, xcd = wgid % 8, off = wgid / 8; wgid = (xcd < r ? xcd * (q + 1) : r * (q + 1) + (xcd - r) * q) + off; }
            const int nig = WGM * nN, gid = wgid / nig, fm = gid * WGM, gsz = (nM - fm) < WGM ? (nM - fm) : WGM;
            u.x = fm + ((wgid % nig) % gsz); u.y = (wgid % nig) / gsz; u.z = 0;
            u.a = Aall + (size_t)u.x * 256 * 2048; u.b = Ball + (size_t)u.y * 256 * 2048;
        } else {
            int k = L - nwg;
            if (k < 32) { u.x = k >> 2; u.y = k & 3; u.z = 1; u.a = Aall + (size_t)(68 + u.x) * 256 * 2048; u.b = Ball + (size_t)(53 + u.y) * 256 * 2048; }
            else if (k < 64) { k -= 32; u.x = k >> 2; u.y = k & 3; u.z = 2; u.a = Aall + (size_t)(68 + u.x) * 256 * 2048; u.b = Ball + (size_t)(57 + u.y) * 256 * 2048; }
            else { k -= 64; u.x = k >> 3; u.y = k & 7; u.z = 3; u.a = Ball + (size_t)(57 + u.x) * 256 * 2048; u.b = Aall + (size_t)(68 + u.y) * 256 * 2048; }
        }
        return true;
    }
};

struct EpiNull { __device__ __forceinline__ bool operator()(f32x4 (&acc)[2][2][4][2], const Unit& u, int wr, int wc, int fr, int fq) const { float t = 0.f;
#pragma unroll
        for (int a = 0; a < 2; ++a)
#pragma unroll
            for (int b = 0; b < 2; ++b)
#pragma unroll
                for (int m = 0; m < 4; ++m)
#pragma unroll
                    for (int n = 0; n < 2; ++n) t += acc[a][b][m][n][0] + acc[a][b][m][n][1] + acc[a][b][m][n][2] + acc[a][b][m][n][3];
        if (t == 123.456f) sink[0] = t; return false; }
    float* sink; };
struct EpiP1 {
    bf16_t* U; bf16_t* BG; bf16_t* ACT; float* out; bf16_t* Kbf; bf16_t* Vt;
    __device__ __forceinline__ bool operator()(f32x4 (&acc)[2][2][4][2], const Unit& u, int wr, int wc, int fr, int fq) const {
        const int type = u.z;
        if (type == 0) {
            const int pn = u.y, rbase = u.x * 256 + wr * 64 + fr;
            if (pn < 16) {
                const int ch0 = pn * 64 + wc * 16 + fq * 4;
#pragma unroll
                for (int ai = 0; ai < 2; ++ai)
#pragma unroll
                    for (int m = 0; m < 4; ++m) {
                        const int row = rbase + ai * 128 + m * 16;
                        const f32x4 h = acc[ai][0][m][0], Bv = acc[ai][0][m][1], Cv = acc[ai][1][m][0], g = acc[ai][1][m][1];
                        const f32x4 u4 = Cv * h;
                        f32x4 bg;
#pragma unroll
                        for (int e = 0; e < 4; ++e) bg[e] = Bv[e] * siluf_(g[e]);
                        u32x2 o; o[0] = cvt_pk_bf16(u4[0], u4[1]); o[1] = cvt_pk_bf16(u4[2], u4[3]);
                        *(u32x2*)(U + (size_t)row * 1024 + ch0) = o;
                        o[0] = cvt_pk_bf16(bg[0], bg[1]); o[1] = cvt_pk_bf16(bg[2], bg[3]);
                        *(u32x2*)(BG + (size_t)row * 1024 + ch0) = o;
                        if (row < MP) { const int t = row & 2047; if (t >= 2046) *(f32x4*)(out + OUT_CONV_P + (size_t)((row >> 11) * 2 + (t - 2046)) * 1024 + ch0) = u4; }
                        else { const int rs = row - MP, t = rs & 7; if (t >= 6) *(f32x4*)(out + OUT_CONV_S + (size_t)((rs >> 3) * 2 + (t - 6)) * 1024 + ch0) = u4; }
                    }
            } else {
                const int L0 = (pn - 16) * 256;
                const int kind = pn <= 28 ? 0 : pn <= 32 ? 1 : pn <= 36 ? 2 : pn <= 40 ? 1 : 3;
#pragma unroll
                for (int ai = 0; ai < 2; ++ai)
#pragma unroll
                    for (int m = 0; m < 4; ++m) {
                        const int row = rbase + ai * 128 + m * 16;
#pragma unroll
                        for (int bj = 0; bj < 2; ++bj) {
                            const int L = L0 + 128 * bj + 32 * wc + 8 * fq;
                            f32x4 v0 = acc[ai][bj][m][0], v1 = acc[ai][bj][m][1];
                            if (kind == 0) {
                                if (L < DSHIFT) {
                                    if (row < MP) { if ((row & 2047) == 2047) { float* d = out + OUT_SHIFT_P + (size_t)(row >> 11) * DSHIFT + L; *(f32x4*)d = v0; *(f32x4*)(d + 4) = v1; } }
                                    else { const int rs = row - MP; if ((rs & 7) == 7) { float* d = out + OUT_SHIFT_S + (size_t)(rs >> 3) * DSHIFT + L; *(f32x4*)d = v0; *(f32x4*)(d + 4) = v1; } }
                                }
                            } else if (kind == 1) {
#pragma unroll
                                for (int e = 0; e < 4; ++e) { v0[e] = siluf_(v0[e]); v1[e] = siluf_(v1[e]); }
                            } else if (kind == 2) { v0 *= 0.0625f; v1 *= 0.0625f; }
                            else {
#pragma unroll
                                for (int e = 0; e < 4; ++e) { v0[e] = sigmoidf_(v0[e]); v1[e] = sigmoidf_(v1[e]); }
                            }
                            u32x4 o; o[0] = cvt_pk_bf16(v0[0], v0[1]); o[1] = cvt_pk_bf16(v0[2], v0[3]); o[2] = cvt_pk_bf16(v1[0], v1[1]); o[3] = cvt_pk_bf16(v1[2], v1[3]);
                            *(u32x4*)(ACT + (size_t)row * ACT_LD + L) = o;
                        }
                    }
            }
        } else {
            const int rbase = u.x * 256 + wr * 64 + fr, cbase = u.y * 256 + wc * 32 + fq * 4;
#pragma unroll
            for (int ai = 0; ai < 2; ++ai)
#pragma unroll
                for (int m = 0; m < 4; ++m) {
                    const int row = rbase + ai * 128 + m * 16;
#pragma unroll
                    for (int bj = 0; bj < 2; ++bj)
#pragma unroll
                        for (int n = 0; n < 2; ++n) {
                            const int col = cbase + bj * 128 + n * 16;
                            const f32x4 v = acc[ai][bj][m][n];
                            if (type == 1) { *(f32x4*)(out + OUT_MK + (size_t)row * 1024 + col) = v;
                                u32x2 o; o[0] = cvt_pk_bf16(v[0], v[1]); o[1] = cvt_pk_bf16(v[2], v[3]); *(u32x2*)(Kbf + (size_t)row * 1024 + col) = o; }
                            else if (type == 2) { *(f32x4*)(out + OUT_MV + (size_t)row * 1024 + col) = v; }
                            else { u32x2 o; o[0] = cvt_pk_bf16(v[0], v[1]); o[1] = cvt_pk_bf16(v[2], v[3]); *(u32x2*)(Vt + (size_t)row * 2048 + col) = o; }
                        }
                }
        }
        return false;
    }
};

struct ChunkDesc { int r0, b, h, half, samp, t0, n, first, last, bstep; };
__device__ __forceinline__ int n_chunks(const int bid, const int G) {
    const int n_long = bid < 256 ? (255 - bid) / G + 1 : 0, n_samp = bid < 4096 ? (4095 - bid) / G + 1 : 0;
    return n_long * 64 + ((n_samp + 3) >> 2);
}
__device__ __forceinline__ bool chunk_desc(const int ci, const int bid, const int G, ChunkDesc& d) {
    const int n_long = bid < 256 ? (255 - bid) / G + 1 : 0;
    const int n_samp = bid < 4096 ? (4095 - bid) / G + 1 : 0;
    const int nc_long = n_long * 64;
    if (ci < nc_long) { const int k = ci >> 6, it = bid + k * G, chain = it >> 1; d.b = chain >> 4; d.h = chain & 15; d.half = it & 1; d.samp = 0; d.r0 = d.b * TP; d.bstep = 0;
        d.t0 = (ci & 63) * 32; d.n = 32; d.first = (ci & 63) == 0; d.last = (ci & 63) == 63; return true; }
    const int k0 = (ci - nc_long) * 4; if (ci < 0 || k0 >= n_samp) return false;
    const int it = bid + k0 * G, chain = it >> 1; d.b = chain >> 4; d.h = chain & 15; d.half = it & 1; d.samp = 1; d.r0 = 0; d.t0 = 0; d.bstep = G >> 5;
    const int ni = n_samp - k0 < 4 ? n_samp - k0 : 4; d.n = ni * 8; d.first = 1; d.last = 1; return true;
}
__device__ __forceinline__ int cd_batch(const ChunkDesc& d, const int t) { return d.samp ? d.b + (t >> 3) * d.bstep : d.b; }
__device__ __forceinline__ int cd_row(const ChunkDesc& d, const int t) { return d.samp ? MP + (d.b + (t >> 3) * d.bstep) * 8 + (t & 7) : d.r0 + d.t0 + t; }
__device__ __forceinline__ bool cd_first(const ChunkDesc& d, const int t) { return d.samp ? (t & 7) == 0 : (d.t0 + t) == 0; }
constexpr int SROW = 68;
constexpr int SBUF = 6 * 32 * SROW + 64;
__device__ __forceinline__ f32x2 lo2(const f32x4 v) { return __builtin_shufflevector(v, v, 0, 1); }
__device__ __forceinline__ f32x2 hi2(const f32x4 v) { return __builtin_shufflevector(v, v, 2, 3); }
__device__ __forceinline__ float tanh_fast(float x) { return 1.0f - 2.0f * fast_rcp(1.0f + __expf(2.0f * x)); }

__device__ __forceinline__ void unpack4(const u32x2 v, float (&o)[4]) { o[0] = bflo(v[0]); o[1] = bfhi(v[0]); o[2] = bflo(v[1]); o[3] = bfhi(v[1]); }

struct OpSet { f32x4 kk, wr, w, b, k; f32x2 v, cc; };
__device__ __forceinline__ void reduce4_row16(float a0, float a1, float b0, float b1, float c0, float c1, float d0, float d1, float& A, float& B, float& C, float& D) {
    asm volatile(
        "v_add_f32 %0, %4, %5\n\tv_add_f32 %1, %6, %7\n\tv_add_f32 %2, %8, %9\n\tv_add_f32 %3, %10, %11\n\t"
        "v_add_f32_dpp %0, %0, %0 quad_perm:[1,0,3,2] row_mask:0xf bank_mask:0xf\n\tv_add_f32_dpp %1, %1, %1 quad_perm:[1,0,3,2] row_mask:0xf bank_mask:0xf\n\t"
        "v_add_f32_dpp %2, %2, %2 quad_perm:[1,0,3,2] row_mask:0xf bank_mask:0xf\n\tv_add_f32_dpp %3, %3, %3 quad_perm:[1,0,3,2] row_mask:0xf bank_mask:0xf\n\t"
        "v_add_f32_dpp %0, %0, %0 quad_perm:[2,3,0,1] row_mask:0xf bank_mask:0xf\n\tv_add_f32_dpp %1, %1, %1 quad_perm:[2,3,0,1] row_mask:0xf bank_mask:0xf\n\t"
        "v_add_f32_dpp %2, %2, %2 quad_perm:[2,3,0,1] row_mask:0xf bank_mask:0xf\n\tv_add_f32_dpp %3, %3, %3 quad_perm:[2,3,0,1] row_mask:0xf bank_mask:0xf\n\t"
        "v_add_f32_dpp %0, %0, %0 row_half_mirror row_mask:0xf bank_mask:0xf\n\tv_add_f32_dpp %1, %1, %1 row_half_mirror row_mask:0xf bank_mask:0xf\n\t"
        "v_add_f32_dpp %2, %2, %2 row_half_mirror row_mask:0xf bank_mask:0xf\n\tv_add_f32_dpp %3, %3, %3 row_half_mirror row_mask:0xf bank_mask:0xf\n\t"
        "v_add_f32_dpp %0, %0, %0 row_mirror row_mask:0xf bank_mask:0xf\n\tv_add_f32_dpp %1, %1, %1 row_mirror row_mask:0xf bank_mask:0xf\n\t"
        "v_add_f32_dpp %2, %2, %2 row_mirror row_mask:0xf bank_mask:0xf\n\tv_add_f32_dpp %3, %3, %3 row_mirror row_mask:0xf bank_mask:0xf\n\t"
        "s_nop 1"
        : "=&v"(A), "=&v"(B), "=&v"(C), "=&v"(D)
        : "v"(a0), "v"(a1), "v"(b0), "v"(b1), "v"(c0), "v"(c1), "v"(d0), "v"(d1));
}
struct PrepState { f32x4 aw[4], aa[4]; float ksf[16]; float rn; };

struct PrepRaw { u32x4 wdc[2], wdp[2], adc[2], adp[2]; u32x2 kc[4], kp[4]; };
struct PrepRaw2 { u32x2 rc[4], rp[4], vc[4], vp[4]; };
__device__ __forceinline__ void prep_load(const Params& p, const ChunkDesc& d, const int tb, const int lane, PrepRaw& R) {
    const int fr = lane & 15, fq = lane >> 4;
    const int t = tb + fr; const int tt = t < d.n ? t : d.n - 1;
    const size_t row = (size_t)cd_row(d, tt);
    const bool isfirst = cd_first(d, tt);
    const bf16_t* cur = (const bf16_t*)(p.ws + WS_ACT) + row * ACT_LD;
    const bf16_t* prv = isfirst ? cur : cur - ACT_LD;
    const int hc = d.h * 64 + 4 * fq;
#pragma unroll
    for (int ks = 0; ks < 2; ++ks) {
        R.wdc[ks] = *(const u32x4*)(cur + C_WD + ks * 32 + fq * 8); R.wdp[ks] = *(const u32x4*)(prv + C_WD + ks * 32 + fq * 8);
        R.adc[ks] = *(const u32x4*)(cur + C_AD + ks * 32 + fq * 8); R.adp[ks] = *(const u32x4*)(prv + C_AD + ks * 32 + fq * 8);
    }
#pragma unroll
    for (int it = 0; it < 4; ++it) { R.kc[it] = *(const u32x2*)(cur + C_PK + hc + it * 16); R.kp[it] = *(const u32x2*)(prv + C_PK + hc + it * 16); }
}
__device__ __forceinline__ void prep_load2(const Params& p, const ChunkDesc& d, const int tb, const int lane, PrepRaw2& R) {
    const int fr = lane & 15, fq = lane >> 4;
    const int t = tb + fr; const int tt = t < d.n ? t : d.n - 1;
    const size_t row = (size_t)cd_row(d, tt);
    const bool isfirst = cd_first(d, tt);
    const bf16_t* cur = (const bf16_t*)(p.ws + WS_ACT) + row * ACT_LD;
    const bf16_t* prv = isfirst ? cur : cur - ACT_LD;
    const int hc = d.h * 64 + 4 * fq;
#pragma unroll
    for (int it = 0; it < 4; ++it) {
        R.rc[it] = *(const u32x2*)(cur + C_PR + hc + it * 16); R.rp[it] = *(const u32x2*)(prv + C_PR + hc + it * 16);
        R.vc[it] = *(const u32x2*)(cur + C_PV + hc + it * 16); R.vp[it] = *(const u32x2*)(prv + C_PV + hc + it * 16);
    }
}
__device__ __forceinline__ void shift4(const u32x2 cu, const u32x2 pr, const float* st, const bool isfirst, const bool samp, const int col, const f32x4 mu, float (&o)[4]) {
    float c[4], q[4];
    unpack4(cu, c); unpack4(pr, q);
    if (isfirst) {
        if (samp) { const f32x4 v = *(const f32x4*)(st + col); q[0] = v[0]; q[1] = v[1]; q[2] = v[2]; q[3] = v[3]; }
        else { q[0] = 0.f; q[1] = 0.f; q[2] = 0.f; q[3] = 0.f; }
    }
#pragma unroll
    for (int e = 0; e < 4; ++e) o[e] = c[e] + mu[e] * (q[e] - c[e]);
}

__device__ __forceinline__ void prep_stage1(const Params& p, const ChunkDesc& d, const int tb, const float* par, const int lane, const PrepRaw& R, PrepState& S) {
    const int fr = lane & 15, fq = lane >> 4;
    const int t = tb + fr; const int tt = t < d.n ? t : d.n - 1;
    const bool isfirst = cd_first(d, tt), samp = d.samp != 0;
    const float* st = p.state_shift + (size_t)cd_batch(d, tt) * DSHIFT;
    bf16x8 bw[2], ba[2];
#pragma unroll
    for (int ks = 0; ks < 2; ++ks) {
#pragma unroll
        for (int which = 0; which < 2; ++which) {
            const int col = (which ? C_AD : C_WD) + ks * 32 + fq * 8;
            const u32x4 cu = which ? R.adc[ks] : R.wdc[ks], pr = which ? R.adp[ks] : R.wdp[ks];
            float x0[4], x1[4];
            shift4((u32x2){cu[0], cu[1]}, (u32x2){pr[0], pr[1]}, st, isfirst, samp, col, *(const f32x4*)(par + 512 + which * 64 + ks * 32 + fq * 8), x0);
            shift4((u32x2){cu[2], cu[3]}, (u32x2){pr[2], pr[3]}, st, isfirst, samp, col + 4, *(const f32x4*)(par + 512 + which * 64 + ks * 32 + fq * 8 + 4), x1);
            if (!which) {
#pragma unroll
                for (int e = 0; e < 4; ++e) { x0[e] = tanh_fast(x0[e]); x1[e] = tanh_fast(x1[e]); }
            }
            u32x4 pk; pk[0] = cvt_pk_bf16(x0[0], x0[1]); pk[1] = cvt_pk_bf16(x0[2], x0[3]); pk[2] = cvt_pk_bf16(x1[0], x1[1]); pk[3] = cvt_pk_bf16(x1[2], x1[3]);
            if (which) ba[ks] = __builtin_bit_cast(bf16x8, pk); else bw[ks] = __builtin_bit_cast(bf16x8, pk);
        }
    }
    const bf16x8* ft = (const bf16x8*)(p.ws + WS_FRAG) + (size_t)d.h * 1024 + lane;
    __builtin_amdgcn_sched_barrier(0);
#pragma unroll
    for (int it = 0; it < 4; ++it) {
        S.aw[it] = (f32x4){0.f, 0.f, 0.f, 0.f}; S.aa[it] = S.aw[it];
#pragma unroll
        for (int ks = 0; ks < 2; ++ks) {
            S.aw[it] = __builtin_amdgcn_mfma_f32_16x16x32_bf16(ft[(it * 2 + ks) * 64], bw[ks], S.aw[it], 0, 0, 0);
            S.aa[it] = __builtin_amdgcn_mfma_f32_16x16x32_bf16(ft[(8 + it * 2 + ks) * 64], ba[ks], S.aa[it], 0, 0, 0);
        }
        if (it & 1) __builtin_amdgcn_sched_barrier(0);
    }
    const int hc = d.h * 64 + 4 * fq;
    float ss = 0.f;
#pragma unroll
    for (int it = 0; it < 4; ++it) {
        const int po = it * 16 + 4 * fq;
        float k4[4];
        shift4(R.kc[it], R.kp[it], st, isfirst, samp, C_PK + hc + it * 16, *(const f32x4*)(par + 64 + po), k4);
        const f32x4 kkp = *(const f32x4*)(par + 5 * 64 + po);
#pragma unroll
        for (int e = 0; e < 4; ++e) { S.ksf[it * 4 + e] = k4[e]; const float kr = k4[e] * kkp[e]; ss += kr * kr; }
        __builtin_amdgcn_sched_barrier(0);
    }
    ss += __shfl_xor(ss, 16, 64); ss += __shfl_xor(ss, 32, 64);
    S.rn = rsqrtf(ss + 1e-12f);
}

__device__ __forceinline__ void prep_stage2(const Params& p, const ChunkDesc& d, const int tb, float* buf, const float* par, const int lane, const PrepRaw2& R, const PrepState& S) {
    const int fr = lane & 15, fq = lane >> 4;
    const int t = tb + fr; const bool valid = t < d.n; const int tt = valid ? t : d.n - 1;
    const bool isfirst = cd_first(d, tt), samp = d.samp != 0;
    const float* st = p.state_shift + (size_t)cd_batch(d, tt) * DSHIFT;
    const int hc = d.h * 64 + 4 * fq;
    float c1 = 0.f, c2 = 0.f, c3 = 0.f;
    float* kkA = buf; float* wrA = buf + 32 * SROW; float* wA = buf + 2 * 32 * SROW; float* bA = buf + 3 * 32 * SROW; float* kpA = buf + 4 * 32 * SROW; float* vsA = buf + 5 * 32 * SROW; float* c12 = buf + 6 * 32 * SROW;
#pragma unroll
    for (int it = 0; it < 4; ++it) {
        const int po = it * 16 + 4 * fq;
        const f32x4 w0 = *(const f32x4*)(par + 3 * 64 + po), a0 = *(const f32x4*)(par + 4 * 64 + po), kkp = *(const f32x4*)(par + 5 * 64 + po), ka = *(const f32x4*)(par + 6 * 64 + po), rk = *(const f32x4*)(par + 7 * 64 + po);
        f32x4 o_kk, o_wr, o_w, o_b, o_kp, o_vs;
        float r4[4], v4[4];
        shift4(R.rc[it], R.rp[it], st, isfirst, samp, C_PR + hc + it * 16, *(const f32x4*)(par + po), r4);
        shift4(R.vc[it], R.vp[it], st, isfirst, samp, C_PV + hc + it * 16, *(const f32x4*)(par + 128 + po), v4);
#pragma unroll
        for (int e = 0; e < 4; ++e) {
            const float r_ = r4[e], k_ = S.ksf[it * 4 + e];
            const float dec = __expf(-0.6065306597f * sigmoidf_(S.aw[it][e] + w0[e]));
            const float a = sigmoidf_(S.aa[it][e] + a0[e]);
            const float kn = k_ * kkp[e] * S.rn;
            const float kpv = k_ * (1.0f + (a - 1.0f) * ka[e]);
            const float bv = kn * a;
            c1 += bv * r_; c2 += kpv * r_; c3 += r_ * kpv * rk[e];
            o_kk[e] = kn; o_wr[e] = dec * r_; o_w[e] = dec; o_b[e] = bv; o_kp[e] = kpv; o_vs[e] = v4[e];
        }
        if (valid) {
            const int o = t * SROW + po;
            *(f32x4*)(kkA + o) = o_kk; *(f32x4*)(wrA + o) = o_wr; *(f32x4*)(wA + o) = o_w; *(f32x4*)(bA + o) = o_b; *(f32x4*)(kpA + o) = o_kp; *(f32x4*)(vsA + o) = o_vs;
        }
        __builtin_amdgcn_sched_barrier(0);
    }
    c1 += __shfl_xor(c1, 16, 64); c1 += __shfl_xor(c1, 32, 64);
    c2 += __shfl_xor(c2, 16, 64); c2 += __shfl_xor(c2, 32, 64);
    c3 += __shfl_xor(c3, 16, 64); c3 += __shfl_xor(c3, 32, 64);
    if (valid && fq == 0) { c12[t * 2] = c1; c12[t * 2 + 1] = c2; if (d.half == 0) ((float*)(p.ws + WS_C3))[(size_t)cd_row(d, t) * 16 + d.h] = c3; }
}

__device__ void phase2_scan(const Params& p, unsigned char* smem) {
    const int tid = opaque_tid(), lane = tid & 63, wid = __builtin_amdgcn_readfirstlane(tid >> 6);
    const int bid = blockIdx.x, G = gridDim.x;
    float* sm = (float*)smem;
    float* bufs = sm;
    float* obuf = sm + 2 * SBUF;
    float* parb = obuf + 2 * 1024;
    const int NC = n_chunks(bid, G);
    float* ORAW = p.out + OUT_Y;
    __syncthreads();
    if (NC == 0) return;
    if (wid < 4) {
        __builtin_amdgcn_s_setprio(3);
        const int c = lane & 15, rg = lane >> 4, rl = wid * 8 + rg * 2;
        f32x2 s00 = (f32x2){0.f, 0.f}, s01 = s00, s10 = s00, s11 = s00;
        __syncthreads();
        __syncthreads();
        for (int ci = 0; ci < NC; ++ci) {
            ChunkDesc d; chunk_desc(ci, bid, G, d);
            const float* buf = bufs + (ci & 1) * SBUF;
            const float* kkA = buf + 4 * c; const float* vsA = buf + 5 * 32 * SROW + d.half * 32 + rl; const float* c12 = buf + 6 * 32 * SROW;
            float* ob = obuf + (ci & 1) * 1024 + rl;
            const int nsub = d.samp ? (d.n >> 3) : 1;
            OpSet A, B;
            auto ld = [&](OpSet& o, const int t) {
                o.kk = *(const f32x4*)(kkA + t * SROW); o.wr = *(const f32x4*)(kkA + 32 * SROW + t * SROW); o.w = *(const f32x4*)(kkA + 2 * 32 * SROW + t * SROW);
                o.b = *(const f32x4*)(kkA + 3 * 32 * SROW + t * SROW); o.k = *(const f32x4*)(kkA + 4 * 32 * SROW + t * SROW);
                o.v = *(const f32x2*)(vsA + t * SROW); o.cc = *(const f32x2*)(c12 + t * 2);
            };
            auto step = [&](const OpSet& o, const int t) {
                const f32x2 pd0 = s00 * lo2(o.kk) + s01 * hi2(o.kk), pd1 = s10 * lo2(o.kk) + s11 * hi2(o.kk);
                const f32x2 pe0 = s00 * lo2(o.wr) + s01 * hi2(o.wr), pe1 = s10 * lo2(o.wr) + s11 * hi2(o.wr);
                float d0, d1, e0, e1;
                reduce4_row16(pd0[0], pd0[1], pd1[0], pd1[1], pe0[0], pe0[1], pe1[0], pe1[1], d0, d1, e0, e1);
                const f32x2 vv0 = (f32x2){o.v[0], o.v[0]}, vv1 = (f32x2){o.v[1], o.v[1]}, dd0 = (f32x2){d0, d0}, dd1 = (f32x2){d1, d1};
                s00 = s00 * lo2(o.w) + (lo2(o.k) * vv0 - lo2(o.b) * dd0);
                s01 = s01 * hi2(o.w) + (hi2(o.k) * vv0 - hi2(o.b) * dd0);
                s10 = s10 * lo2(o.w) + (lo2(o.k) * vv1 - lo2(o.b) * dd1);
                s11 = s11 * hi2(o.w) + (hi2(o.k) * vv1 - hi2(o.b) * dd1);
                if (c == 0) { f32x2 ov; ov[0] = e0 - d0 * o.cc[0] + o.v[0] * o.cc[1]; ov[1] = e1 - d1 * o.cc[0] + o.v[1] * o.cc[1]; *(f32x2*)(ob + t * 32) = ov; }
            };
            auto run = [&](const int tbeg, const int tend) {
                ld(A, tbeg);
                for (int t = tbeg; t < tend; t += 2) {
                    ld(B, t + 1);
                    step(A, t);
                    ld(A, (t + 2 < tend) ? t + 2 : t);
                    step(B, t + 1);
                }
            };
            auto put_state = [&](float* so) {
                f32x4 a, b2; a[0] = s00[0]; a[1] = s00[1]; a[2] = s01[0]; a[3] = s01[1]; b2[0] = s10[0]; b2[1] = s10[1]; b2[2] = s11[0]; b2[3] = s11[1];
                *(f32x4*)so = a; *(f32x4*)(so + 64) = b2;
            };
            if (d.samp) {
                f32x4 ia[4], ib[4]; size_t off[4];
#pragma unroll
                for (int sub = 0; sub < 4; ++sub) {
                    const int sb = sub < nsub ? sub : nsub - 1;
                    off[sub] = ((size_t)(cd_batch(d, sb * 8) * 16 + d.h) * 64 + d.half * 32 + rl) * 64 + 4 * c;
                    ia[sub] = *(const f32x4*)(p.state_wkv + off[sub]); ib[sub] = *(const f32x4*)(p.state_wkv + off[sub] + 64);
                }
#pragma unroll
                for (int sub = 0; sub < 4; ++sub) {
                    if (sub < nsub) {
                        s00 = lo2(ia[sub]); s01 = hi2(ia[sub]); s10 = lo2(ib[sub]); s11 = hi2(ib[sub]);
                        run(sub * 8, sub * 8 + 8);
                        put_state(p.out + OUT_WKV_S + off[sub]);
                    }
                }
            } else {
                if (d.first) { s00 = (f32x2){0.f, 0.f}; s01 = s00; s10 = s00; s11 = s00; }
                run(0, d.n);
                if (d.last) put_state(p.out + OUT_WKV_P + ((size_t)(d.b * 16 + d.h) * 64 + d.half * 32 + rl) * 64 + 4 * c);
            }
            __syncthreads();
        }
        __syncthreads();
        __builtin_amdgcn_s_setprio(0);
    } else {
        const int q = (wid >> 1) & 1, tb = (wid & 1) * 16;
        float* par = parb + (wid & 3) * 640;
        PrepState S;
        int cur_h = -1;
        for (int i = -2; i <= NC; ++i) {
            if ((i & 1) == q) {
                ChunkDesc d;
                int ck = i + 2; ck = ck < 0 ? 0 : (ck > NC - 1 ? NC - 1 : ck);
                chunk_desc(ck, bid, G, d);
                if (d.h != cur_h) {
                    cur_h = d.h;
                    const int ch = d.h * 64 + lane;
                    par[lane] = p.shift_mu[ch]; par[64 + lane] = p.shift_mu[1024 + ch]; par[128 + lane] = p.shift_mu[2048 + ch]; par[192 + lane] = p.decay_w0[ch];
                    par[256 + lane] = p.icl_a0[ch]; par[320 + lane] = p.k_k[ch]; par[384 + lane] = p.k_a[ch]; par[448 + lane] = p.r_k[ch];
                    par[512 + lane] = p.shift_mu[C_WD + lane]; par[576 + lane] = p.shift_mu[C_AD + lane];
                }
                PrepRaw R;
                prep_load(p, d, tb, lane, R);
                prep_stage1(p, d, tb, par, lane, R, S);
            } else {
                ChunkDesc d, d2;
                PrepRaw2 R2;
                const bool has2 = i >= -1 && i + 1 < NC && chunk_desc(i + 1, bid, G, d2) && tb < d2.n;
                if (has2) prep_load2(p, d2, tb, lane, R2);
                if (i >= 1 && chunk_desc(i - 1, bid, G, d)) {
                    const float* ob = obuf + ((i - 1) & 1) * 1024;
                    for (int idx = (wid & 1) * 64 + lane; idx < d.n * 8; idx += 128) { const int t = idx >> 3, j = (idx & 7) * 4; *(f32x4*)(ORAW + (size_t)cd_row(d, t) * 1024 + d.h * 64 + d.half * 32 + j) = *(const f32x4*)(ob + t * 32 + j); }
                }
                if (has2) prep_stage2(p, d2, tb, bufs + ((i + 1) & 1) * SBUF, par, lane, R2, S);
            }
            __syncthreads();
        }
    }
}

__device__ void attn_unit(const Params& p, unsigned char* smem, const int unit) {
    const int tid = opaque_tid(), lane = tid & 63, wid = __builtin_amdgcn_readfirstlane(tid >> 6), fr = lane & 15, fq = lane >> 4;
    const int b = unit >> 6, h = (unit >> 4) & 3, tile = unit & 15;
    const bf16_t* ACT = (const bf16_t*)(p.ws + WS_ACT);
    const bf16_t* Kbf = (const bf16_t*)(p.ws + WS_KBF);
    const bf16_t* Vt = (const bf16_t*)(p.ws + WS_VT);
    bf16_t* Ymem = (bf16_t*)(p.ws + WS_YMEM);
    bf16_t* Kc = (bf16_t*)smem;
    bf16_t* Vc = (bf16_t*)smem;
    const int row = b * 2048 + tile * 128 + wid * 16 + fr;
    u32x4 st[8];
    auto ldK = [&](const int hf) {
#pragma unroll
        for (int i = 0; i < 8; ++i) { const int id = tid + i * NTHREADS, key = id >> 5, d = (id & 31) * 8; st[i] = *(const u32x4*)(Kbf + (size_t)(b * 256 + hf * 128 + key) * 1024 + h * 256 + d); }
    };
    auto stK = [&]() {
#pragma unroll
        for (int i = 0; i < 8; ++i) { const int id = tid + i * NTHREADS, key = id >> 5, d = (id & 31) * 8; *(u32x4*)(Kc + key * 264 + d) = st[i]; }
    };
    auto ldV = [&](const int hf) {
#pragma unroll
        for (int i = 0; i < 8; ++i) { const int id = tid + i * NTHREADS, d = id >> 4, kc = (id & 15) * 8; st[i] = *(const u32x4*)(Vt + (size_t)(h * 256 + d) * 2048 + b * 256 + hf * 128 + kc); }
    };
    auto stV = [&]() {
#pragma unroll
        for (int i = 0; i < 8; ++i) { const int id = tid + i * NTHREADS, d = id >> 4, kc = (id & 15) * 8; *(u32x4*)(Vc + d * 136 + kc) = st[i]; }
    };
    ldK(0);
    bf16x8 qf[8];
#pragma unroll
    for (int ks = 0; ks < 8; ++ks) qf[ks] = *(const bf16x8*)(ACT + (size_t)row * ACT_LD + C_QM + h * 256 + ks * 32 + fq * 8);
    f32x4 sacc[16];
#pragma unroll
    for (int i = 0; i < 16; ++i) sacc[i] = (f32x4){0.f, 0.f, 0.f, 0.f};
#pragma unroll
    for (int hf = 0; hf < 2; ++hf) {
        __syncthreads();
        stK();
        __syncthreads();
        if (hf == 0) ldK(1); else ldV(0);
#pragma unroll
        for (int kt = 0; kt < 8; ++kt)
#pragma unroll
            for (int ks = 0; ks < 8; ++ks) {
                const bf16x8 kf = *(const bf16x8*)(Kc + (kt * 16 + fr) * 264 + ks * 32 + fq * 8);
                sacc[hf * 8 + kt] = __builtin_amdgcn_mfma_f32_16x16x32_bf16(kf, qf[ks], sacc[hf * 8 + kt], 0, 0, 0);
            }
    }
    float mx = -3.0e38f;
#pragma unroll
    for (int i = 0; i < 16; ++i) mx = fmaxf(mx, fmaxf(fmaxf(sacc[i][0], sacc[i][1]), fmaxf(sacc[i][2], sacc[i][3])));
    mx = fmaxf(mx, __shfl_xor(mx, 16, 64)); mx = fmaxf(mx, __shfl_xor(mx, 32, 64));
    float sum = 0.f;
#pragma unroll
    for (int i = 0; i < 16; ++i)
#pragma unroll
        for (int e = 0; e < 4; ++e) { const float ex = __expf(sacc[i][e] - mx); sacc[i][e] = ex; sum += ex; }
    sum += __shfl_xor(sum, 16, 64); sum += __shfl_xor(sum, 32, 64);
    const float inv = fast_rcp(sum);
    bf16x8 pf[8];
#pragma unroll
    for (int s2 = 0; s2 < 8; ++s2) {
        u32x4 t; t[0] = cvt_pk_bf16(sacc[2 * s2][0], sacc[2 * s2][1]); t[1] = cvt_pk_bf16(sacc[2 * s2][2], sacc[2 * s2][3]);
        t[2] = cvt_pk_bf16(sacc[2 * s2 + 1][0], sacc[2 * s2 + 1][1]); t[3] = cvt_pk_bf16(sacc[2 * s2 + 1][2], sacc[2 * s2 + 1][3]);
        pf[s2] = __builtin_bit_cast(bf16x8, t);
    }
    f32x4 oacc[16];
#pragma unroll
    for (int i = 0; i < 16; ++i) oacc[i] = (f32x4){0.f, 0.f, 0.f, 0.f};
#pragma unroll
    for (int hf = 0; hf < 2; ++hf) {
        __syncthreads();
        stV();
        __syncthreads();
        if (hf == 0) ldV(1);
#pragma unroll
        for (int dt = 0; dt < 16; ++dt)
#pragma unroll
            for (int s2 = 0; s2 < 4; ++s2) {
                const u32x2 lo = *(const u32x2*)(Vc + (dt * 16 + fr) * 136 + s2 * 32 + 4 * fq), hi = *(const u32x2*)(Vc + (dt * 16 + fr) * 136 + s2 * 32 + 16 + 4 * fq);
                u32x4 t; t[0] = lo[0]; t[1] = lo[1]; t[2] = hi[0]; t[3] = hi[1];
                oacc[dt] = __builtin_amdgcn_mfma_f32_16x16x32_bf16(__builtin_bit_cast(bf16x8, t), pf[hf * 4 + s2], oacc[dt], 0, 0, 0);
            }
    }
#pragma unroll
    for (int dt = 0; dt < 16; ++dt) {
        const int d = h * 256 + dt * 16 + 4 * fq;
        const u32x2 g = *(const u32x2*)(ACT + (size_t)row * ACT_LD + C_SGM + d);
        u32x2 o; o[0] = cvt_pk_bf16(oacc[dt][0] * inv * bflo(g[0]), oacc[dt][1] * inv * bfhi(g[0])); o[1] = cvt_pk_bf16(oacc[dt][2] * inv * bflo(g[1]), oacc[dt][3] * inv * bfhi(g[1]));
        *(u32x2*)(Ymem + (size_t)row * 1024 + d) = o;
    }
}

__device__ void attn_sample_unit(const Params& p, unsigned char* smem, const int b, const int h) {
    const int tid = opaque_tid(), lane = tid & 63, wid = __builtin_amdgcn_readfirstlane(tid >> 6), fr = lane & 15, fq = lane >> 4;
    const bf16_t* ACT = (const bf16_t*)(p.ws + WS_ACT);
    bf16_t* Ymem = (bf16_t*)(p.ws + WS_YMEM);
    bf16_t* Kc = (bf16_t*)smem;
    float* Ored = (float*)smem;
    float* Pl = (float*)(smem + 69632);
    const int row = MP + b * 8 + (fr & 7);
    bf16x8 qf[8];
#pragma unroll
    for (int ks = 0; ks < 8; ++ks) qf[ks] = *(const bf16x8*)(ACT + (size_t)row * ACT_LD + C_QM + h * 256 + ks * 32 + fq * 8);
    const float* vbase = p.cache_v + ((size_t)(b * 256 + wid * 32) * 4 + h) * 256 + lane * 4;
    f32x4 vv[8];
#pragma unroll
    for (int i = 0; i < 8; ++i) vv[i] = *(const f32x4*)(vbase + (size_t)i * 1024);
    f32x4 sacc[16];
#pragma unroll
    for (int i = 0; i < 16; ++i) sacc[i] = (f32x4){0.f, 0.f, 0.f, 0.f};
#pragma unroll
    for (int hf = 0; hf < 2; ++hf) {
        __syncthreads();
#pragma unroll
        for (int i = 0; i < 8; ++i) {
            const int id = tid + i * NTHREADS, key = id >> 5, d = (id & 31) * 8;
            const float* s_ = p.cache_k + ((size_t)(b * 256 + hf * 128 + key) * 4 + h) * 256 + d; const f32x4 x0 = *(const f32x4*)s_, x1 = *(const f32x4*)(s_ + 4);
            u32x4 v; v[0] = cvt_pk_bf16(x0[0], x0[1]); v[1] = cvt_pk_bf16(x0[2], x0[3]); v[2] = cvt_pk_bf16(x1[0], x1[1]); v[3] = cvt_pk_bf16(x1[2], x1[3]);
            *(u32x4*)(Kc + key * 264 + d) = v;
        }
        __syncthreads();
#pragma unroll
        for (int kt = 0; kt < 8; ++kt)
#pragma unroll
            for (int ks = 0; ks < 8; ++ks) {
                const bf16x8 kf = *(const bf16x8*)(Kc + (kt * 16 + fr) * 264 + ks * 32 + fq * 8);
                sacc[hf * 8 + kt] = __builtin_amdgcn_mfma_f32_16x16x32_bf16(kf, qf[ks], sacc[hf * 8 + kt], 0, 0, 0);
            }
    }
    float mx = -3.0e38f;
#pragma unroll
    for (int i = 0; i < 16; ++i) mx = fmaxf(mx, fmaxf(fmaxf(sacc[i][0], sacc[i][1]), fmaxf(sacc[i][2], sacc[i][3])));
    mx = fmaxf(mx, __shfl_xor(mx, 16, 64)); mx = fmaxf(mx, __shfl_xor(mx, 32, 64));
    float sum = 0.f;
#pragma unroll
    for (int i = 0; i < 16; ++i)
#pragma unroll
        for (int e = 0; e < 4; ++e) { const float ex = __expf(sacc[i][e] - mx); sacc[i][e] = ex; sum += ex; }
    sum += __shfl_xor(sum, 16, 64); sum += __shfl_xor(sum, 32, 64);
    const float inv = fast_rcp(sum);
    if (wid == 0 && fr < 8) {
#pragma unroll
        for (int i = 0; i < 16; ++i)
#pragma unroll
            for (int e = 0; e < 4; ++e) Pl[(i * 16 + 4 * fq + e) * 8 + fr] = sacc[i][e] * inv;
    }
    __syncthreads();
    f32x4 o[8];
#pragma unroll
    for (int t = 0; t < 8; ++t) o[t] = (f32x4){0.f, 0.f, 0.f, 0.f};
#pragma unroll
    for (int half = 0; half < 4; ++half) {
        if (half >= 1) {
#pragma unroll
            for (int i = 0; i < 8; ++i) vv[i] = *(const f32x4*)(vbase + (size_t)(half * 8 + i) * 1024);
        }
#pragma unroll
        for (int i = 0; i < 8; ++i) {
            const float* pp = Pl + (wid * 32 + half * 8 + i) * 8;
            const f32x4 p0 = *(const f32x4*)pp, p1 = *(const f32x4*)(pp + 4);
#pragma unroll
            for (int t = 0; t < 4; ++t) { o[t] += vv[i] * p0[t]; o[4 + t] += vv[i] * p1[t]; }
        }
    }
#pragma unroll
    for (int t = 0; t < 8; ++t) *(f32x4*)(Ored + (wid * 8 + t) * 256 + lane * 4) = o[t];
    __syncthreads();
    {
        const int t = tid >> 6, d = (tid & 63) * 4;
        f32x4 acc = (f32x4){0.f, 0.f, 0.f, 0.f};
#pragma unroll
        for (int w = 0; w < 8; ++w) acc += *(const f32x4*)(Ored + (w * 8 + t) * 256 + d);
        const size_t orow = (size_t)(MP + b * 8 + t);
        const u32x2 g = *(const u32x2*)(ACT + orow * ACT_LD + C_SGM + h * 256 + d);
        u32x2 ov; ov[0] = cvt_pk_bf16(acc[0] * bflo(g[0]), acc[1] * bfhi(g[0])); ov[1] = cvt_pk_bf16(acc[2] * bflo(g[1]), acc[3] * bfhi(g[1]));
        *(u32x2*)(Ymem + orow * 1024 + h * 256 + d) = ov;
    }
}

__device__ void phase2_attn(const Params& p, unsigned char* smem) {
    __syncthreads();
    for (int k = blockIdx.x; k < 1024; k += gridDim.x) {
        const int u = (k + ((blockIdx.x & 1) << 9)) & 1023;
        if (u < 512) attn_unit(p, smem, u); else attn_sample_unit(p, smem, (u - 512) >> 2, u & 3);
    }
}

__device__ __forceinline__ void ld16bf(const bf16_t* ptr, float (&o)[16]) {
    const u32x4 a = *(const u32x4*)ptr, b = *(const u32x4*)(ptr + 8);
#pragma unroll
    for (int e = 0; e < 4; ++e) { o[2 * e] = bflo(a[e]); o[2 * e + 1] = bfhi(a[e]); o[8 + 2 * e] = bflo(b[e]); o[8 + 2 * e + 1] = bfhi(b[e]); }
}
__device__ __forceinline__ void ld16f(const float* ptr, float (&o)[16]) {
#pragma unroll
    for (int q = 0; q < 4; ++q) { const f32x4 v = *(const f32x4*)(ptr + 4 * q); o[4 * q] = v[0]; o[4 * q + 1] = v[1]; o[4 * q + 2] = v[2]; o[4 * q + 3] = v[3]; }
}
__device__ __forceinline__ void st16bf(bf16_t* ptr, const float (&y)[16]) {
    u32x4 a, b;
#pragma unroll
    for (int e = 0; e < 4; ++e) { a[e] = cvt_pk_bf16(y[2 * e], y[2 * e + 1]); b[e] = cvt_pk_bf16(y[8 + 2 * e], y[8 + 2 * e + 1]); }
    *(u32x4*)ptr = a; *(u32x4*)(ptr + 8) = b;
}
__device__ __forceinline__ float quad_sum(float x) { x += dpp_f<0xB1>(x); x += dpp_f<0x4E>(x); return x; }
struct RowRaw { u32x4 u0[2], u1[2], u2[2], bg[2], vc[2], vq[2], sg[2]; f32x4 o[4]; float c3; };
__device__ __forceinline__ void up16(const u32x4 (&r)[2], float (&o)[16]) {
#pragma unroll
    for (int e = 0; e < 4; ++e) { o[2 * e] = bflo(r[0][e]); o[2 * e + 1] = bfhi(r[0][e]); o[8 + 2 * e] = bflo(r[1][e]); o[8 + 2 * e + 1] = bfhi(r[1][e]); }
}
__device__ __forceinline__ float bfe16(const u32x4 (&r)[2], const int i) { const unsigned w = r[i >> 3][(i >> 1) & 3]; return (i & 1) ? bfhi(w) : bflo(w); }
__device__ void phase2b(const Params& p, unsigned char* smem) {
    const int tid = opaque_tid(), lane = tid & 63, wid = tid >> 6;
    float* tab = (float*)smem;
    __syncthreads();
    for (int idx = tid; idx < 7168; idx += NTHREADS)
        tab[idx] = idx < 3072 ? p.conv_w[idx] : idx < 4096 ? p.conv_b[idx - 3072] : idx < 5120 ? p.shift_mu[2048 + idx - 4096] : idx < 6144 ? p.ln_g[idx - 5120] : p.ln_b[idx - 6144];
    __syncthreads();
    const bf16_t* U = (const bf16_t*)(p.ws + WS_U); const bf16_t* BG = (const bf16_t*)(p.ws + WS_BG); const bf16_t* ACT = (const bf16_t*)(p.ws + WS_ACT);
    const float* ORAW = p.out + OUT_Y; const float* C3 = (const float*)(p.ws + WS_C3);
    bf16_t* Yc = (bf16_t*)(p.ws + WS_YCONV); bf16_t* Yr = (bf16_t*)(p.ws + WS_YRWKV);
    const int ch = lane * 16;
    auto load_row = [&](const int row, RowRaw& R) {
        const bool samp = row >= MP; const int t = samp ? ((row - MP) & 7) : (row & 2047);
        const int r1 = t >= 1 ? row - 1 : row, r2 = t >= 2 ? row - 2 : row;
#pragma unroll
        for (int q = 0; q < 2; ++q) {
            R.u0[q] = *(const u32x4*)(U + (size_t)row * 1024 + ch + 8 * q); R.u1[q] = *(const u32x4*)(U + (size_t)r1 * 1024 + ch + 8 * q); R.u2[q] = *(const u32x4*)(U + (size_t)r2 * 1024 + ch + 8 * q);
            R.bg[q] = *(const u32x4*)(BG + (size_t)row * 1024 + ch + 8 * q);
            R.vc[q] = *(const u32x4*)(ACT + (size_t)row * ACT_LD + C_PV + ch + 8 * q); R.vq[q] = *(const u32x4*)(ACT + (size_t)r1 * ACT_LD + C_PV + ch + 8 * q);
            R.sg[q] = *(const u32x4*)(ACT + (size_t)row * ACT_LD + C_SGR + ch + 8 * q);
        }
#pragma unroll
        for (int q = 0; q < 4; ++q) R.o[q] = *(const f32x4*)(ORAW + (size_t)row * 1024 + ch + 4 * q);
        R.c3 = C3[(size_t)row * 16 + (lane >> 2)];
    };
    auto process_row = [&](const int row, const RowRaw& R) {
        int b, t; const bool samp = row >= MP;
        if (!samp) { b = row >> 11; t = row & 2047; } else { b = (row - MP) >> 3; t = (row - MP) & 7; }
        const bool z1 = t < 1, z2 = t < 2;
        u32x4 yo[2];
#pragma unroll
        for (int q = 0; q < 4; ++q) {
            const f32x4 w0 = *(const f32x4*)(tab + ch + 4 * q), w1 = *(const f32x4*)(tab + 1024 + ch + 4 * q), w2 = *(const f32x4*)(tab + 2048 + ch + 4 * q), cb = *(const f32x4*)(tab + 3072 + ch + 4 * q);
            f32x4 m1 = (f32x4){0.f, 0.f, 0.f, 0.f}, m2 = m1;
            if (z1) { if (samp) m1 = *(const f32x4*)(p.state_conv + ((size_t)b * 2 + 1) * 1024 + ch + 4 * q); }
            else { m1[0] = bfe16(R.u1, 4 * q); m1[1] = bfe16(R.u1, 4 * q + 1); m1[2] = bfe16(R.u1, 4 * q + 2); m1[3] = bfe16(R.u1, 4 * q + 3); }
            if (z2) { if (samp) m2 = *(const f32x4*)(p.state_conv + ((size_t)b * 2 + t) * 1024 + ch + 4 * q); }
            else { m2[0] = bfe16(R.u2, 4 * q); m2[1] = bfe16(R.u2, 4 * q + 1); m2[2] = bfe16(R.u2, 4 * q + 2); m2[3] = bfe16(R.u2, 4 * q + 3); }
            float y[4];
#pragma unroll
            for (int e = 0; e < 4; ++e) { const int i = 4 * q + e; y[e] = bfe16(R.bg, i) * (cb[e] + w0[e] * m2[e] + w1[e] * m1[e] + w2[e] * bfe16(R.u0, i)); }
            yo[q >> 1][(q & 1) * 2] = cvt_pk_bf16(y[0], y[1]); yo[q >> 1][(q & 1) * 2 + 1] = cvt_pk_bf16(y[2], y[3]);
        }
        *(u32x4*)(Yc + (size_t)row * 1024 + ch) = yo[0]; *(u32x4*)(Yc + (size_t)row * 1024 + ch + 8) = yo[1];
        float sm_ = 0.f;
#pragma unroll
        for (int q = 0; q < 4; ++q) sm_ += R.o[q][0] + R.o[q][1] + R.o[q][2] + R.o[q][3];
        const float mean = quad_sum(sm_) * (1.0f / 64.0f);
        float vr = 0.f;
#pragma unroll
        for (int q = 0; q < 4; ++q)
#pragma unroll
            for (int e = 0; e < 4; ++e) { const float dl = R.o[q][e] - mean; vr += dl * dl; }
        const float rstd = rsqrtf(quad_sum(vr) * (1.0f / 64.0f) + 6.4e-4f);
#pragma unroll
        for (int q = 0; q < 4; ++q) {
            const f32x4 mv = *(const f32x4*)(tab + 4096 + ch + 4 * q), lg = *(const f32x4*)(tab + 5120 + ch + 4 * q), lb = *(const f32x4*)(tab + 6144 + ch + 4 * q);
            f32x4 pq = (f32x4){0.f, 0.f, 0.f, 0.f};
            if (z1) { if (samp) pq = *(const f32x4*)(p.state_shift + (size_t)b * DSHIFT + 2048 + ch + 4 * q); }
            else { pq[0] = bfe16(R.vq, 4 * q); pq[1] = bfe16(R.vq, 4 * q + 1); pq[2] = bfe16(R.vq, 4 * q + 2); pq[3] = bfe16(R.vq, 4 * q + 3); }
            float y[4];
#pragma unroll
            for (int e = 0; e < 4; ++e) { const int i = 4 * q + e; const float vcu = bfe16(R.vc, i); const float vs = vcu + mv[e] * (pq[e] - vcu); y[e] = ((R.o[q][e] - mean) * rstd * lg[e] + lb[e] + R.c3 * vs) * bfe16(R.sg, i); }
            yo[q >> 1][(q & 1) * 2] = cvt_pk_bf16(y[0], y[1]); yo[q >> 1][(q & 1) * 2 + 1] = cvt_pk_bf16(y[2], y[3]);
        }
        *(u32x4*)(Yr + (size_t)row * 1024 + ch) = yo[0]; *(u32x4*)(Yr + (size_t)row * 1024 + ch + 8) = yo[1];
    };
    for (int row = blockIdx.x * 8 + wid; row < MALL; row += gridDim.x * 8) {
        RowRaw Ra;
        load_row(row, Ra);
        process_row(row, Ra);
    }
}

struct SchedP3 {
    int G, c; const char* ws;
    __device__ __forceinline__ bool next(int i, Unit& u) const {
        const int tl = (i / 3) * G + c, seg = i % 3;
        if (tl >= 256) return false;
        u.x = tl >> 2; u.y = tl & 3; u.z = seg;
        u.a = ws + (seg == 0 ? WS_YCONV : seg == 1 ? WS_YRWKV : WS_YMEM) + (size_t)u.x * 256 * 2048; u.b = ws + WS_WB + ((size_t)seg * 1024 + (size_t)u.y * 256) * 2048;
        return true;
    }
};
struct SchedP3T {
    int G, c; const char* ws;
    __device__ __forceinline__ bool next(int i, Unit& u) const {
        const int e = i * G + c;
        if (e >= 96) return false;
        const int tt = e / 6, r = e % 6, seg = r >> 1, kh = r & 1;
        u.x = 64 + (tt >> 2); u.y = tt & 3; u.z = r;
        u.a = ws + (seg == 0 ? WS_YCONV : seg == 1 ? WS_YRWKV : WS_YMEM) + (size_t)u.x * 256 * 2048 + kh * 1024;
        u.b = ws + WS_WB + ((size_t)seg * 1024 + (size_t)u.y * 256) * 2048 + kh * 1024;
        return true;
    }
};
struct EpiP3T {
    const bf16_t* ACT; float* PART;
    __device__ __forceinline__ bool operator()(f32x4 (&acc)[2][2][4][2], const Unit& u, int wr, int wc, int fr, int fq) const {
        const int seg = u.z >> 1, rbase = u.x * 256 + wr * 64 + fr, cb = u.y * 256 + wc * 32 + 8 * fq;
        const bf16_t* gbase = ACT + C_GATE + seg * 1024 + cb;
#pragma unroll
        for (int ai = 0; ai < 2; ++ai) {
            u32x4 g[4][2];
#pragma unroll
            for (int m = 0; m < 4; ++m)
#pragma unroll
                for (int bj = 0; bj < 2; ++bj) g[m][bj] = *(const u32x4*)(gbase + (size_t)(rbase + ai * 128 + m * 16) * ACT_LD + 128 * bj);
#pragma unroll
            for (int m = 0; m < 4; ++m)
#pragma unroll
                for (int bj = 0; bj < 2; ++bj) {
                    f32x4 v0 = acc[ai][bj][m][0], v1 = acc[ai][bj][m][1];
                    v0[0] *= bflo(g[m][bj][0]); v0[1] *= bfhi(g[m][bj][0]); v0[2] *= bflo(g[m][bj][1]); v0[3] *= bfhi(g[m][bj][1]);
                    v1[0] *= bflo(g[m][bj][2]); v1[1] *= bfhi(g[m][bj][2]); v1[2] *= bflo(g[m][bj][3]); v1[3] *= bfhi(g[m][bj][3]);
                    float* dst = PART + ((size_t)u.z * 1024 + (size_t)(rbase + ai * 128 + m * 16 - MP)) * 1024 + cb + 128 * bj;
                    *(f32x4*)dst = v0; *(f32x4*)(dst + 4) = v1;
                }
        }
        return false;
    }
};
struct EpiP3 {
    const bf16_t* ACT; bf16_t* MERGED;
    __device__ __forceinline__ bool operator()(f32x4 (&acc)[2][2][4][2], const Unit& u, int wr, int wc, int fr, int fq) const {
        const int seg = u.z, rbase = u.x * 256 + wr * 64 + fr, cb = u.y * 256 + wc * 32 + 8 * fq;
        const bf16_t* gbase = ACT + C_GATE + seg * 1024 + cb;
#pragma unroll
        for (int ai = 0; ai < 2; ++ai) {
            u32x4 g[4][2], g2[4][2];
#pragma unroll
            for (int m = 0; m < 4; ++m)
#pragma unroll
                for (int bj = 0; bj < 2; ++bj) {
                    const bf16_t* gp = gbase + (size_t)(rbase + ai * 128 + m * 16) * ACT_LD + 128 * bj;
                    g[m][bj] = *(const u32x4*)gp;
                    if (seg < 2) g2[m][bj] = *(const u32x4*)(gp + 1024);
                }
#pragma unroll
            for (int m = 0; m < 4; ++m)
#pragma unroll
                for (int bj = 0; bj < 2; ++bj) {
                    float f[8];
#pragma unroll
                    for (int e = 0; e < 4; ++e) { f[2 * e] = bflo(g[m][bj][e]); f[2 * e + 1] = bfhi(g[m][bj][e]); }
                    if (seg < 2) {
#pragma unroll
                        for (int e = 0; e < 4; ++e) { f[2 * e] *= fast_rcp(bflo(g2[m][bj][e])); f[2 * e + 1] *= fast_rcp(bfhi(g2[m][bj][e])); }
                    }
                    f32x4& v0 = acc[ai][bj][m][0]; f32x4& v1 = acc[ai][bj][m][1];
#pragma unroll
                    for (int e = 0; e < 4; ++e) { v0[e] *= f[e]; v1[e] *= f[4 + e]; }
                    if (seg == 2) {
                        u32x4 o; o[0] = cvt_pk_bf16(v0[0], v0[1]); o[1] = cvt_pk_bf16(v0[2], v0[3]); o[2] = cvt_pk_bf16(v1[0], v1[1]); o[3] = cvt_pk_bf16(v1[2], v1[3]);
                        *(u32x4*)(MERGED + (size_t)(rbase + ai * 128 + m * 16) * 1024 + cb + 128 * bj) = o;
                    }
                }
        }
        return seg < 2;
    }
};
struct SchedP4 {
    int G, c; const char* A; const char* B;
    __device__ __forceinline__ bool next(int i, Unit& u) const {
        const int tl = i * G + c;
        if (tl >= 256) return false;
        u.x = tl >> 2; u.y = tl & 3; u.z = 0;
        u.a = A + (size_t)u.x * 256 * 2048; u.b = B + (size_t)u.y * 256 * 2048;
        return true;
    }
};
struct SchedP4T {
    int G, c; const char* A; const char* B;
    __device__ __forceinline__ bool next(int i, Unit& u) const {
        const int e = i * G + c;
        if (e >= 64) return false;
        const int tt = e >> 2, kq = e & 3;
        u.x = 64 + (tt >> 2); u.y = tt & 3; u.z = kq;
        u.a = A + (size_t)u.x * 256 * 2048 + kq * 512; u.b = B + (size_t)u.y * 256 * 2048 + kq * 512;
        return true;
    }
};
struct EpiP4T {
    float* PART;
    __device__ __forceinline__ bool operator()(f32x4 (&acc)[2][2][4][2], const Unit& u, int wr, int wc, int fr, int fq) const {
        const int rbase = u.x * 256 + wr * 64 + fr - MP, cbase = u.y * 256 + wc * 32 + fq * 8;
#pragma unroll
        for (int ai = 0; ai < 2; ++ai)
#pragma unroll
            for (int m = 0; m < 4; ++m)
#pragma unroll
                for (int bj = 0; bj < 2; ++bj)
#pragma unroll
                    for (int n = 0; n < 2; ++n)
                        *(f32x4*)(PART + ((size_t)u.z * 1024 + (size_t)(rbase + ai * 128 + m * 16)) * 1024 + cbase + bj * 128 + n * 4) = acc[ai][bj][m][n];
        return false;
    }
};
__device__ void p3_tail_fixup(const Params& p) {
    const int tid = opaque_tid();
    const float* P0 = (const float*)(p.ws + WS_PART);
    bf16_t* dst = (bf16_t*)(p.ws + WS_MERGED) + (size_t)MP * 1024;
    for (int idx = blockIdx.x * NTHREADS + tid; idx < 1024 * 128; idx += gridDim.x * NTHREADS) {
        const size_t o = (size_t)idx * 8;
        f32x4 a0 = *(const f32x4*)(P0 + o), a1 = *(const f32x4*)(P0 + o + 4);
#pragma unroll
        for (int q = 1; q < 6; ++q) { a0 += *(const f32x4*)(P0 + (size_t)q * 1024 * 1024 + o); a1 += *(const f32x4*)(P0 + (size_t)q * 1024 * 1024 + o + 4); }
        u32x4 w; w[0] = cvt_pk_bf16(a0[0], a0[1]); w[1] = cvt_pk_bf16(a0[2], a0[3]); w[2] = cvt_pk_bf16(a1[0], a1[1]); w[3] = cvt_pk_bf16(a1[2], a1[3]);
        *(u32x4*)(dst + o) = w;
    }
}
struct EpiP4 {
    const float* xp; bf16_t* H16; float* SUMSQ;
    __device__ __forceinline__ bool operator()(f32x4 (&acc)[2][2][4][2], const Unit& u, int wr, int wc, int fr, int fq) const {
        const int rbase = u.x * 256 + wr * 64 + fr, cb = u.y * 256 + wc * 32 + 8 * fq;
#pragma unroll
        for (int ai = 0; ai < 2; ++ai) {
            f32x4 xv[4][2][2];
#pragma unroll
            for (int m = 0; m < 4; ++m) {
                const float* xr = xp + (size_t)(rbase + ai * 128 + m * 16) * 1024 + cb;
#pragma unroll
                for (int bj = 0; bj < 2; ++bj) { xv[m][bj][0] = *(const f32x4*)(xr + bj * 128); xv[m][bj][1] = *(const f32x4*)(xr + bj * 128 + 4); }
            }
#pragma unroll
            for (int m = 0; m < 4; ++m) {
                const int row = rbase + ai * 128 + m * 16;
                float ss = 0.f;
#pragma unroll
                for (int bj = 0; bj < 2; ++bj) {
                    const f32x4 v0 = acc[ai][bj][m][0] + xv[m][bj][0], v1 = acc[ai][bj][m][1] + xv[m][bj][1];
                    ss += v0[0] * v0[0] + v0[1] * v0[1] + v0[2] * v0[2] + v0[3] * v0[3] + v1[0] * v1[0] + v1[1] * v1[1] + v1[2] * v1[2] + v1[3] * v1[3];
                    u32x4 o; o[0] = cvt_pk_bf16(v0[0], v0[1]); o[1] = cvt_pk_bf16(v0[2], v0[3]); o[2] = cvt_pk_bf16(v1[0], v1[1]); o[3] = cvt_pk_bf16(v1[2], v1[3]);
                    *(u32x4*)(H16 + (size_t)row * 1024 + cb + bj * 128) = o;
                }
                ss += __shfl_xor(ss, 16, 64); ss += __shfl_xor(ss, 32, 64);
                if (fq == 0) SUMSQ[(size_t)row * 16 + u.y * 4 + wc] = ss;
            }
        }
        return false;
    }
};
__device__ void phase5(const Params& p) {
    const int tid5 = opaque_tid(); const int lane = tid5 & 63, wid = tid5 >> 6;
    const float* SUMSQ = (const float*)(p.ws + WS_SUMSQ);
    const float* PART = (const float*)(p.ws + WS_PART);
    for (int row = blockIdx.x * 8 + wid; row < MALL; row += gridDim.x * 8) {
        float* y = p.out + OUT_Y + (size_t)row * 1024;
        f32x4 v[4]; float ss;
        if (row < MP) {
            ss = lane < 16 ? SUMSQ[(size_t)row * 16 + lane] : 0.f;
            const bf16_t* hr = (const bf16_t*)(p.ws + WS_YMEM) + (size_t)row * 1024;
#pragma unroll
            for (int i = 0; i < 4; ++i) { const u32x2 w = *(const u32x2*)(hr + i * 256 + lane * 4); v[i][0] = bflo(w[0]); v[i][1] = bfhi(w[0]); v[i][2] = bflo(w[1]); v[i][3] = bfhi(w[1]); }
        } else {
            const float* xr = p.x_sample + (size_t)(row - MP) * 1024; ss = 0.f;
#pragma unroll
            for (int i = 0; i < 4; ++i) {
                v[i] = *(const f32x4*)(xr + i * 256 + lane * 4);
#pragma unroll
                for (int q = 0; q < 4; ++q) v[i] += *(const f32x4*)(PART + ((size_t)q * 1024 + (size_t)(row - MP)) * 1024 + i * 256 + lane * 4);
                ss += v[i][0] * v[i][0] + v[i][1] * v[i][1] + v[i][2] * v[i][2] + v[i][3] * v[i][3];
            }
        }
        ss = wave_sum(ss);
        const float inv = rsqrtf(ss * (1.0f / 1024.0f) + 1e-6f);
#pragma unroll
        for (int i = 0; i < 4; ++i) {
            const f32x4 g = *(const f32x4*)(p.norm_final + i * 256 + lane * 4);
            *(f32x4*)(y + i * 256 + lane * 4) = v[i] * inv * g;
        }
    }
}

__global__ void __launch_bounds__(NTHREADS) fwd_megakernel(Params p) {
    extern __shared__ __attribute__((aligned(16))) unsigned char smem[];
    cg::grid_group grid = cg::this_grid();
    LAS unsigned char* lds = (LAS unsigned char*)smem;
#ifndef PROBE_REP
#define PROBE_REP 0
#endif
#define REP(k) for (int _r = 0; _r < ((PROBE_REP == (k)) ? 2 : 1); ++_r)
    volatile LAS unsigned* xst = (volatile LAS unsigned*)(lds + LDS_MAIN);
    if (threadIdx.x == 0) { xst[0] = 0u; xst[1] = 0u; xst[2] = 0u; xst[3] = 0u; }
    __syncthreads();
    (void)xcd_barrier_post((unsigned*)(p.ws + WS_BAR), xst);
#define XBAR() do { XcdBarrier _b; _b.bar = (unsigned*)(p.ws + WS_BAR); _b.x = xb_xcc_id(); _b.st = (volatile LAS unsigned*)(lds + LDS_MAIN); xcd_barrier(_b); } while (0)
    REP(1) { phase0(p, smem); if (PROBE_REP == 1 && _r == 0) XBAR(); }
    if (p.ws == nullptr) grid.sync();
    XBAR();
    REP(2) {
        SchedP1 S{(int)gridDim.x, (int)blockIdx.x, (const char*)(p.ws + WS_AALL), (const char*)(p.ws + WS_BALL)};
        EpiP1 E{(bf16_t*)(p.ws + WS_U), (bf16_t*)(p.ws + WS_BG), (bf16_t*)(p.ws + WS_ACT), p.out, (bf16_t*)(p.ws + WS_KBF), (bf16_t*)(p.ws + WS_VT)};
        gemm_phase(lds, 2048, 2048, 1024, S, E);
        XBAR();
        if (PROBE_REP == 9) { EpiNull EN{(float*)(p.ws + WS_SUMSQ)}; gemm_phase(lds, 2048, 2048, 1024, S, EN); XBAR(); }
    }
    REP(3) { phase2_scan(p, smem); if (PROBE_REP == 3) XBAR(); }
    REP(5) { phase2_attn(p, smem); if (PROBE_REP == 5) XBAR(); }
    XBAR();
    REP(6) { phase2b(p, smem); XBAR(); }
    REP(7) {
        SchedP3 S{(int)gridDim.x, (int)blockIdx.x, (const char*)p.ws};
        EpiP3 E{(const bf16_t*)(p.ws + WS_ACT), (bf16_t*)(p.ws + WS_MERGED)};
        gemm_phase(lds, 2048, 2048, 1024, S, E);
        SchedP3T ST{(int)gridDim.x, (int)blockIdx.x, (const char*)p.ws};
        EpiP3T ET{(const bf16_t*)(p.ws + WS_ACT), (float*)(p.ws + WS_PART)};
        gemm_phase(lds, 2048, 2048, 512, ST, ET);
        XBAR();
        if (_r == 0) { p3_tail_fixup(p); XBAR(); }
    }
    REP(8) {
        SchedP4 S{(int)gridDim.x, (int)blockIdx.x, (const char*)(p.ws + WS_MERGED), (const char*)(p.ws + WS_WO)};
        EpiP4 E{p.x_prompt, (bf16_t*)(p.ws + WS_YMEM), (float*)(p.ws + WS_SUMSQ)};
        gemm_phase(lds, 2048, 2048, 1024, S, E);
        SchedP4T ST{(int)gridDim.x, (int)blockIdx.x, (const char*)(p.ws + WS_MERGED), (const char*)(p.ws + WS_WO)};
        EpiP4T ET{(float*)(p.ws + WS_PART)};
        gemm_phase(lds, 2048, 2048, 256, ST, ET);
        XBAR();
    }
    phase5(p);
}

extern "C" void kernel_launch(void* const* d_in, const int* in_sizes, int n_in, void* d_out, int out_size, void* d_ws, size_t ws_size, hipStream_t stream) {
    static int grid_blocks = 0;
    if (!grid_blocks) {
        int dev = 0, cus = 0, per_cu = 0;
        hipGetDevice(&dev);
        hipDeviceGetAttribute(&cus, hipDeviceAttributeMultiprocessorCount, dev);
        if (hipFuncSetAttribute((const void*)fwd_megakernel, hipFuncAttributeMaxDynamicSharedMemorySize, LDS_BYTES) != hipSuccess) fprintf(stderr, "hipFuncSetAttribute failed\n");
        hipOccupancyMaxActiveBlocksPerMultiprocessor(&per_cu, (const void*)fwd_megakernel, NTHREADS, LDS_BYTES);
        if (per_cu < 1) { fprintf(stderr, "occupancy query returned %d\n", per_cu); per_cu = 1; }
        if (per_cu > 1) per_cu = 1;
        grid_blocks = cus * per_cu;
        if (grid_blocks > 256) grid_blocks = 256;
        grid_blocks &= ~31;
        if (grid_blocks < 64) grid_blocks = -1;
        if (ws_size < WS_END) { fprintf(stderr, "workspace too small: %zu < %zu\n", ws_size, (size_t)WS_END); grid_blocks = -1; }
    }
    if (grid_blocks < 0) return;
    Params p{};
    const float** pp = (const float**)&p;
    for (int i = 0; i < 27; ++i) pp[i] = (const float*)d_in[i];
    p.out = (float*)d_out; p.ws = (unsigned char*)d_ws;
    if (hipMemsetAsync((char*)d_ws + WS_BAR, 0, (size_t)XCD_BAR_WORDS_C * 4, stream) != hipSuccess) fprintf(stderr, "memset of barrier words failed\n");
    void* args[] = {&p};
    hipError_t e = hipLaunchCooperativeKernel((const void*)fwd_megakernel, dim3(grid_blocks), dim3(NTHREADS), args, LDS_BYTES, stream);
    if (e != hipSuccess) fprintf(stderr, "cooperative launch failed: %s (grid %d)\n", hipGetErrorString(e), grid_blocks);
}
```

```cpp
#include <hip/hip_runtime.h>
#include <hip/hip_cooperative_groups.h>
#include <cstdio>
namespace cg = cooperative_groups;

#define LAS __attribute__((address_space(3)))
typedef unsigned short bf16_t;
typedef short bf16x8 __attribute__((ext_vector_type(8)));
typedef float f32x4 __attribute__((ext_vector_type(4)));
typedef float f32x2 __attribute__((ext_vector_type(2)));
typedef unsigned u32x4 __attribute__((ext_vector_type(4)));
typedef unsigned u32x2 __attribute__((ext_vector_type(2)));

constexpr int DM = 1024, TP = 2048, BP = 8, MP = BP * TP, BS = 128, TS = 8, MS = BS * TS, MALL = MP + MS;
constexpr int NMEM = 256, DIN = 13440, DSHIFT = 3200;
constexpr int NPAD = 13568;
constexpr int ACT_LD = 9472;
constexpr int C_PR = 0, C_PK = 1024, C_PV = 2048, C_WD = 3072, C_AD = 3136, C_SGR = 3328, C_QM = 4352, C_SGM = 5376, C_GATE = 6400;
constexpr size_t OUT_Y = 0, OUT_MK = 17825792, OUT_MV = 19922944, OUT_CONV_P = 22020096, OUT_SHIFT_P = 22036480, OUT_WKV_P = 22062080,
                 OUT_CONV_S = 22586368, OUT_SHIFT_S = 22848512, OUT_WKV_S = 23258112;
constexpr size_t al256(size_t x) { return (x + 255) & ~(size_t)255; }
constexpr int XCD_BAR_WORDS_C = 3456;
constexpr size_t WS_AALL = 0;
constexpr size_t WS_BALL = al256(WS_AALL + (size_t)19456 * 1024 * 2);
constexpr size_t WS_YMEM = WS_AALL;
constexpr size_t WS_YCONV = WS_AALL + (size_t)MALL * 1024 * 2;
constexpr size_t WS_WB = al256(WS_BALL + (size_t)15616 * 1024 * 2);
constexpr size_t WS_WO = al256(WS_WB + (size_t)3072 * 1024 * 2);
constexpr size_t WS_U = al256(WS_WO + (size_t)1024 * 1024 * 2);
constexpr size_t WS_MERGED = WS_U;
constexpr size_t WS_BG = al256(WS_U + (size_t)MALL * 1024 * 2);
constexpr size_t WS_PART = WS_BG;
constexpr size_t WS_PRIV = WS_BG + (size_t)6 * 1024 * 1024 * 4;
constexpr size_t WS_ACT = al256(WS_BG + (size_t)MALL * 1024 * 2);
constexpr size_t WS_KBF = al256(WS_ACT + (size_t)MALL * ACT_LD * 2);
constexpr size_t WS_VT = al256(WS_KBF + (size_t)2048 * 1024 * 2);
constexpr size_t WS_YRWKV = al256(WS_VT + (size_t)2048 * 1024 * 2);
constexpr size_t WS_C3 = al256(WS_YRWKV + (size_t)MALL * 1024 * 2);
constexpr size_t WS_SUMSQ = al256(WS_C3 + (size_t)MALL * 16 * 4);
constexpr size_t WS_BAR = al256(WS_SUMSQ + (size_t)MALL * 16 * 4);
constexpr size_t WS_FRAG = al256(WS_BAR + (size_t)XCD_BAR_WORDS_C * 4);
constexpr size_t WS_END = al256(WS_FRAG + (size_t)16 * 2 * 8 * 64 * 16);
static_assert(WS_YCONV + (size_t)MALL * 1024 * 2 <= WS_WB, "alias overflow");
static_assert(WS_END <= 536870912, "workspace too large");
static_assert(WS_PRIV + (size_t)16 * 256 * 1024 * 2 <= WS_ACT, "tail scratch overflows BG");

constexpr int NTHREADS = 512;
constexpr int LDS_MAIN = 131072;
constexpr int LDS_BYTES = LDS_MAIN + 16;

struct Params {
    const float *x_prompt, *x_sample, *mem_prompt, *cache_k, *cache_v, *state_conv, *state_shift, *state_wkv, *norm_in, *w_in, *conv_w, *conv_b,
        *shift_mu, *decay_w0, *decay_up, *icl_a0, *icl_up, *k_k, *k_a, *r_k, *ln_g, *ln_b, *norm_mem, *w_mem_kv, *w_branch, *w_out, *norm_final;
    float* out;
    unsigned char* ws;
};

__device__ __forceinline__ int opaque_tid() { int t = threadIdx.x; asm volatile("" : "+v"(t)); return t; }
__device__ __forceinline__ float bf2f(bf16_t v) { return __uint_as_float(((unsigned)v) << 16); }
__device__ __forceinline__ unsigned cvt_pk_bf16(float lo, float hi) { unsigned r; asm volatile("v_cvt_pk_bf16_f32 %0, %1, %2" : "=v"(r) : "v"(lo), "v"(hi)); return r; }
__device__ __forceinline__ float bflo(unsigned u) { return __uint_as_float(u << 16); }
__device__ __forceinline__ float bfhi(unsigned u) { return __uint_as_float(u & 0xffff0000u); }
__device__ __forceinline__ float fast_rcp(float x) { return __builtin_amdgcn_rcpf(x); }
__device__ __forceinline__ float sigmoidf_(float x) { return fast_rcp(1.0f + __expf(-x)); }
__device__ __forceinline__ float siluf_(float x) { return x * sigmoidf_(x); }
__device__ __forceinline__ float wave_sum(float v) {
#pragma unroll
    for (int o = 32; o > 0; o >>= 1) v += __shfl_xor(v, o, 64);
    return v;
}
template <int CTRL> __device__ __forceinline__ float dpp_f(float x) {
    return __int_as_float(__builtin_amdgcn_update_dpp(0, __float_as_int(x), CTRL, 0xF, 0xF, true));
}
__device__ __forceinline__ float row16_sum(float x) {
    x += dpp_f<0xB1>(x);
    x += dpp_f<0x4E>(x);
    x += dpp_f<0x141>(x);
    x += dpp_f<0x140>(x);
    return x;
}


#define XB_TMO      128
#define XB_XCNT(j)  (256  + 64 * (j))
#define XB_XSUB(j)  (1280 + 64 * (j))
#define XB_XGEN(j)  (2304 + 64 * (j))
#define XB_TOP      3328
#define XB_TOPGEN   3392
#define XCD_BAR_WORDS 3456
#define XB_SPIN_CAP (1u << 22)
__device__ __forceinline__ unsigned xb_ld(unsigned* p)              { return __hip_atomic_load(p, __ATOMIC_RELAXED, __HIP_MEMORY_SCOPE_AGENT); }
__device__ __forceinline__ unsigned xb_add(unsigned* p, unsigned v) { return __hip_atomic_fetch_add(p, v, __ATOMIC_RELAXED, __HIP_MEMORY_SCOPE_AGENT); }
__device__ __forceinline__ unsigned xb_xcc_id() { return (unsigned)__builtin_amdgcn_s_getreg((3 << 11) | 20) & 0xFu; }
#define XB_SPIN(cond, bar) do { unsigned _sp = 0; while (cond) { __builtin_amdgcn_s_sleep(1); \
    if ((++_sp & 255u) == 0u) { if (xb_ld(&(bar)[XB_TMO])) break; if (_sp > XB_SPIN_CAP) { atomicAdd(&(bar)[XB_TMO], 1u); break; } } } } while (0)
struct XcdBarrier { unsigned* bar; unsigned x; volatile LAS unsigned* st; };
__device__ __forceinline__ XcdBarrier xcd_barrier_post(unsigned* bar, volatile LAS unsigned* st) {
    XcdBarrier b; b.bar = bar; b.x = xb_xcc_id(); b.st = st;
    if (threadIdx.x == 0) (void)xb_add(&bar[XB_XCNT(b.x)], 1u);
    return b;
}
__device__ __forceinline__ void xcd_barrier_complete(unsigned* bar, unsigned x, unsigned& nloc, unsigned& nx) {
    const unsigned G = gridDim.x * gridDim.y * gridDim.z;
    unsigned sum, cnt, mine, sp = 0u;
    for (;;) {
        sum = 0u; cnt = 0u; mine = 0u;
#pragma unroll
        for (unsigned j = 0; j < 16; ++j) { const unsigned c = xb_ld(&bar[XB_XCNT(j)]); sum += c; cnt += (c > 0u) ? 1u : 0u; mine = (j == x) ? c : mine; }
        if (sum == G) break;
        __builtin_amdgcn_s_sleep(1);
        if ((++sp & 255u) == 0u) { if (xb_ld(&bar[XB_TMO])) break; if (sp > XB_SPIN_CAP) { atomicAdd(&bar[XB_TMO], 1u); break; } }
    }
    nloc = mine > 0u ? mine : 1u; nx = cnt > 0u ? cnt : 1u;
}
__device__ __forceinline__ void xcd_barrier(const XcdBarrier& b) {
    asm volatile("s_waitcnt vmcnt(0)" ::: "memory");
    __syncthreads();
    if (threadIdx.x == 0) {
        unsigned* bar = b.bar;
        __builtin_amdgcn_s_waitcnt(0);
        unsigned nloc = b.st[0], nx = b.st[1];
        if (nloc == 0u) { xcd_barrier_complete(bar, b.x, nloc, nx); b.st[0] = nloc; b.st[1] = nx; }
        const unsigned old = xb_add(&bar[XB_XSUB(b.x)], 1u);
        const unsigned gen = old / nloc;
        if (old + 1u == (gen + 1u) * nloc) {
            __builtin_amdgcn_fence(__ATOMIC_RELEASE, "agent");
            asm volatile("s_waitcnt vmcnt(0)" ::: "memory");
            const unsigned og = xb_add(&bar[XB_TOP], 1u);
            const unsigned tg = og / nx;
            if (og + 1u == (tg + 1u) * nx) xb_add(&bar[XB_TOPGEN], 1u);
            else XB_SPIN(xb_ld(&bar[XB_TOPGEN]) == tg, bar);
            __builtin_amdgcn_fence(__ATOMIC_ACQUIRE, "agent");
            xb_add(&bar[XB_XGEN(b.x)], 1u);
            asm volatile("s_waitcnt vmcnt(0)" ::: "memory");
        } else {
            XB_SPIN(xb_ld(&bar[XB_XGEN(b.x)]) == gen, bar);
            __builtin_amdgcn_fence(__ATOMIC_ACQUIRE, "agent");
            asm volatile("s_waitcnt vmcnt(0)" ::: "memory");
        }
    }
    __syncthreads();
}

constexpr int BM = 256, BK = 64, HALF = 128, HTB = HALF * BK * 2;
__device__ __forceinline__ int lds_byte(int r, int c) { const int st = (r >> 4) * 2 + (c >> 5), rr = r & 15, cc = c & 31, ob = rr * 64 + cc * 2; return st * 1024 + (ob ^ (((ob >> 9) & 1) << 5)); }
__device__ __forceinline__ void stage_rc(int b, int& R, int& C) { const int st = b / 1024, sb = b % 1024, swz = sb ^ (((sb >> 9) & 1) << 5); R = (st >> 1) * 16 + swz / 64; C = (st & 1) * 32 + (swz % 64) / 2; }

struct Unit { const char* a; const char* b; int x, y, z; };

template <class Sched, class Epi>
__device__ __forceinline__ void gemm_phase(LAS unsigned char* lds, const int lda, const int ldb, const int K, const Sched& S, const Epi& E) {
    const int tid = opaque_tid(), wid = __builtin_amdgcn_readfirstlane(tid >> 6), lane = tid & 63, wr = wid >> 2, wc = wid & 3, fr = lane & 15, fq = lane >> 4;
    const int nt = K / BK;
    unsigned voffA[2], voffB[2];
#pragma unroll
    for (int i = 0; i < 2; ++i) { int R, C; stage_rc(tid * 16 + i * 8192, R, C); voffA[i] = (unsigned)(R * lda + C * 2); voffB[i] = (unsigned)(R * ldb + C * 2); }
    const size_t kstep = (size_t)(BK * 2);
    const size_t hA = (size_t)HALF * lda, hB = (size_t)HALF * ldb;
    const unsigned ldsw = (unsigned)wid * 1024u;
    const int aoff = lds_byte(wr * 64 + fr, fq * 8), boff = lds_byte(wc * 32 + fr, fq * 8);
#define G_SA(b, h) (((b) * 2 + (h)) * HTB)
#define G_SB(b, h) ((4 + (b) * 2 + (h)) * HTB)
#define G_STAGE(bufoff, gbase, voff) do { _Pragma("unroll") for (int _i = 0; _i < 2; ++_i) \
        __builtin_amdgcn_global_load_lds((const unsigned*)((const char*)(gbase) + (voff)[_i]), (LAS unsigned*)(lds + (bufoff) + ldsw + _i * 8192), 16, 0, 0); } while (0)
#define G_LDA(dst, b, h) do { _Pragma("unroll") for (int m = 0; m < 4; ++m) _Pragma("unroll") for (int k = 0; k < 2; ++k) dst[m][k] = *(const LAS bf16x8*)(lds + G_SA(b, h) + aoff + m * 2048 + k * 1024); } while (0)
#define G_LDB(dst, b, h) do { _Pragma("unroll") for (int n = 0; n < 2; ++n) _Pragma("unroll") for (int k = 0; k < 2; ++k) dst[n][k] = *(const LAS bf16x8*)(lds + G_SB(b, h) + boff + n * 2048 + k * 1024); } while (0)
#define G_MMA(ai, bj, At, Bt) do { __builtin_amdgcn_s_setprio(1); _Pragma("unroll") for (int m = 0; m < 4; ++m) _Pragma("unroll") for (int n = 0; n < 2; ++n) _Pragma("unroll") for (int k = 0; k < 2; ++k) \
        acc[ai][bj][m][n] = __builtin_amdgcn_mfma_f32_16x16x32_bf16(Bt[n][k], At[m][k], acc[ai][bj][m][n], 0, 0, 0); __builtin_amdgcn_s_setprio(0); } while (0)
#define G_WAIT_V(n) asm volatile("s_waitcnt vmcnt(" #n ")" ::: "memory")
#define G_WAIT_L(n) asm volatile("s_waitcnt lgkmcnt(" #n ")" ::: "memory")
#define G_BAR __builtin_amdgcn_s_barrier()
#define G_SCHED __builtin_amdgcn_sched_barrier(0)
    Unit cur, nxt; int ui = 0;
    if (!S.next(0, cur)) return;
    f32x4 acc[2][2][4][2];
#pragma unroll
    for (int a = 0; a < 2; ++a)
#pragma unroll
        for (int b = 0; b < 2; ++b)
#pragma unroll
            for (int m = 0; m < 4; ++m)
#pragma unroll
                for (int n = 0; n < 2; ++n) acc[a][b][m][n] = (f32x4){0.f, 0.f, 0.f, 0.f};
    bf16x8 At[4][2], B0[2][2], B1[2][2];
    const char* cA = cur.a; const char* cB = cur.b;
    G_STAGE(G_SB(0, 0), cB, voffB); G_STAGE(G_SA(0, 0), cA, voffA); G_STAGE(G_SB(0, 1), cB + hB, voffB); G_STAGE(G_SA(0, 1), cA + hA, voffA);
    if (wr == 1) G_BAR;
    G_WAIT_V(4); G_BAR;
    G_STAGE(G_SB(1, 0), cB + kstep, voffB); G_STAGE(G_SA(1, 0), cA + kstep, voffA); G_STAGE(G_SB(1, 1), cB + hB + kstep, voffB);
    G_WAIT_V(6); G_BAR;
    for (;;) {
        const bool has_next = S.next(ui + 1, nxt);
        const char* nA = has_next ? nxt.a : cA; const char* nB = has_next ? nxt.b : cB;
        for (int t = 0; t < nt; t += 2) {
            const bool last = (t == nt - 2);
            const char* a1 = cA + (size_t)(t + 1) * kstep;
            const char* a2 = last ? nA : cA + (size_t)(t + 2) * kstep; const char* b2 = last ? nB : cB + (size_t)(t + 2) * kstep;
            const char* a3 = a2 + kstep; const char* b3 = b2 + kstep;
            G_LDB(B0, 0, 0); G_SCHED; G_LDA(At, 0, 0); G_STAGE(G_SA(1, 1), a1 + hA, voffA);
            G_WAIT_L(8); G_BAR; G_WAIT_L(0); G_MMA(0, 0, At, B0); G_BAR; G_SCHED;
            G_LDB(B1, 0, 1); G_STAGE(G_SB(0, 0), b2, voffB);
            G_BAR; G_WAIT_L(0); G_MMA(0, 1, At, B1); G_BAR;
            G_LDA(At, 0, 1); G_STAGE(G_SA(0, 0), a2, voffA);
            G_BAR; G_WAIT_L(0); G_MMA(1, 0, At, B0); G_BAR; G_SCHED;
            G_STAGE(G_SB(0, 1), b2 + hB, voffB);
            G_WAIT_V(6); G_BAR; G_MMA(1, 1, At, B1); G_BAR;
            G_LDB(B0, 1, 0); G_SCHED; G_LDA(At, 1, 0); G_STAGE(G_SA(0, 1), a2 + hA, voffA);
            G_WAIT_L(8); G_BAR; G_WAIT_L(0); G_MMA(0, 0, At, B0); G_BAR; G_SCHED;
            G_LDB(B1, 1, 1); G_STAGE(G_SB(1, 0), b3, voffB);
            G_BAR; G_WAIT_L(0); G_MMA(0, 1, At, B1); G_BAR;
            G_LDA(At, 1, 1); G_STAGE(G_SA(1, 0), a3, voffA);
            G_BAR; G_WAIT_L(0); G_MMA(1, 0, At, B0); G_BAR; G_SCHED;
            G_STAGE(G_SB(1, 1), b3 + hB, voffB);
            G_WAIT_V(6); G_BAR; G_MMA(1, 1, At, B1); G_BAR;
        }
        const bool keep = E(acc, cur, wr, wc, fr, fq);
        if (!has_next) break;
        if (!keep) {
#pragma unroll
            for (int a = 0; a < 2; ++a)
#pragma unroll
                for (int b = 0; b < 2; ++b)
#pragma unroll
                    for (int m = 0; m < 4; ++m)
#pragma unroll
                        for (int n = 0; n < 2; ++n) acc[a][b][m][n] = (f32x4){0.f, 0.f, 0.f, 0.f};
        }
        cur = nxt; cA = nA; cB = nB; ++ui;
    }
    G_WAIT_V(0);
    if (wr == 0) G_BAR;
    G_BAR;
#undef G_SA
#undef G_SB
#undef G_STAGE
#undef G_LDA
#undef G_LDB
#undef G_MMA
#undef G_WAIT_V
#undef G_WAIT_L
#undef G_BAR
#undef G_SCHED
}

__device__ __forceinline__ int perm8_local(int c) {
    const int bj = c >> 7, wc = (c >> 5) & 3, n = (c >> 4) & 1, fq = (c >> 2) & 3, e = c & 3;
    return 128 * bj + 32 * wc + 8 * fq + 4 * n + e;
}
__device__ __forceinline__ int colmap_in(int np) {
    const int j = np >> 8, c = np & 255;
    if (j < 16) {
        const int bj = c >> 7, wc = (c >> 5) & 3, n = (c >> 4) & 1, fq = (c >> 2) & 3, e = c & 3;
        return (2 * bj + n) * 1024 + j * 64 + wc * 16 + fq * 4 + e;
    }
    const int L = (j - 16) * 256 + perm8_local(c);
    if (L < 3200) return 4096 + L;
    if (L < 3328) return -1;
    return L + 3968;
}

__device__ void phase0(const Params& p, unsigned char* smem) {
    const int tid = opaque_tid(), lane = tid & 63, wid = tid >> 6;
    bf16_t* Aall = (bf16_t*)(p.ws + WS_AALL);
    for (int row = blockIdx.x * 8 + wid; row < 19456; row += gridDim.x * 8) {
        const float* src; const float* g;
        if (row < MP) { src = p.x_prompt + (size_t)row * 1024; g = p.norm_in; }
        else if (row < MALL) { src = p.x_sample + (size_t)(row - MP) * 1024; g = p.norm_in; }
        else { src = p.mem_prompt + (size_t)(row - MALL) * 1024; g = p.norm_mem; }
        f32x4 v[4]; float ss = 0.f;
#pragma unroll
        for (int i = 0; i < 4; ++i) { v[i] = *(const f32x4*)(src + i * 256 + lane * 4); ss += v[i][0] * v[i][0] + v[i][1] * v[i][1] + v[i][2] * v[i][2] + v[i][3] * v[i][3]; }
        ss = wave_sum(ss);
        const float inv = rsqrtf(ss * (1.0f / 1024.0f) + 1e-6f);
#pragma unroll
        for (int i = 0; i < 4; ++i) {
            const f32x4 gg = *(const f32x4*)(g + i * 256 + lane * 4);
            u32x2 o; o[0] = cvt_pk_bf16(v[i][0] * inv * gg[0], v[i][1] * inv * gg[1]); o[1] = cvt_pk_bf16(v[i][2] * inv * gg[2], v[i][3] * inv * gg[3]);
            *(u32x2*)(Aall + (size_t)row * 1024 + i * 256 + lane * 4) = o;
        }
    }
    for (int idx = blockIdx.x * NTHREADS + tid; idx < 16 * 2 * 8 * 64; idx += gridDim.x * NTHREADS) {
        const int ln = idx & 63, f = (idx >> 6) & 7, mat = (idx >> 9) & 1, hh = idx >> 10;
        const int it = f >> 1, ks = f & 1, fr = ln & 15, fq = ln >> 4;
        const float* src = mat ? p.icl_up : p.decay_up;
        float w[8];
#pragma unroll
        for (int jj = 0; jj < 8; ++jj) w[jj] = src[(size_t)(ks * 32 + fq * 8 + jj) * 1024 + hh * 64 + it * 16 + fr];
        u32x4 pk; pk[0] = cvt_pk_bf16(w[0], w[1]); pk[1] = cvt_pk_bf16(w[2], w[3]); pk[2] = cvt_pk_bf16(w[4], w[5]); pk[3] = cvt_pk_bf16(w[6], w[7]);
        *(u32x4*)(p.ws + WS_FRAG + (size_t)idx * 16) = pk;
    }
    bf16_t* T = (bf16_t*)smem;
    const int NT_IN = 212 * 16, NT_KV = 32 * 16, NT_WB = 3 * 16 * 16, NT_WO = 16 * 16;
    const int total = NT_IN + NT_KV + NT_WB + NT_WO;
    for (int tix = blockIdx.x; tix < total; tix += gridDim.x) {
        const float* src; int src_ld; bf16_t* dst; int n0, k0, mode;
        if (tix < NT_IN) { src = p.w_in; src_ld = DIN; dst = (bf16_t*)(p.ws + WS_BALL); n0 = (tix >> 4) * 64; k0 = (tix & 15) * 64; mode = 0; }
        else if (tix < NT_IN + NT_KV) { const int t2 = tix - NT_IN; src = p.w_mem_kv; src_ld = 2048; dst = (bf16_t*)(p.ws + WS_BALL) + (size_t)NPAD * 1024; n0 = (t2 >> 4) * 64; k0 = (t2 & 15) * 64; mode = 1; }
        else if (tix < NT_IN + NT_KV + NT_WB) { const int t2 = tix - NT_IN - NT_KV; const int i = t2 >> 8, t3 = t2 & 255; src = p.w_branch + (size_t)i * 1024 * 1024; src_ld = 1024;
            dst = (bf16_t*)(p.ws + WS_WB) + (size_t)i * 1024 * 1024; n0 = (t3 >> 4) * 64; k0 = (t3 & 15) * 64; mode = 2; }
        else { const int t3 = tix - NT_IN - NT_KV - NT_WB; src = p.w_out; src_ld = 1024; dst = (bf16_t*)(p.ws + WS_WO); n0 = (t3 >> 4) * 64; k0 = (t3 & 15) * 64; mode = 2; }
        {
            const int kk = tid >> 3, seg = tid & 7;
#pragma unroll
            for (int q = 0; q < 2; ++q) {
                const int nl = seg * 8 + q * 4, np = n0 + nl;
                int sc;
                if (mode == 0) sc = colmap_in(np);
                else if (mode == 1) sc = np;
                else sc = (np & ~255) + perm8_local(np & 255);
                f32x4 v = (f32x4){0.f, 0.f, 0.f, 0.f};
                if (sc >= 0) v = *(const f32x4*)(src + (size_t)(k0 + kk) * src_ld + sc);
                const unsigned a = cvt_pk_bf16(v[0], v[1]), b = cvt_pk_bf16(v[2], v[3]);
                T[(nl + 0) * 66 + kk] = (bf16_t)(a & 0xffff); T[(nl + 1) * 66 + kk] = (bf16_t)(a >> 16);
                T[(nl + 2) * 66 + kk] = (bf16_t)(b & 0xffff); T[(nl + 3) * 66 + kk] = (bf16_t)(b >> 16);
            }
        }
        __syncthreads();
        {
            const int nl = tid >> 3, ks = tid & 7;
            const unsigned* tp = (const unsigned*)(T + nl * 66 + ks * 8);
            u32x4 v; v[0] = tp[0]; v[1] = tp[1]; v[2] = tp[2]; v[3] = tp[3];
            *(u32x4*)(dst + (size_t)(n0 + nl) * 1024 + k0 + ks * 8) = v;
        }
        __syncthreads();
    }
}

struct SchedP1 {
    int G, c; const char* Aall; const char* Ball;
    __device__ __forceinline__ bool next(int i, Unit& u) const {
        const int L = i * G + c;
        constexpr int nM = 68, nN = 53, nwg = nM * nN, WGM = 8;
        if (L >= nwg + 96) return false;
        if (L < nwg) {
            int wgid = L; { const int q = nwg / 8, r = nwg % 8, xcd = wgid % 8, off = wgid / 8; wgid = (xcd < r ? xcd * (q + 1) : r * (q + 1) + (xcd - r) * q) + off; }
            const int nig = WGM * nN, gid = wgid / nig, fm = gid * WGM, gsz = (nM - fm) < WGM ? (nM - fm) : WGM;
            u.x = fm + ((wgid % nig) % gsz); u.y = (wgid % nig) / gsz; u.z = 0;
            u.a = Aall + (size_t)u.x * 256 * 2048; u.b = Ball + (size_t)u.y * 256 * 2048;
        } else {
            int k = L - nwg;
            if (k < 32) { u.x = k >> 2; u.y = k & 3; u.z = 1; u.a = Aall + (size_t)(68 + u.x) * 256 * 2048; u.b = Ball + (size_t)(53 + u.y) * 256 * 2048; }
            else if (k < 64) { k -= 32; u.x = k >> 2; u.y = k & 3; u.z = 2; u.a = Aall + (size_t)(68 + u.x) * 256 * 2048; u.b = Ball + (size_t)(57 + u.y) * 256 * 2048; }
            else { k -= 64; u.x = k >> 3; u.y = k & 7; u.z = 3; u.a = Ball + (size_t)(57 + u.x) * 256 * 2048; u.b = Aall + (size_t)(68 + u.y) * 256 * 2048; }
        }
        return true;
    }
};

struct EpiNull { __device__ __forceinline__ bool operator()(f32x4 (&acc)[2][2][4][2], const Unit& u, int wr, int wc, int fr, int fq) const { float t = 0.f;
#pragma unroll
        for (int a = 0; a < 2; ++a)
#pragma unroll
            for (int b = 0; b < 2; ++b)
#pragma unroll
                for (int m = 0; m < 4; ++m)
#pragma unroll
                    for (int n = 0; n < 2; ++n) t += acc[a][b][m][n][0] + acc[a][b][m][n][1] + acc[a][b][m][n][2] + acc[a][b][m][n][3];
        if (t == 123.456f) sink[0] = t; return false; }
    float* sink; };
struct EpiP1 {
    bf16_t* U; bf16_t* BG; bf16_t* ACT; float* out; bf16_t* Kbf; bf16_t* Vt;
    __device__ __forceinline__ bool operator()(f32x4 (&acc)[2][2][4][2], const Unit& u, int wr, int wc, int fr, int fq) const {
        const int type = u.z;
        if (type == 0) {
            const int pn = u.y, rbase = u.x * 256 + wr * 64 + fr;
            if (pn < 16) {
                const int ch0 = pn * 64 + wc * 16 + fq * 4;
#pragma unroll
                for (int ai = 0; ai < 2; ++ai)
#pragma unroll
                    for (int m = 0; m < 4; ++m) {
                        const int row = rbase + ai * 128 + m * 16;
                        const f32x4 h = acc[ai][0][m][0], Bv = acc[ai][0][m][1], Cv = acc[ai][1][m][0], g = acc[ai][1][m][1];
                        const f32x4 u4 = Cv * h;
                        f32x4 bg;
#pragma unroll
                        for (int e = 0; e < 4; ++e) bg[e] = Bv[e] * siluf_(g[e]);
                        u32x2 o; o[0] = cvt_pk_bf16(u4[0], u4[1]); o[1] = cvt_pk_bf16(u4[2], u4[3]);
                        *(u32x2*)(U + (size_t)row * 1024 + ch0) = o;
                        o[0] = cvt_pk_bf16(bg[0], bg[1]); o[1] = cvt_pk_bf16(bg[2], bg[3]);
                        *(u32x2*)(BG + (size_t)row * 1024 + ch0) = o;
                        if (row < MP) { const int t = row & 2047; if (t >= 2046) *(f32x4*)(out + OUT_CONV_P + (size_t)((row >> 11) * 2 + (t - 2046)) * 1024 + ch0) = u4; }
                        else { const int rs = row - MP, t = rs & 7; if (t >= 6) *(f32x4*)(out + OUT_CONV_S + (size_t)((rs >> 3) * 2 + (t - 6)) * 1024 + ch0) = u4; }
                    }
            } else {
                const int L0 = (pn - 16) * 256;
                const int kind = pn <= 28 ? 0 : pn <= 32 ? 1 : pn <= 36 ? 2 : pn <= 40 ? 1 : 3;
#pragma unroll
                for (int ai = 0; ai < 2; ++ai)
#pragma unroll
                    for (int m = 0; m < 4; ++m) {
                        const int row = rbase + ai * 128 + m * 16;
#pragma unroll
                        for (int bj = 0; bj < 2; ++bj) {
                            const int L = L0 + 128 * bj + 32 * wc + 8 * fq;
                            f32x4 v0 = acc[ai][bj][m][0], v1 = acc[ai][bj][m][1];
                            if (kind == 0) {
                                if (L < DSHIFT) {
                                    if (row < MP) { if ((row & 2047) == 2047) { float* d = out + OUT_SHIFT_P + (size_t)(row >> 11) * DSHIFT + L; *(f32x4*)d = v0; *(f32x4*)(d + 4) = v1; } }
                                    else { const int rs = row - MP; if ((rs & 7) == 7) { float* d = out + OUT_SHIFT_S + (size_t)(rs >> 3) * DSHIFT + L; *(f32x4*)d = v0; *(f32x4*)(d + 4) = v1; } }
                                }
                            } else if (kind == 1) {
#pragma unroll
                                for (int e = 0; e < 4; ++e) { v0[e] = siluf_(v0[e]); v1[e] = siluf_(v1[e]); }
                            } else if (kind == 2) { v0 *= 0.0625f; v1 *= 0.0625f; }
                            else {
#pragma unroll
                                for (int e = 0; e < 4; ++e) { v0[e] = sigmoidf_(v0[e]); v1[e] = sigmoidf_(v1[e]); }
                            }
                            u32x4 o; o[0] = cvt_pk_bf16(v0[0], v0[1]); o[1] = cvt_pk_bf16(v0[2], v0[3]); o[2] = cvt_pk_bf16(v1[0], v1[1]); o[3] = cvt_pk_bf16(v1[2], v1[3]);
                            *(u32x4*)(ACT + (size_t)row * ACT_LD + L) = o;
                        }
                    }
            }
        } else {
            const int rbase = u.x * 256 + wr * 64 + fr, cbase = u.y * 256 + wc * 32 + fq * 4;
#pragma unroll
            for (int ai = 0; ai < 2; ++ai)
#pragma unroll
                for (int m = 0; m < 4; ++m) {
                    const int row = rbase + ai * 128 + m * 16;
#pragma unroll
                    for (int bj = 0; bj < 2; ++bj)
#pragma unroll
                        for (int n = 0; n < 2; ++n) {
                            const int col = cbase + bj * 128 + n * 16;
                            const f32x4 v = acc[ai][bj][m][n];
                            if (type == 1) { *(f32x4*)(out + OUT_MK + (size_t)row * 1024 + col) = v;
                                u32x2 o; o[0] = cvt_pk_bf16(v[0], v[1]); o[1] = cvt_pk_bf16(v[2], v[3]); *(u32x2*)(Kbf + (size_t)row * 1024 + col) = o; }
                            else if (type == 2) { *(f32x4*)(out + OUT_MV + (size_t)row * 1024 + col) = v; }
                            else { u32x2 o; o[0] = cvt_pk_bf16(v[0], v[1]); o[1] = cvt_pk_bf16(v[2], v[3]); *(u32x2*)(Vt + (size_t)row * 2048 + col) = o; }
                        }
                }
        }
        return false;
    }
};

struct ChunkDesc { int r0, b, h, half, samp, t0, n, first, last, bstep; };
__device__ __forceinline__ int n_chunks(const int bid, const int G) {
    const int n_long = bid < 256 ? (255 - bid) / G + 1 : 0, n_samp = bid < 4096 ? (4095 - bid) / G + 1 : 0;
    return n_long * 64 + ((n_samp + 3) >> 2);
}
__device__ __forceinline__ bool chunk_desc(const int ci, const int bid, const int G, ChunkDesc& d) {
    const int n_long = bid < 256 ? (255 - bid) / G + 1 : 0;
    const int n_samp = bid < 4096 ? (4095 - bid) / G + 1 : 0;
    const int nc_long = n_long * 64;
    if (ci < nc_long) { const int k = ci >> 6, it = bid + k * G, chain = it >> 1; d.b = chain >> 4; d.h = chain & 15; d.half = it & 1; d.samp = 0; d.r0 = d.b * TP; d.bstep = 0;
        d.t0 = (ci & 63) * 32; d.n = 32; d.first = (ci & 63) == 0; d.last = (ci & 63) == 63; return true; }
    const int k0 = (ci - nc_long) * 4; if (ci < 0 || k0 >= n_samp) return false;
    const int it = bid + k0 * G, chain = it >> 1; d.b = chain >> 4; d.h = chain & 15; d.half = it & 1; d.samp = 1; d.r0 = 0; d.t0 = 0; d.bstep = G >> 5;
    const int ni = n_samp - k0 < 4 ? n_samp - k0 : 4; d.n = ni * 8; d.first = 1; d.last = 1; return true;
}
__device__ __forceinline__ int cd_batch(const ChunkDesc& d, const int t) { return d.samp ? d.b + (t >> 3) * d.bstep : d.b; }
__device__ __forceinline__ int cd_row(const ChunkDesc& d, const int t) { return d.samp ? MP + (d.b + (t >> 3) * d.bstep) * 8 + (t & 7) : d.r0 + d.t0 + t; }
__device__ __forceinline__ bool cd_first(const ChunkDesc& d, const int t) { return d.samp ? (t & 7) == 0 : (d.t0 + t) == 0; }
constexpr int SROW = 68;
constexpr int SBUF = 6 * 32 * SROW + 64;
__device__ __forceinline__ f32x2 lo2(const f32x4 v) { return __builtin_shufflevector(v, v, 0, 1); }
__device__ __forceinline__ f32x2 hi2(const f32x4 v) { return __builtin_shufflevector(v, v, 2, 3); }
__device__ __forceinline__ float tanh_fast(float x) { return 1.0f - 2.0f * fast_rcp(1.0f + __expf(2.0f * x)); }

__device__ __forceinline__ void unpack4(const u32x2 v, float (&o)[4]) { o[0] = bflo(v[0]); o[1] = bfhi(v[0]); o[2] = bflo(v[1]); o[3] = bfhi(v[1]); }

struct OpSet { f32x4 kk, wr, w, b, k; f32x2 v, cc; };
__device__ __forceinline__ void reduce4_row16(float a0, float a1, float b0, float b1, float c0, float c1, float d0, float d1, float& A, float& B, float& C, float& D) {
    asm volatile(
        "v_add_f32 %0, %4, %5\n\tv_add_f32 %1, %6, %7\n\tv_add_f32 %2, %8, %9\n\tv_add_f32 %3, %10, %11\n\t"
        "v_add_f32_dpp %0, %0, %0 quad_perm:[1,0,3,2] row_mask:0xf bank_mask:0xf\n\tv_add_f32_dpp %1, %1, %1 quad_perm:[1,0,3,2] row_mask:0xf bank_mask:0xf\n\t"
        "v_add_f32_dpp %2, %2, %2 quad_perm:[1,0,3,2] row_mask:0xf bank_mask:0xf\n\tv_add_f32_dpp %3, %3, %3 quad_perm:[1,0,3,2] row_mask:0xf bank_mask:0xf\n\t"
        "v_add_f32_dpp %0, %0, %0 quad_perm:[2,3,0,1] row_mask:0xf bank_mask:0xf\n\tv_add_f32_dpp %1, %1, %1 quad_perm:[2,3,0,1] row_mask:0xf bank_mask:0xf\n\t"
        "v_add_f32_dpp %2, %2, %2 quad_perm:[2,3,0,1] row_mask:0xf bank_mask:0xf\n\tv_add_f32_dpp %3, %3, %3 quad_perm:[2,3,0,1] row_mask:0xf bank_mask:0xf\n\t"
        "v_add_f32_dpp %0, %0, %0 row_half_mirror row_mask:0xf bank_mask:0xf\n\tv_add_f32_dpp %1, %1, %1 row_half_mirror row_mask:0xf bank_mask:0xf\n\t"
        "v_add_f32_dpp %2, %2, %2 row_half_mirror row_mask:0xf bank_mask:0xf\n\tv_add_f32_dpp %3, %3, %3 row_half_mirror row_mask:0xf bank_mask:0xf\n\t"
        "v_add_f32_dpp %0, %0, %0 row_mirror row_mask:0xf bank_mask:0xf\n\tv_add_f32_dpp %1, %1, %1 row_mirror row_mask:0xf bank_mask:0xf\n\t"
        "v_add_f32_dpp %2, %2, %2 row_mirror row_mask:0xf bank_mask:0xf\n\tv_add_f32_dpp %3, %3, %3 row_mirror row_mask:0xf bank_mask:0xf\n\t"
        "s_nop 1"
        : "=&v"(A), "=&v"(B), "=&v"(C), "=&v"(D)
        : "v"(a0), "v"(a1), "v"(b0), "v"(b1), "v"(c0), "v"(c1), "v"(d0), "v"(d1));
}
struct PrepState { f32x4 aw[4], aa[4]; float ksf[16]; float rn; };

struct PrepRaw { u32x4 wdc[2], wdp[2], adc[2], adp[2]; u32x2 kc[4], kp[4]; };
struct PrepRaw2 { u32x2 rc[4], rp[4], vc[4], vp[4]; };
__device__ __forceinline__ void prep_load(const Params& p, const ChunkDesc& d, const int tb, const int lane, PrepRaw& R) {
    const int fr = lane & 15, fq = lane >> 4;
    const int t = tb + fr; const int tt = t < d.n ? t : d.n - 1;
    const size_t row = (size_t)cd_row(d, tt);
    const bool isfirst = cd_first(d, tt);
    const bf16_t* cur = (const bf16_t*)(p.ws + WS_ACT) + row * ACT_LD;
    const bf16_t* prv = isfirst ? cur : cur - ACT_LD;
    const int hc = d.h * 64 + 4 * fq;
#pragma unroll
    for (int ks = 0; ks < 2; ++ks) {
        R.wdc[ks] = *(const u32x4*)(cur + C_WD + ks * 32 + fq * 8); R.wdp[ks] = *(const u32x4*)(prv + C_WD + ks * 32 + fq * 8);
        R.adc[ks] = *(const u32x4*)(cur + C_AD + ks * 32 + fq * 8); R.adp[ks] = *(const u32x4*)(prv + C_AD + ks * 32 + fq * 8);
    }
#pragma unroll
    for (int it = 0; it < 4; ++it) { R.kc[it] = *(const u32x2*)(cur + C_PK + hc + it * 16); R.kp[it] = *(const u32x2*)(prv + C_PK + hc + it * 16); }
}
__device__ __forceinline__ void prep_load2(const Params& p, const ChunkDesc& d, const int tb, const int lane, PrepRaw2& R) {
    const int fr = lane & 15, fq = lane >> 4;
    const int t = tb + fr; const int tt = t < d.n ? t : d.n - 1;
    const size_t row = (size_t)cd_row(d, tt);
    const bool isfirst = cd_first(d, tt);
    const bf16_t* cur = (const bf16_t*)(p.ws + WS_ACT) + row * ACT_LD;
    const bf16_t* prv = isfirst ? cur : cur - ACT_LD;
    const int hc = d.h * 64 + 4 * fq;
#pragma unroll
    for (int it = 0; it < 4; ++it) {
        R.rc[it] = *(const u32x2*)(cur + C_PR + hc + it * 16); R.rp[it] = *(const u32x2*)(prv + C_PR + hc + it * 16);
        R.vc[it] = *(const u32x2*)(cur + C_PV + hc + it * 16); R.vp[it] = *(const u32x2*)(prv + C_PV + hc + it * 16);
    }
}
__device__ __forceinline__ void shift4(const u32x2 cu, const u32x2 pr, const float* st, const bool isfirst, const bool samp, const int col, const f32x4 mu, float (&o)[4]) {
    float c[4], q[4];
    unpack4(cu, c); unpack4(pr, q);
    if (isfirst) {
        if (samp) { const f32x4 v = *(const f32x4*)(st + col); q[0] = v[0]; q[1] = v[1]; q[2] = v[2]; q[3] = v[3]; }
        else { q[0] = 0.f; q[1] = 0.f; q[2] = 0.f; q[3] = 0.f; }
    }
#pragma unroll
    for (int e = 0; e < 4; ++e) o[e] = c[e] + mu[e] * (q[e] - c[e]);
}

__device__ __forceinline__ void prep_stage1(const Params& p, const ChunkDesc& d, const int tb, const float* par, const int lane, const PrepRaw& R, PrepState& S) {
    const int fr = lane & 15, fq = lane >> 4;
    const int t = tb + fr; const int tt = t < d.n ? t : d.n - 1;
    const bool isfirst = cd_first(d, tt), samp = d.samp != 0;
    const float* st = p.state_shift + (size_t)cd_batch(d, tt) * DSHIFT;
    bf16x8 bw[2], ba[2];
#pragma unroll
    for (int ks = 0; ks < 2; ++ks) {
#pragma unroll
        for (int which = 0; which < 2; ++which) {
            const int col = (which ? C_AD : C_WD) + ks * 32 + fq * 8;
            const u32x4 cu = which ? R.adc[ks] : R.wdc[ks], pr = which ? R.adp[ks] : R.wdp[ks];
            float x0[4], x1[4];
            shift4((u32x2){cu[0], cu[1]}, (u32x2){pr[0], pr[1]}, st, isfirst, samp, col, *(const f32x4*)(par + 512 + which * 64 + ks * 32 + fq * 8), x0);
            shift4((u32x2){cu[2], cu[3]}, (u32x2){pr[2], pr[3]}, st, isfirst, samp, col + 4, *(const f32x4*)(par + 512 + which * 64 + ks * 32 + fq * 8 + 4), x1);
            if (!which) {
#pragma unroll
                for (int e = 0; e < 4; ++e) { x0[e] = tanh_fast(x0[e]); x1[e] = tanh_fast(x1[e]); }
            }
            u32x4 pk; pk[0] = cvt_pk_bf16(x0[0], x0[1]); pk[1] = cvt_pk_bf16(x0[2], x0[3]); pk[2] = cvt_pk_bf16(x1[0], x1[1]); pk[3] = cvt_pk_bf16(x1[2], x1[3]);
            if (which) ba[ks] = __builtin_bit_cast(bf16x8, pk); else bw[ks] = __builtin_bit_cast(bf16x8, pk);
        }
    }
    const bf16x8* ft = (const bf16x8*)(p.ws + WS_FRAG) + (size_t)d.h * 1024 + lane;
    __builtin_amdgcn_sched_barrier(0);
#pragma unroll
    for (int it = 0; it < 4; ++it) {
        S.aw[it] = (f32x4){0.f, 0.f, 0.f, 0.f}; S.aa[it] = S.aw[it];
#pragma unroll
        for (int ks = 0; ks < 2; ++ks) {
            S.aw[it] = __builtin_amdgcn_mfma_f32_16x16x32_bf16(ft[(it * 2 + ks) * 64], bw[ks], S.aw[it], 0, 0, 0);
            S.aa[it] = __builtin_amdgcn_mfma_f32_16x16x32_bf16(ft[(8 + it * 2 + ks) * 64], ba[ks], S.aa[it], 0, 0, 0);
        }
        if (it & 1) __builtin_amdgcn_sched_barrier(0);
    }
    const int hc = d.h * 64 + 4 * fq;
    float ss = 0.f;
#pragma unroll
    for (int it = 0; it < 4; ++it) {
        const int po = it * 16 + 4 * fq;
        float k4[4];
        shift4(R.kc[it], R.kp[it], st, isfirst, samp, C_PK + hc + it * 16, *(const f32x4*)(par + 64 + po), k4);
        const f32x4 kkp = *(const f32x4*)(par + 5 * 64 + po);
#pragma unroll
        for (int e = 0; e < 4; ++e) { S.ksf[it * 4 + e] = k4[e]; const float kr = k4[e] * kkp[e]; ss += kr * kr; }
        __builtin_amdgcn_sched_barrier(0);
    }
    ss += __shfl_xor(ss, 16, 64); ss += __shfl_xor(ss, 32, 64);
    S.rn = rsqrtf(ss + 1e-12f);
}

__device__ __forceinline__ void prep_stage2(const Params& p, const ChunkDesc& d, const int tb, float* buf, const float* par, const int lane, const PrepRaw2& R, const PrepState& S) {
    const int fr = lane & 15, fq = lane >> 4;
    const int t = tb + fr; const bool valid = t < d.n; const int tt = valid ? t : d.n - 1;
    const bool isfirst = cd_first(d, tt), samp = d.samp != 0;
    const float* st = p.state_shift + (size_t)cd_batch(d, tt) * DSHIFT;
    const int hc = d.h * 64 + 4 * fq;
    float c1 = 0.f, c2 = 0.f, c3 = 0.f;
    float* kkA = buf; float* wrA = buf + 32 * SROW; float* wA = buf + 2 * 32 * SROW; float* bA = buf + 3 * 32 * SROW; float* kpA = buf + 4 * 32 * SROW; float* vsA = buf + 5 * 32 * SROW; float* c12 = buf + 6 * 32 * SROW;
#pragma unroll
    for (int it = 0; it < 4; ++it) {
        const int po = it * 16 + 4 * fq;
        const f32x4 w0 = *(const f32x4*)(par + 3 * 64 + po), a0 = *(const f32x4*)(par + 4 * 64 + po), kkp = *(const f32x4*)(par + 5 * 64 + po), ka = *(const f32x4*)(par + 6 * 64 + po), rk = *(const f32x4*)(par + 7 * 64 + po);
        f32x4 o_kk, o_wr, o_w, o_b, o_kp, o_vs;
        float r4[4], v4[4];
        shift4(R.rc[it], R.rp[it], st, isfirst, samp, C_PR + hc + it * 16, *(const f32x4*)(par + po), r4);
        shift4(R.vc[it], R.vp[it], st, isfirst, samp, C_PV + hc + it * 16, *(const f32x4*)(par + 128 + po), v4);
#pragma unroll
        for (int e = 0; e < 4; ++e) {
            const float r_ = r4[e], k_ = S.ksf[it * 4 + e];
            const float dec = __expf(-0.6065306597f * sigmoidf_(S.aw[it][e] + w0[e]));
            const float a = sigmoidf_(S.aa[it][e] + a0[e]);
            const float kn = k_ * kkp[e] * S.rn;
            const float kpv = k_ * (1.0f + (a - 1.0f) * ka[e]);
            const float bv = kn * a;
            c1 += bv * r_; c2 += kpv * r_; c3 += r_ * kpv * rk[e];
            o_kk[e] = kn; o_wr[e] = dec * r_; o_w[e] = dec; o_b[e] = bv; o_kp[e] = kpv; o_vs[e] = v4[e];
        }
        if (valid) {
            const int o = t * SROW + po;
            *(f32x4*)(kkA + o) = o_kk; *(f32x4*)(wrA + o) = o_wr; *(f32x4*)(wA + o) = o_w; *(f32x4*)(bA + o) = o_b; *(f32x4*)(kpA + o) = o_kp; *(f32x4*)(vsA + o) = o_vs;
        }
        __builtin_amdgcn_sched_barrier(0);
    }
    c1 += __shfl_xor(c1, 16, 64); c1 += __shfl_xor(c1, 32, 64);
    c2 += __shfl_xor(c2, 16, 64); c2 += __shfl_xor(c2, 32, 64);
    c3 += __shfl_xor(c3, 16, 64); c3 += __shfl_xor(c3, 32, 64);
    if (valid && fq == 0) { c12[t * 2] = c1; c12[t * 2 + 1] = c2; if (d.half == 0) ((float*)(p.ws + WS_C3))[(size_t)cd_row(d, t) * 16 + d.h] = c3; }
}

__device__ void phase2_scan(const Params& p, unsigned char* smem) {
    const int tid = opaque_tid(), lane = tid & 63, wid = __builtin_amdgcn_readfirstlane(tid >> 6);
    const int bid = blockIdx.x, G = gridDim.x;
    float* sm = (float*)smem;
    float* bufs = sm;
    float* obuf = sm + 2 * SBUF;
    float* parb = obuf + 2 * 1024;
    const int NC = n_chunks(bid, G);
    bf16_t* ORAW = (bf16_t*)(p.out + OUT_Y);
    __syncthreads();
    if (NC == 0) return;
    if (wid < 4) {
        __builtin_amdgcn_s_setprio(3);
        const int c = lane & 15, rg = lane >> 4, rl = wid * 8 + rg * 2;
        f32x2 s00 = (f32x2){0.f, 0.f}, s01 = s00, s10 = s00, s11 = s00;
        __syncthreads();
        __syncthreads();
        for (int ci = 0; ci < NC; ++ci) {
            ChunkDesc d; chunk_desc(ci, bid, G, d);
            const float* buf = bufs + (ci & 1) * SBUF;
            const float* kkA = buf + 4 * c; const float* vsA = buf + 5 * 32 * SROW + d.half * 32 + rl; const float* c12 = buf + 6 * 32 * SROW;
            float* ob = obuf + (ci & 1) * 1024 + rl;
            const int nsub = d.samp ? (d.n >> 3) : 1;
            OpSet A, B;
            auto ld = [&](OpSet& o, const int t) {
                o.kk = *(const f32x4*)(kkA + t * SROW); o.wr = *(const f32x4*)(kkA + 32 * SROW + t * SROW); o.w = *(const f32x4*)(kkA + 2 * 32 * SROW + t * SROW);
                o.b = *(const f32x4*)(kkA + 3 * 32 * SROW + t * SROW); o.k = *(const f32x4*)(kkA + 4 * 32 * SROW + t * SROW);
                o.v = *(const f32x2*)(vsA + t * SROW); o.cc = *(const f32x2*)(c12 + t * 2);
            };
            auto step = [&](const OpSet& o, const int t) {
                const f32x2 pd0 = s00 * lo2(o.kk) + s01 * hi2(o.kk), pd1 = s10 * lo2(o.kk) + s11 * hi2(o.kk);
                const f32x2 pe0 = s00 * lo2(o.wr) + s01 * hi2(o.wr), pe1 = s10 * lo2(o.wr) + s11 * hi2(o.wr);
                float d0, d1, e0, e1;
                reduce4_row16(pd0[0], pd0[1], pd1[0], pd1[1], pe0[0], pe0[1], pe1[0], pe1[1], d0, d1, e0, e1);
                const f32x2 vv0 = (f32x2){o.v[0], o.v[0]}, vv1 = (f32x2){o.v[1], o.v[1]}, dd0 = (f32x2){d0, d0}, dd1 = (f32x2){d1, d1};
                s00 = s00 * lo2(o.w) + (lo2(o.k) * vv0 - lo2(o.b) * dd0);
                s01 = s01 * hi2(o.w) + (hi2(o.k) * vv0 - hi2(o.b) * dd0);
                s10 = s10 * lo2(o.w) + (lo2(o.k) * vv1 - lo2(o.b) * dd1);
                s11 = s11 * hi2(o.w) + (hi2(o.k) * vv1 - hi2(o.b) * dd1);
                if (c == 0) { f32x2 ov; ov[0] = e0 - d0 * o.cc[0] + o.v[0] * o.cc[1]; ov[1] = e1 - d1 * o.cc[0] + o.v[1] * o.cc[1]; *(f32x2*)(ob + t * 32) = ov; }
            };
            auto run = [&](const int tbeg, const int tend) {
                ld(A, tbeg);
                for (int t = tbeg; t < tend; t += 2) {
                    ld(B, t + 1);
                    step(A, t);
                    ld(A, (t + 2 < tend) ? t + 2 : t);
                    step(B, t + 1);
                }
            };
            auto put_state = [&](float* so) {
                f32x4 a, b2; a[0] = s00[0]; a[1] = s00[1]; a[2] = s01[0]; a[3] = s01[1]; b2[0] = s10[0]; b2[1] = s10[1]; b2[2] = s11[0]; b2[3] = s11[1];
                *(f32x4*)so = a; *(f32x4*)(so + 64) = b2;
            };
            if (d.samp) {
                f32x4 ia[4], ib[4]; size_t off[4];
#pragma unroll
                for (int sub = 0; sub < 4; ++sub) {
                    const int sb = sub < nsub ? sub : nsub - 1;
                    off[sub] = ((size_t)(cd_batch(d, sb * 8) * 16 + d.h) * 64 + d.half * 32 + rl) * 64 + 4 * c;
                    ia[sub] = *(const f32x4*)(p.state_wkv + off[sub]); ib[sub] = *(const f32x4*)(p.state_wkv + off[sub] + 64);
                }
#pragma unroll
                for (int sub = 0; sub < 4; ++sub) {
                    if (sub < nsub) {
                        s00 = lo2(ia[sub]); s01 = hi2(ia[sub]); s10 = lo2(ib[sub]); s11 = hi2(ib[sub]);
                        run(sub * 8, sub * 8 + 8);
                        put_state(p.out + OUT_WKV_S + off[sub]);
                    }
                }
            } else {
                if (d.first) { s00 = (f32x2){0.f, 0.f}; s01 = s00; s10 = s00; s11 = s00; }
                run(0, d.n);
                if (d.last) put_state(p.out + OUT_WKV_P + ((size_t)(d.b * 16 + d.h) * 64 + d.half * 32 + rl) * 64 + 4 * c);
            }
            __syncthreads();
        }
        __syncthreads();
        __builtin_amdgcn_s_setprio(0);
    } else {
        const int q = (wid >> 1) & 1, tb = (wid & 1) * 16;
        float* par = parb + (wid & 3) * 640;
        PrepState S;
        int cur_h = -1;
        for (int i = -2; i <= NC; ++i) {
            if ((i & 1) == q) {
                ChunkDesc d;
                int ck = i + 2; ck = ck < 0 ? 0 : (ck > NC - 1 ? NC - 1 : ck);
                chunk_desc(ck, bid, G, d);
                if (d.h != cur_h) {
                    cur_h = d.h;
                    const int ch = d.h * 64 + lane;
                    par[lane] = p.shift_mu[ch]; par[64 + lane] = p.shift_mu[1024 + ch]; par[128 + lane] = p.shift_mu[2048 + ch]; par[192 + lane] = p.decay_w0[ch];
                    par[256 + lane] = p.icl_a0[ch]; par[320 + lane] = p.k_k[ch]; par[384 + lane] = p.k_a[ch]; par[448 + lane] = p.r_k[ch];
                    par[512 + lane] = p.shift_mu[C_WD + lane]; par[576 + lane] = p.shift_mu[C_AD + lane];
                }
                PrepRaw R;
                prep_load(p, d, tb, lane, R);
                prep_stage1(p, d, tb, par, lane, R, S);
            } else {
                ChunkDesc d, d2;
                PrepRaw2 R2;
                const bool has2 = i >= -1 && i + 1 < NC && chunk_desc(i + 1, bid, G, d2) && tb < d2.n;
                if (has2) prep_load2(p, d2, tb, lane, R2);
                if (i >= 1 && chunk_desc(i - 1, bid, G, d)) {
                    const float* ob = obuf + ((i - 1) & 1) * 1024;
                    for (int idx = (wid & 1) * 64 + lane; idx < d.n * 4; idx += 128) { const int t = idx >> 2, j = (idx & 3) * 8;
                        const f32x4 o0 = *(const f32x4*)(ob + t * 32 + j), o1 = *(const f32x4*)(ob + t * 32 + j + 4);
                        u32x4 w; w[0] = cvt_pk_bf16(o0[0], o0[1]); w[1] = cvt_pk_bf16(o0[2], o0[3]); w[2] = cvt_pk_bf16(o1[0], o1[1]); w[3] = cvt_pk_bf16(o1[2], o1[3]);
                        *(u32x4*)(ORAW + (size_t)cd_row(d, t) * 1024 + d.h * 64 + d.half * 32 + j) = w; }
                }
                if (has2) prep_stage2(p, d2, tb, bufs + ((i + 1) & 1) * SBUF, par, lane, R2, S);
            }
            __syncthreads();
        }
    }
}

__device__ void attn_unit(const Params& p, unsigned char* smem, const int unit) {
    const int tid = opaque_tid(), lane = tid & 63, wid = __builtin_amdgcn_readfirstlane(tid >> 6), fr = lane & 15, fq = lane >> 4;
    const int b = unit >> 6, h = (unit >> 4) & 3, tile = unit & 15;
    const bf16_t* ACT = (const bf16_t*)(p.ws + WS_ACT);
    const bf16_t* Kbf = (const bf16_t*)(p.ws + WS_KBF);
    const bf16_t* Vt = (const bf16_t*)(p.ws + WS_VT);
    bf16_t* Ymem = (bf16_t*)(p.ws + WS_YMEM);
    bf16_t* Kc = (bf16_t*)smem;
    bf16_t* Vc = (bf16_t*)smem;
    const int row = b * 2048 + tile * 128 + wid * 16 + fr;
    u32x4 st[8];
    auto ldK = [&](const int hf) {
#pragma unroll
        for (int i = 0; i < 8; ++i) { const int id = tid + i * NTHREADS, key = id >> 5, d = (id & 31) * 8; st[i] = *(const u32x4*)(Kbf + (size_t)(b * 256 + hf * 128 + key) * 1024 + h * 256 + d); }
    };
    auto stK = [&]() {
#pragma unroll
        for (int i = 0; i < 8; ++i) { const int id = tid + i * NTHREADS, key = id >> 5, d = (id & 31) * 8; *(u32x4*)(Kc + key * 264 + d) = st[i]; }
    };
    auto ldV = [&](const int hf) {
#pragma unroll
        for (int i = 0; i < 8; ++i) { const int id = tid + i * NTHREADS, d = id >> 4, kc = (id & 15) * 8; st[i] = *(const u32x4*)(Vt + (size_t)(h * 256 + d) * 2048 + b * 256 + hf * 128 + kc); }
    };
    auto stV = [&]() {
#pragma unroll
        for (int i = 0; i < 8; ++i) { const int id = tid + i * NTHREADS, d = id >> 4, kc = (id & 15) * 8; *(u32x4*)(Vc + d * 136 + kc) = st[i]; }
    };
    ldK(0);
    bf16x8 qf[8];
#pragma unroll
    for (int ks = 0; ks < 8; ++ks) qf[ks] = *(const bf16x8*)(ACT + (size_t)row * ACT_LD + C_QM + h * 256 + ks * 32 + fq * 8);
    f32x4 sacc[16];
#pragma unroll
    for (int i = 0; i < 16; ++i) sacc[i] = (f32x4){0.f, 0.f, 0.f, 0.f};
#pragma unroll
    for (int hf = 0; hf < 2; ++hf) {
        __syncthreads();
        stK();
        __syncthreads();
        if (hf == 0) ldK(1); else ldV(0);
#pragma unroll
        for (int kt = 0; kt < 8; ++kt)
#pragma unroll
            for (int ks = 0; ks < 8; ++ks) {
                const bf16x8 kf = *(const bf16x8*)(Kc + (kt * 16 + fr) * 264 + ks * 32 + fq * 8);
                sacc[hf * 8 + kt] = __builtin_amdgcn_mfma_f32_16x16x32_bf16(kf, qf[ks], sacc[hf * 8 + kt], 0, 0, 0);
            }
    }
    float mx = -3.0e38f;
#pragma unroll
    for (int i = 0; i < 16; ++i) mx = fmaxf(mx, fmaxf(fmaxf(sacc[i][0], sacc[i][1]), fmaxf(sacc[i][2], sacc[i][3])));
    mx = fmaxf(mx, __shfl_xor(mx, 16, 64)); mx = fmaxf(mx, __shfl_xor(mx, 32, 64));
    float sum = 0.f;
#pragma unroll
    for (int i = 0; i < 16; ++i)
#pragma unroll
        for (int e = 0; e < 4; ++e) { const float ex = __expf(sacc[i][e] - mx); sacc[i][e] = ex; sum += ex; }
    sum += __shfl_xor(sum, 16, 64); sum += __shfl_xor(sum, 32, 64);
    const float inv = fast_rcp(sum);
    bf16x8 pf[8];
#pragma unroll
    for (int s2 = 0; s2 < 8; ++s2) {
        u32x4 t; t[0] = cvt_pk_bf16(sacc[2 * s2][0], sacc[2 * s2][1]); t[1] = cvt_pk_bf16(sacc[2 * s2][2], sacc[2 * s2][3]);
        t[2] = cvt_pk_bf16(sacc[2 * s2 + 1][0], sacc[2 * s2 + 1][1]); t[3] = cvt_pk_bf16(sacc[2 * s2 + 1][2], sacc[2 * s2 + 1][3]);
        pf[s2] = __builtin_bit_cast(bf16x8, t);
    }
    f32x4 oacc[16];
#pragma unroll
    for (int i = 0; i < 16; ++i) oacc[i] = (f32x4){0.f, 0.f, 0.f, 0.f};
#pragma unroll
    for (int hf = 0; hf < 2; ++hf) {
        __syncthreads();
        stV();
        __syncthreads();
        if (hf == 0) ldV(1);
#pragma unroll
        for (int dt = 0; dt < 16; ++dt)
#pragma unroll
            for (int s2 = 0; s2 < 4; ++s2) {
                const u32x2 lo = *(const u32x2*)(Vc + (dt * 16 + fr) * 136 + s2 * 32 + 4 * fq), hi = *(const u32x2*)(Vc + (dt * 16 + fr) * 136 + s2 * 32 + 16 + 4 * fq);
                u32x4 t; t[0] = lo[0]; t[1] = lo[1]; t[2] = hi[0]; t[3] = hi[1];
                oacc[dt] = __builtin_amdgcn_mfma_f32_16x16x32_bf16(__builtin_bit_cast(bf16x8, t), pf[hf * 4 + s2], oacc[dt], 0, 0, 0);
            }
    }
#pragma unroll
    for (int dt = 0; dt < 16; ++dt) {
        const int d = h * 256 + dt * 16 + 4 * fq;
        const u32x2 g = *(const u32x2*)(ACT + (size_t)row * ACT_LD + C_SGM + d);
        u32x2 o; o[0] = cvt_pk_bf16(oacc[dt][0] * inv * bflo(g[0]), oacc[dt][1] * inv * bfhi(g[0])); o[1] = cvt_pk_bf16(oacc[dt][2] * inv * bflo(g[1]), oacc[dt][3] * inv * bfhi(g[1]));
        *(u32x2*)(Ymem + (size_t)row * 1024 + d) = o;
    }
}

__device__ void attn_sample_unit(const Params& p, unsigned char* smem, const int b, const int h) {
    const int tid = opaque_tid(), lane = tid & 63, wid = __builtin_amdgcn_readfirstlane(tid >> 6), fr = lane & 15, fq = lane >> 4;
    const bf16_t* ACT = (const bf16_t*)(p.ws + WS_ACT);
    bf16_t* Ymem = (bf16_t*)(p.ws + WS_YMEM);
    bf16_t* Kc = (bf16_t*)smem;
    float* Ored = (float*)smem;
    float* Pl = (float*)(smem + 69632);
    const int row = MP + b * 8 + (fr & 7);
    bf16x8 qf[8];
#pragma unroll
    for (int ks = 0; ks < 8; ++ks) qf[ks] = *(const bf16x8*)(ACT + (size_t)row * ACT_LD + C_QM + h * 256 + ks * 32 + fq * 8);
    const float* vbase = p.cache_v + ((size_t)(b * 256 + wid * 32) * 4 + h) * 256 + lane * 4;
    f32x4 vv[8];
#pragma unroll
    for (int i = 0; i < 8; ++i) vv[i] = *(const f32x4*)(vbase + (size_t)i * 1024);
    f32x4 sacc[16];
#pragma unroll
    for (int i = 0; i < 16; ++i) sacc[i] = (f32x4){0.f, 0.f, 0.f, 0.f};
#pragma unroll
    for (int hf = 0; hf < 2; ++hf) {
        __syncthreads();
#pragma unroll
        for (int i = 0; i < 8; ++i) {
            const int id = tid + i * NTHREADS, key = id >> 5, d = (id & 31) * 8;
            const float* s_ = p.cache_k + ((size_t)(b * 256 + hf * 128 + key) * 4 + h) * 256 + d; const f32x4 x0 = *(const f32x4*)s_, x1 = *(const f32x4*)(s_ + 4);
            u32x4 v; v[0] = cvt_pk_bf16(x0[0], x0[1]); v[1] = cvt_pk_bf16(x0[2], x0[3]); v[2] = cvt_pk_bf16(x1[0], x1[1]); v[3] = cvt_pk_bf16(x1[2], x1[3]);
            *(u32x4*)(Kc + key * 264 + d) = v;
        }
        __syncthreads();
#pragma unroll
        for (int kt = 0; kt < 8; ++kt)
#pragma unroll
            for (int ks = 0; ks < 8; ++ks) {
                const bf16x8 kf = *(const bf16x8*)(Kc + (kt * 16 + fr) * 264 + ks * 32 + fq * 8);
                sacc[hf * 8 + kt] = __builtin_amdgcn_mfma_f32_16x16x32_bf16(kf, qf[ks], sacc[hf * 8 + kt], 0, 0, 0);
            }
    }
    float mx = -3.0e38f;
#pragma unroll
    for (int i = 0; i < 16; ++i) mx = fmaxf(mx, fmaxf(fmaxf(sacc[i][0], sacc[i][1]), fmaxf(sacc[i][2], sacc[i][3])));
    mx = fmaxf(mx, __shfl_xor(mx, 16, 64)); mx = fmaxf(mx, __shfl_xor(mx, 32, 64));
    float sum = 0.f;
#pragma unroll
    for (int i = 0; i < 16; ++i)
#pragma unroll
        for (int e = 0; e < 4; ++e) { const float ex = __expf(sacc[i][e] - mx); sacc[i][e] = ex; sum += ex; }
    sum += __shfl_xor(sum, 16, 64); sum += __shfl_xor(sum, 32, 64);
    const float inv = fast_rcp(sum);
    if (wid == 0 && fr < 8) {
#pragma unroll
        for (int i = 0; i < 16; ++i)
#pragma unroll
            for (int e = 0; e < 4; ++e) Pl[(i * 16 + 4 * fq + e) * 8 + fr] = sacc[i][e] * inv;
    }
    __syncthreads();
    f32x4 o[8];
#pragma unroll
    for (int t = 0; t < 8; ++t) o[t] = (f32x4){0.f, 0.f, 0.f, 0.f};
#pragma unroll
    for (int half = 0; half < 4; ++half) {
        if (half >= 1) {
#pragma unroll
            for (int i = 0; i < 8; ++i) vv[i] = *(const f32x4*)(vbase + (size_t)(half * 8 + i) * 1024);
        }
#pragma unroll
        for (int i = 0; i < 8; ++i) {
            const float* pp = Pl + (wid * 32 + half * 8 + i) * 8;
            const f32x4 p0 = *(const f32x4*)pp, p1 = *(const f32x4*)(pp + 4);
#pragma unroll
            for (int t = 0; t < 4; ++t) { o[t] += vv[i] * p0[t]; o[4 + t] += vv[i] * p1[t]; }
        }
    }
#pragma unroll
    for (int t = 0; t < 8; ++t) *(f32x4*)(Ored + (wid * 8 + t) * 256 + lane * 4) = o[t];
    __syncthreads();
    {
        const int t = tid >> 6, d = (tid & 63) * 4;
        f32x4 acc = (f32x4){0.f, 0.f, 0.f, 0.f};
#pragma unroll
        for (int w = 0; w < 8; ++w) acc += *(const f32x4*)(Ored + (w * 8 + t) * 256 + d);
        const size_t orow = (size_t)(MP + b * 8 + t);
        const u32x2 g = *(const u32x2*)(ACT + orow * ACT_LD + C_SGM + h * 256 + d);
        u32x2 ov; ov[0] = cvt_pk_bf16(acc[0] * bflo(g[0]), acc[1] * bfhi(g[0])); ov[1] = cvt_pk_bf16(acc[2] * bflo(g[1]), acc[3] * bfhi(g[1]));
        *(u32x2*)(Ymem + orow * 1024 + h * 256 + d) = ov;
    }
}

__device__ void phase2_attn(const Params& p, unsigned char* smem) {
    __syncthreads();
    for (int k = blockIdx.x; k < 1024; k += gridDim.x) {
        const int u = (k + ((blockIdx.x & 1) << 9)) & 1023;
        if (u < 512) attn_unit(p, smem, u); else attn_sample_unit(p, smem, (u - 512) >> 2, u & 3);
    }
}

__device__ __forceinline__ void ld16bf(const bf16_t* ptr, float (&o)[16]) {
    const u32x4 a = *(const u32x4*)ptr, b = *(const u32x4*)(ptr + 8);
#pragma unroll
    for (int e = 0; e < 4; ++e) { o[2 * e] = bflo(a[e]); o[2 * e + 1] = bfhi(a[e]); o[8 + 2 * e] = bflo(b[e]); o[8 + 2 * e + 1] = bfhi(b[e]); }
}
__device__ __forceinline__ void ld16f(const float* ptr, float (&o)[16]) {
#pragma unroll
    for (int q = 0; q < 4; ++q) { const f32x4 v = *(const f32x4*)(ptr + 4 * q); o[4 * q] = v[0]; o[4 * q + 1] = v[1]; o[4 * q + 2] = v[2]; o[4 * q + 3] = v[3]; }
}
__device__ __forceinline__ void st16bf(bf16_t* ptr, const float (&y)[16]) {
    u32x4 a, b;
#pragma unroll
    for (int e = 0; e < 4; ++e) { a[e] = cvt_pk_bf16(y[2 * e], y[2 * e + 1]); b[e] = cvt_pk_bf16(y[8 + 2 * e], y[8 + 2 * e + 1]); }
    *(u32x4*)ptr = a; *(u32x4*)(ptr + 8) = b;
}
__device__ __forceinline__ float quad_sum(float x) { x += dpp_f<0xB1>(x); x += dpp_f<0x4E>(x); return x; }
struct RowRaw { u32x4 u0[2], u1[2], u2[2], bg[2], vc[2], vq[2], sg[2], o[2]; float c3; };
__device__ __forceinline__ void up16(const u32x4 (&r)[2], float (&o)[16]) {
#pragma unroll
    for (int e = 0; e < 4; ++e) { o[2 * e] = bflo(r[0][e]); o[2 * e + 1] = bfhi(r[0][e]); o[8 + 2 * e] = bflo(r[1][e]); o[8 + 2 * e + 1] = bfhi(r[1][e]); }
}
__device__ __forceinline__ float bfe16(const u32x4 (&r)[2], const int i) { const unsigned w = r[i >> 3][(i >> 1) & 3]; return (i & 1) ? bfhi(w) : bflo(w); }
__device__ void phase2b(const Params& p, unsigned char* smem) {
    const int tid = opaque_tid(), lane = tid & 63, wid = tid >> 6;
    float* tab = (float*)smem;
    __syncthreads();
    for (int idx = tid; idx < 7168; idx += NTHREADS)
        tab[idx] = idx < 3072 ? p.conv_w[idx] : idx < 4096 ? p.conv_b[idx - 3072] : idx < 5120 ? p.shift_mu[2048 + idx - 4096] : idx < 6144 ? p.ln_g[idx - 5120] : p.ln_b[idx - 6144];
    __syncthreads();
    const bf16_t* U = (const bf16_t*)(p.ws + WS_U); const bf16_t* BG = (const bf16_t*)(p.ws + WS_BG); const bf16_t* ACT = (const bf16_t*)(p.ws + WS_ACT);
    const bf16_t* ORAW = (const bf16_t*)(p.out + OUT_Y); const float* C3 = (const float*)(p.ws + WS_C3);
    bf16_t* Yc = (bf16_t*)(p.ws + WS_YCONV); bf16_t* Yr = (bf16_t*)(p.ws + WS_YRWKV);
    const int ch = lane * 16;
    auto load_row = [&](const int row, RowRaw& R) {
        const bool samp = row >= MP; const int t = samp ? ((row - MP) & 7) : (row & 2047);
        const int r1 = t >= 1 ? row - 1 : row, r2 = t >= 2 ? row - 2 : row;
#pragma unroll
        for (int q = 0; q < 2; ++q) {
            R.u0[q] = *(const u32x4*)(U + (size_t)row * 1024 + ch + 8 * q); R.u1[q] = *(const u32x4*)(U + (size_t)r1 * 1024 + ch + 8 * q); R.u2[q] = *(const u32x4*)(U + (size_t)r2 * 1024 + ch + 8 * q);
            R.bg[q] = *(const u32x4*)(BG + (size_t)row * 1024 + ch + 8 * q);
            R.vc[q] = *(const u32x4*)(ACT + (size_t)row * ACT_LD + C_PV + ch + 8 * q); R.vq[q] = *(const u32x4*)(ACT + (size_t)r1 * ACT_LD + C_PV + ch + 8 * q);
            R.sg[q] = *(const u32x4*)(ACT + (size_t)row * ACT_LD + C_SGR + ch + 8 * q);
        }
#pragma unroll
        for (int q = 0; q < 2; ++q) R.o[q] = *(const u32x4*)(ORAW + (size_t)row * 1024 + ch + 8 * q);
        R.c3 = C3[(size_t)row * 16 + (lane >> 2)];
    };
    auto process_row = [&](const int row, const RowRaw& R) {
        int b, t; const bool samp = row >= MP;
        if (!samp) { b = row >> 11; t = row & 2047; } else { b = (row - MP) >> 3; t = (row - MP) & 7; }
        const bool z1 = t < 1, z2 = t < 2;
        u32x4 yo[2];
#pragma unroll
        for (int q = 0; q < 4; ++q) {
            const f32x4 w0 = *(const f32x4*)(tab + ch + 4 * q), w1 = *(const f32x4*)(tab + 1024 + ch + 4 * q), w2 = *(const f32x4*)(tab + 2048 + ch + 4 * q), cb = *(const f32x4*)(tab + 3072 + ch + 4 * q);
            f32x4 m1 = (f32x4){0.f, 0.f, 0.f, 0.f}, m2 = m1;
            if (z1) { if (samp) m1 = *(const f32x4*)(p.state_conv + ((size_t)b * 2 + 1) * 1024 + ch + 4 * q); }
            else { m1[0] = bfe16(R.u1, 4 * q); m1[1] = bfe16(R.u1, 4 * q + 1); m1[2] = bfe16(R.u1, 4 * q + 2); m1[3] = bfe16(R.u1, 4 * q + 3); }
            if (z2) { if (samp) m2 = *(const f32x4*)(p.state_conv + ((size_t)b * 2 + t) * 1024 + ch + 4 * q); }
            else { m2[0] = bfe16(R.u2, 4 * q); m2[1] = bfe16(R.u2, 4 * q + 1); m2[2] = bfe16(R.u2, 4 * q + 2); m2[3] = bfe16(R.u2, 4 * q + 3); }
            float y[4];
#pragma unroll
            for (int e = 0; e < 4; ++e) { const int i = 4 * q + e; y[e] = bfe16(R.bg, i) * (cb[e] + w0[e] * m2[e] + w1[e] * m1[e] + w2[e] * bfe16(R.u0, i)); }
            yo[q >> 1][(q & 1) * 2] = cvt_pk_bf16(y[0], y[1]); yo[q >> 1][(q & 1) * 2 + 1] = cvt_pk_bf16(y[2], y[3]);
        }
        *(u32x4*)(Yc + (size_t)row * 1024 + ch) = yo[0]; *(u32x4*)(Yc + (size_t)row * 1024 + ch + 8) = yo[1];
        float oo[16]; up16(R.o, oo);
        float sm_ = 0.f;
#pragma unroll
        for (int e = 0; e < 16; ++e) sm_ += oo[e];
        const float mean = quad_sum(sm_) * (1.0f / 64.0f);
        float vr = 0.f;
#pragma unroll
        for (int e = 0; e < 16; ++e) { const float dl = oo[e] - mean; vr += dl * dl; }
        const float rstd = rsqrtf(quad_sum(vr) * (1.0f / 64.0f) + 6.4e-4f);
#pragma unroll
        for (int q = 0; q < 4; ++q) {
            const f32x4 mv = *(const f32x4*)(tab + 4096 + ch + 4 * q), lg = *(const f32x4*)(tab + 5120 + ch + 4 * q), lb = *(const f32x4*)(tab + 6144 + ch + 4 * q);
            f32x4 pq = (f32x4){0.f, 0.f, 0.f, 0.f};
            if (z1) { if (samp) pq = *(const f32x4*)(p.state_shift + (size_t)b * DSHIFT + 2048 + ch + 4 * q); }
            else { pq[0] = bfe16(R.vq, 4 * q); pq[1] = bfe16(R.vq, 4 * q + 1); pq[2] = bfe16(R.vq, 4 * q + 2); pq[3] = bfe16(R.vq, 4 * q + 3); }
            float y[4];
#pragma unroll
            for (int e = 0; e < 4; ++e) { const int i = 4 * q + e; const float vcu = bfe16(R.vc, i); const float vs = vcu + mv[e] * (pq[e] - vcu); y[e] = ((oo[i] - mean) * rstd * lg[e] + lb[e] + R.c3 * vs) * bfe16(R.sg, i); }
            yo[q >> 1][(q & 1) * 2] = cvt_pk_bf16(y[0], y[1]); yo[q >> 1][(q & 1) * 2 + 1] = cvt_pk_bf16(y[2], y[3]);
        }
        *(u32x4*)(Yr + (size_t)row * 1024 + ch) = yo[0]; *(u32x4*)(Yr + (size_t)row * 1024 + ch + 8) = yo[1];
    };
    for (int row = blockIdx.x * 8 + wid; row < MALL; row += gridDim.x * 8) {
        RowRaw Ra;
        load_row(row, Ra);
        process_row(row, Ra);
    }
}

struct SchedP3 {
    int G, c; const char* ws;
    __device__ __forceinline__ bool next(int i, Unit& u) const {
        const int tl = (i / 3) * G + c, seg = i % 3;
        if (tl >= 256) return false;
        u.x = tl >> 2; u.y = tl & 3; u.z = seg;
        u.a = ws + (seg == 0 ? WS_YCONV : seg == 1 ? WS_YRWKV : WS_YMEM) + (size_t)u.x * 256 * 2048; u.b = ws + WS_WB + ((size_t)seg * 1024 + (size_t)u.y * 256) * 2048;
        return true;
    }
};
struct SchedP3T {
    int G, c; const char* ws;
    __device__ __forceinline__ bool next(int i, Unit& u) const {
        const int e = i * G + c;
        if (e >= 96) return false;
        const int tt = e / 6, r = e % 6, seg = r >> 1, kh = r & 1;
        u.x = 64 + (tt >> 2); u.y = tt & 3; u.z = r;
        u.a = ws + (seg == 0 ? WS_YCONV : seg == 1 ? WS_YRWKV : WS_YMEM) + (size_t)u.x * 256 * 2048 + kh * 1024;
        u.b = ws + WS_WB + ((size_t)seg * 1024 + (size_t)u.y * 256) * 2048 + kh * 1024;
        return true;
    }
};
struct EpiP3T {
    const bf16_t* ACT; float* PART;
    __device__ __forceinline__ bool operator()(f32x4 (&acc)[2][2][4][2], const Unit& u, int wr, int wc, int fr, int fq) const {
        const int seg = u.z >> 1, rbase = u.x * 256 + wr * 64 + fr, cb = u.y * 256 + wc * 32 + 8 * fq;
        const bf16_t* gbase = ACT + C_GATE + seg * 1024 + cb;
#pragma unroll
        for (int ai = 0; ai < 2; ++ai) {
            u32x4 g[4][2];
#pragma unroll
            for (int m = 0; m < 4; ++m)
#pragma unroll
                for (int bj = 0; bj < 2; ++bj) g[m][bj] = *(const u32x4*)(gbase + (size_t)(rbase + ai * 128 + m * 16) * ACT_LD + 128 * bj);
#pragma unroll
            for (int m = 0; m < 4; ++m)
#pragma unroll
                for (int bj = 0; bj < 2; ++bj) {
                    f32x4 v0 = acc[ai][bj][m][0], v1 = acc[ai][bj][m][1];
                    v0[0] *= bflo(g[m][bj][0]); v0[1] *= bfhi(g[m][bj][0]); v0[2] *= bflo(g[m][bj][1]); v0[3] *= bfhi(g[m][bj][1]);
                    v1[0] *= bflo(g[m][bj][2]); v1[1] *= bfhi(g[m][bj][2]); v1[2] *= bflo(g[m][bj][3]); v1[3] *= bfhi(g[m][bj][3]);
                    float* dst = PART + ((size_t)u.z * 1024 + (size_t)(rbase + ai * 128 + m * 16 - MP)) * 1024 + cb + 128 * bj;
                    *(f32x4*)dst = v0; *(f32x4*)(dst + 4) = v1;
                }
        }
        return false;
    }
};
struct EpiP3 {
    const bf16_t* ACT; bf16_t* MERGED;
    __device__ __forceinline__ bool operator()(f32x4 (&acc)[2][2][4][2], const Unit& u, int wr, int wc, int fr, int fq) const {
        const int seg = u.z, rbase = u.x * 256 + wr * 64 + fr, cb = u.y * 256 + wc * 32 + 8 * fq;
        const bf16_t* gbase = ACT + C_GATE + seg * 1024 + cb;
#pragma unroll
        for (int ai = 0; ai < 2; ++ai) {
            u32x4 g[4][2], g2[4][2];
#pragma unroll
            for (int m = 0; m < 4; ++m)
#pragma unroll
                for (int bj = 0; bj < 2; ++bj) {
                    const bf16_t* gp = gbase + (size_t)(rbase + ai * 128 + m * 16) * ACT_LD + 128 * bj;
                    g[m][bj] = *(const u32x4*)gp;
                    if (seg < 2) g2[m][bj] = *(const u32x4*)(gp + 1024);
                }
#pragma unroll
            for (int m = 0; m < 4; ++m)
#pragma unroll
                for (int bj = 0; bj < 2; ++bj) {
                    float f[8];
#pragma unroll
                    for (int e = 0; e < 4; ++e) { f[2 * e] = bflo(g[m][bj][e]); f[2 * e + 1] = bfhi(g[m][bj][e]); }
                    if (seg < 2) {
#pragma unroll
                        for (int e = 0; e < 4; ++e) { f[2 * e] *= fast_rcp(bflo(g2[m][bj][e])); f[2 * e + 1] *= fast_rcp(bfhi(g2[m][bj][e])); }
                    }
                    f32x4& v0 = acc[ai][bj][m][0]; f32x4& v1 = acc[ai][bj][m][1];
#pragma unroll
                    for (int e = 0; e < 4; ++e) { v0[e] *= f[e]; v1[e] *= f[4 + e]; }
                    if (seg == 2) {
                        u32x4 o; o[0] = cvt_pk_bf16(v0[0], v0[1]); o[1] = cvt_pk_bf16(v0[2], v0[3]); o[2] = cvt_pk_bf16(v1[0], v1[1]); o[3] = cvt_pk_bf16(v1[2], v1[3]);
                        *(u32x4*)(MERGED + (size_t)(rbase + ai * 128 + m * 16) * 1024 + cb + 128 * bj) = o;
                    }
                }
        }
        return seg < 2;
    }
};
struct SchedP4 {
    int G, c; const char* A; const char* B;
    __device__ __forceinline__ bool next(int i, Unit& u) const {
        const int tl = i * G + c;
        if (tl >= 256) return false;
        u.x = tl >> 2; u.y = tl & 3; u.z = 0;
        u.a = A + (size_t)u.x * 256 * 2048; u.b = B + (size_t)u.y * 256 * 2048;
        return true;
    }
};
struct SchedP4T {
    int G, c; const char* A; const char* B;
    __device__ __forceinline__ bool next(int i, Unit& u) const {
        const int e = i * G + c;
        if (e >= 64) return false;
        const int tt = e >> 2, kq = e & 3;
        u.x = 64 + (tt >> 2); u.y = tt & 3; u.z = kq;
        u.a = A + (size_t)u.x * 256 * 2048 + kq * 512; u.b = B + (size_t)u.y * 256 * 2048 + kq * 512;
        return true;
    }
};
struct EpiP4T {
    float* PART;
    __device__ __forceinline__ bool operator()(f32x4 (&acc)[2][2][4][2], const Unit& u, int wr, int wc, int fr, int fq) const {
        const int rbase = u.x * 256 + wr * 64 + fr - MP, cbase = u.y * 256 + wc * 32 + fq * 8;
#pragma unroll
        for (int ai = 0; ai < 2; ++ai)
#pragma unroll
            for (int m = 0; m < 4; ++m)
#pragma unroll
                for (int bj = 0; bj < 2; ++bj)
#pragma unroll
                    for (int n = 0; n < 2; ++n)
                        *(f32x4*)(PART + ((size_t)u.z * 1024 + (size_t)(rbase + ai * 128 + m * 16)) * 1024 + cbase + bj * 128 + n * 4) = acc[ai][bj][m][n];
        return false;
    }
};
__device__ void p3_tail_fixup(const Params& p) {
    const int tid = opaque_tid();
    const float* P0 = (const float*)(p.ws + WS_PART);
    bf16_t* dst = (bf16_t*)(p.ws + WS_MERGED) + (size_t)MP * 1024;
    for (int idx = blockIdx.x * NTHREADS + tid; idx < 1024 * 128; idx += gridDim.x * NTHREADS) {
        const size_t o = (size_t)idx * 8;
        f32x4 a0 = *(const f32x4*)(P0 + o), a1 = *(const f32x4*)(P0 + o + 4);
#pragma unroll
        for (int q = 1; q < 6; ++q) { a0 += *(const f32x4*)(P0 + (size_t)q * 1024 * 1024 + o); a1 += *(const f32x4*)(P0 + (size_t)q * 1024 * 1024 + o + 4); }
        u32x4 w; w[0] = cvt_pk_bf16(a0[0], a0[1]); w[1] = cvt_pk_bf16(a0[2], a0[3]); w[2] = cvt_pk_bf16(a1[0], a1[1]); w[3] = cvt_pk_bf16(a1[2], a1[3]);
        *(u32x4*)(dst + o) = w;
    }
}
struct EpiP4 {
    const float* xp; bf16_t* H16; float* SUMSQ;
    __device__ __forceinline__ bool operator()(f32x4 (&acc)[2][2][4][2], const Unit& u, int wr, int wc, int fr, int fq) const {
        const int rbase = u.x * 256 + wr * 64 + fr, cb = u.y * 256 + wc * 32 + 8 * fq;
#pragma unroll
        for (int ai = 0; ai < 2; ++ai) {
            f32x4 xv[4][2][2];
#pragma unroll
            for (int m = 0; m < 4; ++m) {
                const float* xr = xp + (size_t)(rbase + ai * 128 + m * 16) * 1024 + cb;
#pragma unroll
                for (int bj = 0; bj < 2; ++bj) { xv[m][bj][0] = *(const f32x4*)(xr + bj * 128); xv[m][bj][1] = *(const f32x4*)(xr + bj * 128 + 4); }
            }
#pragma unroll
            for (int m = 0; m < 4; ++m) {
                const int row = rbase + ai * 128 + m * 16;
                float ss = 0.f;
#pragma unroll
                for (int bj = 0; bj < 2; ++bj) {
                    const f32x4 v0 = acc[ai][bj][m][0] + xv[m][bj][0], v1 = acc[ai][bj][m][1] + xv[m][bj][1];
                    ss += v0[0] * v0[0] + v0[1] * v0[1] + v0[2] * v0[2] + v0[3] * v0[3] + v1[0] * v1[0] + v1[1] * v1[1] + v1[2] * v1[2] + v1[3] * v1[3];
                    u32x4 o; o[0] = cvt_pk_bf16(v0[0], v0[1]); o[1] = cvt_pk_bf16(v0[2], v0[3]); o[2] = cvt_pk_bf16(v1[0], v1[1]); o[3] = cvt_pk_bf16(v1[2], v1[3]);
                    *(u32x4*)(H16 + (size_t)row * 1024 + cb + bj * 128) = o;
                }
                ss += __shfl_xor(ss, 16, 64); ss += __shfl_xor(ss, 32, 64);
                if (fq == 0) SUMSQ[(size_t)row * 16 + u.y * 4 + wc] = ss;
            }
        }
        return false;
    }
};
__device__ void phase5(const Params& p) {
    const int tid5 = opaque_tid(); const int lane = tid5 & 63, wid = tid5 >> 6;
    const float* SUMSQ = (const float*)(p.ws + WS_SUMSQ);
    const float* PART = (const float*)(p.ws + WS_PART);
    for (int row = blockIdx.x * 8 + wid; row < MALL; row += gridDim.x * 8) {
        float* y = p.out + OUT_Y + (size_t)row * 1024;
        f32x4 v[4]; float ss;
        if (row < MP) {
            ss = lane < 16 ? SUMSQ[(size_t)row * 16 + lane] : 0.f;
            const bf16_t* hr = (const bf16_t*)(p.ws + WS_YMEM) + (size_t)row * 1024;
#pragma unroll
            for (int i = 0; i < 4; ++i) { const u32x2 w = *(const u32x2*)(hr + i * 256 + lane * 4); v[i][0] = bflo(w[0]); v[i][1] = bfhi(w[0]); v[i][2] = bflo(w[1]); v[i][3] = bfhi(w[1]); }
        } else {
            const float* xr = p.x_sample + (size_t)(row - MP) * 1024; ss = 0.f;
#pragma unroll
            for (int i = 0; i < 4; ++i) {
                v[i] = *(const f32x4*)(xr + i * 256 + lane * 4);
#pragma unroll
                for (int q = 0; q < 4; ++q) v[i] += *(const f32x4*)(PART + ((size_t)q * 1024 + (size_t)(row - MP)) * 1024 + i * 256 + lane * 4);
                ss += v[i][0] * v[i][0] + v[i][1] * v[i][1] + v[i][2] * v[i][2] + v[i][3] * v[i][3];
            }
        }
        ss = wave_sum(ss);
        const float inv = rsqrtf(ss * (1.0f / 1024.0f) + 1e-6f);
#pragma unroll
        for (int i = 0; i < 4; ++i) {
            const f32x4 g = *(const f32x4*)(p.norm_final + i * 256 + lane * 4);
            *(f32x4*)(y + i * 256 + lane * 4) = v[i] * inv * g;
        }
    }
}

__global__ void __launch_bounds__(NTHREADS) fwd_megakernel(Params p) {
    extern __shared__ __attribute__((aligned(16))) unsigned char smem[];
    cg::grid_group grid = cg::this_grid();
    LAS unsigned char* lds = (LAS unsigned char*)smem;
#ifndef PROBE_REP
#define PROBE_REP 0
#endif
#define REP(k) for (int _r = 0; _r < ((PROBE_REP == (k)) ? 2 : 1); ++_r)
    volatile LAS unsigned* xst = (volatile LAS unsigned*)(lds + LDS_MAIN);
    if (threadIdx.x == 0) { xst[0] = 0u; xst[1] = 0u; xst[2] = 0u; xst[3] = 0u; }
    __syncthreads();
    (void)xcd_barrier_post((unsigned*)(p.ws + WS_BAR), xst);
#define XBAR() do { XcdBarrier _b; _b.bar = (unsigned*)(p.ws + WS_BAR); _b.x = xb_xcc_id(); _b.st = (volatile LAS unsigned*)(lds + LDS_MAIN); xcd_barrier(_b); } while (0)
    REP(1) { phase0(p, smem); if (PROBE_REP == 1 && _r == 0) XBAR(); }
    if (p.ws == nullptr) grid.sync();
    XBAR();
    REP(2) {
        SchedP1 S{(int)gridDim.x, (int)blockIdx.x, (const char*)(p.ws + WS_AALL), (const char*)(p.ws + WS_BALL)};
        EpiP1 E{(bf16_t*)(p.ws + WS_U), (bf16_t*)(p.ws + WS_BG), (bf16_t*)(p.ws + WS_ACT), p.out, (bf16_t*)(p.ws + WS_KBF), (bf16_t*)(p.ws + WS_VT)};
        gemm_phase(lds, 2048, 2048, 1024, S, E);
        XBAR();
        if (PROBE_REP == 9) { EpiNull EN{(float*)(p.ws + WS_SUMSQ)}; gemm_phase(lds, 2048, 2048, 1024, S, EN); XBAR(); }
    }
    REP(3) { phase2_scan(p, smem); if (PROBE_REP == 3) XBAR(); }
    REP(5) { phase2_attn(p, smem); if (PROBE_REP == 5) XBAR(); }
    XBAR();
    REP(6) { phase2b(p, smem); XBAR(); }
    REP(7) {
        SchedP3 S{(int)gridDim.x, (int)blockIdx.x, (const char*)p.ws};
        EpiP3 E{(const bf16_t*)(p.ws + WS_ACT), (bf16_t*)(p.ws + WS_MERGED)};
        gemm_phase(lds, 2048, 2048, 1024, S, E);
        SchedP3T ST{(int)gridDim.x, (int)blockIdx.x, (const char*)p.ws};
        EpiP3T ET{(const bf16_t*)(p.ws + WS_ACT), (float*)(p.ws + WS_PART)};
        gemm_phase(lds, 2048, 2048, 512, ST, ET);
        XBAR();
        if (_r == 0) { p3_tail_fixup(p); XBAR(); }
    }
    REP(8) {
        SchedP4 S{(int)gridDim.x, (int)blockIdx.x, (const char*)(p.ws + WS_MERGED), (const char*)(p.ws + WS_WO)};
        EpiP4 E{p.x_prompt, (bf16_t*)(p.ws + WS_YMEM), (float*)(p.ws + WS_SUMSQ)};
        gemm_phase(lds, 2048, 2048, 1024, S, E);
        SchedP4T ST{(int)gridDim.x, (int)blockIdx.x, (const char*)(p.ws + WS_MERGED), (const char*)(p.ws + WS_WO)};
        EpiP4T ET{(float*)(p.ws + WS_PART)};
        gemm_phase(lds, 2048, 2048, 256, ST, ET);
        XBAR();
    }
    phase5(p);
}

extern "C" void kernel_launch(void* const* d_in, const int* in_sizes, int n_in, void* d_out, int out_size, void* d_ws, size_t ws_size, hipStream_t stream) {
    static int grid_blocks = 0;
    if (!grid_blocks) {
        int dev = 0, cus = 0, per_cu = 0;
        hipGetDevice(&dev);
        hipDeviceGetAttribute(&cus, hipDeviceAttributeMultiprocessorCount, dev);
        if (hipFuncSetAttribute((const void*)fwd_megakernel, hipFuncAttributeMaxDynamicSharedMemorySize, LDS_BYTES) != hipSuccess) fprintf(stderr, "hipFuncSetAttribute failed\n");
        hipOccupancyMaxActiveBlocksPerMultiprocessor(&per_cu, (const void*)fwd_megakernel, NTHREADS, LDS_BYTES);
        if (per_cu < 1) { fprintf(stderr, "occupancy query returned %d\n", per_cu); per_cu = 1; }
        if (per_cu > 1) per_cu = 1;
        grid_blocks = cus * per_cu;
        if (grid_blocks > 256) grid_blocks = 256;
        grid_blocks &= ~31;
        if (grid_blocks < 64) grid_blocks = -1;
        if (ws_size < WS_END) { fprintf(stderr, "workspace too small: %zu < %zu\n", ws_size, (size_t)WS_END); grid_blocks = -1; }
    }
    if (grid_blocks < 0) return;
    Params p{};
    const float** pp = (const float**)&p;
    for (int i = 0; i < 27; ++i) pp[i] = (const float*)d_in[i];
    p.out = (float*)d_out; p.ws = (unsigned char*)d_ws;
    if (hipMemsetAsync((char*)d_ws + WS_BAR, 0, (size_t)XCD_BAR_WORDS_C * 4, stream) != hipSuccess) fprintf(stderr, "memset of barrier words failed\n");
    void* args[] = {&p};
    hipError_t e = hipLaunchCooperativeKernel((const void*)fwd_megakernel, dim3(grid_blocks), dim3(NTHREADS), args, LDS_BYTES, stream);
    if (e != hipSuccess) fprintf(stderr, "cooperative launch failed: %s (grid %d)\n", hipGetErrorString(e), grid_blocks);
}
```

```cpp
#include <hip/hip_runtime.h>
#include <hip/hip_cooperative_groups.h>
#include <cstdio>
namespace cg = cooperative_groups;

#define LAS __attribute__((address_space(3)))
typedef unsigned short bf16_t;
typedef short bf16x8 __attribute__((ext_vector_type(8)));
typedef float f32x4 __attribute__((ext_vector_type(4)));
typedef float f32x2 __attribute__((ext_vector_type(2)));
typedef unsigned u32x4 __attribute__((ext_vector_type(4)));
typedef unsigned u32x2 __attribute__((ext_vector_type(2)));

constexpr int DM = 1024, TP = 2048, BP = 8, MP = BP * TP, BS = 128, TS = 8, MS = BS * TS, MALL = MP + MS;
constexpr int NMEM = 256, DIN = 13440, DSHIFT = 3200;
constexpr int NPAD = 13568;
constexpr int ACT_LD = 9472;
constexpr int C_PR = 0, C_PK = 1024, C_PV = 2048, C_WD = 3072, C_AD = 3136, C_SGR = 3328, C_QM = 4352, C_SGM = 5376, C_GATE = 6400;
constexpr size_t OUT_Y = 0, OUT_MK = 17825792, OUT_MV = 19922944, OUT_CONV_P = 22020096, OUT_SHIFT_P = 22036480, OUT_WKV_P = 22062080,
                 OUT_CONV_S = 22586368, OUT_SHIFT_S = 22848512, OUT_WKV_S = 23258112;
constexpr size_t al256(size_t x) { return (x + 255) & ~(size_t)255; }
constexpr int XCD_BAR_WORDS_C = 3456;
constexpr size_t WS_AALL = 0;
constexpr size_t WS_BALL = al256(WS_AALL + (size_t)19456 * 1024 * 2);
constexpr size_t WS_YMEM = WS_AALL;
constexpr size_t WS_YCONV = WS_AALL + (size_t)MALL * 1024 * 2;
constexpr size_t WS_WB = al256(WS_BALL + (size_t)15616 * 1024 * 2);
constexpr size_t WS_WO = al256(WS_WB + (size_t)3072 * 1024 * 2);
constexpr size_t WS_U = al256(WS_WO + (size_t)1024 * 1024 * 2);
constexpr size_t WS_MERGED = WS_U;
constexpr size_t WS_BG = al256(WS_U + (size_t)MALL * 1024 * 2);
constexpr size_t WS_PART = WS_BG;
constexpr size_t WS_PRIV = WS_BG + (size_t)6 * 1024 * 1024 * 4;
constexpr size_t WS_ACT = al256(WS_BG + (size_t)MALL * 1024 * 2);
constexpr size_t WS_KBF = al256(WS_ACT + (size_t)MALL * ACT_LD * 2);
constexpr size_t WS_VT = al256(WS_KBF + (size_t)2048 * 1024 * 2);
constexpr size_t WS_YRWKV = al256(WS_VT + (size_t)2048 * 1024 * 2);
constexpr size_t WS_C3 = al256(WS_YRWKV + (size_t)MALL * 1024 * 2);
constexpr size_t WS_SUMSQ = al256(WS_C3 + (size_t)MALL * 16 * 4);
constexpr size_t WS_BAR = al256(WS_SUMSQ + (size_t)MALL * 16 * 4);
constexpr size_t WS_FRAG = al256(WS_BAR + (size_t)XCD_BAR_WORDS_C * 4);
constexpr size_t WS_END = al256(WS_FRAG + (size_t)16 * 2 * 8 * 64 * 16);
static_assert(WS_YCONV + (size_t)MALL * 1024 * 2 <= WS_WB, "alias overflow");
static_assert(WS_END <= 536870912, "workspace too large");
static_assert(WS_PRIV + (size_t)16 * 256 * 1024 * 2 <= WS_ACT, "tail scratch overflows BG");

constexpr int NTHREADS = 512;
constexpr int LDS_MAIN = 131072;
constexpr int LDS_BYTES = LDS_MAIN + 16;

struct Params {
    const float *x_prompt, *x_sample, *mem_prompt, *cache_k, *cache_v, *state_conv, *state_shift, *state_wkv, *norm_in, *w_in, *conv_w, *conv_b,
        *shift_mu, *decay_w0, *decay_up, *icl_a0, *icl_up, *k_k, *k_a, *r_k, *ln_g, *ln_b, *norm_mem, *w_mem_kv, *w_branch, *w_out, *norm_final;
    float* out;
    unsigned char* ws;
};

__device__ __forceinline__ int opaque_tid() { int t = threadIdx.x; asm volatile("" : "+v"(t)); return t; }
__device__ __forceinline__ float bf2f(bf16_t v) { return __uint_as_float(((unsigned)v) << 16); }
__device__ __forceinline__ unsigned cvt_pk_bf16(float lo, float hi) { unsigned r; asm volatile("v_cvt_pk_bf16_f32 %0, %1, %2" : "=v"(r) : "v"(lo), "v"(hi)); return r; }
__device__ __forceinline__ float bflo(unsigned u) { return __uint_as_float(u << 16); }
__device__ __forceinline__ float bfhi(unsigned u) { return __uint_as_float(u & 0xffff0000u); }
__device__ __forceinline__ float fast_rcp(float x) { return __builtin_amdgcn_rcpf(x); }
__device__ __forceinline__ float sigmoidf_(float x) { return fast_rcp(1.0f + __expf(-x)); }
__device__ __forceinline__ float siluf_(float x) { return x * sigmoidf_(x); }
__device__ __forceinline__ float wave_sum(float v) {
#pragma unroll
    for (int o = 32; o > 0; o >>= 1) v += __shfl_xor(v, o, 64);
    return v;
}
template <int CTRL> __device__ __forceinline__ float dpp_f(float x) {
    return __int_as_float(__builtin_amdgcn_update_dpp(0, __float_as_int(x), CTRL, 0xF, 0xF, true));
}
__device__ __forceinline__ float row16_sum(float x) {
    x += dpp_f<0xB1>(x);
    x += dpp_f<0x4E>(x);
    x += dpp_f<0x141>(x);
    x += dpp_f<0x140>(x);
    return x;
}


#define XB_TMO      128
#define XB_XCNT(j)  (256  + 64 * (j))
#define XB_XSUB(j)  (1280 + 64 * (j))
#define XB_XGEN(j)  (2304 + 64 * (j))
#define XB_TOP      3328
#define XB_TOPGEN   3392
#define XCD_BAR_WORDS 3456
#define XB_SPIN_CAP (1u << 22)
__device__ __forceinline__ unsigned xb_ld(unsigned* p)              { return __hip_atomic_load(p, __ATOMIC_RELAXED, __HIP_MEMORY_SCOPE_AGENT); }
__device__ __forceinline__ unsigned xb_add(unsigned* p, unsigned v) { return __hip_atomic_fetch_add(p, v, __ATOMIC_RELAXED, __HIP_MEMORY_SCOPE_AGENT); }
__device__ __forceinline__ unsigned xb_xcc_id() { return (unsigned)__builtin_amdgcn_s_getreg((3 << 11) | 20) & 0xFu; }
#define XB_SPIN(cond, bar) do { unsigned _sp = 0; while (cond) { __builtin_amdgcn_s_sleep(1); \
    if ((++_sp & 255u) == 0u) { if (xb_ld(&(bar)[XB_TMO])) break; if (_sp > XB_SPIN_CAP) { atomicAdd(&(bar)[XB_TMO], 1u); break; } } } } while (0)
struct XcdBarrier { unsigned* bar; unsigned x; volatile LAS unsigned* st; };
__device__ __forceinline__ XcdBarrier xcd_barrier_post(unsigned* bar, volatile LAS unsigned* st) {
    XcdBarrier b; b.bar = bar; b.x = xb_xcc_id(); b.st = st;
    if (threadIdx.x == 0) (void)xb_add(&bar[XB_XCNT(b.x)], 1u);
    return b;
}
__device__ __forceinline__ void xcd_barrier_complete(unsigned* bar, unsigned x, unsigned& nloc, unsigned& nx) {
    const unsigned G = gridDim.x * gridDim.y * gridDim.z;
    unsigned sum, cnt, mine, sp = 0u;
    for (;;) {
        sum = 0u; cnt = 0u; mine = 0u;
#pragma unroll
        for (unsigned j = 0; j < 16; ++j) { const unsigned c = xb_ld(&bar[XB_XCNT(j)]); sum += c; cnt += (c > 0u) ? 1u : 0u; mine = (j == x) ? c : mine; }
        if (sum == G) break;
        __builtin_amdgcn_s_sleep(1);
        if ((++sp & 255u) == 0u) { if (xb_ld(&bar[XB_TMO])) break; if (sp > XB_SPIN_CAP) { atomicAdd(&bar[XB_TMO], 1u); break; } }
    }
    nloc = mine > 0u ? mine : 1u; nx = cnt > 0u ? cnt : 1u;
}
__device__ __forceinline__ void xcd_barrier(const XcdBarrier& b) {
    asm volatile("s_waitcnt vmcnt(0)" ::: "memory");
    __syncthreads();
    if (threadIdx.x == 0) {
        unsigned* bar = b.bar;
        __builtin_amdgcn_s_waitcnt(0);
        unsigned nloc = b.st[0], nx = b.st[1];
        if (nloc == 0u) { xcd_barrier_complete(bar, b.x, nloc, nx); b.st[0] = nloc; b.st[1] = nx; }
        const unsigned old = xb_add(&bar[XB_XSUB(b.x)], 1u);
        const unsigned gen = old / nloc;
        if (old + 1u == (gen + 1u) * nloc) {
            __builtin_amdgcn_fence(__ATOMIC_RELEASE, "agent");
            asm volatile("s_waitcnt vmcnt(0)" ::: "memory");
            const unsigned og = xb_add(&bar[XB_TOP], 1u);
            const unsigned tg = og / nx;
            if (og + 1u == (tg + 1u) * nx) xb_add(&bar[XB_TOPGEN], 1u);
            else XB_SPIN(xb_ld(&bar[XB_TOPGEN]) == tg, bar);
            __builtin_amdgcn_fence(__ATOMIC_ACQUIRE, "agent");
            xb_add(&bar[XB_XGEN(b.x)], 1u);
            asm volatile("s_waitcnt vmcnt(0)" ::: "memory");
        } else {
            XB_SPIN(xb_ld(&bar[XB_XGEN(b.x)]) == gen, bar);
            __builtin_amdgcn_fence(__ATOMIC_ACQUIRE, "agent");
            asm volatile("s_waitcnt vmcnt(0)" ::: "memory");
        }
    }
    __syncthreads();
}

constexpr int BM = 256, BK = 64, HALF = 128, HTB = HALF * BK * 2;
__device__ __forceinline__ int lds_byte(int r, int c) { const int st = (r >> 4) * 2 + (c >> 5), rr = r & 15, cc = c & 31, ob = rr * 64 + cc * 2; return st * 1024 + (ob ^ (((ob >> 9) & 1) << 5)); }
__device__ __forceinline__ void stage_rc(int b, int& R, int& C) { const int st = b / 1024, sb = b % 1024, swz = sb ^ (((sb >> 9) & 1) << 5); R = (st >> 1) * 16 + swz / 64; C = (st & 1) * 32 + (swz % 64) / 2; }

struct Unit { const char* a; const char* b; int x, y, z; };

template <class Sched, class Epi>
__device__ __forceinline__ void gemm_phase(LAS unsigned char* lds, const int lda, const int ldb, const int K, const Sched& S, const Epi& E) {
    const int tid = opaque_tid(), wid = __builtin_amdgcn_readfirstlane(tid >> 6), lane = tid & 63, wr = wid >> 2, wc = wid & 3, fr = lane & 15, fq = lane >> 4;
    const int nt = K / BK;
    unsigned voffA[2], voffB[2];
#pragma unroll
    for (int i = 0; i < 2; ++i) { int R, C; stage_rc(tid * 16 + i * 8192, R, C); voffA[i] = (unsigned)(R * lda + C * 2); voffB[i] = (unsigned)(R * ldb + C * 2); }
    const size_t kstep = (size_t)(BK * 2);
    const size_t hA = (size_t)HALF * lda, hB = (size_t)HALF * ldb;
    const unsigned ldsw = (unsigned)wid * 1024u;
    const int aoff = lds_byte(wr * 64 + fr, fq * 8), boff = lds_byte(wc * 32 + fr, fq * 8);
#define G_SA(b, h) (((b) * 2 + (h)) * HTB)
#define G_SB(b, h) ((4 + (b) * 2 + (h)) * HTB)
#define G_STAGE(bufoff, gbase, voff) do { _Pragma("unroll") for (int _i = 0; _i < 2; ++_i) \
        __builtin_amdgcn_global_load_lds((const unsigned*)((const char*)(gbase) + (voff)[_i]), (LAS unsigned*)(lds + (bufoff) + ldsw + _i * 8192), 16, 0, 0); } while (0)
#define G_LDA(dst, b, h) do { _Pragma("unroll") for (int m = 0; m < 4; ++m) _Pragma("unroll") for (int k = 0; k < 2; ++k) dst[m][k] = *(const LAS bf16x8*)(lds + G_SA(b, h) + aoff + m * 2048 + k * 1024); } while (0)
#define G_LDB(dst, b, h) do { _Pragma("unroll") for (int n = 0; n < 2; ++n) _Pragma("unroll") for (int k = 0; k < 2; ++k) dst[n][k] = *(const LAS bf16x8*)(lds + G_SB(b, h) + boff + n * 2048 + k * 1024); } while (0)
#define G_MMA(ai, bj, At, Bt) do { __builtin_amdgcn_s_setprio(1); _Pragma("unroll") for (int m = 0; m < 4; ++m) _Pragma("unroll") for (int n = 0; n < 2; ++n) _Pragma("unroll") for (int k = 0; k < 2; ++k) \
        acc[ai][bj][m][n] = __builtin_amdgcn_mfma_f32_16x16x32_bf16(Bt[n][k], At[m][k], acc[ai][bj][m][n], 0, 0, 0); __builtin_amdgcn_s_setprio(0); } while (0)
#define G_WAIT_V(n) asm volatile("s_waitcnt vmcnt(" #n ")" ::: "memory")
#define G_WAIT_L(n) asm volatile("s_waitcnt lgkmcnt(" #n ")" ::: "memory")
#define G_BAR __builtin_amdgcn_s_barrier()
#define G_SCHED __builtin_amdgcn_sched_barrier(0)
    Unit cur, nxt; int ui = 0;
    if (!S.next(0, cur)) return;
    f32x4 acc[2][2][4][2];
#pragma unroll
    for (int a = 0; a < 2; ++a)
#pragma unroll
        for (int b = 0; b < 2; ++b)
#pragma unroll
            for (int m = 0; m < 4; ++m)
#pragma unroll
                for (int n = 0; n < 2; ++n) acc[a][b][m][n] = (f32x4){0.f, 0.f, 0.f, 0.f};
    bf16x8 At[4][2], B0[2][2], B1[2][2];
    const char* cA = cur.a; const char* cB = cur.b;
    G_STAGE(G_SB(0, 0), cB, voffB); G_STAGE(G_SA(0, 0), cA, voffA); G_STAGE(G_SB(0, 1), cB + hB, voffB); G_STAGE(G_SA(0, 1), cA + hA, voffA);
    if (wr == 1) G_BAR;
    G_WAIT_V(4); G_BAR;
    G_STAGE(G_SB(1, 0), cB + kstep, voffB); G_STAGE(G_SA(1, 0), cA + kstep, voffA); G_STAGE(G_SB(1, 1), cB + hB + kstep, voffB);
    G_WAIT_V(6); G_BAR;
    for (;;) {
        const bool has_next = S.next(ui + 1, nxt);
        const char* nA = has_next ? nxt.a : cA; const char* nB = has_next ? nxt.b : cB;
        for (int t = 0; t < nt; t += 2) {
            const bool last = (t == nt - 2);
            const char* a1 = cA + (size_t)(t + 1) * kstep;
            const char* a2 = last ? nA : cA + (size_t)(t + 2) * kstep; const char* b2 = last ? nB : cB + (size_t)(t + 2) * kstep;
            const char* a3 = a2 + kstep; const char* b3 = b2 + kstep;
            G_LDB(B0, 0, 0); G_SCHED; G_LDA(At, 0, 0); G_STAGE(G_SA(1, 1), a1 + hA, voffA);
            G_WAIT_L(8); G_BAR; G_WAIT_L(0); G_MMA(0, 0, At, B0); G_BAR; G_SCHED;
            G_LDB(B1, 0, 1); G_STAGE(G_SB(0, 0), b2, voffB);
            G_BAR; G_WAIT_L(0); G_MMA(0, 1, At, B1); G_BAR;
            G_LDA(At, 0, 1); G_STAGE(G_SA(0, 0), a2, voffA);
            G_BAR; G_WAIT_L(0); G_MMA(1, 0, At, B0); G_BAR; G_SCHED;
            G_STAGE(G_SB(0, 1), b2 + hB, voffB);
            G_WAIT_V(6); G_BAR; G_MMA(1, 1, At, B1); G_BAR;
            G_LDB(B0, 1, 0); G_SCHED; G_LDA(At, 1, 0); G_STAGE(G_SA(0, 1), a2 + hA, voffA);
            G_WAIT_L(8); G_BAR; G_WAIT_L(0); G_MMA(0, 0, At, B0); G_BAR; G_SCHED;
            G_LDB(B1, 1, 1); G_STAGE(G_SB(1, 0), b3, voffB);
            G_BAR; G_WAIT_L(0); G_MMA(0, 1, At, B1); G_BAR;
            G_LDA(At, 1, 1); G_STAGE(G_SA(1, 0), a3, voffA);
            G_BAR; G_WAIT_L(0); G_MMA(1, 0, At, B0); G_BAR; G_SCHED;
            G_STAGE(G_SB(1, 1), b3 + hB, voffB);
            G_WAIT_V(6); G_BAR; G_MMA(1, 1, At, B1); G_BAR;
        }
        const bool keep = E(acc, cur, wr, wc, fr, fq);
        if (!has_next) break;
        if (!keep) {
#pragma unroll
            for (int a = 0; a < 2; ++a)
#pragma unroll
                for (int b = 0; b < 2; ++b)
#pragma unroll
                    for (int m = 0; m < 4; ++m)
#pragma unroll
                        for (int n = 0; n < 2; ++n) acc[a][b][m][n] = (f32x4){0.f, 0.f, 0.f, 0.f};
        }
        cur = nxt; cA = nA; cB = nB; ++ui;
    }
    G_WAIT_V(0);
    if (wr == 0) G_BAR;
    G_BAR;
#undef G_SA
#undef G_SB
#undef G_STAGE
#undef G_LDA
#undef G_LDB
#undef G_MMA
#undef G_WAIT_V
#undef G_WAIT_L
#undef G_BAR
#undef G_SCHED
}

__device__ __forceinline__ int perm8_local(int c) {
    const int bj = c >> 7, wc = (c >> 5) & 3, n = (c >> 4) & 1, fq = (c >> 2) & 3, e = c & 3;
    return 128 * bj + 32 * wc + 8 * fq + 4 * n + e;
}
__device__ __forceinline__ int colmap_in(int np) {
    const int j = np >> 8, c = np & 255;
    if (j < 16) {
        const int bj = c >> 7, wc = (c >> 5) & 3, n = (c >> 4) & 1, fq = (c >> 2) & 3, e = c & 3;
        return (2 * bj + n) * 1024 + j * 64 + wc * 16 + fq * 4 + e;
    }
    const int L = (j - 16) * 256 + perm8_local(c);
    if (L < 3200) return 4096 + L;
    if (L < 3328) return -1;
    return L + 3968;
}

__device__ void phase0(const Params& p, unsigned char* smem) {
    const int tid = opaque_tid(), lane = tid & 63, wid = tid >> 6;
    bf16_t* Aall = (bf16_t*)(p.ws + WS_AALL);
    for (int row = blockIdx.x * 8 + wid; row < 19456; row += gridDim.x * 8) {
        const float* src; const float* g;
        if (row < MP) { src = p.x_prompt + (size_t)row * 1024; g = p.norm_in; }
        else if (row < MALL) { src = p.x_sample + (size_t)(row - MP) * 1024; g = p.norm_in; }
        else { src = p.mem_prompt + (size_t)(row - MALL) * 1024; g = p.norm_mem; }
        f32x4 v[4]; float ss = 0.f;
#pragma unroll
        for (int i = 0; i < 4; ++i) { v[i] = *(const f32x4*)(src + i * 256 + lane * 4); ss += v[i][0] * v[i][0] + v[i][1] * v[i][1] + v[i][2] * v[i][2] + v[i][3] * v[i][3]; }
        ss = wave_sum(ss);
        const float inv = rsqrtf(ss * (1.0f / 1024.0f) + 1e-6f);
#pragma unroll
        for (int i = 0; i < 4; ++i) {
            const f32x4 gg = *(const f32x4*)(g + i * 256 + lane * 4);
            u32x2 o; o[0] = cvt_pk_bf16(v[i][0] * inv * gg[0], v[i][1] * inv * gg[1]); o[1] = cvt_pk_bf16(v[i][2] * inv * gg[2], v[i][3] * inv * gg[3]);
            *(u32x2*)(Aall + (size_t)row * 1024 + i * 256 + lane * 4) = o;
        }
    }
    for (int idx = blockIdx.x * NTHREADS + tid; idx < 16 * 2 * 8 * 64; idx += gridDim.x * NTHREADS) {
        const int ln = idx & 63, f = (idx >> 6) & 7, mat = (idx >> 9) & 1, hh = idx >> 10;
        const int it = f >> 1, ks = f & 1, fr = ln & 15, fq = ln >> 4;
        const float* src = mat ? p.icl_up : p.decay_up;
        float w[8];
#pragma unroll
        for (int jj = 0; jj < 8; ++jj) w[jj] = src[(size_t)(ks * 32 + fq * 8 + jj) * 1024 + hh * 64 + it * 16 + fr];
        u32x4 pk; pk[0] = cvt_pk_bf16(w[0], w[1]); pk[1] = cvt_pk_bf16(w[2], w[3]); pk[2] = cvt_pk_bf16(w[4], w[5]); pk[3] = cvt_pk_bf16(w[6], w[7]);
        *(u32x4*)(p.ws + WS_FRAG + (size_t)idx * 16) = pk;
    }
    bf16_t* T = (bf16_t*)smem;
    const int NT_IN = 212 * 16, NT_KV = 32 * 16, NT_WB = 3 * 16 * 16, NT_WO = 16 * 16;
    const int total = NT_IN + NT_KV + NT_WB + NT_WO;
    for (int tix = blockIdx.x; tix < total; tix += gridDim.x) {
        const float* src; int src_ld; bf16_t* dst; int n0, k0, mode;
        if (tix < NT_IN) { src = p.w_in; src_ld = DIN; dst = (bf16_t*)(p.ws + WS_BALL); n0 = (tix >> 4) * 64; k0 = (tix & 15) * 64; mode = 0; }
        else if (tix < NT_IN + NT_KV) { const int t2 = tix - NT_IN; src = p.w_mem_kv; src_ld = 2048; dst = (bf16_t*)(p.ws + WS_BALL) + (size_t)NPAD * 1024; n0 = (t2 >> 4) * 64; k0 = (t2 & 15) * 64; mode = 1; }
        else if (tix < NT_IN + NT_KV + NT_WB) { const int t2 = tix - NT_IN - NT_KV; const int i = t2 >> 8, t3 = t2 & 255; src = p.w_branch + (size_t)i * 1024 * 1024; src_ld = 1024;
            dst = (bf16_t*)(p.ws + WS_WB) + (size_t)i * 1024 * 1024; n0 = (t3 >> 4) * 64; k0 = (t3 & 15) * 64; mode = 2; }
        else { const int t3 = tix - NT_IN - NT_KV - NT_WB; src = p.w_out; src_ld = 1024; dst = (bf16_t*)(p.ws + WS_WO); n0 = (t3 >> 4) * 64; k0 = (t3 & 15) * 64; mode = 2; }
        {
            const int kk = tid >> 3, seg = tid & 7;
#pragma unroll
            for (int q = 0; q < 2; ++q) {
                const int nl = seg * 8 + q * 4, np = n0 + nl;
                int sc;
                if (mode == 0) sc = colmap_in(np);
                else if (mode == 1) sc = np;
                else sc = (np & ~255) + perm8_local(np & 255);
                f32x4 v = (f32x4){0.f, 0.f, 0.f, 0.f};
                if (sc >= 0) v = *(const f32x4*)(src + (size_t)(k0 + kk) * src_ld + sc);
                const unsigned a = cvt_pk_bf16(v[0], v[1]), b = cvt_pk_bf16(v[2], v[3]);
                T[(nl + 0) * 66 + kk] = (bf16_t)(a & 0xffff); T[(nl + 1) * 66 + kk] = (bf16_t)(a >> 16);
                T[(nl + 2) * 66 + kk] = (bf16_t)(b & 0xffff); T[(nl + 3) * 66 + kk] = (bf16_t)(b >> 16);
            }
        }
        __syncthreads();
        {
            const int nl = tid >> 3, ks = tid & 7;
            const unsigned* tp = (const unsigned*)(T + nl * 66 + ks * 8);
            u32x4 v; v[0] = tp[0]; v[1] = tp[1]; v[2] = tp[2]; v[3] = tp[3];
            *(u32x4*)(dst + (size_t)(n0 + nl) * 1024 + k0 + ks * 8) = v;
        }
        __syncthreads();
    }
}

struct SchedP1 {
    int G, c; const char* Aall; const char* Ball;
    __device__ __forceinline__ bool next(int i, Unit& u) const {
        const int L = i * G + c;
        constexpr int nM = 68, nN = 53, nwg = nM * nN, WGM = 8;
        if (L >= nwg + 96) return false;
        if (L < nwg) {
            int wgid = L; { const int q = nwg / 8, r = nwg % 8, xcd = wgid % 8, off = wgid / 8; wgid = (xcd < r ? xcd * (q + 1) : r * (q + 1) + (xcd - r) * q) + off; }
            const int nig = WGM * nN, gid = wgid / nig, fm = gid * WGM, gsz = (nM - fm) < WGM ? (nM - fm) : WGM;
            u.x = fm + ((wgid % nig) % gsz); u.y = (wgid % nig) / gsz; u.z = 0;
            u.a = Aall + (size_t)u.x * 256 * 2048; u.b = Ball + (size_t)u.y * 256 * 2048;
        } else {
            int k = L - nwg;
            if (k < 32) { u.x = k >> 2; u.y = k & 3; u.z = 1; u.a = Aall + (size_t)(68 + u.x) * 256 * 2048; u.b = Ball + (size_t)(53 + u.y) * 256 * 2048; }
            else if (k < 64) { k -= 32; u.x = k >> 2; u.y = k & 3; u.z = 2; u.a = Aall + (size_t)(68 + u.x) * 256 * 2048; u.b = Ball + (size_t)(57 + u.y) * 256 * 2048; }
            else { k -= 64; u.x = k >> 3; u.y = k & 7; u.z = 3; u.a = Ball + (size_t)(57 + u.x) * 256 * 2048; u.b = Aall + (size_t)(68 + u.y) * 256 * 2048; }
        }
        return true;
    }
};

struct EpiNull { __device__ __forceinline__ bool operator()(f32x4 (&acc)[2][2][4][2], const Unit& u, int wr, int wc, int fr, int fq) const { float t = 0.f;
#pragma unroll
        for (int a = 0; a < 2; ++a)
#pragma unroll
            for (int b = 0; b < 2; ++b)
#pragma unroll
                for (int m = 0; m < 4; ++m)
#pragma unroll
                    for (int n = 0; n < 2; ++n) t += acc[a][b][m][n][0] + acc[a][b][m][n][1] + acc[a][b][m][n][2] + acc[a][b][m][n][3];
        if (t == 123.456f) sink[0] = t; return false; }
    float* sink; };
struct EpiP1 {
    bf16_t* U; bf16_t* BG; bf16_t* ACT; float* out; bf16_t* Kbf; bf16_t* Vt;
    __device__ __forceinline__ bool operator()(f32x4 (&acc)[2][2][4][2], const Unit& u, int wr, int wc, int fr, int fq) const {
        const int type = u.z;
        if (type == 0) {
            const int pn = u.y, rbase = u.x * 256 + wr * 64 + fr;
            if (pn < 16) {
                const int ch0 = pn * 64 + wc * 16 + fq * 4;
#pragma unroll
                for (int ai = 0; ai < 2; ++ai)
#pragma unroll
                    for (int m = 0; m < 4; ++m) {
                        const int row = rbase + ai * 128 + m * 16;
                        const f32x4 h = acc[ai][0][m][0], Bv = acc[ai][0][m][1], Cv = acc[ai][1][m][0], g = acc[ai][1][m][1];
                        const f32x4 u4 = Cv * h;
                        f32x4 bg;
#pragma unroll
                        for (int e = 0; e < 4; ++e) bg[e] = Bv[e] * siluf_(g[e]);
                        u32x2 o; o[0] = cvt_pk_bf16(u4[0], u4[1]); o[1] = cvt_pk_bf16(u4[2], u4[3]);
                        *(u32x2*)(U + (size_t)row * 1024 + ch0) = o;
                        o[0] = cvt_pk_bf16(bg[0], bg[1]); o[1] = cvt_pk_bf16(bg[2], bg[3]);
                        *(u32x2*)(BG + (size_t)row * 1024 + ch0) = o;
                        if (row < MP) { const int t = row & 2047; if (t >= 2046) *(f32x4*)(out + OUT_CONV_P + (size_t)((row >> 11) * 2 + (t - 2046)) * 1024 + ch0) = u4; }
                        else { const int rs = row - MP, t = rs & 7; if (t >= 6) *(f32x4*)(out + OUT_CONV_S + (size_t)((rs >> 3) * 2 + (t - 6)) * 1024 + ch0) = u4; }
                    }
            } else {
                const int L0 = (pn - 16) * 256;
                const int kind = pn <= 28 ? 0 : pn <= 32 ? 1 : pn <= 36 ? 2 : pn <= 40 ? 1 : 3;
#pragma unroll
                for (int ai = 0; ai < 2; ++ai)
#pragma unroll
                    for (int m = 0; m < 4; ++m) {
                        const int row = rbase + ai * 128 + m * 16;
#pragma unroll
                        for (int bj = 0; bj < 2; ++bj) {
                            const int L = L0 + 128 * bj + 32 * wc + 8 * fq;
                            f32x4 v0 = acc[ai][bj][m][0], v1 = acc[ai][bj][m][1];
                            if (kind == 0) {
                                if (L < DSHIFT) {
                                    if (row < MP) { if ((row & 2047) == 2047) { float* d = out + OUT_SHIFT_P + (size_t)(row >> 11) * DSHIFT + L; *(f32x4*)d = v0; *(f32x4*)(d + 4) = v1; } }
                                    else { const int rs = row - MP; if ((rs & 7) == 7) { float* d = out + OUT_SHIFT_S + (size_t)(rs >> 3) * DSHIFT + L; *(f32x4*)d = v0; *(f32x4*)(d + 4) = v1; } }
                                }
                            } else if (kind == 1) {
#pragma unroll
                                for (int e = 0; e < 4; ++e) { v0[e] = siluf_(v0[e]); v1[e] = siluf_(v1[e]); }
                            } else if (kind == 2) { v0 *= 0.0625f; v1 *= 0.0625f; }
                            else {
#pragma unroll
                                for (int e = 0; e < 4; ++e) { v0[e] = sigmoidf_(v0[e]); v1[e] = sigmoidf_(v1[e]); }
                            }
                            u32x4 o; o[0] = cvt_pk_bf16(v0[0], v0[1]); o[1] = cvt_pk_bf16(v0[2], v0[3]); o[2] = cvt_pk_bf16(v1[0], v1[1]); o[3] = cvt_pk_bf16(v1[2], v1[3]);
                            if (kind != 0 || L < DSHIFT) *(u32x4*)(ACT + (size_t)row * ACT_LD + L) = o;
                        }
                    }
            }
        } else {
            const int rbase = u.x * 256 + wr * 64 + fr, cbase = u.y * 256 + wc * 32 + fq * 4;
#pragma unroll
            for (int ai = 0; ai < 2; ++ai)
#pragma unroll
                for (int m = 0; m < 4; ++m) {
                    const int row = rbase + ai * 128 + m * 16;
#pragma unroll
                    for (int bj = 0; bj < 2; ++bj)
#pragma unroll
                        for (int n = 0; n < 2; ++n) {
                            const int col = cbase + bj * 128 + n * 16;
                            const f32x4 v = acc[ai][bj][m][n];
                            if (type == 1) { *(f32x4*)(out + OUT_MK + (size_t)row * 1024 + col) = v;
                                u32x2 o; o[0] = cvt_pk_bf16(v[0], v[1]); o[1] = cvt_pk_bf16(v[2], v[3]); *(u32x2*)(Kbf + (size_t)row * 1024 + col) = o; }
                            else if (type == 2) { *(f32x4*)(out + OUT_MV + (size_t)row * 1024 + col) = v; }
                            else { u32x2 o; o[0] = cvt_pk_bf16(v[0], v[1]); o[1] = cvt_pk_bf16(v[2], v[3]); *(u32x2*)(Vt + (size_t)row * 2048 + col) = o; }
                        }
                }
        }
        return false;
    }
};

struct ChunkDesc { int r0, b, h, half, samp, t0, n, first, last, bstep; };
__device__ __forceinline__ int n_chunks(const int bid, const int G) {
    const int n_long = bid < 256 ? (255 - bid) / G + 1 : 0, n_samp = bid < 4096 ? (4095 - bid) / G + 1 : 0;
    return n_long * 64 + ((n_samp + 3) >> 2);
}
__device__ __forceinline__ bool chunk_desc(const int ci, const int bid, const int G, ChunkDesc& d) {
    const int n_long = bid < 256 ? (255 - bid) / G + 1 : 0;
    const int n_samp = bid < 4096 ? (4095 - bid) / G + 1 : 0;
    const int nc_long = n_long * 64;
    if (ci < nc_long) { const int k = ci >> 6, it = bid + k * G, chain = it >> 1; d.b = chain >> 4; d.h = chain & 15; d.half = it & 1; d.samp = 0; d.r0 = d.b * TP; d.bstep = 0;
        d.t0 = (ci & 63) * 32; d.n = 32; d.first = (ci & 63) == 0; d.last = (ci & 63) == 63; return true; }
    const int k0 = (ci - nc_long) * 4; if (ci < 0 || k0 >= n_samp) return false;
    const int it = bid + k0 * G, chain = it >> 1; d.b = chain >> 4; d.h = chain & 15; d.half = it & 1; d.samp = 1; d.r0 = 0; d.t0 = 0; d.bstep = G >> 5;
    const int ni = n_samp - k0 < 4 ? n_samp - k0 : 4; d.n = ni * 8; d.first = 1; d.last = 1; return true;
}
__device__ __forceinline__ int cd_batch(const ChunkDesc& d, const int t) { return d.samp ? d.b + (t >> 3) * d.bstep : d.b; }
__device__ __forceinline__ int cd_row(const ChunkDesc& d, const int t) { return d.samp ? MP + (d.b + (t >> 3) * d.bstep) * 8 + (t & 7) : d.r0 + d.t0 + t; }
__device__ __forceinline__ bool cd_first(const ChunkDesc& d, const int t) { return d.samp ? (t & 7) == 0 : (d.t0 + t) == 0; }
constexpr int SROW = 68;
constexpr int SBUF = 6 * 32 * SROW + 64;
__device__ __forceinline__ f32x2 lo2(const f32x4 v) { return __builtin_shufflevector(v, v, 0, 1); }
__device__ __forceinline__ f32x2 hi2(const f32x4 v) { return __builtin_shufflevector(v, v, 2, 3); }
__device__ __forceinline__ float tanh_fast(float x) { return 1.0f - 2.0f * fast_rcp(1.0f + __expf(2.0f * x)); }

__device__ __forceinline__ void unpack4(const u32x2 v, float (&o)[4]) { o[0] = bflo(v[0]); o[1] = bfhi(v[0]); o[2] = bflo(v[1]); o[3] = bfhi(v[1]); }

struct OpSet { f32x4 kk, wr, w, b, k; f32x2 v, cc; };
__device__ __forceinline__ void reduce4_row16(float a0, float a1, float b0, float b1, float c0, float c1, float d0, float d1, float& A, float& B, float& C, float& D) {
    asm volatile(
        "v_add_f32 %0, %4, %5\n\tv_add_f32 %1, %6, %7\n\tv_add_f32 %2, %8, %9\n\tv_add_f32 %3, %10, %11\n\t"
        "v_add_f32_dpp %0, %0, %0 quad_perm:[1,0,3,2] row_mask:0xf bank_mask:0xf\n\tv_add_f32_dpp %1, %1, %1 quad_perm:[1,0,3,2] row_mask:0xf bank_mask:0xf\n\t"
        "v_add_f32_dpp %2, %2, %2 quad_perm:[1,0,3,2] row_mask:0xf bank_mask:0xf\n\tv_add_f32_dpp %3, %3, %3 quad_perm:[1,0,3,2] row_mask:0xf bank_mask:0xf\n\t"
        "v_add_f32_dpp %0, %0, %0 quad_perm:[2,3,0,1] row_mask:0xf bank_mask:0xf\n\tv_add_f32_dpp %1, %1, %1 quad_perm:[2,3,0,1] row_mask:0xf bank_mask:0xf\n\t"
        "v_add_f32_dpp %2, %2, %2 quad_perm:[2,3,0,1] row_mask:0xf bank_mask:0xf\n\tv_add_f32_dpp %3, %3, %3 quad_perm:[2,3,0,1] row_mask:0xf bank_mask:0xf\n\t"
        "v_add_f32_dpp %0, %0, %0 row_half_mirror row_mask:0xf bank_mask:0xf\n\tv_add_f32_dpp %1, %1, %1 row_half_mirror row_mask:0xf bank_mask:0xf\n\t"
        "v_add_f32_dpp %2, %2, %2 row_half_mirror row_mask:0xf bank_mask:0xf\n\tv_add_f32_dpp %3, %3, %3 row_half_mirror row_mask:0xf bank_mask:0xf\n\t"
        "v_add_f32_dpp %0, %0, %0 row_mirror row_mask:0xf bank_mask:0xf\n\tv_add_f32_dpp %1, %1, %1 row_mirror row_mask:0xf bank_mask:0xf\n\t"
        "v_add_f32_dpp %2, %2, %2 row_mirror row_mask:0xf bank_mask:0xf\n\tv_add_f32_dpp %3, %3, %3 row_mirror row_mask:0xf bank_mask:0xf\n\t"
        "s_nop 1"
        : "=&v"(A), "=&v"(B), "=&v"(C), "=&v"(D)
        : "v"(a0), "v"(a1), "v"(b0), "v"(b1), "v"(c0), "v"(c1), "v"(d0), "v"(d1));
}
struct PrepState { f32x4 aw[4], aa[4]; float ksf[16]; float rn; };

struct PrepRaw { u32x4 wdc[2], wdp[2], adc[2], adp[2]; u32x2 kc[4], kp[4]; };
struct PrepRaw2 { u32x2 rc[4], rp[4], vc[4], vp[4]; };
__device__ __forceinline__ void prep_load(const Params& p, const ChunkDesc& d, const int tb, const int lane, PrepRaw& R) {
    const int fr = lane & 15, fq = lane >> 4;
    const int t = tb + fr; const int tt = t < d.n ? t : d.n - 1;
    const size_t row = (size_t)cd_row(d, tt);
    const bool isfirst = cd_first(d, tt);
    const bf16_t* cur = (const bf16_t*)(p.ws + WS_ACT) + row * ACT_LD;
    const bf16_t* prv = isfirst ? cur : cur - ACT_LD;
    const int hc = d.h * 64 + 4 * fq;
#pragma unroll
    for (int ks = 0; ks < 2; ++ks) {
        R.wdc[ks] = *(const u32x4*)(cur + C_WD + ks * 32 + fq * 8); R.wdp[ks] = *(const u32x4*)(prv + C_WD + ks * 32 + fq * 8);
        R.adc[ks] = *(const u32x4*)(cur + C_AD + ks * 32 + fq * 8); R.adp[ks] = *(const u32x4*)(prv + C_AD + ks * 32 + fq * 8);
    }
#pragma unroll
    for (int it = 0; it < 4; ++it) { R.kc[it] = *(const u32x2*)(cur + C_PK + hc + it * 16); R.kp[it] = *(const u32x2*)(prv + C_PK + hc + it * 16); }
}
__device__ __forceinline__ void prep_load2(const Params& p, const ChunkDesc& d, const int tb, const int lane, PrepRaw2& R) {
    const int fr = lane & 15, fq = lane >> 4;
    const int t = tb + fr; const int tt = t < d.n ? t : d.n - 1;
    const size_t row = (size_t)cd_row(d, tt);
    const bool isfirst = cd_first(d, tt);
    const bf16_t* cur = (const bf16_t*)(p.ws + WS_ACT) + row * ACT_LD;
    const bf16_t* prv = isfirst ? cur : cur - ACT_LD;
    const int hc = d.h * 64 + 4 * fq;
#pragma unroll
    for (int it = 0; it < 4; ++it) {
        R.rc[it] = *(const u32x2*)(cur + C_PR + hc + it * 16); R.rp[it] = *(const u32x2*)(prv + C_PR + hc + it * 16);
        R.vc[it] = *(const u32x2*)(cur + C_PV + hc + it * 16); R.vp[it] = *(const u32x2*)(prv + C_PV + hc + it * 16);
    }
}
__device__ __forceinline__ void shift4(const u32x2 cu, const u32x2 pr, const float* st, const bool isfirst, const bool samp, const int col, const f32x4 mu, float (&o)[4]) {
    float c[4], q[4];
    unpack4(cu, c); unpack4(pr, q);
    if (isfirst) {
        if (samp) { const f32x4 v = *(const f32x4*)(st + col); q[0] = v[0]; q[1] = v[1]; q[2] = v[2]; q[3] = v[3]; }
        else { q[0] = 0.f; q[1] = 0.f; q[2] = 0.f; q[3] = 0.f; }
    }
#pragma unroll
    for (int e = 0; e < 4; ++e) o[e] = c[e] + mu[e] * (q[e] - c[e]);
}

__device__ __forceinline__ void prep_stage1(const Params& p, const ChunkDesc& d, const int tb, const float* par, const int lane, const PrepRaw& R, PrepState& S) {
    const int fr = lane & 15, fq = lane >> 4;
    const int t = tb + fr; const int tt = t < d.n ? t : d.n - 1;
    const bool isfirst = cd_first(d, tt), samp = d.samp != 0;
    const float* st = p.state_shift + (size_t)cd_batch(d, tt) * DSHIFT;
    bf16x8 bw[2], ba[2];
#pragma unroll
    for (int ks = 0; ks < 2; ++ks) {
#pragma unroll
        for (int which = 0; which < 2; ++which) {
            const int col = (which ? C_AD : C_WD) + ks * 32 + fq * 8;
            const u32x4 cu = which ? R.adc[ks] : R.wdc[ks], pr = which ? R.adp[ks] : R.wdp[ks];
            float x0[4], x1[4];
            shift4((u32x2){cu[0], cu[1]}, (u32x2){pr[0], pr[1]}, st, isfirst, samp, col, *(const f32x4*)(par + 512 + which * 64 + ks * 32 + fq * 8), x0);
            shift4((u32x2){cu[2], cu[3]}, (u32x2){pr[2], pr[3]}, st, isfirst, samp, col + 4, *(const f32x4*)(par + 512 + which * 64 + ks * 32 + fq * 8 + 4), x1);
            if (!which) {
#pragma unroll
                for (int e = 0; e < 4; ++e) { x0[e] = tanh_fast(x0[e]); x1[e] = tanh_fast(x1[e]); }
            }
            u32x4 pk; pk[0] = cvt_pk_bf16(x0[0], x0[1]); pk[1] = cvt_pk_bf16(x0[2], x0[3]); pk[2] = cvt_pk_bf16(x1[0], x1[1]); pk[3] = cvt_pk_bf16(x1[2], x1[3]);
            if (which) ba[ks] = __builtin_bit_cast(bf16x8, pk); else bw[ks] = __builtin_bit_cast(bf16x8, pk);
        }
    }
    const bf16x8* ft = (const bf16x8*)(p.ws + WS_FRAG) + (size_t)d.h * 1024 + lane;
    __builtin_amdgcn_sched_barrier(0);
#pragma unroll
    for (int it = 0; it < 4; ++it) {
        S.aw[it] = (f32x4){0.f, 0.f, 0.f, 0.f}; S.aa[it] = S.aw[it];
#pragma unroll
        for (int ks = 0; ks < 2; ++ks) {
            S.aw[it] = __builtin_amdgcn_mfma_f32_16x16x32_bf16(ft[(it * 2 + ks) * 64], bw[ks], S.aw[it], 0, 0, 0);
            S.aa[it] = __builtin_amdgcn_mfma_f32_16x16x32_bf16(ft[(8 + it * 2 + ks) * 64], ba[ks], S.aa[it], 0, 0, 0);
        }
        if (it & 1) __builtin_amdgcn_sched_barrier(0);
    }
    const int hc = d.h * 64 + 4 * fq;
    float ss = 0.f;
#pragma unroll
    for (int it = 0; it < 4; ++it) {
        const int po = it * 16 + 4 * fq;
        float k4[4];
        shift4(R.kc[it], R.kp[it], st, isfirst, samp, C_PK + hc + it * 16, *(const f32x4*)(par + 64 + po), k4);
        const f32x4 kkp = *(const f32x4*)(par + 5 * 64 + po);
#pragma unroll
        for (int e = 0; e < 4; ++e) { S.ksf[it * 4 + e] = k4[e]; const float kr = k4[e] * kkp[e]; ss += kr * kr; }
        __builtin_amdgcn_sched_barrier(0);
    }
    ss += __shfl_xor(ss, 16, 64); ss += __shfl_xor(ss, 32, 64);
    S.rn = rsqrtf(ss + 1e-12f);
}

__device__ __forceinline__ void prep_stage2(const Params& p, const ChunkDesc& d, const int tb, float* buf, const float* par, const int lane, const PrepRaw2& R, const PrepState& S) {
    const int fr = lane & 15, fq = lane >> 4;
    const int t = tb + fr; const bool valid = t < d.n; const int tt = valid ? t : d.n - 1;
    const bool isfirst = cd_first(d, tt), samp = d.samp != 0;
    const float* st = p.state_shift + (size_t)cd_batch(d, tt) * DSHIFT;
    const int hc = d.h * 64 + 4 * fq;
    float c1 = 0.f, c2 = 0.f, c3 = 0.f;
    float* kkA = buf; float* wrA = buf + 32 * SROW; float* wA = buf + 2 * 32 * SROW; float* bA = buf + 3 * 32 * SROW; float* kpA = buf + 4 * 32 * SROW; float* vsA = buf + 5 * 32 * SROW; float* c12 = buf + 6 * 32 * SROW;
#pragma unroll
    for (int it = 0; it < 4; ++it) {
        const int po = it * 16 + 4 * fq;
        const f32x4 w0 = *(const f32x4*)(par + 3 * 64 + po), a0 = *(const f32x4*)(par + 4 * 64 + po), kkp = *(const f32x4*)(par + 5 * 64 + po), ka = *(const f32x4*)(par + 6 * 64 + po), rk = *(const f32x4*)(par + 7 * 64 + po);
        f32x4 o_kk, o_wr, o_w, o_b, o_kp, o_vs;
        float r4[4], v4[4];
        shift4(R.rc[it], R.rp[it], st, isfirst, samp, C_PR + hc + it * 16, *(const f32x4*)(par + po), r4);
        shift4(R.vc[it], R.vp[it], st, isfirst, samp, C_PV + hc + it * 16, *(const f32x4*)(par + 128 + po), v4);
#pragma unroll
        for (int e = 0; e < 4; ++e) {
            const float r_ = r4[e], k_ = S.ksf[it * 4 + e];
            const float dec = __expf(-0.6065306597f * sigmoidf_(S.aw[it][e] + w0[e]));
            const float a = sigmoidf_(S.aa[it][e] + a0[e]);
            const float kn = k_ * kkp[e] * S.rn;
            const float kpv = k_ * (1.0f + (a - 1.0f) * ka[e]);
            const float bv = kn * a;
            c1 += bv * r_; c2 += kpv * r_; c3 += r_ * kpv * rk[e];
            o_kk[e] = kn; o_wr[e] = dec * r_; o_w[e] = dec; o_b[e] = bv; o_kp[e] = kpv; o_vs[e] = v4[e];
        }
        if (valid) {
            const int o = t * SROW + po;
            *(f32x4*)(kkA + o) = o_kk; *(f32x4*)(wrA + o) = o_wr; *(f32x4*)(wA + o) = o_w; *(f32x4*)(bA + o) = o_b; *(f32x4*)(kpA + o) = o_kp; *(f32x4*)(vsA + o) = o_vs;
        }
        __builtin_amdgcn_sched_barrier(0);
    }
    c1 += __shfl_xor(c1, 16, 64); c1 += __shfl_xor(c1, 32, 64);
    c2 += __shfl_xor(c2, 16, 64); c2 += __shfl_xor(c2, 32, 64);
    c3 += __shfl_xor(c3, 16, 64); c3 += __shfl_xor(c3, 32, 64);
    if (valid && fq == 0) { c12[t * 2] = c1; c12[t * 2 + 1] = c2; if (d.half == 0) ((float*)(p.ws + WS_C3))[(size_t)cd_row(d, t) * 16 + d.h] = c3; }
}

__device__ void phase2_scan(const Params& p, unsigned char* smem) {
    const int tid = opaque_tid(), lane = tid & 63, wid = __builtin_amdgcn_readfirstlane(tid >> 6);
    const int bid = blockIdx.x, G = gridDim.x;
    float* sm = (float*)smem;
    float* bufs = sm;
    float* obuf = sm + 2 * SBUF;
    float* parb = obuf + 2 * 1024;
    const int NC = n_chunks(bid, G);
    bf16_t* ORAW = (bf16_t*)(p.out + OUT_Y);
    __syncthreads();
    if (NC == 0) return;
    if (wid < 4) {
        __builtin_amdgcn_s_setprio(3);
        const int c = lane & 15, rg = lane >> 4, rl = wid * 8 + rg * 2;
        f32x2 s00 = (f32x2){0.f, 0.f}, s01 = s00, s10 = s00, s11 = s00;
        __syncthreads();
        __syncthreads();
        for (int ci = 0; ci < NC; ++ci) {
            ChunkDesc d; chunk_desc(ci, bid, G, d);
            const float* buf = bufs + (ci & 1) * SBUF;
            const float* kkA = buf + 4 * c; const float* vsA = buf + 5 * 32 * SROW + d.half * 32 + rl; const float* c12 = buf + 6 * 32 * SROW;
            float* ob = obuf + (ci & 1) * 1024 + rl;
            const int nsub = d.samp ? (d.n >> 3) : 1;
            OpSet A, B;
            auto ld = [&](OpSet& o, const int t) {
                o.kk = *(const f32x4*)(kkA + t * SROW); o.wr = *(const f32x4*)(kkA + 32 * SROW + t * SROW); o.w = *(const f32x4*)(kkA + 2 * 32 * SROW + t * SROW);
                o.b = *(const f32x4*)(kkA + 3 * 32 * SROW + t * SROW); o.k = *(const f32x4*)(kkA + 4 * 32 * SROW + t * SROW);
                o.v = *(const f32x2*)(vsA + t * SROW); o.cc = *(const f32x2*)(c12 + t * 2);
            };
            auto step = [&](const OpSet& o, const int t) {
                const f32x2 pd0 = s00 * lo2(o.kk) + s01 * hi2(o.kk), pd1 = s10 * lo2(o.kk) + s11 * hi2(o.kk);
                const f32x2 pe0 = s00 * lo2(o.wr) + s01 * hi2(o.wr), pe1 = s10 * lo2(o.wr) + s11 * hi2(o.wr);
                float d0, d1, e0, e1;
                reduce4_row16(pd0[0], pd0[1], pd1[0], pd1[1], pe0[0], pe0[1], pe1[0], pe1[1], d0, d1, e0, e1);
                const f32x2 vv0 = (f32x2){o.v[0], o.v[0]}, vv1 = (f32x2){o.v[1], o.v[1]}, dd0 = (f32x2){d0, d0}, dd1 = (f32x2){d1, d1};
                s00 = s00 * lo2(o.w) + (lo2(o.k) * vv0 - lo2(o.b) * dd0);
                s01 = s01 * hi2(o.w) + (hi2(o.k) * vv0 - hi2(o.b) * dd0);
                s10 = s10 * lo2(o.w) + (lo2(o.k) * vv1 - lo2(o.b) * dd1);
                s11 = s11 * hi2(o.w) + (hi2(o.k) * vv1 - hi2(o.b) * dd1);
                if (c == 0) { f32x2 ov; ov[0] = e0 - d0 * o.cc[0] + o.v[0] * o.cc[1]; ov[1] = e1 - d1 * o.cc[0] + o.v[1] * o.cc[1]; *(f32x2*)(ob + t * 32) = ov; }
            };
            auto run = [&](const int tbeg, const int tend) {
                ld(A, tbeg);
                for (int t = tbeg; t < tend; t += 2) {
                    ld(B, t + 1);
                    step(A, t);
                    ld(A, (t + 2 < tend) ? t + 2 : t);
                    step(B, t + 1);
                }
            };
            auto put_state = [&](float* so) {
                f32x4 a, b2; a[0] = s00[0]; a[1] = s00[1]; a[2] = s01[0]; a[3] = s01[1]; b2[0] = s10[0]; b2[1] = s10[1]; b2[2] = s11[0]; b2[3] = s11[1];
                *(f32x4*)so = a; *(f32x4*)(so + 64) = b2;
            };
            if (d.samp) {
                f32x4 ia[4], ib[4]; size_t off[4];
#pragma unroll
                for (int sub = 0; sub < 4; ++sub) {
                    const int sb = sub < nsub ? sub : nsub - 1;
                    off[sub] = ((size_t)(cd_batch(d, sb * 8) * 16 + d.h) * 64 + d.half * 32 + rl) * 64 + 4 * c;
                    ia[sub] = *(const f32x4*)(p.state_wkv + off[sub]); ib[sub] = *(const f32x4*)(p.state_wkv + off[sub] + 64);
                }
#pragma unroll
                for (int sub = 0; sub < 4; ++sub) {
                    if (sub < nsub) {
                        s00 = lo2(ia[sub]); s01 = hi2(ia[sub]); s10 = lo2(ib[sub]); s11 = hi2(ib[sub]);
                        run(sub * 8, sub * 8 + 8);
                        put_state(p.out + OUT_WKV_S + off[sub]);
                    }
                }
            } else {
                if (d.first) { s00 = (f32x2){0.f, 0.f}; s01 = s00; s10 = s00; s11 = s00; }
                run(0, d.n);
                if (d.last) put_state(p.out + OUT_WKV_P + ((size_t)(d.b * 16 + d.h) * 64 + d.half * 32 + rl) * 64 + 4 * c);
            }
            __syncthreads();
        }
        __syncthreads();
        __builtin_amdgcn_s_setprio(0);
    } else {
        const int q = (wid >> 1) & 1, tb = (wid & 1) * 16;
        float* par = parb + (wid & 3) * 640;
        PrepState S;
        int cur_h = -1;
        for (int i = -2; i <= NC; ++i) {
            if ((i & 1) == q) {
                ChunkDesc d;
                int ck = i + 2; ck = ck < 0 ? 0 : (ck > NC - 1 ? NC - 1 : ck);
                chunk_desc(ck, bid, G, d);
                if (d.h != cur_h) {
                    cur_h = d.h;
                    const int ch = d.h * 64 + lane;
                    par[lane] = p.shift_mu[ch]; par[64 + lane] = p.shift_mu[1024 + ch]; par[128 + lane] = p.shift_mu[2048 + ch]; par[192 + lane] = p.decay_w0[ch];
                    par[256 + lane] = p.icl_a0[ch]; par[320 + lane] = p.k_k[ch]; par[384 + lane] = p.k_a[ch]; par[448 + lane] = p.r_k[ch];
                    par[512 + lane] = p.shift_mu[C_WD + lane]; par[576 + lane] = p.shift_mu[C_AD + lane];
                }
                PrepRaw R;
                prep_load(p, d, tb, lane, R);
                prep_stage1(p, d, tb, par, lane, R, S);
            } else {
                ChunkDesc d, d2;
                PrepRaw2 R2;
                const bool has2 = i >= -1 && i + 1 < NC && chunk_desc(i + 1, bid, G, d2) && tb < d2.n;
                if (has2) prep_load2(p, d2, tb, lane, R2);
                if (i >= 1 && chunk_desc(i - 1, bid, G, d)) {
                    const float* ob = obuf + ((i - 1) & 1) * 1024;
                    for (int idx = (wid & 1) * 64 + lane; idx < d.n * 4; idx += 128) { const int t = idx >> 2, j = (idx & 3) * 8;
                        const f32x4 o0 = *(const f32x4*)(ob + t * 32 + j), o1 = *(const f32x4*)(ob + t * 32 + j + 4);
                        u32x4 w; w[0] = cvt_pk_bf16(o0[0], o0[1]); w[1] = cvt_pk_bf16(o0[2], o0[3]); w[2] = cvt_pk_bf16(o1[0], o1[1]); w[3] = cvt_pk_bf16(o1[2], o1[3]);
                        *(u32x4*)(ORAW + (size_t)cd_row(d, t) * 1024 + d.h * 64 + d.half * 32 + j) = w; }
                }
                if (has2) prep_stage2(p, d2, tb, bufs + ((i + 1) & 1) * SBUF, par, lane, R2, S);
            }
            __syncthreads();
        }
    }
}

__device__ void attn_unit(const Params& p, unsigned char* smem, const int unit) {
    const int tid = opaque_tid(), lane = tid & 63, wid = __builtin_amdgcn_readfirstlane(tid >> 6), fr = lane & 15, fq = lane >> 4;
    const int b = unit >> 6, h = (unit >> 4) & 3, tile = unit & 15;
    const bf16_t* ACT = (const bf16_t*)(p.ws + WS_ACT);
    const bf16_t* Kbf = (const bf16_t*)(p.ws + WS_KBF);
    const bf16_t* Vt = (const bf16_t*)(p.ws + WS_VT);
    bf16_t* Ymem = (bf16_t*)(p.ws + WS_YMEM);
    bf16_t* Kc = (bf16_t*)smem;
    bf16_t* Vc = (bf16_t*)smem;
    const int row = b * 2048 + tile * 128 + wid * 16 + fr;
    u32x4 st[8];
    auto ldK = [&](const int hf) {
#pragma unroll
        for (int i = 0; i < 8; ++i) { const int id = tid + i * NTHREADS, key = id >> 5, d = (id & 31) * 8; st[i] = *(const u32x4*)(Kbf + (size_t)(b * 256 + hf * 128 + key) * 1024 + h * 256 + d); }
    };
    auto stK = [&]() {
#pragma unroll
        for (int i = 0; i < 8; ++i) { const int id = tid + i * NTHREADS, key = id >> 5, d = (id & 31) * 8; *(u32x4*)(Kc + key * 264 + d) = st[i]; }
    };
    auto ldV = [&](const int hf) {
#pragma unroll
        for (int i = 0; i < 8; ++i) { const int id = tid + i * NTHREADS, d = id >> 4, kc = (id & 15) * 8; st[i] = *(const u32x4*)(Vt + (size_t)(h * 256 + d) * 2048 + b * 256 + hf * 128 + kc); }
    };
    auto stV = [&]() {
#pragma unroll
        for (int i = 0; i < 8; ++i) { const int id = tid + i * NTHREADS, d = id >> 4, kc = (id & 15) * 8; *(u32x4*)(Vc + d * 136 + kc) = st[i]; }
    };
    ldK(0);
    bf16x8 qf[8];
#pragma unroll
    for (int ks = 0; ks < 8; ++ks) qf[ks] = *(const bf16x8*)(ACT + (size_t)row * ACT_LD + C_QM + h * 256 + ks * 32 + fq * 8);
    f32x4 sacc[16];
#pragma unroll
    for (int i = 0; i < 16; ++i) sacc[i] = (f32x4){0.f, 0.f, 0.f, 0.f};
#pragma unroll
    for (int hf = 0; hf < 2; ++hf) {
        __syncthreads();
        stK();
        __syncthreads();
        if (hf == 0) ldK(1); else ldV(0);
#pragma unroll
        for (int kt = 0; kt < 8; ++kt)
#pragma unroll
            for (int ks = 0; ks < 8; ++ks) {
                const bf16x8 kf = *(const bf16x8*)(Kc + (kt * 16 + fr) * 264 + ks * 32 + fq * 8);
                sacc[hf * 8 + kt] = __builtin_amdgcn_mfma_f32_16x16x32_bf16(kf, qf[ks], sacc[hf * 8 + kt], 0, 0, 0);
            }
    }
    float mx = -3.0e38f;
#pragma unroll
    for (int i = 0; i < 16; ++i) mx = fmaxf(mx, fmaxf(fmaxf(sacc[i][0], sacc[i][1]), fmaxf(sacc[i][2], sacc[i][3])));
    mx = fmaxf(mx, __shfl_xor(mx, 16, 64)); mx = fmaxf(mx, __shfl_xor(mx, 32, 64));
    float sum = 0.f;
#pragma unroll
    for (int i = 0; i < 16; ++i)
#pragma unroll
        for (int e = 0; e < 4; ++e) { const float ex = __expf(sacc[i][e] - mx); sacc[i][e] = ex; sum += ex; }
    sum += __shfl_xor(sum, 16, 64); sum += __shfl_xor(sum, 32, 64);
    const float inv = fast_rcp(sum);
    bf16x8 pf[8];
#pragma unroll
    for (int s2 = 0; s2 < 8; ++s2) {
        u32x4 t; t[0] = cvt_pk_bf16(sacc[2 * s2][0], sacc[2 * s2][1]); t[1] = cvt_pk_bf16(sacc[2 * s2][2], sacc[2 * s2][3]);
        t[2] = cvt_pk_bf16(sacc[2 * s2 + 1][0], sacc[2 * s2 + 1][1]); t[3] = cvt_pk_bf16(sacc[2 * s2 + 1][2], sacc[2 * s2 + 1][3]);
        pf[s2] = __builtin_bit_cast(bf16x8, t);
    }
    f32x4 oacc[16];
#pragma unroll
    for (int i = 0; i < 16; ++i) oacc[i] = (f32x4){0.f, 0.f, 0.f, 0.f};
#pragma unroll
    for (int hf = 0; hf < 2; ++hf) {
        __syncthreads();
        stV();
        __syncthreads();
        if (hf == 0) ldV(1);
#pragma unroll
        for (int dt = 0; dt < 16; ++dt)
#pragma unroll
            for (int s2 = 0; s2 < 4; ++s2) {
                const u32x2 lo = *(const u32x2*)(Vc + (dt * 16 + fr) * 136 + s2 * 32 + 4 * fq), hi = *(const u32x2*)(Vc + (dt * 16 + fr) * 136 + s2 * 32 + 16 + 4 * fq);
                u32x4 t; t[0] = lo[0]; t[1] = lo[1]; t[2] = hi[0]; t[3] = hi[1];
                oacc[dt] = __builtin_amdgcn_mfma_f32_16x16x32_bf16(__builtin_bit_cast(bf16x8, t), pf[hf * 4 + s2], oacc[dt], 0, 0, 0);
            }
    }
#pragma unroll
    for (int dt = 0; dt < 16; ++dt) {
        const int d = h * 256 + dt * 16 + 4 * fq;
        const u32x2 g = *(const u32x2*)(ACT + (size_t)row * ACT_LD + C_SGM + d);
        u32x2 o; o[0] = cvt_pk_bf16(oacc[dt][0] * inv * bflo(g[0]), oacc[dt][1] * inv * bfhi(g[0])); o[1] = cvt_pk_bf16(oacc[dt][2] * inv * bflo(g[1]), oacc[dt][3] * inv * bfhi(g[1]));
        *(u32x2*)(Ymem + (size_t)row * 1024 + d) = o;
    }
}

__device__ void attn_sample_unit(const Params& p, unsigned char* smem, const int b, const int h) {
    const int tid = opaque_tid(), lane = tid & 63, wid = __builtin_amdgcn_readfirstlane(tid >> 6), fr = lane & 15, fq = lane >> 4;
    const bf16_t* ACT = (const bf16_t*)(p.ws + WS_ACT);
    bf16_t* Ymem = (bf16_t*)(p.ws + WS_YMEM);
    bf16_t* Kc = (bf16_t*)smem;
    float* Ored = (float*)smem;
    float* Pl = (float*)(smem + 69632);
    const int row = MP + b * 8 + (fr & 7);
    bf16x8 qf[8];
#pragma unroll
    for (int ks = 0; ks < 8; ++ks) qf[ks] = *(const bf16x8*)(ACT + (size_t)row * ACT_LD + C_QM + h * 256 + ks * 32 + fq * 8);
    const float* vbase = p.cache_v + ((size_t)(b * 256 + wid * 32) * 4 + h) * 256 + lane * 4;
    f32x4 vv[8];
#pragma unroll
    for (int i = 0; i < 8; ++i) vv[i] = *(const f32x4*)(vbase + (size_t)i * 1024);
    f32x4 sacc[16];
#pragma unroll
    for (int i = 0; i < 16; ++i) sacc[i] = (f32x4){0.f, 0.f, 0.f, 0.f};
#pragma unroll
    for (int hf = 0; hf < 2; ++hf) {
        __syncthreads();
#pragma unroll
        for (int i = 0; i < 8; ++i) {
            const int id = tid + i * NTHREADS, key = id >> 5, d = (id & 31) * 8;
            const float* s_ = p.cache_k + ((size_t)(b * 256 + hf * 128 + key) * 4 + h) * 256 + d; const f32x4 x0 = *(const f32x4*)s_, x1 = *(const f32x4*)(s_ + 4);
            u32x4 v; v[0] = cvt_pk_bf16(x0[0], x0[1]); v[1] = cvt_pk_bf16(x0[2], x0[3]); v[2] = cvt_pk_bf16(x1[0], x1[1]); v[3] = cvt_pk_bf16(x1[2], x1[3]);
            *(u32x4*)(Kc + key * 264 + d) = v;
        }
        __syncthreads();
#pragma unroll
        for (int kt = 0; kt < 8; ++kt)
#pragma unroll
            for (int ks = 0; ks < 8; ++ks) {
                const bf16x8 kf = *(const bf16x8*)(Kc + (kt * 16 + fr) * 264 + ks * 32 + fq * 8);
                sacc[hf * 8 + kt] = __builtin_amdgcn_mfma_f32_16x16x32_bf16(kf, qf[ks], sacc[hf * 8 + kt], 0, 0, 0);
            }
    }
    float mx = -3.0e38f;
#pragma unroll
    for (int i = 0; i < 16; ++i) mx = fmaxf(mx, fmaxf(fmaxf(sacc[i][0], sacc[i][1]), fmaxf(sacc[i][2], sacc[i][3])));
    mx = fmaxf(mx, __shfl_xor(mx, 16, 64)); mx = fmaxf(mx, __shfl_xor(mx, 32, 64));
    float sum = 0.f;
#pragma unroll
    for (int i = 0; i < 16; ++i)
#pragma unroll
        for (int e = 0; e < 4; ++e) { const float ex = __expf(sacc[i][e] - mx); sacc[i][e] = ex; sum += ex; }
    sum += __shfl_xor(sum, 16, 64); sum += __shfl_xor(sum, 32, 64);
    const float inv = fast_rcp(sum);
    if (wid == 0 && fr < 8) {
#pragma unroll
        for (int i = 0; i < 16; ++i)
#pragma unroll
            for (int e = 0; e < 4; ++e) Pl[(i * 16 + 4 * fq + e) * 8 + fr] = sacc[i][e] * inv;
    }
    __syncthreads();
    f32x4 o[8];
#pragma unroll
    for (int t = 0; t < 8; ++t) o[t] = (f32x4){0.f, 0.f, 0.f, 0.f};
#pragma unroll
    for (int half = 0; half < 4; ++half) {
        if (half >= 1) {
#pragma unroll
            for (int i = 0; i < 8; ++i) vv[i] = *(const f32x4*)(vbase + (size_t)(half * 8 + i) * 1024);
        }
#pragma unroll
        for (int i = 0; i < 8; ++i) {
            const float* pp = Pl + (wid * 32 + half * 8 + i) * 8;
            const f32x4 p0 = *(const f32x4*)pp, p1 = *(const f32x4*)(pp + 4);
#pragma unroll
            for (int t = 0; t < 4; ++t) { o[t] += vv[i] * p0[t]; o[4 + t] += vv[i] * p1[t]; }
        }
    }
#pragma unroll
    for (int t = 0; t < 8; ++t) *(f32x4*)(Ored + (wid * 8 + t) * 256 + lane * 4) = o[t];
    __syncthreads();
    {
        const int t = tid >> 6, d = (tid & 63) * 4;
        f32x4 acc = (f32x4){0.f, 0.f, 0.f, 0.f};
#pragma unroll
        for (int w = 0; w < 8; ++w) acc += *(const f32x4*)(Ored + (w * 8 + t) * 256 + d);
        const size_t orow = (size_t)(MP + b * 8 + t);
        const u32x2 g = *(const u32x2*)(ACT + orow * ACT_LD + C_SGM + h * 256 + d);
        u32x2 ov; ov[0] = cvt_pk_bf16(acc[0] * bflo(g[0]), acc[1] * bfhi(g[0])); ov[1] = cvt_pk_bf16(acc[2] * bflo(g[1]), acc[3] * bfhi(g[1]));
        *(u32x2*)(Ymem + orow * 1024 + h * 256 + d) = ov;
    }
}

__device__ void phase2_attn(const Params& p, unsigned char* smem) {
    __syncthreads();
    for (int k = blockIdx.x; k < 1024; k += gridDim.x) {
        const int u = (k + ((blockIdx.x & 1) << 9)) & 1023;
        if (u < 512) attn_unit(p, smem, u); else attn_sample_unit(p, smem, (u - 512) >> 2, u & 3);
    }
}

__device__ __forceinline__ void ld16bf(const bf16_t* ptr, float (&o)[16]) {
    const u32x4 a = *(const u32x4*)ptr, b = *(const u32x4*)(ptr + 8);
#pragma unroll
    for (int e = 0; e < 4; ++e) { o[2 * e] = bflo(a[e]); o[2 * e + 1] = bfhi(a[e]); o[8 + 2 * e] = bflo(b[e]); o[8 + 2 * e + 1] = bfhi(b[e]); }
}
__device__ __forceinline__ void ld16f(const float* ptr, float (&o)[16]) {
#pragma unroll
    for (int q = 0; q < 4; ++q) { const f32x4 v = *(const f32x4*)(ptr + 4 * q); o[4 * q] = v[0]; o[4 * q + 1] = v[1]; o[4 * q + 2] = v[2]; o[4 * q + 3] = v[3]; }
}
__device__ __forceinline__ void st16bf(bf16_t* ptr, const float (&y)[16]) {
    u32x4 a, b;
#pragma unroll
    for (int e = 0; e < 4; ++e) { a[e] = cvt_pk_bf16(y[2 * e], y[2 * e + 1]); b[e] = cvt_pk_bf16(y[8 + 2 * e], y[8 + 2 * e + 1]); }
    *(u32x4*)ptr = a; *(u32x4*)(ptr + 8) = b;
}
__device__ __forceinline__ float quad_sum(float x) { x += dpp_f<0xB1>(x); x += dpp_f<0x4E>(x); return x; }
struct RowRaw { u32x4 u0[2], u1[2], u2[2], bg[2], vc[2], vq[2], sg[2], o[2]; float c3; };
__device__ __forceinline__ void up16(const u32x4 (&r)[2], float (&o)[16]) {
#pragma unroll
    for (int e = 0; e < 4; ++e) { o[2 * e] = bflo(r[0][e]); o[2 * e + 1] = bfhi(r[0][e]); o[8 + 2 * e] = bflo(r[1][e]); o[8 + 2 * e + 1] = bfhi(r[1][e]); }
}
__device__ __forceinline__ float bfe16(const u32x4 (&r)[2], const int i) { const unsigned w = r[i >> 3][(i >> 1) & 3]; return (i & 1) ? bfhi(w) : bflo(w); }
__device__ void phase2b(const Params& p, unsigned char* smem) {
    const int tid = opaque_tid(), lane = tid & 63, wid = tid >> 6;
    float* tab = (float*)smem;
    __syncthreads();
    for (int idx = tid; idx < 7168; idx += NTHREADS)
        tab[idx] = idx < 3072 ? p.conv_w[idx] : idx < 4096 ? p.conv_b[idx - 3072] : idx < 5120 ? p.shift_mu[2048 + idx - 4096] : idx < 6144 ? p.ln_g[idx - 5120] : p.ln_b[idx - 6144];
    __syncthreads();
    const bf16_t* U = (const bf16_t*)(p.ws + WS_U); const bf16_t* BG = (const bf16_t*)(p.ws + WS_BG); const bf16_t* ACT = (const bf16_t*)(p.ws + WS_ACT);
    const bf16_t* ORAW = (const bf16_t*)(p.out + OUT_Y); const float* C3 = (const float*)(p.ws + WS_C3);
    bf16_t* Yc = (bf16_t*)(p.ws + WS_YCONV); bf16_t* Yr = (bf16_t*)(p.ws + WS_YRWKV);
    const int ch = lane * 16;
    auto load_row = [&](const int row, RowRaw& R) {
        const bool samp = row >= MP; const int t = samp ? ((row - MP) & 7) : (row & 2047);
        const int r1 = t >= 1 ? row - 1 : row, r2 = t >= 2 ? row - 2 : row;
#pragma unroll
        for (int q = 0; q < 2; ++q) {
            R.u0[q] = *(const u32x4*)(U + (size_t)row * 1024 + ch + 8 * q); R.u1[q] = *(const u32x4*)(U + (size_t)r1 * 1024 + ch + 8 * q); R.u2[q] = *(const u32x4*)(U + (size_t)r2 * 1024 + ch + 8 * q);
            R.bg[q] = *(const u32x4*)(BG + (size_t)row * 1024 + ch + 8 * q);
            R.vc[q] = *(const u32x4*)(ACT + (size_t)row * ACT_LD + C_PV + ch + 8 * q); R.vq[q] = *(const u32x4*)(ACT + (size_t)r1 * ACT_LD + C_PV + ch + 8 * q);
            R.sg[q] = *(const u32x4*)(ACT + (size_t)row * ACT_LD + C_SGR + ch + 8 * q);
        }
#pragma unroll
        for (int q = 0; q < 2; ++q) R.o[q] = *(const u32x4*)(ORAW + (size_t)row * 1024 + ch + 8 * q);
        R.c3 = C3[(size_t)row * 16 + (lane >> 2)];
    };
    auto process_row = [&](const int row, const RowRaw& R) {
        int b, t; const bool samp = row >= MP;
        if (!samp) { b = row >> 11; t = row & 2047; } else { b = (row - MP) >> 3; t = (row - MP) & 7; }
        const bool z1 = t < 1, z2 = t < 2;
        u32x4 yo[2];
#pragma unroll
        for (int q = 0; q < 4; ++q) {
            const f32x4 w0 = *(const f32x4*)(tab + ch + 4 * q), w1 = *(const f32x4*)(tab + 1024 + ch + 4 * q), w2 = *(const f32x4*)(tab + 2048 + ch + 4 * q), cb = *(const f32x4*)(tab + 3072 + ch + 4 * q);
            f32x4 m1 = (f32x4){0.f, 0.f, 0.f, 0.f}, m2 = m1;
            if (z1) { if (samp) m1 = *(const f32x4*)(p.state_conv + ((size_t)b * 2 + 1) * 1024 + ch + 4 * q); }
            else { m1[0] = bfe16(R.u1, 4 * q); m1[1] = bfe16(R.u1, 4 * q + 1); m1[2] = bfe16(R.u1, 4 * q + 2); m1[3] = bfe16(R.u1, 4 * q + 3); }
            if (z2) { if (samp) m2 = *(const f32x4*)(p.state_conv + ((size_t)b * 2 + t) * 1024 + ch + 4 * q); }
            else { m2[0] = bfe16(R.u2, 4 * q); m2[1] = bfe16(R.u2, 4 * q + 1); m2[2] = bfe16(R.u2, 4 * q + 2); m2[3] = bfe16(R.u2, 4 * q + 3); }
            float y[4];
#pragma unroll
            for (int e = 0; e < 4; ++e) { const int i = 4 * q + e; y[e] = bfe16(R.bg, i) * (cb[e] + w0[e] * m2[e] + w1[e] * m1[e] + w2[e] * bfe16(R.u0, i)); }
            yo[q >> 1][(q & 1) * 2] = cvt_pk_bf16(y[0], y[1]); yo[q >> 1][(q & 1) * 2 + 1] = cvt_pk_bf16(y[2], y[3]);
        }
        *(u32x4*)(Yc + (size_t)row * 1024 + ch) = yo[0]; *(u32x4*)(Yc + (size_t)row * 1024 + ch + 8) = yo[1];
        float oo[16]; up16(R.o, oo);
        float sm_ = 0.f;
#pragma unroll
        for (int e = 0; e < 16; ++e) sm_ += oo[e];
        const float mean = quad_sum(sm_) * (1.0f / 64.0f);
        float vr = 0.f;
#pragma unroll
        for (int e = 0; e < 16; ++e) { const float dl = oo[e] - mean; vr += dl * dl; }
        const float rstd = rsqrtf(quad_sum(vr) * (1.0f / 64.0f) + 6.4e-4f);
#pragma unroll
        for (int q = 0; q < 4; ++q) {
            const f32x4 mv = *(const f32x4*)(tab + 4096 + ch + 4 * q), lg = *(const f32x4*)(tab + 5120 + ch + 4 * q), lb = *(const f32x4*)(tab + 6144 + ch + 4 * q);
            f32x4 pq = (f32x4){0.f, 0.f, 0.f, 0.f};
            if (z1) { if (samp) pq = *(const f32x4*)(p.state_shift + (size_t)b * DSHIFT + 2048 + ch + 4 * q); }
            else { pq[0] = bfe16(R.vq, 4 * q); pq[1] = bfe16(R.vq, 4 * q + 1); pq[2] = bfe16(R.vq, 4 * q + 2); pq[3] = bfe16(R.vq, 4 * q + 3); }
            float y[4];
#pragma unroll
            for (int e = 0; e < 4; ++e) { const int i = 4 * q + e; const float vcu = bfe16(R.vc, i); const float vs = vcu + mv[e] * (pq[e] - vcu); y[e] = ((oo[i] - mean) * rstd * lg[e] + lb[e] + R.c3 * vs) * bfe16(R.sg, i); }
            yo[q >> 1][(q & 1) * 2] = cvt_pk_bf16(y[0], y[1]); yo[q >> 1][(q & 1) * 2 + 1] = cvt_pk_bf16(y[2], y[3]);
        }
        *(u32x4*)(Yr + (size_t)row * 1024 + ch) = yo[0]; *(u32x4*)(Yr + (size_t)row * 1024 + ch + 8) = yo[1];
    };
    for (int row = blockIdx.x * 8 + wid; row < MALL; row += gridDim.x * 8) {
        RowRaw Ra;
        load_row(row, Ra);
        process_row(row, Ra);
    }
}

struct SchedP3 {
    int G, c; const char* ws;
    __device__ __forceinline__ bool next(int i, Unit& u) const {
        const int tl = (i / 3) * G + c, seg = i % 3;
        if (tl >= 256) return false;
        u.x = tl >> 2; u.y = tl & 3; u.z = seg;
        u.a = ws + (seg == 0 ? WS_YCONV : seg == 1 ? WS_YRWKV : WS_YMEM) + (size_t)u.x * 256 * 2048; u.b = ws + WS_WB + ((size_t)seg * 1024 + (size_t)u.y * 256) * 2048;
        return true;
    }
};
struct SchedP3T {
    int G, c; const char* ws;
    __device__ __forceinline__ bool next(int i, Unit& u) const {
        const int e = i * G + c;
        if (e >= 96) return false;
        const int tt = e / 6, r = e % 6, seg = r >> 1, kh = r & 1;
        u.x = 64 + (tt >> 2); u.y = tt & 3; u.z = r;
        u.a = ws + (seg == 0 ? WS_YCONV : seg == 1 ? WS_YRWKV : WS_YMEM) + (size_t)u.x * 256 * 2048 + kh * 1024;
        u.b = ws + WS_WB + ((size_t)seg * 1024 + (size_t)u.y * 256) * 2048 + kh * 1024;
        return true;
    }
};
struct EpiP3T {
    const bf16_t* ACT; bf16_t* PART;
    __device__ __forceinline__ bool operator()(f32x4 (&acc)[2][2][4][2], const Unit& u, int wr, int wc, int fr, int fq) const {
        const int seg = u.z >> 1, rbase = u.x * 256 + wr * 64 + fr, cb = u.y * 256 + wc * 32 + 8 * fq;
        const bf16_t* gbase = ACT + C_GATE + seg * 1024 + cb;
#pragma unroll
        for (int ai = 0; ai < 2; ++ai) {
            u32x4 g[4][2];
#pragma unroll
            for (int m = 0; m < 4; ++m)
#pragma unroll
                for (int bj = 0; bj < 2; ++bj) g[m][bj] = *(const u32x4*)(gbase + (size_t)(rbase + ai * 128 + m * 16) * ACT_LD + 128 * bj);
#pragma unroll
            for (int m = 0; m < 4; ++m)
#pragma unroll
                for (int bj = 0; bj < 2; ++bj) {
                    f32x4 v0 = acc[ai][bj][m][0], v1 = acc[ai][bj][m][1];
                    v0[0] *= bflo(g[m][bj][0]); v0[1] *= bfhi(g[m][bj][0]); v0[2] *= bflo(g[m][bj][1]); v0[3] *= bfhi(g[m][bj][1]);
                    v1[0] *= bflo(g[m][bj][2]); v1[1] *= bfhi(g[m][bj][2]); v1[2] *= bflo(g[m][bj][3]); v1[3] *= bfhi(g[m][bj][3]);
                    bf16_t* dst = PART + ((size_t)u.z * 1024 + (size_t)(rbase + ai * 128 + m * 16 - MP)) * 1024 + cb + 128 * bj;
                    u32x4 o; o[0] = cvt_pk_bf16(v0[0], v0[1]); o[1] = cvt_pk_bf16(v0[2], v0[3]); o[2] = cvt_pk_bf16(v1[0], v1[1]); o[3] = cvt_pk_bf16(v1[2], v1[3]);
                    *(u32x4*)dst = o;
                }
        }
        return false;
    }
};
struct EpiP3 {
    const bf16_t* ACT; bf16_t* MERGED;
    __device__ __forceinline__ bool operator()(f32x4 (&acc)[2][2][4][2], const Unit& u, int wr, int wc, int fr, int fq) const {
        const int seg = u.z, rbase = u.x * 256 + wr * 64 + fr, cb = u.y * 256 + wc * 32 + 8 * fq;
        const bf16_t* gbase = ACT + C_GATE + seg * 1024 + cb;
#pragma unroll
        for (int ai = 0; ai < 2; ++ai) {
            u32x4 g[4][2], g2[4][2];
#pragma unroll
            for (int m = 0; m < 4; ++m)
#pragma unroll
                for (int bj = 0; bj < 2; ++bj) {
                    const bf16_t* gp = gbase + (size_t)(rbase + ai * 128 + m * 16) * ACT_LD + 128 * bj;
                    g[m][bj] = *(const u32x4*)gp;
                    if (seg < 2) g2[m][bj] = *(const u32x4*)(gp + 1024);
                }
#pragma unroll
            for (int m = 0; m < 4; ++m)
#pragma unroll
                for (int bj = 0; bj < 2; ++bj) {
                    float f[8];
#pragma unroll
                    for (int e = 0; e < 4; ++e) { f[2 * e] = bflo(g[m][bj][e]); f[2 * e + 1] = bfhi(g[m][bj][e]); }
                    if (seg < 2) {
#pragma unroll
                        for (int e = 0; e < 4; ++e) { f[2 * e] *= fast_rcp(bflo(g2[m][bj][e])); f[2 * e + 1] *= fast_rcp(bfhi(g2[m][bj][e])); }
                    }
                    f32x4& v0 = acc[ai][bj][m][0]; f32x4& v1 = acc[ai][bj][m][1];
#pragma unroll
                    for (int e = 0; e < 4; ++e) { v0[e] *= f[e]; v1[e] *= f[4 + e]; }
                    if (seg == 2) {
                        u32x4 o; o[0] = cvt_pk_bf16(v0[0], v0[1]); o[1] = cvt_pk_bf16(v0[2], v0[3]); o[2] = cvt_pk_bf16(v1[0], v1[1]); o[3] = cvt_pk_bf16(v1[2], v1[3]);
                        *(u32x4*)(MERGED + (size_t)(rbase + ai * 128 + m * 16) * 1024 + cb + 128 * bj) = o;
                    }
                }
        }
        return seg < 2;
    }
};
struct SchedP4 {
    int G, c; const char* A; const char* B;
    __device__ __forceinline__ bool next(int i, Unit& u) const {
        const int tl = i * G + c;
        if (tl >= 256) return false;
        u.x = tl >> 2; u.y = tl & 3; u.z = 0;
        u.a = A + (size_t)u.x * 256 * 2048; u.b = B + (size_t)u.y * 256 * 2048;
        return true;
    }
};
struct SchedP4T {
    int G, c; const char* A; const char* B;
    __device__ __forceinline__ bool next(int i, Unit& u) const {
        const int e = i * G + c;
        if (e >= 64) return false;
        const int tt = e >> 2, kq = e & 3;
        u.x = 64 + (tt >> 2); u.y = tt & 3; u.z = kq;
        u.a = A + (size_t)u.x * 256 * 2048 + kq * 512; u.b = B + (size_t)u.y * 256 * 2048 + kq * 512;
        return true;
    }
};
struct EpiP4T {
    bf16_t* PART;
    __device__ __forceinline__ bool operator()(f32x4 (&acc)[2][2][4][2], const Unit& u, int wr, int wc, int fr, int fq) const {
        const int rbase = u.x * 256 + wr * 64 + fr - MP, cbase = u.y * 256 + wc * 32 + fq * 8;
#pragma unroll
        for (int ai = 0; ai < 2; ++ai)
#pragma unroll
            for (int m = 0; m < 4; ++m)
#pragma unroll
                for (int bj = 0; bj < 2; ++bj) {
                    const f32x4 v0 = acc[ai][bj][m][0], v1 = acc[ai][bj][m][1];
                    u32x4 o; o[0] = cvt_pk_bf16(v0[0], v0[1]); o[1] = cvt_pk_bf16(v0[2], v0[3]); o[2] = cvt_pk_bf16(v1[0], v1[1]); o[3] = cvt_pk_bf16(v1[2], v1[3]);
                    *(u32x4*)(PART + ((size_t)u.z * 1024 + (size_t)(rbase + ai * 128 + m * 16)) * 1024 + cbase + bj * 128) = o;
                }
        return false;
    }
};
__device__ void p3_tail_fixup(const Params& p) {
    const int tid = opaque_tid();
    const bf16_t* P0 = (const bf16_t*)(p.ws + WS_PART);
    bf16_t* dst = (bf16_t*)(p.ws + WS_MERGED) + (size_t)MP * 1024;
    for (int idx = blockIdx.x * NTHREADS + tid; idx < 1024 * 128; idx += gridDim.x * NTHREADS) {
        const size_t o = (size_t)idx * 8;
        u32x4 q[6];
#pragma unroll
        for (int j = 0; j < 6; ++j) q[j] = *(const u32x4*)(P0 + (size_t)j * 1024 * 1024 + o);
        u32x4 w;
#pragma unroll
        for (int e = 0; e < 4; ++e) {
            float lo = 0.f, hi = 0.f;
#pragma unroll
            for (int j = 0; j < 6; ++j) { lo += bflo(q[j][e]); hi += bfhi(q[j][e]); }
            w[e] = cvt_pk_bf16(lo, hi);
        }
        *(u32x4*)(dst + o) = w;
    }
}
struct EpiP4 {
    const float* xp; bf16_t* H16; float* SUMSQ;
    __device__ __forceinline__ bool operator()(f32x4 (&acc)[2][2][4][2], const Unit& u, int wr, int wc, int fr, int fq) const {
        const int rbase = u.x * 256 + wr * 64 + fr, cb = u.y * 256 + wc * 32 + 8 * fq;
#pragma unroll
        for (int ai = 0; ai < 2; ++ai) {
            f32x4 xv[4][2][2];
#pragma unroll
            for (int m = 0; m < 4; ++m) {
                const float* xr = xp + (size_t)(rbase + ai * 128 + m * 16) * 1024 + cb;
#pragma unroll
                for (int bj = 0; bj < 2; ++bj) { xv[m][bj][0] = *(const f32x4*)(xr + bj * 128); xv[m][bj][1] = *(const f32x4*)(xr + bj * 128 + 4); }
            }
#pragma unroll
            for (int m = 0; m < 4; ++m) {
                const int row = rbase + ai * 128 + m * 16;
                float ss = 0.f;
#pragma unroll
                for (int bj = 0; bj < 2; ++bj) {
                    const f32x4 v0 = acc[ai][bj][m][0] + xv[m][bj][0], v1 = acc[ai][bj][m][1] + xv[m][bj][1];
                    ss += v0[0] * v0[0] + v0[1] * v0[1] + v0[2] * v0[2] + v0[3] * v0[3] + v1[0] * v1[0] + v1[1] * v1[1] + v1[2] * v1[2] + v1[3] * v1[3];
                    u32x4 o; o[0] = cvt_pk_bf16(v0[0], v0[1]); o[1] = cvt_pk_bf16(v0[2], v0[3]); o[2] = cvt_pk_bf16(v1[0], v1[1]); o[3] = cvt_pk_bf16(v1[2], v1[3]);
                    *(u32x4*)(H16 + (size_t)row * 1024 + cb + bj * 128) = o;
                }
                ss += __shfl_xor(ss, 16, 64); ss += __shfl_xor(ss, 32, 64);
                if (fq == 0) SUMSQ[(size_t)row * 16 + u.y * 4 + wc] = ss;
            }
        }
        return false;
    }
};
__device__ void phase5(const Params& p) {
    const int tid5 = opaque_tid(); const int lane = tid5 & 63, wid = tid5 >> 6;
    const float* SUMSQ = (const float*)(p.ws + WS_SUMSQ);
    const bf16_t* PART = (const bf16_t*)(p.ws + WS_PART);
    for (int row = blockIdx.x * 8 + wid; row < MALL; row += gridDim.x * 8) {
        float* y = p.out + OUT_Y + (size_t)row * 1024;
        f32x4 v[4]; float ss;
        if (row < MP) {
            ss = lane < 16 ? SUMSQ[(size_t)row * 16 + lane] : 0.f;
            const bf16_t* hr = (const bf16_t*)(p.ws + WS_YMEM) + (size_t)row * 1024;
#pragma unroll
            for (int i = 0; i < 4; ++i) { const u32x2 w = *(const u32x2*)(hr + i * 256 + lane * 4); v[i][0] = bflo(w[0]); v[i][1] = bfhi(w[0]); v[i][2] = bflo(w[1]); v[i][3] = bfhi(w[1]); }
        } else {
            const float* xr = p.x_sample + (size_t)(row - MP) * 1024; ss = 0.f;
#pragma unroll
            for (int i = 0; i < 4; ++i) {
                v[i] = *(const f32x4*)(xr + i * 256 + lane * 4);
#pragma unroll
                for (int q = 0; q < 4; ++q) { const u32x2 w = *(const u32x2*)(PART + ((size_t)q * 1024 + (size_t)(row - MP)) * 1024 + i * 256 + lane * 4);
                    v[i][0] += bflo(w[0]); v[i][1] += bfhi(w[0]); v[i][2] += bflo(w[1]); v[i][3] += bfhi(w[1]); }
                ss += v[i][0] * v[i][0] + v[i][1] * v[i][1] + v[i][2] * v[i][2] + v[i][3] * v[i][3];
            }
        }
        ss = wave_sum(ss);
        const float inv = rsqrtf(ss * (1.0f / 1024.0f) + 1e-6f);
#pragma unroll
        for (int i = 0; i < 4; ++i) {
            const f32x4 g = *(const f32x4*)(p.norm_final + i * 256 + lane * 4);
            *(f32x4*)(y + i * 256 + lane * 4) = v[i] * inv * g;
        }
    }
}

__global__ void __launch_bounds__(NTHREADS) fwd_megakernel(Params p) {
    extern __shared__ __attribute__((aligned(16))) unsigned char smem[];
    cg::grid_group grid = cg::this_grid();
    LAS unsigned char* lds = (LAS unsigned char*)smem;
#ifndef PROBE_REP
#define PROBE_REP 0
#endif
#define REP(k) for (int _r = 0; _r < ((PROBE_REP == (k)) ? 2 : 1); ++_r)
    volatile LAS unsigned* xst = (volatile LAS unsigned*)(lds + LDS_MAIN);
    if (threadIdx.x == 0) { xst[0] = 0u; xst[1] = 0u; xst[2] = 0u; xst[3] = 0u; }
    __syncthreads();
    (void)xcd_barrier_post((unsigned*)(p.ws + WS_BAR), xst);
#define XBAR() do { XcdBarrier _b; _b.bar = (unsigned*)(p.ws + WS_BAR); _b.x = xb_xcc_id(); _b.st = (volatile LAS unsigned*)(lds + LDS_MAIN); xcd_barrier(_b); } while (0)
    REP(1) { phase0(p, smem); if (PROBE_REP == 1 && _r == 0) XBAR(); }
    if (p.ws == nullptr) grid.sync();
    XBAR();
    REP(2) {
        SchedP1 S{(int)gridDim.x, (int)blockIdx.x, (const char*)(p.ws + WS_AALL), (const char*)(p.ws + WS_BALL)};
        EpiP1 E{(bf16_t*)(p.ws + WS_U), (bf16_t*)(p.ws + WS_BG), (bf16_t*)(p.ws + WS_ACT), p.out, (bf16_t*)(p.ws + WS_KBF), (bf16_t*)(p.ws + WS_VT)};
        gemm_phase(lds, 2048, 2048, 1024, S, E);
        XBAR();
        if (PROBE_REP == 9) { EpiNull EN{(float*)(p.ws + WS_SUMSQ)}; gemm_phase(lds, 2048, 2048, 1024, S, EN); XBAR(); }
    }
    REP(3) { phase2_scan(p, smem); if (PROBE_REP == 3) XBAR(); }
    REP(5) { phase2_attn(p, smem); if (PROBE_REP == 5) XBAR(); }
    XBAR();
    REP(6) { phase2b(p, smem); XBAR(); }
    REP(7) {
        SchedP3 S{(int)gridDim.x, (int)blockIdx.x, (const char*)p.ws};
        EpiP3 E{(const bf16_t*)(p.ws + WS_ACT), (bf16_t*)(p.ws + WS_MERGED)};
        gemm_phase(lds, 2048, 2048, 1024, S, E);
        SchedP3T ST{(int)gridDim.x, (int)blockIdx.x, (const char*)p.ws};
        EpiP3T ET{(const bf16_t*)(p.ws + WS_ACT), (bf16_t*)(p.ws + WS_PART)};
        gemm_phase(lds, 2048, 2048, 512, ST, ET);
        XBAR();
        if (_r == 0) { p3_tail_fixup(p); XBAR(); }
    }
    REP(8) {
        SchedP4 S{(int)gridDim.x, (int)blockIdx.x, (const char*)(p.ws + WS_MERGED), (const char*)(p.ws + WS_WO)};
        EpiP4 E{p.x_prompt, (bf16_t*)(p.ws + WS_YMEM), (float*)(p.ws + WS_SUMSQ)};
        gemm_phase(lds, 2048, 2048, 1024, S, E);
        SchedP4T ST{(int)gridDim.x, (int)blockIdx.x, (const char*)(p.ws + WS_MERGED), (const char*)(p.ws + WS_WO)};
        EpiP4T ET{(bf16_t*)(p.ws + WS_PART)};
        gemm_phase(lds, 2048, 2048, 256, ST, ET);
        XBAR();
    }
    phase5(p);
}

extern "C" void kernel_launch(void* const* d_in, const int* in_sizes, int n_in, void* d_out, int out_size, void* d_ws, size_t ws_size, hipStream_t stream) {
    static int grid_blocks = 0;
    if (!grid_blocks) {
        int dev = 0, cus = 0, per_cu = 0;
        hipGetDevice(&dev);
        hipDeviceGetAttribute(&cus, hipDeviceAttributeMultiprocessorCount, dev);
        if (hipFuncSetAttribute((const void*)fwd_megakernel, hipFuncAttributeMaxDynamicSharedMemorySize, LDS_BYTES) != hipSuccess) fprintf(stderr, "hipFuncSetAttribute failed\n");
        hipOccupancyMaxActiveBlocksPerMultiprocessor(&per_cu, (const void*)fwd_megakernel, NTHREADS, LDS_BYTES);
        if (per_cu < 1) { fprintf(stderr, "occupancy query returned %d\n", per_cu); per_cu = 1; }
        if (per_cu > 1) per_cu = 1;
        grid_blocks = cus * per_cu;
        if (grid_blocks > 256) grid_blocks = 256;
        grid_blocks &= ~31;
        if (grid_blocks < 64) grid_blocks = -1;
        if (ws_size < WS_END) { fprintf(stderr, "workspace too small: %zu < %zu\n", ws_size, (size_t)WS_END); grid_blocks = -1; }
    }
    if (grid_blocks < 0) return;
    Params p{};
    const float** pp = (const float**)&p;
    for (int i = 0; i < 27; ++i) pp[i] = (const float*)d_in[i];
    p.out = (float*)d_out; p.ws = (unsigned char*)d_ws;
    if (hipMemsetAsync((char*)d_ws + WS_BAR, 0, (size_t)XCD_BAR_WORDS_C * 4, stream) != hipSuccess) fprintf(stderr, "memset of barrier words failed\n");
    void* args[] = {&p};
    hipError_t e = hipLaunchCooperativeKernel((const void*)fwd_megakernel, dim3(grid_blocks), dim3(NTHREADS), args, LDS_BYTES, stream);
    if (e != hipSuccess) fprintf(stderr, "cooperative launch failed: %s (grid %d)\n", hipGetErrorString(e), grid_blocks);
}
```
